# Optimizing an MI355X kernel written in HIP

```python
import math
import jax
import jax.numpy as jnp
from jax import lax
import numpy as np

D_MODEL = 1024
BATCH = 4
SEQ = 4096
DEPTH = 1

N_META = 16
DN_HEAD_DIM = 64
DN_WIDTH = D_MODEL // 2
DN_HEADS = DN_WIDTH // DN_HEAD_DIM
CONV_K = 4
CHUNK = 64
S_CH = 16
S_WIDTH = D_MODEL // 2
S_GROUPS = S_WIDTH // S_CH
S_STATE = 64
MOE_GROUPS = 8
EXPERTS_PER_GROUP = 8
N_EXPERTS = MOE_GROUPS * EXPERTS_PER_GROUP
TOP_K = 2
D_EXPERT = D_MODEL // 4
MOE_BLOCK = 128
DEEP_ALPHA = (2 * DEPTH) ** 0.25
DEEP_BETA = (8 * DEPTH) ** -0.25
LN_EPS = 1e-5
NORM_EPS = 1e-6
SPLIT_SIZES = (DN_WIDTH, DN_WIDTH, DN_WIDTH, DN_WIDTH, S_WIDTH, D_MODEL, D_MODEL, DN_HEADS, DN_HEADS)
SPLIT_POINTS = tuple(int(s) for s in np.cumsum(SPLIT_SIZES)[:-1])
IN_WIDTH = int(sum(SPLIT_SIZES))

kernel_name = 'hybrid_deltanet_s5_hmoe_block'


def layer_norm(x, g, b):
    xf = x.astype(jnp.float32)
    mu = jnp.mean(xf, -1, keepdims=True)
    xc = xf - mu
    var = jnp.mean(xc * xc, -1, keepdims=True)
    y = xc * lax.rsqrt(var + LN_EPS) * g.astype(jnp.float32) + b.astype(jnp.float32)
    return y.astype(x.dtype)


def l2_normalize(t):
    return t * lax.rsqrt(jnp.sum(t * t, -1, keepdims=True) + NORM_EPS)


def causal_depthwise_conv(x, w):
    k, c = w.shape
    return lax.conv_general_dilated(x, w[:, None, :].astype(x.dtype), window_strides=(1,), padding=[(k - 1, 0)],
                                    dimension_numbers=('NWC', 'WIO', 'NWC'), feature_group_count=c)


def gated_deltanet(q, k, v, z, a, b, conv_w, a_log, dt_bias, norm_w):
    out_dtype = z.dtype
    f32 = jnp.float32
    bn, ln, _ = q.shape
    qkv = jax.nn.silu(causal_depthwise_conv(jnp.concatenate([q, k, v], -1), conv_w)).astype(f32)
    q, k, v = jnp.split(qkv, 3, axis=-1)
    q = l2_normalize(q.reshape(bn, ln, DN_HEADS, DN_HEAD_DIM)) * (DN_HEAD_DIM ** -0.5)
    k = l2_normalize(k.reshape(bn, ln, DN_HEADS, DN_HEAD_DIM))
    v = v.reshape(bn, ln, DN_HEADS, DN_HEAD_DIM)
    beta = jax.nn.sigmoid(b.astype(f32))
    g = -jnp.exp(a_log.astype(f32)) * jax.nn.softplus(a.astype(f32) + dt_bias.astype(f32))
    pad = (-N_META) % CHUNK
    lp = ln + pad
    nc = lp // CHUNK

    def to_chunks(t):
        t = jnp.pad(t, [(0, 0), (pad, 0)] + [(0, 0)] * (t.ndim - 2))
        t = t.reshape((bn, nc, CHUNK) + t.shape[2:])
        return jnp.moveaxis(t, 3, 1)

    q, k, v, beta, g = (to_chunks(t) for t in (q, k, v, beta, g))
    gc = jnp.cumsum(g, axis=-1)
    incl = jnp.tril(jnp.ones((CHUNK, CHUNK), bool))
    strict = jnp.tril(jnp.ones((CHUNK, CHUNK), bool), -1)
    decay = jnp.exp(jnp.where(incl, gc[..., :, None] - gc[..., None, :], -jnp.inf))
    kb = k * beta[..., None]
    a_mat = jnp.where(strict, jnp.einsum('bhnid,bhnjd->bhnij', kb, k) * decay, 0.0)
    eye = jnp.eye(CHUNK, dtype=f32)
    rhs = jnp.concatenate([v * beta[..., None], kb * jnp.exp(gc)[..., None]], -1)
    sol = lax.linalg.triangular_solve(a_mat + eye, rhs, left_side=True, lower=True, unit_diagonal=True)
    u_c, w_c = sol[..., :DN_HEAD_DIM], sol[..., DN_HEAD_DIM:]
    attn = jnp.einsum('bhnid,bhnjd->bhnij', q, k) * decay
    q_dec = q * jnp.exp(gc)[..., None]
    k_dec = k * jnp.exp(gc[..., -1:] - gc)[..., None]
    g_last = jnp.exp(gc[..., -1])

    def step(state, inp):
        qd, kd, uc, wc, ac, gl = inp
        v_new = uc - jnp.einsum('bhck,bhkv->bhcv', wc, state)
        out = jnp.einsum('bhck,bhkv->bhcv', qd, state) + jnp.einsum('bhij,bhjv->bhiv', ac, v_new)
        state = state * gl[..., None, None] + jnp.einsum('bhck,bhcv->bhkv', kd, v_new)
        return state, out

    xs = tuple(jnp.moveaxis(t, 2, 0) for t in (q_dec, k_dec, u_c, w_c, attn, g_last))
    s0 = jnp.zeros((bn, DN_HEADS, DN_HEAD_DIM, DN_HEAD_DIM), f32)
    _, o = lax.scan(step, s0, xs)
    o = jnp.transpose(o, (1, 0, 3, 2, 4)).reshape(bn, lp, DN_HEADS, DN_HEAD_DIM)[:, pad:]
    o = o * lax.rsqrt(jnp.mean(o * o, -1, keepdims=True) + NORM_EPS) * norm_w.astype(f32)
    o = o * jax.nn.silu(z.astype(f32).reshape(bn, ln, DN_HEADS, DN_HEAD_DIM))
    return o.reshape(bn, ln, DN_WIDTH).astype(out_dtype)


def s5_ssm(u, a_re, a_im, log_dt, b_re, b_im, c_re, c_im, d_skip):
    f32 = jnp.float32
    bn, ln, _ = u.shape
    uf = u.astype(f32).reshape(bn, ln, S_GROUPS, S_CH)
    ar, ai = a_re.astype(f32), a_im.astype(f32)
    dt = jnp.exp(log_dt.astype(f32))[:, None]
    mag = jnp.exp(dt * ar)
    abar_re, abar_im = mag * jnp.cos(dt * ai), mag * jnp.sin(dt * ai)
    den = ar * ar + ai * ai
    nr, ni = abar_re - 1.0, abar_im
    f_re, f_im = (nr * ar + ni * ai) / den, (ni * ar - nr * ai) / den
    br, bi = b_re.astype(f32), b_im.astype(f32)
    bb_re = f_re[..., None] * br - f_im[..., None] * bi
    bb_im = f_re[..., None] * bi + f_im[..., None] * br
    bu_re = jnp.einsum('blgc,gpc->blgp', uf, bb_re)
    bu_im = jnp.einsum('blgc,gpc->blgp', uf, bb_im)
    a_re_t = jnp.broadcast_to(abar_re, bu_re.shape)
    a_im_t = jnp.broadcast_to(abar_im, bu_re.shape)

    def combine(e1, e2):
        a1r, a1i, b1r, b1i = e1
        a2r, a2i, b2r, b2i = e2
        return (a2r * a1r - a2i * a1i, a2r * a1i + a2i * a1r,
                a2r * b1r - a2i * b1i + b2r, a2r * b1i + a2i * b1r + b2i)

    _, _, h_re, h_im = lax.associative_scan(combine, (a_re_t, a_im_t, bu_re, bu_im), axis=1)
    y = (jnp.einsum('blgp,gcp->blgc', h_re, c_re.astype(f32))
         - jnp.einsum('blgp,gcp->blgc', h_im, c_im.astype(f32))
         + d_skip.astype(f32).reshape(S_GROUPS, S_CH) * uf)
    return y.reshape(bn, ln, S_WIDTH)


def hierarchical_moe(h, w_rg, b_rg, w_re, b_re, w1, w3, w2):
    f32 = jnp.float32
    bn, ln, d = h.shape
    t = bn * ln
    xt = h.reshape(t, d)
    g_prob = jax.nn.softmax((xt @ w_rg).astype(f32) + b_rg.astype(f32), axis=-1)
    g_p, g_idx = lax.top_k(g_prob, 1)
    e_logit = ((xt @ w_re).astype(f32) + b_re.astype(f32)).reshape(t, MOE_GROUPS, EXPERTS_PER_GROUP)
    e_logit = jnp.take_along_axis(e_logit, g_idx[:, :, None], axis=1)[:, 0]
    e_top, e_loc = lax.top_k(e_logit, TOP_K)
    gate = jax.nn.softmax(e_top, axis=-1) * g_p
    expert = g_idx * EXPERTS_PER_GROUP + e_loc
    m = t * TOP_K
    e_flat = expert.reshape(m)
    order = jnp.argsort(e_flat)
    e_s = e_flat[order]
    tok_s = order // TOP_K
    w_s = gate.reshape(m)[order]
    counts = jnp.zeros((N_EXPERTS,), jnp.int32).at[e_flat].add(1)
    padded = (counts + MOE_BLOCK - 1) // MOE_BLOCK * MOE_BLOCK
    starts = jnp.cumsum(counts) - counts
    p_ends = jnp.cumsum(padded)
    p_starts = p_ends - padded
    dest = p_starts[e_s] + jnp.arange(m, dtype=jnp.int32) - starts[e_s]
    cap = -(-(m + N_EXPERTS * (MOE_BLOCK - 1)) // MOE_BLOCK) * MOE_BLOCK
    n_blk = cap // MOE_BLOCK
    row_tok = jnp.zeros((cap,), jnp.int32).at[dest].set(tok_s)
    row_w = jnp.zeros((cap,), f32).at[dest].set(w_s)
    blk_expert = jnp.minimum(
        jnp.searchsorted(p_ends, jnp.arange(n_blk, dtype=jnp.int32) * MOE_BLOCK, side='right'), N_EXPERTS - 1)
    xb = xt[row_tok].reshape(n_blk, MOE_BLOCK, d)

    def expert_block(args):
        xblk, e = args
        hid = jax.nn.silu(xblk @ w1[e]) * (xblk @ w3[e])
        return hid @ w2[e]

    yb = lax.map(expert_block, (xb, blk_expert)).reshape(cap, d)
    out = jax.ops.segment_sum(yb * row_w[:, None].astype(yb.dtype), row_tok, num_segments=t)
    return out.reshape(bn, ln, d)


def hybrid_layer(h, w_in, conv_w, dn_a_log, dn_dt_bias, dn_norm_w, ssm_a_re, ssm_a_im, ssm_log_dt,
                 ssm_b_re, ssm_b_im, ssm_c_re, ssm_c_im, ssm_d, w_glu, b_glu, w_branch, w_out,
                 ln1_g, ln1_b, w_rg, b_rg, w_re, b_re, w1, w3, w2, ln2_g, ln2_b):
    proj = h @ w_in
    q, k, v, z, u, gate_a, gate_b, a, b = jnp.split(proj, SPLIT_POINTS, axis=-1)
    o_a = gated_deltanet(q, k, v, z, a, b, conv_w, dn_a_log, dn_dt_bias, dn_norm_w)
    y_b = jax.nn.gelu(s5_ssm(u, ssm_a_re, ssm_a_im, ssm_log_dt, ssm_b_re, ssm_b_im, ssm_c_re, ssm_c_im, ssm_d)).astype(h.dtype)
    o_b = y_b * jax.nn.sigmoid(y_b @ w_glu + b_glu)
    merged = jax.nn.sigmoid(gate_a) * (o_a @ w_branch[0]) + jax.nn.sigmoid(gate_b) * (o_b @ w_branch[1])
    h = layer_norm(DEEP_ALPHA * h + merged @ w_out, ln1_g, ln1_b)
    h = layer_norm(DEEP_ALPHA * h + hierarchical_moe(h, w_rg, b_rg, w_re, b_re, w1, w3, w2), ln2_g, ln2_b)
    return h


def setup_inputs(seed: int = 0) -> dict:
    key = jax.random.key(seed)
    ks = jax.random.split(key, 40)
    f32 = jnp.float32

    def nrm(k, shape, scale):
        return jax.random.normal(k, shape, f32) * scale

    dt_dn = jnp.exp(jax.random.uniform(ks[7], (DEPTH, DN_HEADS), f32, math.log(1e-3), math.log(1e-1)))
    return {
        'x': nrm(ks[0], (BATCH, SEQ, D_MODEL), 1.0),
        'meta': nrm(ks[1], (N_META, D_MODEL), 1.0),
        'ln_emb_g': 1.0 + nrm(ks[2], (D_MODEL,), 0.02),
        'ln_emb_b': nrm(ks[3], (D_MODEL,), 0.02),
        'w_in': nrm(ks[4], (DEPTH, D_MODEL, IN_WIDTH), D_MODEL ** -0.5),
        'conv_w': nrm(ks[5], (DEPTH, CONV_K, 3 * DN_WIDTH), CONV_K ** -0.5),
        'dn_a_log': jnp.log(jax.random.uniform(ks[6], (DEPTH, DN_HEADS), f32, 1.0, 16.0)),
        'dn_dt_bias': dt_dn + jnp.log(-jnp.expm1(-dt_dn)),
        'dn_norm_w': 1.0 + nrm(ks[8], (DEPTH, DN_HEAD_DIM), 0.02),
        'ssm_a_re': -0.5 + nrm(ks[9], (DEPTH, S_GROUPS, S_STATE), 0.01),
        'ssm_a_im': math.pi * jnp.arange(S_STATE, dtype=f32) + nrm(ks[10], (DEPTH, S_GROUPS, S_STATE), 0.01),
        'ssm_log_dt': jax.random.uniform(ks[11], (DEPTH, S_GROUPS), f32, math.log(1e-3), math.log(1e-1)),
        'ssm_b_re': nrm(ks[12], (DEPTH, S_GROUPS, S_STATE, S_CH), (2 * S_CH) ** -0.5),
        'ssm_b_im': nrm(ks[13], (DEPTH, S_GROUPS, S_STATE, S_CH), (2 * S_CH) ** -0.5),
        'ssm_c_re': nrm(ks[14], (DEPTH, S_GROUPS, S_CH, S_STATE), S_STATE ** -0.5),
        'ssm_c_im': nrm(ks[15], (DEPTH, S_GROUPS, S_CH, S_STATE), S_STATE ** -0.5),
        'ssm_d': nrm(ks[16], (DEPTH, S_WIDTH), 1.0),
        'w_glu': nrm(ks[17], (DEPTH, S_WIDTH, S_WIDTH), S_WIDTH ** -0.5),
        'b_glu': nrm(ks[18], (DEPTH, S_WIDTH), 0.02),
        'w_branch': nrm(ks[19], (DEPTH, 2, DN_WIDTH, D_MODEL), DN_WIDTH ** -0.5),
        'w_out': nrm(ks[20], (DEPTH, D_MODEL, D_MODEL), D_MODEL ** -0.5 * DEEP_BETA),
        'ln1_g': 1.0 + nrm(ks[21], (DEPTH, D_MODEL), 0.02),
        'ln1_b': nrm(ks[22], (DEPTH, D_MODEL), 0.02),
        'w_rg': nrm(ks[23], (DEPTH, D_MODEL, MOE_GROUPS), D_MODEL ** -0.5),
        'b_rg': nrm(ks[24], (DEPTH, MOE_GROUPS), 0.01),
        'w_re': nrm(ks[25], (DEPTH, D_MODEL, N_EXPERTS), D_MODEL ** -0.5),
        'b_re': nrm(ks[26], (DEPTH, N_EXPERTS), 0.01),
        'w1': nrm(ks[27], (DEPTH, N_EXPERTS, D_MODEL, D_EXPERT), D_MODEL ** -0.5),
        'w3': nrm(ks[28], (DEPTH, N_EXPERTS, D_MODEL, D_EXPERT), D_MODEL ** -0.5),
        'w2': nrm(ks[29], (DEPTH, N_EXPERTS, D_EXPERT, D_MODEL), D_EXPERT ** -0.5 * DEEP_BETA),
        'ln2_g': 1.0 + nrm(ks[30], (DEPTH, D_MODEL), 0.02),
        'ln2_b': nrm(ks[31], (DEPTH, D_MODEL), 0.02),
    }


def reference(x, meta, ln_emb_g, ln_emb_b, w_in, conv_w, dn_a_log, dn_dt_bias, dn_norm_w, ssm_a_re, ssm_a_im,
              ssm_log_dt, ssm_b_re, ssm_b_im, ssm_c_re, ssm_c_im, ssm_d, w_glu, b_glu, w_branch, w_out,
              ln1_g, ln1_b, w_rg, b_rg, w_re, b_re, w1, w3, w2, ln2_g, ln2_b):
    bn = x.shape[0]
    h = jnp.concatenate([jnp.broadcast_to(meta[None], (bn, N_META, D_MODEL)).astype(x.dtype), x], axis=1)
    h = layer_norm(h, ln_emb_g, ln_emb_b)
    for l in range(DEPTH):
        h = hybrid_layer(h, w_in[l], conv_w[l], dn_a_log[l], dn_dt_bias[l], dn_norm_w[l], ssm_a_re[l], ssm_a_im[l],
                         ssm_log_dt[l], ssm_b_re[l], ssm_b_im[l], ssm_c_re[l], ssm_c_im[l], ssm_d[l], w_glu[l],
                         b_glu[l], w_branch[l], w_out[l], ln1_g[l], ln1_b[l], w_rg[l], b_rg[l], w_re[l], b_re[l],
                         w1[l], w3[l], w2[l], ln2_g[l], ln2_b[l])
    return h[:, N_META:]
```

```cpp
#include <hip/hip_runtime.h>
#include <cstdio>
#include <cstdint>
namespace pg8 {
#define PG8_LAS __attribute__((address_space(3)))
typedef unsigned short bf16_t;
typedef short bf16x8 __attribute__((ext_vector_type(8)));
typedef float f32x4 __attribute__((ext_vector_type(4)));
typedef unsigned u32x4 __attribute__((ext_vector_type(4)));
constexpr int BM = 256, BK = 64, HALF = 128, HTB = HALF * BK * 2  , STAGE_BYTES = 8 * HTB, NXCD = 8, WGM = 8;

__host__ __device__ __forceinline__ int lds_byte(int r, int c) { const int st = (r >> 4) * 2 + (c >> 5), rr = r & 15, cc = c & 31, ob = rr * 64 + cc * 2; return st * 1024 + (ob ^ (((ob >> 9) & 1) << 5)); }
__host__ __device__ __forceinline__ void stage_rc(int b, int& R, int& C) { const int st = b / 1024, sb = b % 1024, swz = sb ^ (((sb >> 9) & 1) << 5); R = (st >> 1) * 16 + swz / 64; C = (st & 1) * 32 + (swz % 64) / 2; }
__host__ __device__ __forceinline__ int perm32(int rho) { const int n = rho >> 4, i = rho & 15; return 8 * (i >> 2) + 4 * n + (i & 3); }

struct Unit { int pm, pn; };
struct Gemm { const bf16_t* A; const bf16_t* Bt; int M, N, K; };

struct StaticOrder {
    int nM, nN, nwg, G, c;
    __host__ __device__ void init(int M, int N, int G_, int c_) { nM = M / BM; nN = N / BM; nwg = nM * nN; G = G_; c = c_; }
    __host__ __device__ bool next(int i, Unit& u) const {
        const long L = (long)i * G + c; if (L >= nwg) return false;
        int wgid = (int)L; { const int q = nwg / NXCD, r = nwg % NXCD, xcd = wgid % NXCD, off = wgid / NXCD; wgid = (xcd < r ? xcd * (q + 1) : r * (q + 1) + (xcd - r) * q) + off; }
        const int nig = WGM * nN, gid = wgid / nig, fm = gid * WGM, gsz = (nM - fm) < WGM ? (nM - fm) : WGM;
        u.pm = fm + ((wgid % nig) % gsz); u.pn = (wgid % nig) / gsz; return true;
    }
    __device__ __forceinline__ void a_ready(const Unit&) const {}
    __device__ __forceinline__ void done(const Unit&) const {}
};

__device__ __forceinline__ unsigned cvt_pk_bf16(float lo, float hi) { unsigned r; asm volatile("v_cvt_pk_bf16_f32 %0, %1, %2" : "=v"(r) : "v"(lo), "v"(hi)); return r; }
template <class Epi, class Sched, bool ALIGN_EPI = false, bool SP2 = false>
__device__ __forceinline__ void gemm_phase(PG8_LAS unsigned char* lds, const Gemm g, const Sched& S, const Epi& E) {
    const int tid = threadIdx.x, wid = __builtin_amdgcn_readfirstlane(tid >> 6), lane = tid & 63, wr = wid >> 2, wc = wid & 3, fr = lane & 15, fq = lane >> 4;
    const int K = g.K, nt = K / BK;
    unsigned voffA[2], voffB[2];
#pragma unroll
    for (int i = 0; i < 2; ++i) { int R, C; stage_rc(tid * 16 + i * 8192, R, C); const int Rb = Epi::PERM ? ((R & ~31) + perm32(R & 31)) : R;
        voffA[i] = (unsigned)(R * K + C) * 2u; voffB[i] = (unsigned)(Rb * K + C) * 2u; }
    const size_t kstep = (size_t)(BK * 2);
    const size_t hstep = (size_t)HALF * K * 2;
    const size_t tstep = 2 * hstep;
    const unsigned ldsw = (unsigned)wid * 1024u;
    const int aoff = lds_byte(wr * 64 + fr, fq * 8), boff = lds_byte(wc * 32 + fr, fq * 8);
#define PG8_SA(b, h) (((b) * 2 + (h)) * HTB)
#define PG8_SB(b, h) ((4 + (b) * 2 + (h)) * HTB)
#define PG8_STAGE(bufoff, gbase, voff) do { _Pragma("unroll") for (int _i = 0; _i < 2; ++_i) \
        __builtin_amdgcn_global_load_lds((const unsigned*)((const char*)(gbase) + (voff)[_i]), (PG8_LAS unsigned*)(lds + (bufoff) + ldsw + _i * 8192), 16, 0, 0); } while (0)
#define PG8_LDA(dst, b, h) do { _Pragma("unroll") for (int m = 0; m < 4; ++m) _Pragma("unroll") for (int k = 0; k < 2; ++k) dst[m][k] = *(const PG8_LAS bf16x8*)(lds + PG8_SA(b, h) + aoff + m * 2048 + k * 1024); } while (0)
#define PG8_LDB(dst, b, h) do { _Pragma("unroll") for (int n = 0; n < 2; ++n) _Pragma("unroll") for (int k = 0; k < 2; ++k) dst[n][k] = *(const PG8_LAS bf16x8*)(lds + PG8_SB(b, h) + boff + n * 2048 + k * 1024); } while (0)
#define PG8_MMA(ai, bj, At, Bt) do { __builtin_amdgcn_s_setprio(1); _Pragma("unroll") for (int m = 0; m < 4; ++m) _Pragma("unroll") for (int n = 0; n < 2; ++n) _Pragma("unroll") for (int k = 0; k < 2; ++k) \
        acc[ai][bj][m][n] = __builtin_amdgcn_mfma_f32_16x16x32_bf16(Bt[n][k], At[m][k], acc[ai][bj][m][n], 0, 0, 0); __builtin_amdgcn_s_setprio(0); } while (0)
#define PG8_WAIT_V(n) asm volatile("s_waitcnt vmcnt(" #n ")" ::: "memory")
#define PG8_WAIT_L(n) asm volatile("s_waitcnt lgkmcnt(" #n ")" ::: "memory")
#define PG8_BAR __builtin_amdgcn_s_barrier()
#define PG8_SCHED __builtin_amdgcn_sched_barrier(0)
    Unit cur, nxt; int ui = 0;
    if (!S.next(0, cur)) return;
    f32x4 acc[2][2][4][2];
#pragma unroll
    for (int a = 0; a < 2; ++a)
#pragma unroll
        for (int b = 0; b < 2; ++b)
#pragma unroll
            for (int m = 0; m < 4; ++m)
#pragma unroll
                for (int n = 0; n < 2; ++n) acc[a][b][m][n] = (f32x4){0.f, 0.f, 0.f, 0.f};
    bf16x8 At[4][2], B0[2][2], B1[2][2];
    const char* cA = (const char*)g.A + (size_t)cur.pm * tstep; const char* cB = (const char*)g.Bt + (size_t)cur.pn * tstep;
    S.a_ready(cur);
    if constexpr (SP2) {
        PG8_STAGE(PG8_SB(0, 0), cB, voffB); PG8_STAGE(PG8_SB(0, 1), cB + hstep, voffB); PG8_STAGE(PG8_SA(0, 0), cA, voffA); PG8_STAGE(PG8_SA(0, 1), cA + hstep, voffA);
        if (wr == 1) PG8_BAR;
        PG8_WAIT_V(2); PG8_BAR;
        PG8_STAGE(PG8_SB(1, 0), cB + kstep, voffB); PG8_STAGE(PG8_SA(1, 0), cA + kstep, voffA); PG8_STAGE(PG8_SB(1, 1), cB + hstep + kstep, voffB);
        PG8_WAIT_V(6); PG8_BAR;
    } else {
        PG8_STAGE(PG8_SB(0, 0), cB, voffB); PG8_STAGE(PG8_SA(0, 0), cA, voffA); PG8_STAGE(PG8_SB(0, 1), cB + hstep, voffB); PG8_STAGE(PG8_SA(0, 1), cA + hstep, voffA);
        if (wr == 1) PG8_BAR;
        PG8_WAIT_V(4); PG8_BAR;
        PG8_STAGE(PG8_SB(1, 0), cB + kstep, voffB); PG8_STAGE(PG8_SA(1, 0), cA + kstep, voffA); PG8_STAGE(PG8_SB(1, 1), cB + hstep + kstep, voffB);
        PG8_WAIT_V(6); PG8_BAR;
    }
    for (;;) {
        const bool has_next = S.next(ui + 1, nxt);
        const char* nA = has_next ? (const char*)g.A + (size_t)nxt.pm * tstep : cA; const char* nB = has_next ? (const char*)g.Bt + (size_t)nxt.pn * tstep : cB;
        for (int t = 0; t < nt; t += 2) {
            const bool last = (t == nt - 2);
            const char* a1 = cA + (size_t)(t + 1) * kstep;
            const char* a2 = last ? nA : cA + (size_t)(t + 2) * kstep; const char* b2 = last ? nB : cB + (size_t)(t + 2) * kstep;
            const char* a3 = a2 + kstep; const char* b3 = b2 + kstep;
            if (last && has_next) S.a_ready(nxt);
            if constexpr (SP2) {
            PG8_LDB(B0, 0, 0); PG8_LDB(B1, 0, 1); PG8_SCHED; PG8_LDA(At, 0, 0); PG8_STAGE(PG8_SA(1, 1), a1 + hstep, voffA);
            PG8_WAIT_V(8); PG8_WAIT_L(0); PG8_BAR; PG8_MMA(0, 0, At, B0); PG8_MMA(0, 1, At, B1); PG8_BAR; PG8_SCHED;
            PG8_LDA(At, 0, 1); PG8_STAGE(PG8_SB(0, 0), b2, voffB); PG8_STAGE(PG8_SB(0, 1), b2 + hstep, voffB); PG8_STAGE(PG8_SA(0, 0), a2, voffA);
            PG8_WAIT_V(8); PG8_WAIT_L(0); PG8_BAR; PG8_MMA(1, 0, At, B0); PG8_MMA(1, 1, At, B1); PG8_BAR; PG8_SCHED;
            PG8_LDB(B0, 1, 0); PG8_LDB(B1, 1, 1); PG8_SCHED; PG8_LDA(At, 1, 0); PG8_STAGE(PG8_SA(0, 1), a2 + hstep, voffA);
            PG8_WAIT_V(8); PG8_WAIT_L(0); PG8_BAR; PG8_MMA(0, 0, At, B0); PG8_MMA(0, 1, At, B1); PG8_BAR; PG8_SCHED;
            PG8_LDA(At, 1, 1); PG8_STAGE(PG8_SB(1, 0), b3, voffB); PG8_STAGE(PG8_SB(1, 1), b3 + hstep, voffB); PG8_STAGE(PG8_SA(1, 0), a3, voffA);
            PG8_WAIT_V(8); PG8_WAIT_L(0); PG8_BAR; PG8_MMA(1, 0, At, B0); PG8_MMA(1, 1, At, B1); PG8_BAR; PG8_SCHED;
            } else {
            PG8_LDB(B0, 0, 0); PG8_SCHED; PG8_LDA(At, 0, 0); PG8_STAGE(PG8_SA(1, 1), a1 + hstep, voffA);
            PG8_WAIT_L(8); PG8_BAR; PG8_WAIT_L(0); PG8_MMA(0, 0, At, B0); PG8_BAR; PG8_SCHED;
            PG8_LDB(B1, 0, 1); PG8_STAGE(PG8_SB(0, 0), b2, voffB);
            PG8_BAR; PG8_WAIT_L(0); PG8_MMA(0, 1, At, B1); PG8_BAR;
            PG8_LDA(At, 0, 1); PG8_STAGE(PG8_SA(0, 0), a2, voffA);
            PG8_BAR; PG8_WAIT_L(0); PG8_MMA(1, 0, At, B0); PG8_BAR; PG8_SCHED;
            PG8_STAGE(PG8_SB(0, 1), b2 + hstep, voffB);
            PG8_WAIT_V(6); PG8_BAR; PG8_MMA(1, 1, At, B1); PG8_BAR;
            PG8_LDB(B0, 1, 0); PG8_SCHED; PG8_LDA(At, 1, 0); PG8_STAGE(PG8_SA(0, 1), a2 + hstep, voffA);
            PG8_WAIT_L(8); PG8_BAR; PG8_WAIT_L(0); PG8_MMA(0, 0, At, B0); PG8_BAR; PG8_SCHED;
            PG8_LDB(B1, 1, 1); PG8_STAGE(PG8_SB(1, 0), b3, voffB);
            PG8_BAR; PG8_WAIT_L(0); PG8_MMA(0, 1, At, B1); PG8_BAR;
            PG8_LDA(At, 1, 1); PG8_STAGE(PG8_SA(1, 0), a3, voffA);
            PG8_BAR; PG8_WAIT_L(0); PG8_MMA(1, 0, At, B0); PG8_BAR; PG8_SCHED;
            PG8_STAGE(PG8_SB(1, 1), b3 + hstep, voffB);
            PG8_WAIT_V(6); PG8_BAR; PG8_MMA(1, 1, At, B1); PG8_BAR;
            }
        }
        if constexpr (ALIGN_EPI) { if (wr == 0) PG8_BAR; }
        if constexpr (!Epi::AFTER_DRAIN) { E(acc, cur, wr, wc, fr, fq); S.done(cur); }
        if (!has_next) break;
#pragma unroll
        for (int a = 0; a < 2; ++a)
#pragma unroll
            for (int b = 0; b < 2; ++b)
#pragma unroll
                for (int m = 0; m < 4; ++m)
#pragma unroll
                    for (int n = 0; n < 2; ++n) acc[a][b][m][n] = (f32x4){0.f, 0.f, 0.f, 0.f};
        cur = nxt; cA = nA; cB = nB; ++ui;
        if constexpr (ALIGN_EPI) { if (wr == 1) PG8_BAR; }
    }
    PG8_WAIT_V(0);
    if constexpr (!ALIGN_EPI) { if (wr == 0) PG8_BAR; }
    PG8_BAR;
    if constexpr (Epi::AFTER_DRAIN) { E.fused(acc, cur, wr, wc, fr, fq, lds, wid, lane); S.done(cur); }
#undef PG8_SA
#undef PG8_SB
#undef PG8_STAGE
#undef PG8_LDA
#undef PG8_LDB
#undef PG8_MMA
#undef PG8_WAIT_V
#undef PG8_WAIT_L
#undef PG8_BAR
#undef PG8_SCHED
}
}
#define GAS __attribute__((address_space(1)))
#define LAS __attribute__((address_space(3)))
typedef unsigned short bf16;
typedef unsigned v4u __attribute__((ext_vector_type(4)));
typedef float f32x4 __attribute__((ext_vector_type(4)));
typedef short bf16x8 __attribute__((ext_vector_type(8)));
typedef GAS unsigned gu32;
typedef GAS unsigned long long gu64;
#define RLX_AGENT __ATOMIC_RELAXED, __HIP_MEMORY_SCOPE_AGENT
#define LDS_WAIT() asm volatile("s_waitcnt lgkmcnt(0)" ::: "memory")
#define VM_WAIT() asm volatile("s_waitcnt vmcnt(0)" ::: "memory")
__device__ __forceinline__ unsigned long long rt() { return __builtin_amdgcn_s_memrealtime(); }
__device__ __forceinline__ unsigned f2bf(float f) { unsigned u = __builtin_bit_cast(unsigned, f); return (u + 0x7fffu + ((u >> 16) & 1u)) >> 16; }
__device__ __forceinline__ unsigned pk2(float lo, float hi) { return f2bf(lo) | (f2bf(hi) << 16); }

#define XB_TMO      128
#define XB_XCNT(j)  (256  + 64 * (j))
#define XB_XSUB(j)  (1280 + 64 * (j))
#define XB_XGEN(j)  (2304 + 64 * (j))
#define XB_TOP      3328
#define XB_TOPGEN   3392
#define XCD_BAR_WORDS 3456
#define XB_SPIN_CAP (1u << 18)

__device__ __forceinline__ unsigned xb_ld(unsigned* p)              { return __hip_atomic_load(p, __ATOMIC_RELAXED, __HIP_MEMORY_SCOPE_AGENT); }
__device__ __forceinline__ unsigned xb_add(unsigned* p, unsigned v) { return __hip_atomic_fetch_add(p, v, __ATOMIC_RELAXED, __HIP_MEMORY_SCOPE_AGENT); }
__device__ __forceinline__ unsigned xb_xcc_id() { return (unsigned)__builtin_amdgcn_s_getreg((3 << 11) | 20) & 0xFu; }
#define XB_SPIN(cond, bar) do { unsigned _sp = 0; while (cond) { __builtin_amdgcn_s_sleep(1); \
    if ((++_sp & 255u) == 0u) { if (xb_ld(&(bar)[XB_TMO])) break; if (_sp > XB_SPIN_CAP) { atomicAdd(&(bar)[XB_TMO], 1u); break; } } } } while (0)

struct XcdBarrier {
    unsigned* bar; unsigned x;
    volatile LAS unsigned* st;
};

__device__ __forceinline__ XcdBarrier xcd_barrier_post(unsigned* bar, volatile LAS unsigned* st) {
    XcdBarrier b; b.bar = bar; b.x = xb_xcc_id(); b.st = st;
    if (threadIdx.x == 0) (void)xb_add(&bar[XB_XCNT(b.x)], 1u);
    return b;
}
__device__ __forceinline__ void xcd_barrier_complete(unsigned* bar, unsigned x, unsigned& nloc, unsigned& nx) {
    const unsigned G = gridDim.x * gridDim.y * gridDim.z;
    unsigned sum, cnt, mine, sp = 0u;
    for (;;) {
        sum = 0u; cnt = 0u; mine = 0u;
#pragma unroll
        for (unsigned j = 0; j < 16; ++j) { const unsigned c = xb_ld(&bar[XB_XCNT(j)]); sum += c; cnt += (c > 0u) ? 1u : 0u; mine = (j == x) ? c : mine; }
        if (sum == G) break;
        __builtin_amdgcn_s_sleep(1);
        if ((++sp & 255u) == 0u) { if (xb_ld(&bar[XB_TMO])) break; if (sp > XB_SPIN_CAP) { atomicAdd(&bar[XB_TMO], 1u); break; } }
    }
    nloc = mine > 0u ? mine : 1u; nx = cnt > 0u ? cnt : 1u;
}

__device__ __forceinline__ void xcd_barrier(const XcdBarrier& b) {
    asm volatile("s_waitcnt vmcnt(0)" ::: "memory");
    __syncthreads();
    if (threadIdx.x == 0) {
        unsigned* bar = b.bar;
        __builtin_amdgcn_s_waitcnt(0);
        unsigned nloc = b.st[0], nx = b.st[1];
        if (nloc == 0u) { xcd_barrier_complete(bar, b.x, nloc, nx); b.st[0] = nloc; b.st[1] = nx; }
        const unsigned old = xb_add(&bar[XB_XSUB(b.x)], 1u);
        const unsigned gen = old / nloc;
        if (old + 1u == (gen + 1u) * nloc) {
            __builtin_amdgcn_fence(__ATOMIC_RELEASE, "agent");
            asm volatile("s_waitcnt vmcnt(0)" ::: "memory");
            const unsigned og = xb_add(&bar[XB_TOP], 1u);
            const unsigned tg = og / nx;
            if (og + 1u == (tg + 1u) * nx) xb_add(&bar[XB_TOPGEN], 1u);
            else XB_SPIN(xb_ld(&bar[XB_TOPGEN]) == tg, bar);
            __builtin_amdgcn_fence(__ATOMIC_ACQUIRE, "agent");
            xb_add(&bar[XB_XGEN(b.x)], 1u);
            asm volatile("s_waitcnt vmcnt(0)" ::: "memory");
        } else {
            XB_SPIN(xb_ld(&bar[XB_XGEN(b.x)]) == gen, bar);
            __builtin_amdgcn_fence(__ATOMIC_ACQUIRE, "agent");
            asm volatile("s_waitcnt vmcnt(0)" ::: "memory");
        }
    }
    __syncthreads();
}

constexpr int NWAVES = 8;
constexpr int D = 1024, NB = 4, SEQ = 4096, PADF = 48, LP = 4160, NCH = 65, MP = NB * LP  , MX = NB * SEQ  ;
constexpr int INW = 4624, INWP = 4864, NH = 8, SG = 32;
constexpr int NE = 64;
constexpr float LN_EPS = 1e-5f, NORM_EPS = 1e-6f, ALPHA = 1.189207115002721f;

constexpr size_t MiB = 1u << 20;
constexpr size_t WS_CTL = 0, CTL_ZERO_BYTES = 1 * MiB;
constexpr size_t WS_STATS = 1 * MiB;
constexpr size_t WS_ROUTE = WS_STATS + 128 * 1024;
constexpr size_t WS_INV = WS_ROUTE + 512 * 1024;
constexpr size_t WS_WRT = WS_INV + 192 * 1024;
constexpr size_t WS_AB = 2 * MiB;
constexpr size_t WS_WGLU = 3 * MiB + 512 * 1024;
constexpr size_t WS_WBR = WS_WGLU + 512 * 1024;
constexpr size_t WS_WOUT = WS_WBR + 2 * MiB;
constexpr size_t WS_W13 = 8 * MiB;
constexpr size_t WS_W2 = WS_W13 + 64 * MiB;
constexpr size_t WS_WINT = 8 * MiB;
constexpr size_t WS_H0B = WS_WINT + (size_t)INWP * D * 2;
constexpr size_t WS_QKV = WS_H0B + (size_t)MP * D * 2;
static_assert(WS_QKV + (size_t)MP * 1536 * 2 <= 104 * MiB, "overlay");
constexpr size_t WS_Z = 104 * MiB;
constexpr size_t WS_U = WS_Z + (size_t)MP * 512 * 2;
constexpr size_t WS_GATES = WS_U + (size_t)MP * 512 * 2;
constexpr size_t WS_OA = WS_GATES + (size_t)MP * 2048 * 2;
constexpr size_t WS_YB = WS_OA + 16 * MiB;
constexpr size_t WS_OB = WS_YB + 16 * MiB;
constexpr size_t WS_MERGED = WS_OB + 16 * MiB;
constexpr size_t WS_END = WS_MERGED + 32 * MiB;
static_assert(WS_END <= 283 * MiB, "d_ws map");
constexpr size_t WS_TMP = WS_Z;
constexpr size_t WS_PRE = WS_GATES;
constexpr size_t WS_H1 = WS_Z;
constexpr size_t WS_HID = WS_OA;
static_assert(WS_TMP + 32 * MiB <= WS_GATES && WS_PRE + 64 * MiB <= WS_OA, "overlays");
constexpr size_t DO_QN = 0, DO_KN = (size_t)MP * 512 * 2, DO_VN = 2 * DO_KN, DO_BETA = 3 * DO_KN, DO_ALPHA = DO_BETA + (size_t)MP * 8 * 4;
constexpr int CW_BAR = 4096, CW_CNT = 16384;
constexpr int RING_BYTES = 131072, LDSCTL_OFF = RING_BYTES, MISC_OFF = LDSCTL_OFF + 320, LDS_BYTES = 147456;

__device__ __forceinline__ float bf2f(unsigned short h) { return __builtin_bit_cast(float, (unsigned)h << 16); }
__device__ __forceinline__ float bflo(unsigned w) { return __builtin_bit_cast(float, w << 16); }
__device__ __forceinline__ float bfhi(unsigned w) { return __builtin_bit_cast(float, w & 0xffff0000u); }
__device__ __forceinline__ float sigm(float x) { return 1.f / (1.f + __expf(-x)); }
__device__ __forceinline__ float silu_(float x) { return x * sigm(x); }
__device__ __forceinline__ float softplus_(float x) { return x > 20.f ? x : log1pf(expf(x)); }
__device__ __forceinline__ float gelu_tanh(float x) { const float u = 0.7978845608028654f * (x + 0.044715f * x * x * x); return 0.5f * x * (1.f + tanhf(u)); }
__device__ __forceinline__ float wave_sum(float v) {
#pragma unroll
    for (int o = 1; o < 64; o <<= 1) v += __shfl_xor(v, o);
    return v;
}
__device__ __forceinline__ int prow_of(int xrow) { return (xrow >> 12) * LP + 64 + (xrow & 4095); }

namespace pg8 {
struct EpiProj {
    static constexpr bool PERM = true, AFTER_DRAIN = false;
    bf16_t *qkv, *z, *u, *gates; float* ab;
    __device__ __forceinline__ void operator()(const f32x4 (&acc)[2][2][4][2], const Unit& un, int wr, int wc, int fr, int fq) const {
        const int pn = un.pn; bf16_t* base; int ld, cb;
        if (pn < 6) { base = qkv; ld = 1536; cb = pn * 256; }
        else if (pn < 8) { base = z; ld = 512; cb = (pn - 6) * 256; }
        else if (pn < 10) { base = u; ld = 512; cb = (pn - 8) * 256; }
        else if (pn < 18) { base = gates; ld = 2048; cb = (pn - 10) * 256; }
        else {
            if (wc == 0 && fq < 2) {
#pragma unroll
                for (int ai = 0; ai < 2; ++ai)
#pragma unroll
                    for (int m = 0; m < 4; ++m) { const int row = un.pm * BM + ai * HALF + wr * 64 + m * 16 + fr; float* p = ab + (size_t)row * 16 + 8 * fq;
                        *(f32x4*)p = acc[ai][0][m][0]; *(f32x4*)(p + 4) = acc[ai][0][m][1]; }
            }
            return;
        }
        const int row0 = un.pm * BM + wr * 64 + fr, col0 = cb + wc * 32 + 8 * fq;
#pragma unroll
        for (int ai = 0; ai < 2; ++ai)
#pragma unroll
            for (int m = 0; m < 4; ++m) { bf16_t* rowp = base + (size_t)(row0 + ai * HALF + m * 16) * ld + col0;
#pragma unroll
                for (int bj = 0; bj < 2; ++bj) { const f32x4 v0 = acc[ai][bj][m][0], v1 = acc[ai][bj][m][1]; u32x4 w;
                    w.x = cvt_pk_bf16(v0[0], v0[1]); w.y = cvt_pk_bf16(v0[2], v0[3]); w.z = cvt_pk_bf16(v1[0], v1[1]); w.w = cvt_pk_bf16(v1[2], v1[3]);
                    *(u32x4*)(rowp + bj * HALF) = w; } }
    }
};
struct EpiGlu {
    static constexpr bool PERM = true, AFTER_DRAIN = false;
    const bf16_t* yb; const float* bglu; bf16_t* ob;
    __device__ __forceinline__ void operator()(const f32x4 (&acc)[2][2][4][2], const Unit& un, int wr, int wc, int fr, int fq) const {
        const int row0 = un.pm * BM + wr * 64 + fr, col0 = un.pn * BM + wc * 32 + 8 * fq;
#pragma unroll
        for (int bj = 0; bj < 2; ++bj) { const int col = col0 + bj * HALF; const f32x4 b0 = *(const f32x4*)(bglu + col), b1 = *(const f32x4*)(bglu + col + 4);
#pragma unroll
            for (int ai = 0; ai < 2; ++ai)
#pragma unroll
                for (int m = 0; m < 4; ++m) { const size_t off = (size_t)(row0 + ai * HALF + m * 16) * 512 + col; const u32x4 y = *(const u32x4*)(yb + off);
                    const f32x4 v0 = acc[ai][bj][m][0] + b0, v1 = acc[ai][bj][m][1] + b1; u32x4 w;
                    w.x = cvt_pk_bf16(bflo(y.x) * sigm(v0[0]), bfhi(y.x) * sigm(v0[1])); w.y = cvt_pk_bf16(bflo(y.y) * sigm(v0[2]), bfhi(y.y) * sigm(v0[3]));
                    w.z = cvt_pk_bf16(bflo(y.z) * sigm(v1[0]), bfhi(y.z) * sigm(v1[1])); w.w = cvt_pk_bf16(bflo(y.w) * sigm(v1[2]), bfhi(y.w) * sigm(v1[3]));
                    *(u32x4*)(ob + off) = w; } }
    }
};
template <bool SECOND> struct EpiBr {
    static constexpr bool PERM = true, AFTER_DRAIN = false;
    const bf16_t* gates; const bf16_t* tin; bf16_t* out;
    __device__ __forceinline__ void operator()(const f32x4 (&acc)[2][2][4][2], const Unit& un, int wr, int wc, int fr, int fq) const {
        const int row0 = un.pm * BM + wr * 64 + fr, col0 = un.pn * BM + wc * 32 + 8 * fq;
#pragma unroll
        for (int ai = 0; ai < 2; ++ai)
#pragma unroll
            for (int m = 0; m < 4; ++m) { const int row = row0 + ai * HALF + m * 16; const size_t goff = (size_t)prow_of(row) * 2048 + (SECOND ? 1024 : 0) + col0, off = (size_t)row * 1024 + col0;
#pragma unroll
                for (int bj = 0; bj < 2; ++bj) { const u32x4 g = *(const u32x4*)(gates + goff + bj * HALF); const f32x4 v0 = acc[ai][bj][m][0], v1 = acc[ai][bj][m][1];
                    float r[8] = { sigm(bflo(g.x)) * v0[0], sigm(bfhi(g.x)) * v0[1], sigm(bflo(g.y)) * v0[2], sigm(bfhi(g.y)) * v0[3],
                                   sigm(bflo(g.z)) * v1[0], sigm(bfhi(g.z)) * v1[1], sigm(bflo(g.w)) * v1[2], sigm(bfhi(g.w)) * v1[3] };
                    if (SECOND) { const u32x4 t = *(const u32x4*)(tin + off + bj * HALF);
                        r[0] += bflo(t.x); r[1] += bfhi(t.x); r[2] += bflo(t.y); r[3] += bfhi(t.y); r[4] += bflo(t.z); r[5] += bfhi(t.z); r[6] += bflo(t.w); r[7] += bfhi(t.w); }
                    u32x4 w; w.x = cvt_pk_bf16(r[0], r[1]); w.y = cvt_pk_bf16(r[2], r[3]); w.z = cvt_pk_bf16(r[4], r[5]); w.w = cvt_pk_bf16(r[6], r[7]);
                    *(u32x4*)(out + off + bj * HALF) = w; } }
    }
};
struct EpiOut {
    static constexpr bool PERM = false, AFTER_DRAIN = false;
    const float* x; const float* stats; const float* g; const float* b; float* pre;
    __device__ __forceinline__ void operator()(const f32x4 (&acc)[2][2][4][2], const Unit& un, int wr, int wc, int fr, int fq) const {
        const int row0 = un.pm * BM + wr * 64 + fr, col0 = un.pn * BM + wc * 32 + 4 * fq;
#pragma unroll
        for (int bj = 0; bj < 2; ++bj)
#pragma unroll
            for (int n = 0; n < 2; ++n) { const int col = col0 + bj * HALF + n * 16; const f32x4 gv = *(const f32x4*)(g + col), bv = *(const f32x4*)(b + col);
#pragma unroll
                for (int ai = 0; ai < 2; ++ai)
#pragma unroll
                    for (int m = 0; m < 4; ++m) { const int row = row0 + ai * HALF + m * 16; const float mean = stats[2 * row], rstd = stats[2 * row + 1];
                        const f32x4 xv = *(const f32x4*)(x + (size_t)row * 1024 + col);
                        const f32x4 h0 = (xv - mean) * rstd * gv + bv;
                        *(f32x4*)(pre + (size_t)row * 1024 + col) = h0 * ALPHA + acc[ai][bj][m][n]; } }
    }
};
}

namespace mg {
typedef unsigned u32x2 __attribute__((ext_vector_type(2)));
constexpr int STG = 49152;
__device__ __forceinline__ int swz(int r, int c16) { return r * 128 + ((c16 ^ (r & 7)) << 4); }
template <class RowPtr, class Epi>
__device__ __forceinline__ void tile(LAS unsigned char* lds, const RowPtr& rowptr, const bf16* Bt, int K, const Epi& epi) {
    const int tid = threadIdx.x, wid = __builtin_amdgcn_readfirstlane(tid >> 6), lane = tid & 63, wr = wid >> 2, wc = wid & 3, fr = lane & 15, fq = lane >> 4;
    const int lr = tid >> 3, lc = tid & 7;
    const bf16* pa0 = rowptr(lr) + lc * 8; const bf16* pa1 = rowptr(lr + 64) + lc * 8;
    const bf16* pb = Bt + (size_t)lr * K + lc * 8;
    v4u ra0, ra1, rb[4];
    f32x4 acc[4][4];
#pragma unroll
    for (int m = 0; m < 4; ++m)
#pragma unroll
        for (int n = 0; n < 4; ++n) acc[m][n] = (f32x4){0.f, 0.f, 0.f, 0.f};
    const int nk = K / 64;
#define MG_LOAD(k0) do { ra0 = *(const v4u*)(pa0 + (k0)); ra1 = *(const v4u*)(pa1 + (k0)); _Pragma("unroll") for (int j = 0; j < 4; ++j) rb[j] = *(const v4u*)(pb + (size_t)(64 * j) * K + (k0)); } while (0)
#define MG_STORE(buf) do { LAS unsigned char* sa = lds + (buf) * STG; LAS unsigned char* sb = sa + 16384; \
        *(LAS v4u*)(sa + swz(lr, lc)) = ra0; *(LAS v4u*)(sa + swz(lr + 64, lc)) = ra1; \
        _Pragma("unroll") for (int j = 0; j < 4; ++j) *(LAS v4u*)(sb + swz(lr + 64 * j, lc)) = rb[j]; } while (0)
    MG_LOAD(0); MG_STORE(0); __syncthreads();
    for (int kt = 0; kt < nk; ++kt) {
        const int cur = kt & 1;
        if (kt + 1 < nk) MG_LOAD((kt + 1) * 64);
        const LAS unsigned char* sa = lds + cur * STG; const LAS unsigned char* sb = sa + 16384;
#pragma unroll
        for (int ks = 0; ks < 2; ++ks) {
            bf16x8 a[4], w[4];
#pragma unroll
            for (int m = 0; m < 4; ++m) a[m] = *(const LAS bf16x8*)(sa + swz(64 * wr + 16 * m + fr, ks * 4 + fq));
#pragma unroll
            for (int n = 0; n < 4; ++n) w[n] = *(const LAS bf16x8*)(sb + swz(64 * wc + 16 * n + fr, ks * 4 + fq));
#pragma unroll
            for (int m = 0; m < 4; ++m)
#pragma unroll
                for (int n = 0; n < 4; ++n) acc[m][n] = __builtin_amdgcn_mfma_f32_16x16x32_bf16(w[n], a[m], acc[m][n], 0, 0, 0);
        }
        if (kt + 1 < nk) MG_STORE(cur ^ 1);
        __syncthreads();
    }
#undef MG_LOAD
#undef MG_STORE
    epi(acc, wr, wc, fr, fq);
}
}

struct Ctx {
    LAS unsigned char* lds; int tid, lane, wave, wg, G;
    const float* const* in; float* out; unsigned char* ws; gu32* ctl;
};

__device__ __forceinline__ void transpose_item(const float* W, int K, int N, bf16* WT, int mode, int row_off, int s13, LAS float* scr, int item, int lane) {
    const int nblk = (N + 31) / 32, kb = item / nblk, nb = item % nblk, k0 = 64 * kb, n0 = 32 * nb;
    const int nn = n0 + (lane & 31); const bool ok = nn < N;
#pragma unroll 8
    for (int i = 0; i < 32; ++i) { const int kk = 2 * i + (lane >> 5); scr[kk * 33 + (lane & 31)] = ok ? W[(size_t)(k0 + kk) * N + nn] : 0.f; }
    LDS_WAIT(); asm volatile("" ::: "memory");
    const int c = lane & 7;
#pragma unroll
    for (int j = 0; j < 4; ++j) { const int n = (lane >> 3) + 8 * j; const LAS float* s = scr + (8 * c) * 33 + n;
        v4u o; o.x = pk2(s[0 * 33], s[1 * 33]); o.y = pk2(s[2 * 33], s[3 * 33]); o.z = pk2(s[4 * 33], s[5 * 33]); o.w = pk2(s[6 * 33], s[7 * 33]);
        const int orow = (mode == 0) ? (row_off + n0 + n) : (row_off + 2 * n0 + n + (n >= 16 ? 16 : 0) + 16 * s13);
        if (n0 + n < N) *(GAS v4u*)(WT + (size_t)orow * K + k0 + 8 * c) = o; }
    LDS_WAIT(); asm volatile("" ::: "memory");
}
__device__ __forceinline__ void ln_row(f32x4 (&v)[4], const float* g, const float* b, int lane, float scale_in, float& mean_o, float& rstd_o) {
    float s = 0.f;
#pragma unroll
    for (int j = 0; j < 4; ++j) { v[j] = v[j] * scale_in; s += (v[j].x + v[j].y) + (v[j].z + v[j].w); }
    const float mean = wave_sum(s) * (1.f / D); float s2 = 0.f;
#pragma unroll
    for (int j = 0; j < 4; ++j) { v[j] = v[j] - mean; s2 += (v[j].x * v[j].x + v[j].y * v[j].y) + (v[j].z * v[j].z + v[j].w * v[j].w); }
    const float rstd = 1.f / sqrtf(wave_sum(s2) * (1.f / D) + LN_EPS);
#pragma unroll
    for (int j = 0; j < 4; ++j) { const f32x4 gv = *(const f32x4*)(g + 4 * lane + 256 * j), bv = *(const f32x4*)(b + 4 * lane + 256 * j); v[j] = v[j] * rstd * gv + bv; }
    mean_o = mean; rstd_o = rstd;
}

__device__ __forceinline__ void phase0(const Ctx& C) {
    LAS float* scr = (LAS float*)(C.lds + C.wave * 16384);
    const int gw = C.wg * NWAVES + C.wave, NGW = C.G * NWAVES, lane = C.lane;
    bf16* WINT = (bf16*)(C.ws + WS_WINT); bf16* WGLU = (bf16*)(C.ws + WS_WGLU); bf16* WBR = (bf16*)(C.ws + WS_WBR); bf16* WOUT = (bf16*)(C.ws + WS_WOUT); bf16* WRT = (bf16*)(C.ws + WS_WRT);
    constexpr int I_IN = 16 * 145, I_GLU = 8 * 16, I_BR = 8 * 32, I_OUT = 16 * 32, I_RG = 16, I_RE = 32;
    constexpr int NITEMS = I_IN + I_GLU + 2 * I_BR + I_OUT + I_RG + I_RE;
    for (int it = gw; it < NITEMS; it += NGW) {
        int r = it;
        if (r < I_IN) { transpose_item(C.in[4], 1024, INW, WINT, 0, 0, 0, scr, r, lane); continue; } r -= I_IN;
        if (r < I_GLU) { transpose_item(C.in[17], 512, 512, WGLU, 0, 0, 0, scr, r, lane); continue; } r -= I_GLU;
        if (r < I_BR) { transpose_item(C.in[19], 512, 1024, WBR, 0, 0, 0, scr, r, lane); continue; } r -= I_BR;
        if (r < I_BR) { transpose_item(C.in[19] + 512 * 1024, 512, 1024, WBR + 1024 * 512, 0, 0, 0, scr, r, lane); continue; } r -= I_BR;
        if (r < I_OUT) { transpose_item(C.in[20], 1024, 1024, WOUT, 0, 0, 0, scr, r, lane); continue; } r -= I_OUT;
        if (r < I_RG) { transpose_item(C.in[23], 1024, 8, WRT, 0, 0, 0, scr, r, lane); continue; } r -= I_RG;
        transpose_item(C.in[25], 1024, 64, WRT, 0, 8, 0, scr, r, lane);
    }
    for (int it = gw; it < (INWP - INW) + 8; it += NGW) { bf16* rowp = (it < INWP - INW) ? WINT + (size_t)(INW + it) * 1024 : WRT + (size_t)(72 + it - (INWP - INW)) * 1024;
        GAS v4u* o = (GAS v4u*)rowp + lane; o[0] = (v4u){0u, 0u, 0u, 0u}; o[64] = (v4u){0u, 0u, 0u, 0u}; }
    bf16* H0B = (bf16*)(C.ws + WS_H0B); float* stats = (float*)(C.ws + WS_STATS);
    const float* x = C.in[0]; const float* meta = C.in[1]; const float* g = C.in[2]; const float* b = C.in[3];
    for (int rp = gw; rp < MP; rp += NGW) {
        const int bb = rp / LP, i = rp % LP;
        GAS unsigned long long* o8 = (GAS unsigned long long*)(H0B + (size_t)rp * D) + lane;
        if (i < PADF) {
#pragma unroll
            for (int j = 0; j < 4; ++j) o8[64 * j] = 0ull;
            continue; }
        const float* src = (i < 64) ? meta + (size_t)(i - PADF) * D : x + ((size_t)bb * SEQ + (i - 64)) * D;
        f32x4 v[4];
#pragma unroll
        for (int j = 0; j < 4; ++j) v[j] = *(const f32x4*)(src + 4 * lane + 256 * j);
        float mean, rstd; ln_row(v, g, b, lane, 1.f, mean, rstd);
        if (i >= 64 && lane == 0) { const int xr = bb * SEQ + (i - 64); stats[2 * xr] = mean; stats[2 * xr + 1] = rstd; }
#pragma unroll
        for (int j = 0; j < 4; ++j) o8[64 * j] = (unsigned long long)pk2(v[j].x, v[j].y) | ((unsigned long long)pk2(v[j].z, v[j].w) << 32);
    }
}

__device__ __forceinline__ void phase2_elem(const Ctx& C) {
    const int gw = C.wg * NWAVES + C.wave, NGW = C.G * NWAVES, lane = C.lane;
    const bf16* qkv = (const bf16*)(C.ws + WS_QKV); const float* ab = (const float*)(C.ws + WS_AB);
    bf16* qn = (bf16*)((unsigned char*)C.out + DO_QN); bf16* kn = (bf16*)((unsigned char*)C.out + DO_KN); bf16* vn = (bf16*)((unsigned char*)C.out + DO_VN);
    float* beta = (float*)((unsigned char*)C.out + DO_BETA); float* alpha = (float*)((unsigned char*)C.out + DO_ALPHA);
    const float* cw = C.in[5]; const float* a_log = C.in[6]; const float* dt_bias = C.in[7];
    for (int it = gw; it < MP * NH; it += NGW) {
        const int rp = it >> 3, h = it & 7, i = rp % LP; const size_t o = (size_t)rp * 512 + h * 64 + lane;
        if (i < PADF) { qn[o] = 0; kn[o] = 0; vn[o] = 0; if (lane == 0) { beta[rp * 8 + h] = 0.f; alpha[rp * 8 + h] = 1.f; } continue; }
        float aq = 0.f, ak = 0.f, av = 0.f; const int ch = h * 64 + lane;
#pragma unroll
        for (int j = 0; j < 4; ++j) { const bf16* r = qkv + (size_t)(rp - 3 + j) * 1536 + ch;
            aq += cw[j * 1536 + ch] * bf2f(r[0]); ak += cw[j * 1536 + 512 + ch] * bf2f(r[512]); av += cw[j * 1536 + 1024 + ch] * bf2f(r[1024]); }
        float q = silu_(aq), k = silu_(ak), v = silu_(av);
        const float sq = wave_sum(q * q), sk = wave_sum(k * k);
        q *= (1.f / sqrtf(sq + NORM_EPS)) * 0.125f; k *= 1.f / sqrtf(sk + NORM_EPS);
        qn[o] = (bf16)f2bf(q); kn[o] = (bf16)f2bf(k); vn[o] = (bf16)f2bf(v);
        if (lane == 0) { const float a = ab[rp * 16 + h], bb = ab[rp * 16 + 8 + h];
            beta[rp * 8 + h] = sigm(bb); alpha[rp * 8 + h] = expf(-expf(a_log[h]) * softplus_(a + dt_bias[h])); }
    }
}

__device__ __forceinline__ void dn_scan_naive(const Ctx& C, int b, int h) {
    if (C.wave != 0) return;
    const int lane = C.lane;
    LAS float* Kl = (LAS float*)C.lds; LAS float* Ql = Kl + 4096; LAS float* Vl = Ql + 4096; LAS float* Zl = Vl + 4096; LAS float* Bl = Zl + 4096; LAS float* Al = Bl + 64;
    const bf16* qn = (const bf16*)((unsigned char*)C.out + DO_QN); const bf16* kn = (const bf16*)((unsigned char*)C.out + DO_KN); const bf16* vn = (const bf16*)((unsigned char*)C.out + DO_VN);
    const float* beta = (const float*)((unsigned char*)C.out + DO_BETA); const float* alpha = (const float*)((unsigned char*)C.out + DO_ALPHA);
    const bf16* z = (const bf16*)(C.ws + WS_Z); bf16* oa = (bf16*)(C.ws + WS_OA);
    const float nw = C.in[8][lane];
    float S[64];
#pragma unroll
    for (int k = 0; k < 64; ++k) S[k] = 0.f;
    for (int n = 0; n < NCH; ++n) {
        const int base = b * LP + 64 * n;
#pragma unroll 8
        for (int i = 0; i < 64; ++i) { const size_t off = (size_t)(base + i) * 512 + h * 64 + lane;
            Kl[i * 64 + lane] = bf2f(kn[off]); Ql[i * 64 + lane] = bf2f(qn[off]); Vl[i * 64 + lane] = bf2f(vn[off]); Zl[i * 64 + lane] = bf2f(z[off]); }
        Bl[lane] = beta[(base + lane) * 8 + h]; Al[lane] = alpha[(base + lane) * 8 + h];
        asm volatile("s_waitcnt vmcnt(0) lgkmcnt(0)" ::: "memory");
#pragma unroll 1
        for (int i = 0; i < 64; ++i) {
            const LAS f32x4* kr = (const LAS f32x4*)(Kl + i * 64); const LAS f32x4* qr = (const LAS f32x4*)(Ql + i * 64);
            const float at = Al[i], bt = Bl[i], vt = Vl[i * 64 + lane];
            float d0 = 0.f, d1 = 0.f, d2 = 0.f, d3 = 0.f;
#pragma unroll
            for (int k4 = 0; k4 < 16; ++k4) { const f32x4 kk = kr[k4]; d0 += S[4 * k4] * kk.x; d1 += S[4 * k4 + 1] * kk.y; d2 += S[4 * k4 + 2] * kk.z; d3 += S[4 * k4 + 3] * kk.w; }
            const float vnew = bt * (vt - at * ((d0 + d1) + (d2 + d3)));
            float o0 = 0.f, o1 = 0.f, o2 = 0.f, o3 = 0.f;
#pragma unroll
            for (int k4 = 0; k4 < 16; ++k4) { const f32x4 kk = kr[k4], qq = qr[k4];
                S[4 * k4] = at * S[4 * k4] + kk.x * vnew; S[4 * k4 + 1] = at * S[4 * k4 + 1] + kk.y * vnew; S[4 * k4 + 2] = at * S[4 * k4 + 2] + kk.z * vnew; S[4 * k4 + 3] = at * S[4 * k4 + 3] + kk.w * vnew;
                o0 += S[4 * k4] * qq.x; o1 += S[4 * k4 + 1] * qq.y; o2 += S[4 * k4 + 2] * qq.z; o3 += S[4 * k4 + 3] * qq.w; }
            if (n >= 1) { const float o = (o0 + o1) + (o2 + o3); const float ss = wave_sum(o * o);
                const float on = o * (1.f / sqrtf(ss * (1.f / 64.f) + NORM_EPS)) * nw * silu_(Zl[i * 64 + lane]);
                oa[(size_t)(b * SEQ + 64 * (n - 1) + i) * 512 + h * 64 + lane] = (bf16)f2bf(on); }
        }
    }
}
__device__ __forceinline__ void s5_naive(const Ctx& C, int b, int g) {
    const int tid = C.tid, lane = C.lane;
    LAS float* uu = (LAS float*)C.lds; LAS float* hh = uu + 1024; LAS float* Cc = hh + 8192; LAS float* Dd = Cc + 2048;
    const bf16* u = (const bf16*)(C.ws + WS_U); bf16* yb = (bf16*)(C.ws + WS_YB);
    const float* c_re = C.in[14] + (size_t)g * 16 * 64; const float* c_im = C.in[15] + (size_t)g * 16 * 64;
    for (int e = tid; e < 1024; e += 512) { const int c = e >> 6, p = e & 63; Cc[c * 128 + p] = c_re[c * 64 + p]; Cc[c * 128 + 64 + p] = -c_im[c * 64 + p]; }
    if (tid < 16) Dd[tid] = C.in[16][g * 16 + tid];
    float ar = 0.f, ai = 0.f, Bbr[16], Bbi[16], hr = 0.f, hi = 0.f;
    if (C.wave == 0) {
        const float dt = expf(C.in[11][g]); const float a_r = C.in[9][g * 64 + lane], a_i = C.in[10][g * 64 + lane];
        const float mag = expf(dt * a_r); ar = mag * cosf(dt * a_i); ai = mag * sinf(dt * a_i);
        const float den = a_r * a_r + a_i * a_i, nr = ar - 1.f, ni = ai;
        const float f_re = (nr * a_r + ni * a_i) / den, f_im = (ni * a_r - nr * a_i) / den;
        const float* br = C.in[12] + ((size_t)g * 64 + lane) * 16; const float* bi = C.in[13] + ((size_t)g * 64 + lane) * 16;
#pragma unroll
        for (int c = 0; c < 16; ++c) { Bbr[c] = f_re * br[c] - f_im * bi[c]; Bbi[c] = f_re * bi[c] + f_im * br[c]; }
    }
    for (int n = 0; n < NCH; ++n) {
        const int base = b * LP + 64 * n;
        { const int row = tid >> 3, c2 = (tid & 7) * 2; const unsigned w = *(const unsigned*)(u + (size_t)(base + row) * 512 + g * 16 + c2); uu[row * 16 + c2] = bflo(w); uu[row * 16 + c2 + 1] = bfhi(w); }
        __syncthreads();
        if (C.wave == 0) {
#pragma unroll 4
            for (int t = 0; t < 64; ++t) { float bur = 0.f, bui = 0.f;
#pragma unroll
                for (int c4 = 0; c4 < 4; ++c4) { const f32x4 uv = *(const LAS f32x4*)(uu + t * 16 + 4 * c4);
                    bur += Bbr[4 * c4] * uv.x + Bbr[4 * c4 + 1] * uv.y + Bbr[4 * c4 + 2] * uv.z + Bbr[4 * c4 + 3] * uv.w;
                    bui += Bbi[4 * c4] * uv.x + Bbi[4 * c4 + 1] * uv.y + Bbi[4 * c4 + 2] * uv.z + Bbi[4 * c4 + 3] * uv.w; }
                const float nhr = ar * hr - ai * hi + bur, nhi = ar * hi + ai * hr + bui; hr = nhr; hi = nhi;
                hh[t * 128 + lane] = hr; hh[t * 128 + 64 + lane] = hi; }
        }
        __syncthreads();
        if (n >= 1) { const int t = tid >> 3;
#pragma unroll
            for (int cc = 0; cc < 2; ++cc) { const int c = (tid & 7) + 8 * cc; float a0 = 0.f, a1 = 0.f;
#pragma unroll 8
                for (int p4 = 0; p4 < 32; ++p4) { const f32x4 cv = *(const LAS f32x4*)(Cc + c * 128 + 4 * p4), hv = *(const LAS f32x4*)(hh + t * 128 + 4 * p4); a0 += cv.x * hv.x + cv.y * hv.y; a1 += cv.z * hv.z + cv.w * hv.w; }
                const float y = a0 + a1 + Dd[c] * uu[t * 16 + c];
                yb[(size_t)(b * SEQ + 64 * (n - 1) + t) * 512 + g * 16 + c] = (bf16)f2bf(gelu_tanh(y)); } }
        __syncthreads();
    }
}
__device__ __forceinline__ void convert_experts(const Ctx& C, int first_w, int n_w) {
    const int gw = C.wg * NWAVES + C.wave - first_w; if (gw < 0) return;
    LAS float* scr = (LAS float*)(C.lds + C.wave * 16384);
    bf16* W13 = (bf16*)(C.ws + WS_W13); bf16* W2 = (bf16*)(C.ws + WS_W2);
    for (int it = gw; it < NE * 384; it += n_w) { const int e = it / 384, r = it % 384;
        if (r < 128) transpose_item(C.in[27] + (size_t)e * 1024 * 256, 1024, 256, W13 + (size_t)e * 512 * 1024, 1, 0, 0, scr, r, C.lane);
        else if (r < 256) transpose_item(C.in[28] + (size_t)e * 1024 * 256, 1024, 256, W13 + (size_t)e * 512 * 1024, 1, 0, 1, scr, r - 128, C.lane);
        else transpose_item(C.in[29] + (size_t)e * 256 * 1024, 256, 1024, W2 + (size_t)e * 1024 * 256, 0, 0, 0, scr, r - 256, C.lane); }
}
__device__ __forceinline__ void phase3_v1(const Ctx& C) {
    const int NSCAN = NB * NH + NB * SG;
    if (C.G > NSCAN) {
        if (C.wg < NB * NH) dn_scan_naive(C, C.wg >> 3, C.wg & 7);
        else if (C.wg < NSCAN) s5_naive(C, (C.wg - NB * NH) >> 5, (C.wg - NB * NH) & 31);
        else convert_experts(C, NSCAN * NWAVES, (C.G - NSCAN) * NWAVES);
    } else {
        for (int it = C.wg; it < NSCAN; it += C.G) { if (it < NB * NH) dn_scan_naive(C, it >> 3, it & 7); else s5_naive(C, (it - NB * NH) >> 5, (it - NB * NH) & 31); __syncthreads(); }
        convert_experts(C, 0, C.G * NWAVES);
    }
}

__device__ __forceinline__ void phase7_rows(const Ctx& C) {
    constexpr int RS = 2064;
    LAS unsigned char* Ht = C.lds; LAS float* Lg = (LAS float*)(C.lds + 32 * RS);
    const float* pre = (const float*)(C.ws + WS_PRE); bf16* h1 = (bf16*)(C.ws + WS_H1); const bf16* WRT = (const bf16*)(C.ws + WS_WRT);
    const float* g1 = C.in[21]; const float* b1 = C.in[22]; const float* b_rg = C.in[24]; const float* b_re = C.in[26];
    int* route = (int*)(C.ws + WS_ROUTE); gu32* cnt = C.ctl + CW_CNT;
    const int lane = C.lane, wave = C.wave, fr = lane & 15, fq = lane >> 4;
    for (int blk = C.wg; blk < MX / 32; blk += C.G) {
#pragma unroll 1
        for (int rr = 0; rr < 4; ++rr) { const int r = wave * 4 + rr; const size_t row = (size_t)blk * 32 + r;
            f32x4 v[4];
#pragma unroll
            for (int j = 0; j < 4; ++j) v[j] = *(const f32x4*)(pre + row * D + 4 * lane + 256 * j);
            float mean, rstd; ln_row(v, g1, b1, lane, 1.f, mean, rstd);
            GAS unsigned long long* o8 = (GAS unsigned long long*)(h1 + row * D) + lane;
#pragma unroll
            for (int j = 0; j < 4; ++j) { const unsigned long long w = (unsigned long long)pk2(v[j].x, v[j].y) | ((unsigned long long)pk2(v[j].z, v[j].w) << 32);
                o8[64 * j] = w; *(LAS unsigned long long*)(Ht + r * RS + (4 * lane + 256 * j) * 2) = w; } }
        __syncthreads();
        { const int rg = wave & 1, q = wave >> 1; f32x4 a0 = (f32x4){0.f, 0.f, 0.f, 0.f}, a1 = a0;
            const LAS unsigned char* ap = Ht + (16 * rg + fr) * RS + fq * 16; const bf16* w0 = WRT + (size_t)(16 * q + fr) * 1024 + fq * 8; const bf16* w1 = WRT + (size_t)(64 + fr) * 1024 + fq * 8;
#pragma unroll 4
            for (int s = 0; s < 32; ++s) { const bf16x8 af = *(const LAS bf16x8*)(ap + s * 64); const bf16x8 wf = *(const bf16x8*)(w0 + s * 32);
                a0 = __builtin_amdgcn_mfma_f32_16x16x32_bf16(wf, af, a0, 0, 0, 0);
                if (q == 0) { const bf16x8 wg = *(const bf16x8*)(w1 + s * 32); a1 = __builtin_amdgcn_mfma_f32_16x16x32_bf16(wg, af, a1, 0, 0, 0); } }
#pragma unroll
            for (int r = 0; r < 4; ++r) { Lg[(16 * rg + fr) * 80 + 16 * q + 4 * fq + r] = a0[r]; if (q == 0) Lg[(16 * rg + fr) * 80 + 64 + 4 * fq + r] = a1[r]; } }
        __syncthreads();
        if (C.tid < 32) { const LAS float* L = Lg + C.tid * 80; const int tok = blk * 32 + C.tid;
            float lg[8]; float mx = -3.0e38f; int gi = 0;
#pragma unroll
            for (int j = 0; j < 8; ++j) { lg[j] = L[j] + b_rg[j]; if (lg[j] > mx) { mx = lg[j]; gi = j; } }
            float se = 0.f;
#pragma unroll
            for (int j = 0; j < 8; ++j) se += __expf(lg[j] - mx);
            const float gp = 1.f / se;
            float t0 = -3.0e38f, t1 = -3.0e38f; int i0 = 0, i1 = 0;
#pragma unroll
            for (int j = 0; j < 8; ++j) { const float le = L[8 + gi * 8 + j] + b_re[gi * 8 + j];
                if (le > t0) { t1 = t0; i1 = i0; t0 = le; i0 = j; } else if (le > t1) { t1 = le; i1 = j; } }
            const float w0 = 1.f / (1.f + __expf(t1 - t0)), w1 = 1.f - w0;
            const int e0 = gi * 8 + i0, e1 = gi * 8 + i1;
            const int r0 = (int)__hip_atomic_fetch_add(cnt + e0, 1u, __ATOMIC_RELAXED, __HIP_MEMORY_SCOPE_AGENT);
            const int r1 = (int)__hip_atomic_fetch_add(cnt + e1, 1u, __ATOMIC_RELAXED, __HIP_MEMORY_SCOPE_AGENT);
            int* ro = route + (size_t)tok * 8; ro[0] = e0; ro[1] = e1; ro[2] = r0; ro[3] = r1; ((float*)ro)[4] = w0 * gp; ((float*)ro)[5] = w1 * gp; }
        __syncthreads();
    }
}
__device__ __forceinline__ void moe_table(const Ctx& C, LAS int* tst) {
    if (C.tid == 0) { int acc = 0; for (int e = 0; e < NE; ++e) { tst[e] = acc; const unsigned c = __hip_atomic_load(C.ctl + CW_CNT + e, RLX_AGENT); tst[80 + e] = (int)c; acc += (int)((c + 127u) >> 7); } tst[NE] = acc; }
    __syncthreads();
}
__device__ __forceinline__ int moe_expert_of(const LAS int* tst, int t) { int e = 0;
#pragma unroll 1
    for (int j = 1; j < NE; ++j) if (tst[j] <= t) e = j;
    return e; }
__device__ __forceinline__ void phase8_dispatch(const Ctx& C) {
    LAS int* tst = (LAS int*)(C.lds + 130048); moe_table(C, tst);
    const int* route = (const int*)(C.ws + WS_ROUTE); int* inv = (int*)(C.ws + WS_INV);
    for (int p = C.wg * 512 + C.tid; p < 2 * MX; p += C.G * 512) { const int tok = p >> 1, k = p & 1; const int e = route[tok * 8 + k], rk = route[tok * 8 + 2 + k]; inv[128 * tst[e] + rk] = p; }
    const int gw = C.wg * NWAVES + C.wave;
    for (int e = gw; e < NE; e += C.G * NWAVES) { const int lo = 128 * tst[e] + tst[80 + e], hi = 128 * tst[e + 1]; for (int p = lo + C.lane; p < hi; p += 64) inv[p] = -1; }
}
struct UpRow { const bf16* h1; const int* inv; int pos0; __device__ __forceinline__ const bf16* operator()(int r) const { const int p = inv[pos0 + r]; return h1 + (size_t)(p < 0 ? 0 : (p >> 1)) * D; } };
struct UpEpi { bf16* hid; int pos0, hc0;
    __device__ __forceinline__ void operator()(const f32x4 (&acc)[4][4], int wr, int wc, int fr, int fq) const {
#pragma unroll
        for (int m = 0; m < 4; ++m) { const int row = pos0 + 64 * wr + 16 * m + fr;
#pragma unroll
            for (int n2 = 0; n2 < 2; ++n2) { const f32x4 a = acc[m][2 * n2], b = acc[m][2 * n2 + 1]; const int hc = hc0 + 32 * wc + 16 * n2 + 4 * fq;
                mg::u32x2 w; w.x = pk2(silu_(a[0]) * b[0], silu_(a[1]) * b[1]); w.y = pk2(silu_(a[2]) * b[2], silu_(a[3]) * b[3]);
                *(mg::u32x2*)(hid + (size_t)row * 256 + hc) = w; } }
    } };
__device__ __forceinline__ void phase9_up(const Ctx& C) {
    LAS int* tst = (LAS int*)(C.lds + 130048); moe_table(C, tst);
    const int ntile = tst[NE];
    for (int un = C.wg; un < ntile * 2; un += C.G) { const int t = un >> 1, nt = un & 1, e = moe_expert_of(tst, t);
        UpRow rp{(const bf16*)(C.ws + WS_H1), (const int*)(C.ws + WS_INV), 128 * t};
        UpEpi ep{(bf16*)(C.ws + WS_HID), 128 * t, 128 * nt};
        mg::tile(C.lds, rp, (const bf16*)(C.ws + WS_W13) + ((size_t)e * 512 + 256 * nt) * 1024, 1024, ep); }
}
struct DnRow { const bf16* hid; int pos0; __device__ __forceinline__ const bf16* operator()(int r) const { return hid + (size_t)(pos0 + r) * 256; } };
struct DnEpi { bf16* slots; const int* inv; const int* route; int pos0, c0;
    __device__ __forceinline__ void operator()(const f32x4 (&acc)[4][4], int wr, int wc, int fr, int fq) const {
#pragma unroll
        for (int m = 0; m < 4; ++m) { const int p = inv[pos0 + 64 * wr + 16 * m + fr]; if (p < 0) continue;
            const float gt = ((const float*)route)[(size_t)(p >> 1) * 8 + 4 + (p & 1)];
#pragma unroll
            for (int n = 0; n < 4; ++n) { const f32x4 a = acc[m][n] * gt; mg::u32x2 w; w.x = pk2(a[0], a[1]); w.y = pk2(a[2], a[3]);
                *(mg::u32x2*)(slots + (size_t)p * D + c0 + 64 * wc + 16 * n + 4 * fq) = w; } }
    } };
__device__ __forceinline__ void phase10_down(const Ctx& C) {
    LAS int* tst = (LAS int*)(C.lds + 130048); moe_table(C, tst);
    const int ntile = tst[NE];
    for (int un = C.wg; un < ntile * 4; un += C.G) { const int t = un >> 2, nt = un & 3, e = moe_expert_of(tst, t);
        DnRow rp{(const bf16*)(C.ws + WS_HID), 128 * t};
        DnEpi ep{(bf16*)C.out, (const int*)(C.ws + WS_INV), (const int*)(C.ws + WS_ROUTE), 128 * t, 256 * nt};
        mg::tile(C.lds, rp, (const bf16*)(C.ws + WS_W2) + ((size_t)e * 1024 + 256 * nt) * 256, 256, ep); }
}
__device__ __forceinline__ void phase11_final(const Ctx& C) {
    const int gw = C.wg * NWAVES + C.wave, NGW = C.G * NWAVES, lane = C.lane;
    const bf16* h1 = (const bf16*)(C.ws + WS_H1); const bf16* slots = (const bf16*)C.out; const float* g2 = C.in[30]; const float* b2 = C.in[31];
    for (int row = gw; row < MX; row += NGW) {
        f32x4 v[4];
#pragma unroll
        for (int j = 0; j < 4; ++j) { const int c = 4 * lane + 256 * j;
            const mg::u32x2 hw = *(const mg::u32x2*)(h1 + (size_t)row * D + c), s0 = *(const mg::u32x2*)(slots + (size_t)(2 * row) * D + c), s1 = *(const mg::u32x2*)(slots + (size_t)(2 * row + 1) * D + c);
            v[j].x = ALPHA * bflo(hw.x) + bflo(s0.x) + bflo(s1.x); v[j].y = ALPHA * bfhi(hw.x) + bfhi(s0.x) + bfhi(s1.x);
            v[j].z = ALPHA * bflo(hw.y) + bflo(s0.y) + bflo(s1.y); v[j].w = ALPHA * bfhi(hw.y) + bfhi(s0.y) + bfhi(s1.y); }
        float mean, rstd; ln_row(v, g2, b2, lane, 1.f, mean, rstd);
        asm volatile("s_waitcnt vmcnt(0)" ::: "memory");
#pragma unroll
        for (int j = 0; j < 4; ++j) *(f32x4*)(C.out + (size_t)row * D + 4 * lane + 256 * j) = v[j];
    }
}

#ifndef MK_N_LAUNCHES
#define MK_N_LAUNCHES 1
#endif
constexpr int N_PHASES = 12;
struct Args { const float* in[32]; float* out; unsigned char* ws; int ph_lo, ph_hi; };
__global__ void __launch_bounds__(NWAVES * 64, 2) mk_fwd(Args args) {
    extern __shared__ __attribute__((aligned(16))) unsigned char lds[];
    Ctx C;
    C.lds = (LAS unsigned char*)lds; C.tid = threadIdx.x; C.lane = C.tid & 63; C.wave = __builtin_amdgcn_readfirstlane(C.tid >> 6);
    C.wg = blockIdx.x; C.G = gridDim.x; C.in = args.in; C.out = args.out; C.ws = args.ws; C.ctl = (gu32*)(args.ws + WS_CTL);
    volatile LAS unsigned* MISC = (volatile LAS unsigned*)(C.lds + MISC_OFF);
    for (int u = C.tid; u < (LDS_BYTES - LDSCTL_OFF) / 4; u += NWAVES * 64) ((LAS unsigned*)(C.lds + LDSCTL_OFF))[u] = 0u;
    __syncthreads();
    XcdBarrier bar; bar.bar = (unsigned*)(C.ctl + CW_BAR); bar.x = 0; bar.st = nullptr;
    if (MK_N_LAUNCHES == 1) bar = xcd_barrier_post((unsigned*)(C.ctl + CW_BAR), MISC + 8);
    const int lo = args.ph_lo, hi = args.ph_hi;
#define IN(k) (lo <= (k) && (k) < hi)
#define SEAM(k) do { if (IN(k) && IN((k) + 1)) xcd_barrier(bar); } while (0)
    unsigned char* ws = args.ws;
    bf16* H0B = (bf16*)(ws + WS_H0B); bf16* WINT = (bf16*)(ws + WS_WINT);

    if (IN(0)) phase0(C);
    SEAM(0);
    if (IN(1)) {
        pg8::Gemm g{H0B, WINT, MP, INWP, D}; pg8::StaticOrder S; S.init(MP, INWP, C.G, C.wg);
        pg8::EpiProj E{(bf16*)(ws + WS_QKV), (bf16*)(ws + WS_Z), (bf16*)(ws + WS_U), (bf16*)(ws + WS_GATES), (float*)(ws + WS_AB)};
        pg8::gemm_phase<pg8::EpiProj, pg8::StaticOrder, true, true>(C.lds, g, S, E);
    }
    SEAM(1);
    if (IN(2)) phase2_elem(C);
    SEAM(2);
    if (IN(3)) phase3_v1(C);
    SEAM(3);
    if (IN(4)) {
        pg8::Gemm g{(const bf16*)(ws + WS_YB), (const bf16*)(ws + WS_WGLU), MX, 512, 512}; pg8::StaticOrder S; S.init(MX, 512, C.G, C.wg);
        pg8::EpiGlu E{(const bf16*)(ws + WS_YB), C.in[18], (bf16*)(ws + WS_OB)};
        pg8::gemm_phase<pg8::EpiGlu, pg8::StaticOrder, true, true>(C.lds, g, S, E);
    }
    SEAM(4);
    if (IN(5)) {
        { pg8::Gemm g{(const bf16*)(ws + WS_OA), (const bf16*)(ws + WS_WBR), MX, 1024, 512}; pg8::StaticOrder S; S.init(MX, 1024, C.G, C.wg);
          pg8::EpiBr<false> E{(const bf16*)(ws + WS_GATES), nullptr, (bf16*)(ws + WS_TMP)};
          pg8::gemm_phase<pg8::EpiBr<false>, pg8::StaticOrder, true, true>(C.lds, g, S, E); }
        asm volatile("s_waitcnt vmcnt(0)" ::: "memory"); __syncthreads();
        { pg8::Gemm g{(const bf16*)(ws + WS_OB), (const bf16*)(ws + WS_WBR) + 1024 * 512, MX, 1024, 512}; pg8::StaticOrder S; S.init(MX, 1024, C.G, C.wg);
          pg8::EpiBr<true> E{(const bf16*)(ws + WS_GATES), (const bf16*)(ws + WS_TMP), (bf16*)(ws + WS_MERGED)};
          pg8::gemm_phase<pg8::EpiBr<true>, pg8::StaticOrder, true, true>(C.lds, g, S, E); }
    }
    SEAM(5);
    if (IN(6)) {
        pg8::Gemm g{(const bf16*)(ws + WS_MERGED), (const bf16*)(ws + WS_WOUT), MX, 1024, 1024}; pg8::StaticOrder S; S.init(MX, 1024, C.G, C.wg);
        pg8::EpiOut E{C.in[0], (const float*)(ws + WS_STATS), C.in[2], C.in[3], (float*)(ws + WS_PRE)};
        pg8::gemm_phase<pg8::EpiOut, pg8::StaticOrder, true, true>(C.lds, g, S, E);
    }
    SEAM(6);
    if (IN(7)) phase7_rows(C);
    SEAM(7);
    if (IN(8)) phase8_dispatch(C);
    SEAM(8);
    if (IN(9)) phase9_up(C);
    SEAM(9);
    if (IN(10)) phase10_down(C);
    SEAM(10);
    if (IN(11)) phase11_final(C);
#undef IN
#undef SEAM
}

extern "C" void kernel_launch(void* const* d_in, const int* in_sizes, int n_in, void* d_out, int out_size, void* d_ws, size_t ws_size, hipStream_t stream) {
    static int grid = 0;
    if (grid == 0) {
        if (n_in != 32 || in_sizes[0] != MX * D || out_size != MX * D || ws_size < WS_END) { fprintf(stderr, "kernel_launch: unexpected shapes (n_in %d, in0 %d, out %d, ws %zu < %zu); nothing launched\n", n_in, n_in > 0 ? in_sizes[0] : -1, out_size, ws_size, (size_t)WS_END); grid = -1; return; }
        int dev = 0, cus = 0, per_cu = 0;
        if (hipGetDevice(&dev) != hipSuccess || hipDeviceGetAttribute(&cus, hipDeviceAttributeMultiprocessorCount, dev) != hipSuccess) { grid = -1; return; }
        if (hipFuncSetAttribute((const void*)mk_fwd, hipFuncAttributeMaxDynamicSharedMemorySize, LDS_BYTES) != hipSuccess) { fprintf(stderr, "kernel_launch: hipFuncSetAttribute failed\n"); grid = -1; return; }
        if (hipOccupancyMaxActiveBlocksPerMultiprocessor(&per_cu, (const void*)mk_fwd, NWAVES * 64, LDS_BYTES) != hipSuccess || per_cu < 1) fprintf(stderr, "kernel_launch: occupancy query says %d\n", per_cu);
        (void)hipGetLastError();
        grid = cus;
    }
    if (grid < 0) return;
    if (hipMemsetAsync((char*)d_ws + WS_CTL, 0, CTL_ZERO_BYTES, stream) != hipSuccess) { fprintf(stderr, "kernel_launch: hipMemsetAsync failed\n"); return; }
    Args a{};
    for (int i = 0; i < 32; ++i) a.in[i] = (const float*)d_in[i];
    a.out = (float*)d_out; a.ws = (unsigned char*)d_ws;
#if MK_N_LAUNCHES == 1
    a.ph_lo = 0; a.ph_hi = N_PHASES;
    hipLaunchKernelGGL(mk_fwd, dim3(grid), dim3(NWAVES * 64), LDS_BYTES, stream, a);
#else
    for (int p = 0; p < N_PHASES; ++p) { a.ph_lo = p; a.ph_hi = p + 1; hipLaunchKernelGGL(mk_fwd, dim3(grid), dim3(NWAVES * 64), LDS_BYTES, stream, a); }
#endif
    const hipError_t le = hipPeekAtLastError();
    if (le != hipSuccess) fprintf(stderr, "kernel_launch: launch failed: %s\n", hipGetErrorName(le));
}
```

```cpp
#include <hip/hip_runtime.h>
#include <cstdio>
#include <cstdint>
namespace pg8 {
#define PG8_LAS __attribute__((address_space(3)))
typedef unsigned short bf16_t;
typedef short bf16x8 __attribute__((ext_vector_type(8)));
typedef float f32x4 __attribute__((ext_vector_type(4)));
typedef unsigned u32x4 __attribute__((ext_vector_type(4)));
constexpr int BM = 256, BK = 64, HALF = 128, HTB = HALF * BK * 2  , STAGE_BYTES = 8 * HTB, NXCD = 8, WGM = 8;

__host__ __device__ __forceinline__ int lds_byte(int r, int c) { const int st = (r >> 4) * 2 + (c >> 5), rr = r & 15, cc = c & 31, ob = rr * 64 + cc * 2; return st * 1024 + (ob ^ (((ob >> 9) & 1) << 5)); }
__host__ __device__ __forceinline__ void stage_rc(int b, int& R, int& C) { const int st = b / 1024, sb = b % 1024, swz = sb ^ (((sb >> 9) & 1) << 5); R = (st >> 1) * 16 + swz / 64; C = (st & 1) * 32 + (swz % 64) / 2; }
__host__ __device__ __forceinline__ int perm32(int rho) { const int n = rho >> 4, i = rho & 15; return 8 * (i >> 2) + 4 * n + (i & 3); }

struct Unit { int pm, pn; };
struct Gemm { const bf16_t* A; const bf16_t* Bt; int M, N, K; };

struct StaticOrder {
    int nM, nN, nwg, G, c;
    __host__ __device__ void init(int M, int N, int G_, int c_) { nM = M / BM; nN = N / BM; nwg = nM * nN; G = G_; c = c_; }
    __host__ __device__ bool next(int i, Unit& u) const {
        const long L = (long)i * G + c; if (L >= nwg) return false;
        int wgid = (int)L; { const int q = nwg / NXCD, r = nwg % NXCD, xcd = wgid % NXCD, off = wgid / NXCD; wgid = (xcd < r ? xcd * (q + 1) : r * (q + 1) + (xcd - r) * q) + off; }
        const int nig = WGM * nN, gid = wgid / nig, fm = gid * WGM, gsz = (nM - fm) < WGM ? (nM - fm) : WGM;
        u.pm = fm + ((wgid % nig) % gsz); u.pn = (wgid % nig) / gsz; return true;
    }
    __device__ __forceinline__ void a_ready(const Unit&) const {}
    __device__ __forceinline__ void done(const Unit&) const {}
};

__device__ __forceinline__ unsigned cvt_pk_bf16(float lo, float hi) { unsigned r; asm volatile("v_cvt_pk_bf16_f32 %0, %1, %2" : "=v"(r) : "v"(lo), "v"(hi)); return r; }
template <class Epi, class Sched, bool ALIGN_EPI = false, bool SP2 = false>
__device__ __forceinline__ void gemm_phase(PG8_LAS unsigned char* lds, const Gemm g, const Sched& S, const Epi& E) {
    const int tid = threadIdx.x, wid = __builtin_amdgcn_readfirstlane(tid >> 6), lane = tid & 63, wr = wid >> 2, wc = wid & 3, fr = lane & 15, fq = lane >> 4;
    const int K = g.K, nt = K / BK;
    unsigned voffA[2], voffB[2];
#pragma unroll
    for (int i = 0; i < 2; ++i) { int R, C; stage_rc(tid * 16 + i * 8192, R, C); const int Rb = Epi::PERM ? ((R & ~31) + perm32(R & 31)) : R;
        voffA[i] = (unsigned)(R * K + C) * 2u; voffB[i] = (unsigned)(Rb * K + C) * 2u; }
    const size_t kstep = (size_t)(BK * 2);
    const size_t hstep = (size_t)HALF * K * 2;
    const size_t tstep = 2 * hstep;
    const unsigned ldsw = (unsigned)wid * 1024u;
    const int aoff = lds_byte(wr * 64 + fr, fq * 8), boff = lds_byte(wc * 32 + fr, fq * 8);
#define PG8_SA(b, h) (((b) * 2 + (h)) * HTB)
#define PG8_SB(b, h) ((4 + (b) * 2 + (h)) * HTB)
#define PG8_STAGE(bufoff, gbase, voff) do { _Pragma("unroll") for (int _i = 0; _i < 2; ++_i) \
        __builtin_amdgcn_global_load_lds((const unsigned*)((const char*)(gbase) + (voff)[_i]), (PG8_LAS unsigned*)(lds + (bufoff) + ldsw + _i * 8192), 16, 0, 0); } while (0)
#define PG8_LDA(dst, b, h) do { _Pragma("unroll") for (int m = 0; m < 4; ++m) _Pragma("unroll") for (int k = 0; k < 2; ++k) dst[m][k] = *(const PG8_LAS bf16x8*)(lds + PG8_SA(b, h) + aoff + m * 2048 + k * 1024); } while (0)
#define PG8_LDB(dst, b, h) do { _Pragma("unroll") for (int n = 0; n < 2; ++n) _Pragma("unroll") for (int k = 0; k < 2; ++k) dst[n][k] = *(const PG8_LAS bf16x8*)(lds + PG8_SB(b, h) + boff + n * 2048 + k * 1024); } while (0)
#define PG8_MMA(ai, bj, At, Bt) do { __builtin_amdgcn_s_setprio(1); _Pragma("unroll") for (int m = 0; m < 4; ++m) _Pragma("unroll") for (int n = 0; n < 2; ++n) _Pragma("unroll") for (int k = 0; k < 2; ++k) \
        acc[ai][bj][m][n] = __builtin_amdgcn_mfma_f32_16x16x32_bf16(Bt[n][k], At[m][k], acc[ai][bj][m][n], 0, 0, 0); __builtin_amdgcn_s_setprio(0); } while (0)
#define PG8_WAIT_V(n) asm volatile("s_waitcnt vmcnt(" #n ")" ::: "memory")
#define PG8_WAIT_L(n) asm volatile("s_waitcnt lgkmcnt(" #n ")" ::: "memory")
#define PG8_BAR __builtin_amdgcn_s_barrier()
#define PG8_SCHED __builtin_amdgcn_sched_barrier(0)
    Unit cur, nxt; int ui = 0;
    if (!S.next(0, cur)) return;
    f32x4 acc[2][2][4][2];
#pragma unroll
    for (int a = 0; a < 2; ++a)
#pragma unroll
        for (int b = 0; b < 2; ++b)
#pragma unroll
            for (int m = 0; m < 4; ++m)
#pragma unroll
                for (int n = 0; n < 2; ++n) acc[a][b][m][n] = (f32x4){0.f, 0.f, 0.f, 0.f};
    bf16x8 At[4][2], B0[2][2], B1[2][2];
    const char* cA = (const char*)g.A + (size_t)cur.pm * tstep; const char* cB = (const char*)g.Bt + (size_t)cur.pn * tstep;
    S.a_ready(cur);
    if constexpr (SP2) {
        PG8_STAGE(PG8_SB(0, 0), cB, voffB); PG8_STAGE(PG8_SB(0, 1), cB + hstep, voffB); PG8_STAGE(PG8_SA(0, 0), cA, voffA); PG8_STAGE(PG8_SA(0, 1), cA + hstep, voffA);
        if (wr == 1) PG8_BAR;
        PG8_WAIT_V(2); PG8_BAR;
        PG8_STAGE(PG8_SB(1, 0), cB + kstep, voffB); PG8_STAGE(PG8_SA(1, 0), cA + kstep, voffA); PG8_STAGE(PG8_SB(1, 1), cB + hstep + kstep, voffB);
        PG8_WAIT_V(6); PG8_BAR;
    } else {
        PG8_STAGE(PG8_SB(0, 0), cB, voffB); PG8_STAGE(PG8_SA(0, 0), cA, voffA); PG8_STAGE(PG8_SB(0, 1), cB + hstep, voffB); PG8_STAGE(PG8_SA(0, 1), cA + hstep, voffA);
        if (wr == 1) PG8_BAR;
        PG8_WAIT_V(4); PG8_BAR;
        PG8_STAGE(PG8_SB(1, 0), cB + kstep, voffB); PG8_STAGE(PG8_SA(1, 0), cA + kstep, voffA); PG8_STAGE(PG8_SB(1, 1), cB + hstep + kstep, voffB);
        PG8_WAIT_V(6); PG8_BAR;
    }
    for (;;) {
        const bool has_next = S.next(ui + 1, nxt);
        const char* nA = has_next ? (const char*)g.A + (size_t)nxt.pm * tstep : cA; const char* nB = has_next ? (const char*)g.Bt + (size_t)nxt.pn * tstep : cB;
        for (int t = 0; t < nt; t += 2) {
            const bool last = (t == nt - 2);
            const char* a1 = cA + (size_t)(t + 1) * kstep;
            const char* a2 = last ? nA : cA + (size_t)(t + 2) * kstep; const char* b2 = last ? nB : cB + (size_t)(t + 2) * kstep;
            const char* a3 = a2 + kstep; const char* b3 = b2 + kstep;
            if (last && has_next) S.a_ready(nxt);
            if constexpr (SP2) {
            PG8_LDB(B0, 0, 0); PG8_LDB(B1, 0, 1); PG8_SCHED; PG8_LDA(At, 0, 0); PG8_STAGE(PG8_SA(1, 1), a1 + hstep, voffA);
            PG8_WAIT_V(8); PG8_WAIT_L(0); PG8_BAR; PG8_MMA(0, 0, At, B0); PG8_MMA(0, 1, At, B1); PG8_BAR; PG8_SCHED;
            PG8_LDA(At, 0, 1); PG8_STAGE(PG8_SB(0, 0), b2, voffB); PG8_STAGE(PG8_SB(0, 1), b2 + hstep, voffB); PG8_STAGE(PG8_SA(0, 0), a2, voffA);
            PG8_WAIT_V(8); PG8_WAIT_L(0); PG8_BAR; PG8_MMA(1, 0, At, B0); PG8_MMA(1, 1, At, B1); PG8_BAR; PG8_SCHED;
            PG8_LDB(B0, 1, 0); PG8_LDB(B1, 1, 1); PG8_SCHED; PG8_LDA(At, 1, 0); PG8_STAGE(PG8_SA(0, 1), a2 + hstep, voffA);
            PG8_WAIT_V(8); PG8_WAIT_L(0); PG8_BAR; PG8_MMA(0, 0, At, B0); PG8_MMA(0, 1, At, B1); PG8_BAR; PG8_SCHED;
            PG8_LDA(At, 1, 1); PG8_STAGE(PG8_SB(1, 0), b3, voffB); PG8_STAGE(PG8_SB(1, 1), b3 + hstep, voffB); PG8_STAGE(PG8_SA(1, 0), a3, voffA);
            PG8_WAIT_V(8); PG8_WAIT_L(0); PG8_BAR; PG8_MMA(1, 0, At, B0); PG8_MMA(1, 1, At, B1); PG8_BAR; PG8_SCHED;
            } else {
            PG8_LDB(B0, 0, 0); PG8_SCHED; PG8_LDA(At, 0, 0); PG8_STAGE(PG8_SA(1, 1), a1 + hstep, voffA);
            PG8_WAIT_L(8); PG8_BAR; PG8_WAIT_L(0); PG8_MMA(0, 0, At, B0); PG8_BAR; PG8_SCHED;
            PG8_LDB(B1, 0, 1); PG8_STAGE(PG8_SB(0, 0), b2, voffB);
            PG8_BAR; PG8_WAIT_L(0); PG8_MMA(0, 1, At, B1); PG8_BAR;
            PG8_LDA(At, 0, 1); PG8_STAGE(PG8_SA(0, 0), a2, voffA);
            PG8_BAR; PG8_WAIT_L(0); PG8_MMA(1, 0, At, B0); PG8_BAR; PG8_SCHED;
            PG8_STAGE(PG8_SB(0, 1), b2 + hstep, voffB);
            PG8_WAIT_V(6); PG8_BAR; PG8_MMA(1, 1, At, B1); PG8_BAR;
            PG8_LDB(B0, 1, 0); PG8_SCHED; PG8_LDA(At, 1, 0); PG8_STAGE(PG8_SA(0, 1), a2 + hstep, voffA);
            PG8_WAIT_L(8); PG8_BAR; PG8_WAIT_L(0); PG8_MMA(0, 0, At, B0); PG8_BAR; PG8_SCHED;
            PG8_LDB(B1, 1, 1); PG8_STAGE(PG8_SB(1, 0), b3, voffB);
            PG8_BAR; PG8_WAIT_L(0); PG8_MMA(0, 1, At, B1); PG8_BAR;
            PG8_LDA(At, 1, 1); PG8_STAGE(PG8_SA(1, 0), a3, voffA);
            PG8_BAR; PG8_WAIT_L(0); PG8_MMA(1, 0, At, B0); PG8_BAR; PG8_SCHED;
            PG8_STAGE(PG8_SB(1, 1), b3 + hstep, voffB);
            PG8_WAIT_V(6); PG8_BAR; PG8_MMA(1, 1, At, B1); PG8_BAR;
            }
        }
        if constexpr (ALIGN_EPI) { if (wr == 0) PG8_BAR; }
        if constexpr (!Epi::AFTER_DRAIN) { E(acc, cur, wr, wc, fr, fq); S.done(cur); }
        if (!has_next) break;
#pragma unroll
        for (int a = 0; a < 2; ++a)
#pragma unroll
            for (int b = 0; b < 2; ++b)
#pragma unroll
                for (int m = 0; m < 4; ++m)
#pragma unroll
                    for (int n = 0; n < 2; ++n) acc[a][b][m][n] = (f32x4){0.f, 0.f, 0.f, 0.f};
        cur = nxt; cA = nA; cB = nB; ++ui;
        if constexpr (ALIGN_EPI) { if (wr == 1) PG8_BAR; }
    }
    PG8_WAIT_V(0);
    if constexpr (!ALIGN_EPI) { if (wr == 0) PG8_BAR; }
    PG8_BAR;
    if constexpr (Epi::AFTER_DRAIN) { E.fused(acc, cur, wr, wc, fr, fq, lds, wid, lane); S.done(cur); }
#undef PG8_SA
#undef PG8_SB
#undef PG8_STAGE
#undef PG8_LDA
#undef PG8_LDB
#undef PG8_MMA
#undef PG8_WAIT_V
#undef PG8_WAIT_L
#undef PG8_BAR
#undef PG8_SCHED
}
}
#define GAS __attribute__((address_space(1)))
#define LAS __attribute__((address_space(3)))
typedef unsigned short bf16;
typedef unsigned v4u __attribute__((ext_vector_type(4)));
typedef float f32x4 __attribute__((ext_vector_type(4)));
typedef short bf16x8 __attribute__((ext_vector_type(8)));
typedef GAS unsigned gu32;
typedef GAS unsigned long long gu64;
#define RLX_AGENT __ATOMIC_RELAXED, __HIP_MEMORY_SCOPE_AGENT
#define LDS_WAIT() asm volatile("s_waitcnt lgkmcnt(0)" ::: "memory")
#define VM_WAIT() asm volatile("s_waitcnt vmcnt(0)" ::: "memory")
__device__ __forceinline__ unsigned long long rt() { return __builtin_amdgcn_s_memrealtime(); }
typedef __bf16 hwbf16x2 __attribute__((ext_vector_type(2)));
typedef float hwf32x2 __attribute__((ext_vector_type(2)));
__device__ __forceinline__ unsigned pk2(float lo, float hi) { return __builtin_bit_cast(unsigned, __builtin_convertvector((hwf32x2){lo, hi}, hwbf16x2)); }
__device__ __forceinline__ unsigned f2bf(float f) { return pk2(f, 0.f) & 0xffffu; }

#define XB_TMO      128
#define XB_XCNT(j)  (256  + 64 * (j))
#define XB_XSUB(j)  (1280 + 64 * (j))
#define XB_XGEN(j)  (2304 + 64 * (j))
#define XB_TOP      3328
#define XB_TOPGEN   3392
#define XCD_BAR_WORDS 3456
#define XB_SPIN_CAP (1u << 18)

__device__ __forceinline__ unsigned xb_ld(unsigned* p)              { return __hip_atomic_load(p, __ATOMIC_RELAXED, __HIP_MEMORY_SCOPE_AGENT); }
__device__ __forceinline__ unsigned xb_add(unsigned* p, unsigned v) { return __hip_atomic_fetch_add(p, v, __ATOMIC_RELAXED, __HIP_MEMORY_SCOPE_AGENT); }
__device__ __forceinline__ unsigned xb_xcc_id() { return (unsigned)__builtin_amdgcn_s_getreg((3 << 11) | 20) & 0xFu; }
#define XB_SPIN(cond, bar) do { unsigned _sp = 0; while (cond) { __builtin_amdgcn_s_sleep(1); \
    if ((++_sp & 255u) == 0u) { if (xb_ld(&(bar)[XB_TMO])) break; if (_sp > XB_SPIN_CAP) { atomicAdd(&(bar)[XB_TMO], 1u); break; } } } } while (0)

struct XcdBarrier {
    unsigned* bar; unsigned x;
    volatile LAS unsigned* st;
};

__device__ __forceinline__ XcdBarrier xcd_barrier_post(unsigned* bar, volatile LAS unsigned* st) {
    XcdBarrier b; b.bar = bar; b.x = xb_xcc_id(); b.st = st;
    if (threadIdx.x == 0) (void)xb_add(&bar[XB_XCNT(b.x)], 1u);
    return b;
}
__device__ __forceinline__ void xcd_barrier_complete(unsigned* bar, unsigned x, unsigned& nloc, unsigned& nx) {
    const unsigned G = gridDim.x * gridDim.y * gridDim.z;
    unsigned sum, cnt, mine, sp = 0u;
    for (;;) {
        sum = 0u; cnt = 0u; mine = 0u;
#pragma unroll
        for (unsigned j = 0; j < 16; ++j) { const unsigned c = xb_ld(&bar[XB_XCNT(j)]); sum += c; cnt += (c > 0u) ? 1u : 0u; mine = (j == x) ? c : mine; }
        if (sum == G) break;
        __builtin_amdgcn_s_sleep(1);
        if ((++sp & 255u) == 0u) { if (xb_ld(&bar[XB_TMO])) break; if (sp > XB_SPIN_CAP) { atomicAdd(&bar[XB_TMO], 1u); break; } }
    }
    nloc = mine > 0u ? mine : 1u; nx = cnt > 0u ? cnt : 1u;
}

__device__ __forceinline__ void xcd_barrier(const XcdBarrier& b) {
    asm volatile("s_waitcnt vmcnt(0)" ::: "memory");
    __syncthreads();
    if (threadIdx.x == 0) {
        unsigned* bar = b.bar;
        __builtin_amdgcn_s_waitcnt(0);
        unsigned nloc = b.st[0], nx = b.st[1];
        if (nloc == 0u) { xcd_barrier_complete(bar, b.x, nloc, nx); b.st[0] = nloc; b.st[1] = nx; }
        const unsigned old = xb_add(&bar[XB_XSUB(b.x)], 1u);
        const unsigned gen = old / nloc;
        if (old + 1u == (gen + 1u) * nloc) {
            __builtin_amdgcn_fence(__ATOMIC_RELEASE, "agent");
            asm volatile("s_waitcnt vmcnt(0)" ::: "memory");
            const unsigned og = xb_add(&bar[XB_TOP], 1u);
            const unsigned tg = og / nx;
            if (og + 1u == (tg + 1u) * nx) xb_add(&bar[XB_TOPGEN], 1u);
            else XB_SPIN(xb_ld(&bar[XB_TOPGEN]) == tg, bar);
            __builtin_amdgcn_fence(__ATOMIC_ACQUIRE, "agent");
            xb_add(&bar[XB_XGEN(b.x)], 1u);
            asm volatile("s_waitcnt vmcnt(0)" ::: "memory");
        } else {
            XB_SPIN(xb_ld(&bar[XB_XGEN(b.x)]) == gen, bar);
            __builtin_amdgcn_fence(__ATOMIC_ACQUIRE, "agent");
            asm volatile("s_waitcnt vmcnt(0)" ::: "memory");
        }
    }
    __syncthreads();
}
namespace pg8 {
struct Gemm2 { const bf16_t* A1; const bf16_t* B1; const bf16_t* A2; const bf16_t* B2; int M, N, Kseg; };
template <class Epi, class Sched, bool ALIGN_EPI = false>
__device__ __forceinline__ void gemm_phase2seg(PG8_LAS unsigned char* lds, const Gemm2 g, const Sched& S, const Epi& E) {
    constexpr bool SP2 = true;
    const int tid = threadIdx.x, wid = __builtin_amdgcn_readfirstlane(tid >> 6), lane = tid & 63, wr = wid >> 2, wc = wid & 3, fr = lane & 15, fq = lane >> 4;
    const int K = g.Kseg, half = K / BK, nt = 2 * half;
    unsigned voffA[2], voffB[2];
#pragma unroll
    for (int i = 0; i < 2; ++i) { int R, C; stage_rc(tid * 16 + i * 8192, R, C); const int Rb = Epi::PERM ? ((R & ~31) + perm32(R & 31)) : R;
        voffA[i] = (unsigned)(R * K + C) * 2u; voffB[i] = (unsigned)(Rb * K + C) * 2u; }
    const size_t kstep = (size_t)(BK * 2);
    const size_t hstep = (size_t)HALF * K * 2;
    const size_t tstep = 2 * hstep;
    const unsigned ldsw = (unsigned)wid * 1024u;
    const int aoff = lds_byte(wr * 64 + fr, fq * 8), boff = lds_byte(wc * 32 + fr, fq * 8);
#define PG8_SA(b, h) (((b) * 2 + (h)) * HTB)
#define PG8_SB(b, h) ((4 + (b) * 2 + (h)) * HTB)
#define PG8_STAGE(bufoff, gbase, voff) do { _Pragma("unroll") for (int _i = 0; _i < 2; ++_i) \
        __builtin_amdgcn_global_load_lds((const unsigned*)((const char*)(gbase) + (voff)[_i]), (PG8_LAS unsigned*)(lds + (bufoff) + ldsw + _i * 8192), 16, 0, 0); } while (0)
#define PG8_LDA(dst, b, h) do { _Pragma("unroll") for (int m = 0; m < 4; ++m) _Pragma("unroll") for (int k = 0; k < 2; ++k) dst[m][k] = *(const PG8_LAS bf16x8*)(lds + PG8_SA(b, h) + aoff + m * 2048 + k * 1024); } while (0)
#define PG8_LDB(dst, b, h) do { _Pragma("unroll") for (int n = 0; n < 2; ++n) _Pragma("unroll") for (int k = 0; k < 2; ++k) dst[n][k] = *(const PG8_LAS bf16x8*)(lds + PG8_SB(b, h) + boff + n * 2048 + k * 1024); } while (0)
#define PG8_MMA(ai, bj, At, Bt) do { __builtin_amdgcn_s_setprio(1); _Pragma("unroll") for (int m = 0; m < 4; ++m) _Pragma("unroll") for (int n = 0; n < 2; ++n) _Pragma("unroll") for (int k = 0; k < 2; ++k) \
        acc[ai][bj][m][n] = __builtin_amdgcn_mfma_f32_16x16x32_bf16(Bt[n][k], At[m][k], acc[ai][bj][m][n], 0, 0, 0); __builtin_amdgcn_s_setprio(0); } while (0)
#define PG8_WAIT_V(n) asm volatile("s_waitcnt vmcnt(" #n ")" ::: "memory")
#define PG8_WAIT_L(n) asm volatile("s_waitcnt lgkmcnt(" #n ")" ::: "memory")
#define PG8_BAR __builtin_amdgcn_s_barrier()
#define PG8_SCHED __builtin_amdgcn_sched_barrier(0)
    Unit cur, nxt; int ui = 0;
    if (!S.next(0, cur)) return;
    f32x4 acc[2][2][4][2];
#pragma unroll
    for (int a = 0; a < 2; ++a)
#pragma unroll
        for (int b = 0; b < 2; ++b)
#pragma unroll
            for (int m = 0; m < 4; ++m)
#pragma unroll
                for (int n = 0; n < 2; ++n) acc[a][b][m][n] = (f32x4){0.f, 0.f, 0.f, 0.f};
    bf16x8 At[4][2], B0[2][2], B1[2][2];
    const char* cA = (const char*)g.A1 + (size_t)cur.pm * tstep; const char* cB = (const char*)g.B1 + (size_t)cur.pn * tstep;
    const char* cA2 = (const char*)g.A2 + (size_t)cur.pm * tstep; const char* cB2 = (const char*)g.B2 + (size_t)cur.pn * tstep;
    S.a_ready(cur);
    if constexpr (SP2) {
        PG8_STAGE(PG8_SB(0, 0), cB, voffB); PG8_STAGE(PG8_SB(0, 1), cB + hstep, voffB); PG8_STAGE(PG8_SA(0, 0), cA, voffA); PG8_STAGE(PG8_SA(0, 1), cA + hstep, voffA);
        if (wr == 1) PG8_BAR;
        PG8_WAIT_V(2); PG8_BAR;
        PG8_STAGE(PG8_SB(1, 0), cB + kstep, voffB); PG8_STAGE(PG8_SA(1, 0), cA + kstep, voffA); PG8_STAGE(PG8_SB(1, 1), cB + hstep + kstep, voffB);
        PG8_WAIT_V(6); PG8_BAR;
    } else {
        PG8_STAGE(PG8_SB(0, 0), cB, voffB); PG8_STAGE(PG8_SA(0, 0), cA, voffA); PG8_STAGE(PG8_SB(0, 1), cB + hstep, voffB); PG8_STAGE(PG8_SA(0, 1), cA + hstep, voffA);
        if (wr == 1) PG8_BAR;
        PG8_WAIT_V(4); PG8_BAR;
        PG8_STAGE(PG8_SB(1, 0), cB + kstep, voffB); PG8_STAGE(PG8_SA(1, 0), cA + kstep, voffA); PG8_STAGE(PG8_SB(1, 1), cB + hstep + kstep, voffB);
        PG8_WAIT_V(6); PG8_BAR;
    }
    for (;;) {
        const bool has_next = S.next(ui + 1, nxt);
        const char* nA = has_next ? (const char*)g.A1 + (size_t)nxt.pm * tstep : cA; const char* nB = has_next ? (const char*)g.B1 + (size_t)nxt.pn * tstep : cB;
        for (int t = 0; t < nt; t += 2) {
            const bool last = (t == nt - 2);
            if (t == half) E.mid(acc, cur, wr, wc, fr, fq);
            const char* a1 = (t + 1 < half) ? cA + (size_t)(t + 1) * kstep : cA2 + (size_t)(t + 1 - half) * kstep;
            const char* a2 = last ? nA : ((t + 2 < half) ? cA + (size_t)(t + 2) * kstep : cA2 + (size_t)(t + 2 - half) * kstep);
            const char* b2 = last ? nB : ((t + 2 < half) ? cB + (size_t)(t + 2) * kstep : cB2 + (size_t)(t + 2 - half) * kstep);
            const char* a3 = a2 + kstep; const char* b3 = b2 + kstep;
            if (last && has_next) S.a_ready(nxt);
            if constexpr (SP2) {
            PG8_LDB(B0, 0, 0); PG8_LDB(B1, 0, 1); PG8_SCHED; PG8_LDA(At, 0, 0); PG8_STAGE(PG8_SA(1, 1), a1 + hstep, voffA);
            PG8_WAIT_V(8); PG8_WAIT_L(0); PG8_BAR; PG8_MMA(0, 0, At, B0); PG8_MMA(0, 1, At, B1); PG8_BAR; PG8_SCHED;
            PG8_LDA(At, 0, 1); PG8_STAGE(PG8_SB(0, 0), b2, voffB); PG8_STAGE(PG8_SB(0, 1), b2 + hstep, voffB); PG8_STAGE(PG8_SA(0, 0), a2, voffA);
            PG8_WAIT_V(8); PG8_WAIT_L(0); PG8_BAR; PG8_MMA(1, 0, At, B0); PG8_MMA(1, 1, At, B1); PG8_BAR; PG8_SCHED;
            PG8_LDB(B0, 1, 0); PG8_LDB(B1, 1, 1); PG8_SCHED; PG8_LDA(At, 1, 0); PG8_STAGE(PG8_SA(0, 1), a2 + hstep, voffA);
            PG8_WAIT_V(8); PG8_WAIT_L(0); PG8_BAR; PG8_MMA(0, 0, At, B0); PG8_MMA(0, 1, At, B1); PG8_BAR; PG8_SCHED;
            PG8_LDA(At, 1, 1); PG8_STAGE(PG8_SB(1, 0), b3, voffB); PG8_STAGE(PG8_SB(1, 1), b3 + hstep, voffB); PG8_STAGE(PG8_SA(1, 0), a3, voffA);
            PG8_WAIT_V(8); PG8_WAIT_L(0); PG8_BAR; PG8_MMA(1, 0, At, B0); PG8_MMA(1, 1, At, B1); PG8_BAR; PG8_SCHED;
            } else {
            PG8_LDB(B0, 0, 0); PG8_SCHED; PG8_LDA(At, 0, 0); PG8_STAGE(PG8_SA(1, 1), a1 + hstep, voffA);
            PG8_WAIT_L(8); PG8_BAR; PG8_WAIT_L(0); PG8_MMA(0, 0, At, B0); PG8_BAR; PG8_SCHED;
            PG8_LDB(B1, 0, 1); PG8_STAGE(PG8_SB(0, 0), b2, voffB);
            PG8_BAR; PG8_WAIT_L(0); PG8_MMA(0, 1, At, B1); PG8_BAR;
            PG8_LDA(At, 0, 1); PG8_STAGE(PG8_SA(0, 0), a2, voffA);
            PG8_BAR; PG8_WAIT_L(0); PG8_MMA(1, 0, At, B0); PG8_BAR; PG8_SCHED;
            PG8_STAGE(PG8_SB(0, 1), b2 + hstep, voffB);
            PG8_WAIT_V(6); PG8_BAR; PG8_MMA(1, 1, At, B1); PG8_BAR;
            PG8_LDB(B0, 1, 0); PG8_SCHED; PG8_LDA(At, 1, 0); PG8_STAGE(PG8_SA(0, 1), a2 + hstep, voffA);
            PG8_WAIT_L(8); PG8_BAR; PG8_WAIT_L(0); PG8_MMA(0, 0, At, B0); PG8_BAR; PG8_SCHED;
            PG8_LDB(B1, 1, 1); PG8_STAGE(PG8_SB(1, 0), b3, voffB);
            PG8_BAR; PG8_WAIT_L(0); PG8_MMA(0, 1, At, B1); PG8_BAR;
            PG8_LDA(At, 1, 1); PG8_STAGE(PG8_SA(1, 0), a3, voffA);
            PG8_BAR; PG8_WAIT_L(0); PG8_MMA(1, 0, At, B0); PG8_BAR; PG8_SCHED;
            PG8_STAGE(PG8_SB(1, 1), b3 + hstep, voffB);
            PG8_WAIT_V(6); PG8_BAR; PG8_MMA(1, 1, At, B1); PG8_BAR;
            }
        }
        if constexpr (ALIGN_EPI) { if (wr == 0) PG8_BAR; }
        if constexpr (!Epi::AFTER_DRAIN) { E(acc, cur, wr, wc, fr, fq); S.done(cur); }
        if (!has_next) break;
#pragma unroll
        for (int a = 0; a < 2; ++a)
#pragma unroll
            for (int b = 0; b < 2; ++b)
#pragma unroll
                for (int m = 0; m < 4; ++m)
#pragma unroll
                    for (int n = 0; n < 2; ++n) acc[a][b][m][n] = (f32x4){0.f, 0.f, 0.f, 0.f};
        cur = nxt; cA = nA; cB = nB; cA2 = (const char*)g.A2 + (size_t)cur.pm * tstep; cB2 = (const char*)g.B2 + (size_t)cur.pn * tstep; ++ui;
        if constexpr (ALIGN_EPI) { if (wr == 1) PG8_BAR; }
    }
    PG8_WAIT_V(0);
    if constexpr (!ALIGN_EPI) { if (wr == 0) PG8_BAR; }
    PG8_BAR;
    if constexpr (Epi::AFTER_DRAIN) { E.fused(acc, cur, wr, wc, fr, fq, lds, wid, lane); S.done(cur); }
#undef PG8_SA
#undef PG8_SB
#undef PG8_STAGE
#undef PG8_LDA
#undef PG8_LDB
#undef PG8_MMA
#undef PG8_WAIT_V
#undef PG8_WAIT_L
#undef PG8_BAR
#undef PG8_SCHED
}
}

constexpr int NWAVES = 8;
constexpr int D = 1024, NB = 4, SEQ = 4096, PADF = 48, LP = 4160, NCH = 65, MP = NB * LP  , MX = NB * SEQ  ;
constexpr int INW = 4624, INWP = 4864, NH = 8, SG = 32;
constexpr int NE = 64;
constexpr float LN_EPS = 1e-5f, NORM_EPS = 1e-6f, ALPHA = 1.189207115002721f;

constexpr size_t MiB = 1u << 20;
constexpr size_t WS_CTL = 0, CTL_ZERO_BYTES = 512 * 1024;
constexpr size_t WS_STATS = 1 * MiB;
constexpr size_t WS_ROUTE = WS_STATS + 128 * 1024;
constexpr size_t WS_INV = WS_ROUTE + 512 * 1024;
constexpr size_t WS_WRT = WS_INV + 192 * 1024;
constexpr size_t WS_AB = 2 * MiB;
constexpr size_t WS_WGLU = 3 * MiB + 512 * 1024;
constexpr size_t WS_WBR = WS_WGLU + 512 * 1024;
constexpr size_t WS_WOUT = WS_WBR + 2 * MiB;
constexpr size_t WS_W13 = 8 * MiB;
constexpr size_t WS_W2 = WS_W13 + 64 * MiB;
constexpr size_t WS_WINT = 8 * MiB;
constexpr size_t WS_H0B = WS_WINT + (size_t)INWP * D * 2;
constexpr size_t WS_QKV = WS_H0B + (size_t)MP * D * 2;
static_assert(WS_QKV + (size_t)MP * 1536 * 2 <= 104 * MiB, "overlay");
constexpr size_t WS_Z = 104 * MiB;
constexpr size_t WS_U = WS_Z + (size_t)MP * 512 * 2;
constexpr size_t WS_GATES = WS_U + (size_t)MP * 512 * 2;
constexpr size_t WS_OA = WS_GATES + (size_t)MP * 2048 * 2;
constexpr size_t WS_YB = WS_OA + 16 * MiB;
constexpr size_t WS_OB = WS_YB + 16 * MiB;
constexpr size_t WS_MERGED = WS_OB + 16 * MiB;
constexpr size_t WS_END = WS_MERGED + 32 * MiB;
static_assert(WS_END <= 283 * MiB, "d_ws map");
constexpr size_t WS_TMP = WS_Z;
constexpr size_t WS_PRE = WS_GATES;
constexpr size_t WS_H1 = WS_Z;
constexpr size_t WS_INV2 = WS_OB;
constexpr size_t WS_HID = WS_OA;
static_assert(WS_TMP + 32 * MiB <= WS_GATES && WS_PRE + 64 * MiB <= WS_OA, "overlays");
constexpr size_t DO_QN = 0, DO_KN = (size_t)MP * 512 * 2, DO_VN = 2 * DO_KN, DO_BETA = 3 * DO_KN, DO_ALPHA = DO_BETA + (size_t)MP * 8 * 4;
constexpr int CW_BAR = 4096, CW_CNT = 65536, CNT_STRIDE = 1024;
constexpr int RING_BYTES = 131072, LDS_BYTES = 163840, LDSCTL_OFF = LDS_BYTES - 1024, MISC_OFF = LDSCTL_OFF + 320;

__device__ __forceinline__ float bf2f(unsigned short h) { return __builtin_bit_cast(float, (unsigned)h << 16); }
__device__ __forceinline__ float bflo(unsigned w) { return __builtin_bit_cast(float, w << 16); }
__device__ __forceinline__ float bfhi(unsigned w) { return __builtin_bit_cast(float, w & 0xffff0000u); }
__device__ __forceinline__ float sigm(float x) { return __builtin_amdgcn_rcpf(1.f + __expf(-x)); }
__device__ __forceinline__ float silu_(float x) { return x * sigm(x); }
__device__ __forceinline__ float softplus_(float x) { return x > 20.f ? x : log1pf(expf(x)); }
__device__ __forceinline__ float gelu_tanh(float x) { const float u = 0.7978845608028654f * (x + 0.044715f * x * x * x); return 0.5f * x * (1.f + tanhf(u)); }
__device__ __forceinline__ float wave_sum(float v) {
#pragma unroll
    for (int o = 1; o < 64; o <<= 1) v += __shfl_xor(v, o);
    return v;
}
__device__ __forceinline__ int prow_of(int xrow) { return (xrow >> 12) * LP + 64 + (xrow & 4095); }

namespace pg8 {
struct EpiProj {
    static constexpr bool PERM = true, AFTER_DRAIN = false;
    bf16_t *qkv, *z, *u, *gates; float* ab;
    __device__ __forceinline__ void operator()(const f32x4 (&acc)[2][2][4][2], const Unit& un, int wr, int wc, int fr, int fq) const {
        const int pn = un.pn; bf16_t* base; int ld, cb;
        if (pn < 6) { base = qkv; ld = 1536; cb = pn * 256; }
        else if (pn < 8) { base = z; ld = 512; cb = (pn - 6) * 256; }
        else if (pn < 10) {
            const int row0u = un.pm * BM + wr * 64 + fr, c0u = (pn - 8) * 256 + wc * 32 + 8 * fq;
#pragma unroll
            for (int ai = 0; ai < 2; ++ai)
#pragma unroll
                for (int m = 0; m < 4; ++m)
#pragma unroll
                    for (int bj = 0; bj < 2; ++bj) { const int col = c0u + bj * HALF, row = row0u + ai * HALF + m * 16; const f32x4 v0 = acc[ai][bj][m][0], v1 = acc[ai][bj][m][1]; u32x4 w;
                        w.x = cvt_pk_bf16(v0[0], v0[1]); w.y = cvt_pk_bf16(v0[2], v0[3]); w.z = cvt_pk_bf16(v1[0], v1[1]); w.w = cvt_pk_bf16(v1[2], v1[3]);
                        *(u32x4*)(u + ((size_t)(col >> 4) * MP + row) * 16 + (col & 15)) = w; }
            return; }
        else if (pn < 18) { base = gates; ld = 2048; cb = (pn - 10) * 256; }
        else {
            if (wc == 0 && fq < 2) {
#pragma unroll
                for (int ai = 0; ai < 2; ++ai)
#pragma unroll
                    for (int m = 0; m < 4; ++m) { const int row = un.pm * BM + ai * HALF + wr * 64 + m * 16 + fr; float* p = ab + (size_t)row * 16 + 8 * fq;
                        *(f32x4*)p = acc[ai][0][m][0]; *(f32x4*)(p + 4) = acc[ai][0][m][1]; }
            }
            return;
        }
        const int row0 = un.pm * BM + wr * 64 + fr, col0 = cb + wc * 32 + 8 * fq;
#pragma unroll
        for (int ai = 0; ai < 2; ++ai)
#pragma unroll
            for (int m = 0; m < 4; ++m) { bf16_t* rowp = base + (size_t)(row0 + ai * HALF + m * 16) * ld + col0;
#pragma unroll
                for (int bj = 0; bj < 2; ++bj) { const f32x4 v0 = acc[ai][bj][m][0], v1 = acc[ai][bj][m][1]; u32x4 w;
                    w.x = cvt_pk_bf16(v0[0], v0[1]); w.y = cvt_pk_bf16(v0[2], v0[3]); w.z = cvt_pk_bf16(v1[0], v1[1]); w.w = cvt_pk_bf16(v1[2], v1[3]);
                    *(u32x4*)(rowp + bj * HALF) = w; } }
    }
};
struct EpiGlu {
    static constexpr bool PERM = true, AFTER_DRAIN = false;
    const bf16_t* yb; const float* bglu; bf16_t* ob;
    __device__ __forceinline__ void operator()(const f32x4 (&acc)[2][2][4][2], const Unit& un, int wr, int wc, int fr, int fq) const {
        const int row0 = un.pm * BM + wr * 64 + fr, col0 = un.pn * BM + wc * 32 + 8 * fq;
#pragma unroll
        for (int bj = 0; bj < 2; ++bj) { const int col = col0 + bj * HALF; const f32x4 b0 = *(const f32x4*)(bglu + col), b1 = *(const f32x4*)(bglu + col + 4);
#pragma unroll
            for (int ai = 0; ai < 2; ++ai)
#pragma unroll
                for (int m = 0; m < 4; ++m) { const size_t off = (size_t)(row0 + ai * HALF + m * 16) * 512 + col; const u32x4 y = *(const u32x4*)(yb + off);
                    const f32x4 v0 = acc[ai][bj][m][0] + b0, v1 = acc[ai][bj][m][1] + b1; u32x4 w;
                    w.x = cvt_pk_bf16(bflo(y.x) * sigm(v0[0]), bfhi(y.x) * sigm(v0[1])); w.y = cvt_pk_bf16(bflo(y.y) * sigm(v0[2]), bfhi(y.y) * sigm(v0[3]));
                    w.z = cvt_pk_bf16(bflo(y.z) * sigm(v1[0]), bfhi(y.z) * sigm(v1[1])); w.w = cvt_pk_bf16(bflo(y.w) * sigm(v1[2]), bfhi(y.w) * sigm(v1[3]));
                    *(u32x4*)(ob + off) = w; } }
    }
};
template <bool SECOND> struct EpiBr {
    static constexpr bool PERM = true, AFTER_DRAIN = false;
    const bf16_t* gates; const bf16_t* tin; bf16_t* out;
    __device__ __forceinline__ void operator()(const f32x4 (&acc)[2][2][4][2], const Unit& un, int wr, int wc, int fr, int fq) const {
        const int row0 = un.pm * BM + wr * 64 + fr, col0 = un.pn * BM + wc * 32 + 8 * fq;
#pragma unroll
        for (int ai = 0; ai < 2; ++ai)
#pragma unroll
            for (int m = 0; m < 4; ++m) { const int row = row0 + ai * HALF + m * 16; const size_t goff = (size_t)prow_of(row) * 2048 + (SECOND ? 1024 : 0) + col0, off = (size_t)row * 1024 + col0;
#pragma unroll
                for (int bj = 0; bj < 2; ++bj) { const u32x4 g = *(const u32x4*)(gates + goff + bj * HALF); const f32x4 v0 = acc[ai][bj][m][0], v1 = acc[ai][bj][m][1];
                    float r[8] = { sigm(bflo(g.x)) * v0[0], sigm(bfhi(g.x)) * v0[1], sigm(bflo(g.y)) * v0[2], sigm(bfhi(g.y)) * v0[3],
                                   sigm(bflo(g.z)) * v1[0], sigm(bfhi(g.z)) * v1[1], sigm(bflo(g.w)) * v1[2], sigm(bfhi(g.w)) * v1[3] };
                    if (SECOND) { const u32x4 t = *(const u32x4*)(tin + off + bj * HALF);
                        r[0] += bflo(t.x); r[1] += bfhi(t.x); r[2] += bflo(t.y); r[3] += bfhi(t.y); r[4] += bflo(t.z); r[5] += bfhi(t.z); r[6] += bflo(t.w); r[7] += bfhi(t.w); }
                    u32x4 w; w.x = cvt_pk_bf16(r[0], r[1]); w.y = cvt_pk_bf16(r[2], r[3]); w.z = cvt_pk_bf16(r[4], r[5]); w.w = cvt_pk_bf16(r[6], r[7]);
                    *(u32x4*)(out + off + bj * HALF) = w; } }
    }
};
struct EpiBrFused {
    static constexpr bool PERM = true, AFTER_DRAIN = false;
    const bf16_t* gates; bf16_t* out;
    __device__ __forceinline__ void mid(f32x4 (&acc)[2][2][4][2], const Unit& un, int wr, int wc, int fr, int fq) const {
        const int row0 = un.pm * BM + wr * 64 + fr, col0 = un.pn * BM + wc * 32 + 8 * fq;
#pragma unroll
        for (int ai = 0; ai < 2; ++ai)
#pragma unroll
            for (int m = 0; m < 4; ++m) { const int row = row0 + ai * HALF + m * 16; const size_t goff = (size_t)prow_of(row) * 2048 + col0;
#pragma unroll
                for (int bj = 0; bj < 2; ++bj) { const u32x4 ga = *(const u32x4*)(gates + goff + bj * HALF), gb = *(const u32x4*)(gates + goff + 1024 + bj * HALF);
                    const float ea[8] = {bflo(ga.x), bfhi(ga.x), bflo(ga.y), bfhi(ga.y), bflo(ga.z), bfhi(ga.z), bflo(ga.w), bfhi(ga.w)};
                    const float eb[8] = {bflo(gb.x), bfhi(gb.x), bflo(gb.y), bfhi(gb.y), bflo(gb.z), bfhi(gb.z), bflo(gb.w), bfhi(gb.w)};
#pragma unroll
                    for (int e = 0; e < 8; ++e) { const float r = (1.f + __expf(-eb[e])) * __builtin_amdgcn_rcpf(1.f + __expf(-ea[e])); acc[ai][bj][m][e >> 2][e & 3] *= r; } } }
    }
    __device__ __forceinline__ void operator()(const f32x4 (&acc)[2][2][4][2], const Unit& un, int wr, int wc, int fr, int fq) const {
        const int row0 = un.pm * BM + wr * 64 + fr, col0 = un.pn * BM + wc * 32 + 8 * fq;
#pragma unroll
        for (int ai = 0; ai < 2; ++ai)
#pragma unroll
            for (int m = 0; m < 4; ++m) { const int row = row0 + ai * HALF + m * 16; const size_t goff = (size_t)prow_of(row) * 2048 + 1024 + col0, off = (size_t)row * 1024 + col0;
#pragma unroll
                for (int bj = 0; bj < 2; ++bj) { const u32x4 g = *(const u32x4*)(gates + goff + bj * HALF); const f32x4 v0 = acc[ai][bj][m][0], v1 = acc[ai][bj][m][1];
                    u32x4 w; w.x = cvt_pk_bf16(sigm(bflo(g.x)) * v0[0], sigm(bfhi(g.x)) * v0[1]); w.y = cvt_pk_bf16(sigm(bflo(g.y)) * v0[2], sigm(bfhi(g.y)) * v0[3]);
                    w.z = cvt_pk_bf16(sigm(bflo(g.z)) * v1[0], sigm(bfhi(g.z)) * v1[1]); w.w = cvt_pk_bf16(sigm(bflo(g.w)) * v1[2], sigm(bfhi(g.w)) * v1[3]);
                    *(u32x4*)(out + off + bj * HALF) = w; } }
    }
};
struct EpiOut {
    static constexpr bool PERM = true, AFTER_DRAIN = false;
    const float* x; const float* stats; const float* g; const float* b; bf16_t* pre;
    __device__ __forceinline__ void operator()(const f32x4 (&acc)[2][2][4][2], const Unit& un, int wr, int wc, int fr, int fq) const {
        const int row0 = un.pm * BM + wr * 64 + fr, col0 = un.pn * BM + wc * 32 + 8 * fq;
#pragma unroll
        for (int bj = 0; bj < 2; ++bj) { const int col = col0 + bj * HALF; const f32x4 g0 = *(const f32x4*)(g + col), g1 = *(const f32x4*)(g + col + 4), b0 = *(const f32x4*)(b + col), b1 = *(const f32x4*)(b + col + 4);
#pragma unroll
            for (int ai = 0; ai < 2; ++ai)
#pragma unroll
                for (int m = 0; m < 4; ++m) { const int row = row0 + ai * HALF + m * 16; const float mean = stats[2 * row], rstd = stats[2 * row + 1];
                    const f32x4 x0 = *(const f32x4*)(x + (size_t)row * 1024 + col), x1 = *(const f32x4*)(x + (size_t)row * 1024 + col + 4);
                    const f32x4 v0 = ((x0 - mean) * rstd * g0 + b0) * ALPHA + acc[ai][bj][m][0], v1 = ((x1 - mean) * rstd * g1 + b1) * ALPHA + acc[ai][bj][m][1];
                    u32x4 w; w.x = cvt_pk_bf16(v0[0], v0[1]); w.y = cvt_pk_bf16(v0[2], v0[3]); w.z = cvt_pk_bf16(v1[0], v1[1]); w.w = cvt_pk_bf16(v1[2], v1[3]);
                    *(u32x4*)(pre + (size_t)row * 1024 + col) = w; } }
    }
};
}

namespace mg {
typedef unsigned u32x2 __attribute__((ext_vector_type(2)));
constexpr int STG = 49152, NSTG = 3;
__device__ __forceinline__ int swz(int r, int c16) { return r * 128 + ((c16 ^ (r & 7)) << 4); }
template <class RowPtr, class Epi>
__device__ __forceinline__ void tile(LAS unsigned char* lds, const RowPtr& rowptr, const bf16* Bt, int K, const Epi& epi) {
    const int tid = threadIdx.x, wid = __builtin_amdgcn_readfirstlane(tid >> 6), lane = tid & 63, wr = wid >> 2, wc = wid & 3, fr = lane & 15, fq = lane >> 4;
    const int lr = tid >> 3, ch = ((lane & 7) ^ ((lane >> 3) & 7)) * 8;
    const bf16* pa0 = rowptr(lr) + ch; const bf16* pa1 = rowptr(lr + 64) + ch;
    const bf16* pb = Bt + (size_t)lr * 64 + ch;
    f32x4 acc[4][4];
#pragma unroll
    for (int m = 0; m < 4; ++m)
#pragma unroll
        for (int n = 0; n < 4; ++n) acc[m][n] = (f32x4){0.f, 0.f, 0.f, 0.f};
    const int nk = K / 64;
#define MG_ISSUE(kt_) do { LAS unsigned char* sa_ = lds + ((kt_) % NSTG) * STG + wid * 1024; const int k0_ = (kt_) * 64; \
        __builtin_amdgcn_global_load_lds((const unsigned*)(pa0 + k0_), (LAS unsigned*)(sa_), 16, 0, 0); \
        __builtin_amdgcn_global_load_lds((const unsigned*)(pa1 + k0_), (LAS unsigned*)(sa_ + 8192), 16, 0, 0); \
        _Pragma("unroll") for (int j_ = 0; j_ < 4; ++j_) __builtin_amdgcn_global_load_lds((const unsigned*)(pb + (size_t)(kt_) * 16384 + j_ * 4096), (LAS unsigned*)(sa_ + 16384 + j_ * 8192), 16, 0, 0); } while (0)
    asm volatile("s_waitcnt vmcnt(0)" ::: "memory");
    __builtin_amdgcn_s_barrier();
    MG_ISSUE(0); if (nk > 1) MG_ISSUE(1);
    for (int kt = 0; kt < nk; ++kt) {
        if (kt + 1 < nk) asm volatile("s_waitcnt vmcnt(6)" ::: "memory"); else asm volatile("s_waitcnt vmcnt(0)" ::: "memory");
        __builtin_amdgcn_s_barrier();
        if (kt + 2 < nk) MG_ISSUE(kt + 2);
        const LAS unsigned char* sa = lds + (kt % NSTG) * STG; const LAS unsigned char* sb = sa + 16384;
#pragma unroll
        for (int ks = 0; ks < 2; ++ks) {
            bf16x8 a[4], w[4];
#pragma unroll
            for (int m = 0; m < 4; ++m) a[m] = *(const LAS bf16x8*)(sa + swz(64 * wr + 16 * m + fr, ks * 4 + fq));
#pragma unroll
            for (int n = 0; n < 4; ++n) w[n] = *(const LAS bf16x8*)(sb + swz(64 * wc + 16 * n + fr, ks * 4 + fq));
            __builtin_amdgcn_s_setprio(1);
#pragma unroll
            for (int m = 0; m < 4; ++m)
#pragma unroll
                for (int n = 0; n < 4; ++n) acc[m][n] = __builtin_amdgcn_mfma_f32_16x16x32_bf16(w[n], a[m], acc[m][n], 0, 0, 0);
            __builtin_amdgcn_s_setprio(0);
        }
        asm volatile("s_waitcnt lgkmcnt(0)" ::: "memory");
    }
#undef MG_ISSUE
    epi(acc, wr, wc, fr, fq);
}

struct Src { const bf16* pa0; const bf16* pa1; const bf16* pb; };
template <class Epi>
__device__ __forceinline__ void tile_pipe(LAS unsigned char* lds, const Src& cur, int nk, bool first, bool has_next, const Src& nxt, int& sbase, const Epi& epi, unsigned* sig = nullptr) {
    const int tid = threadIdx.x, wid = __builtin_amdgcn_readfirstlane(tid >> 6), lane = tid & 63, wr = wid >> 2, wc = wid & 3, fr = lane & 15, fq = lane >> 4;
    f32x4 acc[4][4];
#pragma unroll
    for (int m = 0; m < 4; ++m)
#pragma unroll
        for (int n = 0; n < 4; ++n) acc[m][n] = (f32x4){0.f, 0.f, 0.f, 0.f};
#define MG_ISSUE2(S_, kt_, slot_) do { LAS unsigned char* sa_ = lds + (slot_) * STG + wid * 1024; const int k0_ = (kt_) * 64; \
        __builtin_amdgcn_global_load_lds((const unsigned*)((S_).pa0 + k0_), (LAS unsigned*)(sa_), 16, 0, 0); \
        __builtin_amdgcn_global_load_lds((const unsigned*)((S_).pa1 + k0_), (LAS unsigned*)(sa_ + 8192), 16, 0, 0); \
        _Pragma("unroll") for (int j_ = 0; j_ < 4; ++j_) __builtin_amdgcn_global_load_lds((const unsigned*)((S_).pb + (size_t)(kt_) * 16384 + j_ * 4096), (LAS unsigned*)(sa_ + 16384 + j_ * 8192), 16, 0, 0); } while (0)
    int slot = sbase;
    if (first) {
        asm volatile("s_waitcnt vmcnt(0)" ::: "memory");
        __builtin_amdgcn_s_barrier();
        MG_ISSUE2(cur, 0, slot); MG_ISSUE2(cur, 1, (slot + 1 >= NSTG ? slot + 1 - NSTG : slot + 1));
    }
    for (int kt = 0; kt < nk; ++kt) {
        if (kt == 0 && sig) asm volatile("s_waitcnt vmcnt(0)" ::: "memory"); else asm volatile("s_waitcnt vmcnt(6)" ::: "memory");
        __builtin_amdgcn_s_barrier();
        if (kt == 0 && sig && tid == 0) (void)__hip_atomic_fetch_add(sig, 1u, __ATOMIC_RELAXED, __HIP_MEMORY_SCOPE_AGENT);
        const LAS unsigned char* sa = lds + slot * STG; const LAS unsigned char* sb = sa + 16384;
        bf16x8 a0[4], w0[4], a1[4], w1[4];
#pragma unroll
        for (int m = 0; m < 4; ++m) a0[m] = *(const LAS bf16x8*)(sa + swz(64 * wr + 16 * m + fr, fq));
#pragma unroll
        for (int n = 0; n < 4; ++n) w0[n] = *(const LAS bf16x8*)(sb + swz(64 * wc + 16 * n + fr, fq));
        { const bool own = kt + 2 < nk; const int kk = own ? kt + 2 : kt + 2 - nk, s2 = slot + 2 >= NSTG ? slot + 2 - NSTG : slot + 2;
          Src S; S.pa0 = own ? cur.pa0 : nxt.pa0; S.pa1 = own ? cur.pa1 : nxt.pa1; S.pb = own ? cur.pb : nxt.pb;
          MG_ISSUE2(S, kk, s2); }
        __builtin_amdgcn_sched_barrier(0);
        __builtin_amdgcn_s_setprio(1);
#pragma unroll
        for (int n = 0; n < 4; ++n) acc[0][n] = __builtin_amdgcn_mfma_f32_16x16x32_bf16(w0[n], a0[0], acc[0][n], 0, 0, 0);
        __builtin_amdgcn_sched_barrier(0);
#pragma unroll
        for (int m = 0; m < 4; ++m) a1[m] = *(const LAS bf16x8*)(sa + swz(64 * wr + 16 * m + fr, 4 + fq));
        __builtin_amdgcn_sched_barrier(0);
#pragma unroll
        for (int n = 0; n < 4; ++n) acc[1][n] = __builtin_amdgcn_mfma_f32_16x16x32_bf16(w0[n], a0[1], acc[1][n], 0, 0, 0);
        __builtin_amdgcn_sched_barrier(0);
#pragma unroll
        for (int n = 0; n < 4; ++n) w1[n] = *(const LAS bf16x8*)(sb + swz(64 * wc + 16 * n + fr, 4 + fq));
        __builtin_amdgcn_sched_barrier(0);
#pragma unroll
        for (int m = 2; m < 4; ++m)
#pragma unroll
            for (int n = 0; n < 4; ++n) acc[m][n] = __builtin_amdgcn_mfma_f32_16x16x32_bf16(w0[n], a0[m], acc[m][n], 0, 0, 0);
        __builtin_amdgcn_sched_barrier(0);
#pragma unroll
        for (int m = 0; m < 4; ++m)
#pragma unroll
            for (int n = 0; n < 4; ++n) acc[m][n] = __builtin_amdgcn_mfma_f32_16x16x32_bf16(w1[n], a1[m], acc[m][n], 0, 0, 0);
        __builtin_amdgcn_s_setprio(0);
        asm volatile("s_waitcnt lgkmcnt(0)" ::: "memory");
        slot = slot + 1 >= NSTG ? slot + 1 - NSTG : slot + 1;
    }
#undef MG_ISSUE2
    sbase = slot;
    epi(acc, wr, wc, fr, fq);
}

template <class Epi>
__device__ __forceinline__ void down_unit(LAS unsigned char* lds, const bf16* A  , int ntiles, const bf16* Bt  , Epi& epi) {
    const int tid = threadIdx.x, wid = __builtin_amdgcn_readfirstlane(tid >> 6), lane = tid & 63, wr = wid >> 1, wc = wid & 1, fr = lane & 15, fq = lane >> 4;
    const int lr = tid >> 3;
    __syncthreads();
#pragma unroll
    for (int j = 0; j < 4; ++j)
#pragma unroll
        for (int kk = 0; kk < 4; ++kk) { const int r = lr + 64 * j, c = lane & 7;
            *(LAS v4u*)(lds + kk * 32768 + swz(r, c)) = *(const v4u*)(Bt + (size_t)r * 256 + kk * 64 + c * 8); }
    __syncthreads();
#pragma unroll 1
    for (int mt = 0; mt < ntiles; ++mt) {
        int fr_ = fr; asm volatile("" : "+v"(fr_));
        bf16x8 a[2][8];
#pragma unroll
        for (int m = 0; m < 2; ++m)
#pragma unroll
            for (int ks = 0; ks < 8; ++ks) a[m][ks] = *(const bf16x8*)(A + (size_t)(128 * mt + 32 * wr + 16 * m + fr) * 256 + 32 * ks + 8 * fq);
        epi.prepare(mt, wr, fr);
        f32x4 acc[2][8];
#pragma unroll
        for (int m = 0; m < 2; ++m)
#pragma unroll
            for (int n = 0; n < 8; ++n) acc[m][n] = (f32x4){0.f, 0.f, 0.f, 0.f};
#pragma unroll
        for (int ks = 0; ks < 8; ++ks) { bf16x8 w[8];
#pragma unroll
            for (int n = 0; n < 8; ++n) w[n] = *(const LAS bf16x8*)(lds + (ks >> 1) * 32768 + swz(128 * wc + 16 * n + fr_, (ks & 1) * 4 + fq));
#pragma unroll
            for (int m = 0; m < 2; ++m)
#pragma unroll
                for (int n = 0; n < 8; ++n) acc[m][n] = __builtin_amdgcn_mfma_f32_16x16x32_bf16(w[n], a[m][ks], acc[m][n], 0, 0, 0); }
        epi(acc, wr, wc, fr, fq);
    }
}
struct DownArgs { const bf16* A; int ntiles; const bf16* Bt; const int* lst; const float* route; int cnt; bf16* slots; int c0; };
template <int MODE>
__device__ __forceinline__ void down_unit(LAS unsigned char* lds, const DownArgs& U) {
    const int tid = threadIdx.x, wid = __builtin_amdgcn_readfirstlane(tid >> 6), lane = tid & 63, wr = wid >> 1, wc = wid & 1, fr = lane & 15, fq = lane >> 4;
    const int lr = tid >> 3;
    LAS int* PT = (LAS int*)(lds + 131072);
    __syncthreads();
#pragma unroll
    for (int j = 0; j < 4; ++j)
#pragma unroll
        for (int kk = 0; kk < 4; ++kk) { const int r = lr + 64 * j, c = lane & 7;
            *(LAS v4u*)(lds + kk * 32768 + swz(r, c)) = *(const v4u*)(U.Bt + (size_t)r * 256 + kk * 64 + c * 8); }
#define MGD_LOADA(dst_, mt_) do { _Pragma("unroll") for (int m_ = 0; m_ < 2; ++m_) _Pragma("unroll") for (int ks_ = 0; ks_ < 8; ++ks_) \
        dst_[m_][ks_] = *(const bf16x8*)(U.A + (size_t)(128 * (mt_) + 32 * wr + 16 * m_ + fr) * 256 + 32 * ks_ + 8 * fq); } while (0)
    bf16x8 a[2][8], an[2][8];
    MGD_LOADA(a, 0);
#pragma unroll 1
    for (int mt = 0; mt < U.ntiles; ++mt) {
        if ((mt & 3) == 0) {
            if (mt) __syncthreads();
            const int li = 128 * mt + tid; const int pp = li < U.cnt ? U.lst[li] : -1;
            PT[tid] = pp; PT[512 + tid] = pp < 0 ? 0 : __builtin_bit_cast(int, U.route[(size_t)(pp >> 1) * 8 + 4 + (pp & 1)]);
            __syncthreads();
        }
        if (mt + 1 < U.ntiles) MGD_LOADA(an, mt + 1);
        int fr_ = fr; asm volatile("" : "+v"(fr_));
        f32x4 acc[2][8];
#pragma unroll
        for (int m = 0; m < 2; ++m)
#pragma unroll
            for (int n = 0; n < 8; ++n) acc[m][n] = (f32x4){0.f, 0.f, 0.f, 0.f};
#pragma unroll
        for (int ks = 0; ks < 8; ++ks)
#pragma unroll
            for (int nh = 0; nh < 2; ++nh) { bf16x8 w[4];
#pragma unroll
                for (int n = 0; n < 4; ++n) w[n] = *(const LAS bf16x8*)(lds + (ks >> 1) * 32768 + swz(128 * wc + 16 * (4 * nh + n) + fr_, (ks & 1) * 4 + fq));
#pragma unroll
                for (int m = 0; m < 2; ++m)
#pragma unroll
                    for (int n = 0; n < 4; ++n) acc[m][4 * nh + n] = __builtin_amdgcn_mfma_f32_16x16x32_bf16(w[n], a[m][ks], acc[m][4 * nh + n], 0, 0, 0); }
#pragma unroll
        for (int m = 0; m < 2; ++m) { const int ti = 128 * (mt & 3) + 32 * wr + 16 * m + fr_; const int pp = PT[ti]; const float gt = __builtin_bit_cast(float, PT[512 + ti]);
            if (MODE == 1) { _Pragma("unroll") for (int n = 0; n < 8; ++n) asm volatile("" :: "v"(acc[m][n])); }
            else if (pp >= 0) {
#pragma unroll
                for (int n = 0; n < 8; ++n) { const f32x4 v = acc[m][n] * gt; u32x2 w2; w2.x = pk2(v[0], v[1]); w2.y = pk2(v[2], v[3]);
                    *(u32x2*)(U.slots + (size_t)pp * 1024 + U.c0 + 128 * wc + 16 * n + 4 * fq) = w2; } } }
#pragma unroll
        for (int m = 0; m < 2; ++m)
#pragma unroll
            for (int ks = 0; ks < 8; ++ks) a[m][ks] = an[m][ks];
    }
#undef MGD_LOADA
}
}

struct Ctx {
    LAS unsigned char* lds; int tid, lane, wave, wg, G;
    const float* const* in; float* out; unsigned char* ws; gu32* ctl;
};

template <bool NT>
__device__ __forceinline__ void transpose_item(const float* W, int K, int N, bf16* WT, int mode, int row_off, int s13, LAS float* scr, int item, int lane) {
    const int nblk = (N + 31) / 32, kb = item / nblk, nb = item % nblk, k0 = 64 * kb, n0 = 32 * nb;
    const int kk = lane >> 3, n4 = (lane & 7) * 4; const bool ok = n0 + n4 < N;
    f32x4 v[8];
#pragma unroll
    for (int i = 0; i < 8; ++i) { const f32x4* p = (const f32x4*)(W + (size_t)(k0 + 8 * i + kk) * N + n0 + n4);
        v[i] = ok ? (NT ? __builtin_nontemporal_load(p) : *p) : (f32x4){0.f, 0.f, 0.f, 0.f}; }
#pragma unroll
    for (int i = 0; i < 8; ++i) { LAS float* s = scr + (8 * i + kk) * 33 + n4; s[0] = v[i].x; s[1] = v[i].y; s[2] = v[i].z; s[3] = v[i].w; }
    LDS_WAIT(); asm volatile("" ::: "memory");
    const int c = lane & 7;
#pragma unroll
    for (int j = 0; j < 4; ++j) { const int n = (lane >> 3) + 8 * j; const LAS float* s = scr + (8 * c) * 33 + n;
        v4u o; o.x = pk2(s[0 * 33], s[1 * 33]); o.y = pk2(s[2 * 33], s[3 * 33]); o.z = pk2(s[4 * 33], s[5 * 33]); o.w = pk2(s[6 * 33], s[7 * 33]);
        const int orow = ((mode & 1) == 0) ? (row_off + n0 + n) : (row_off + 2 * n0 + n + (n >= 16 ? 16 : 0) + 16 * s13);
        if (n0 + n < N) { const size_t off = (mode & 2) ? ((size_t)((orow >> 8) * (K >> 6) + (k0 >> 6)) * 16384 + (size_t)(orow & 255) * 64 + 8 * c) : ((size_t)orow * K + k0 + 8 * c); *(GAS v4u*)(WT + off) = o; } }
    LDS_WAIT(); asm volatile("" ::: "memory");
}
__device__ __forceinline__ void ln_row(f32x4 (&v)[4], const float* g, const float* b, int lane, float scale_in, float& mean_o, float& rstd_o) {
    float s = 0.f;
#pragma unroll
    for (int j = 0; j < 4; ++j) { v[j] = v[j] * scale_in; s += (v[j].x + v[j].y) + (v[j].z + v[j].w); }
    const float mean = wave_sum(s) * (1.f / D); float s2 = 0.f;
#pragma unroll
    for (int j = 0; j < 4; ++j) { v[j] = v[j] - mean; s2 += (v[j].x * v[j].x + v[j].y * v[j].y) + (v[j].z * v[j].z + v[j].w * v[j].w); }
    const float rstd = __builtin_amdgcn_rsqf(wave_sum(s2) * (1.f / D) + LN_EPS);
#pragma unroll
    for (int j = 0; j < 4; ++j) { const f32x4 gv = *(const f32x4*)(g + 4 * lane + 256 * j), bv = *(const f32x4*)(b + 4 * lane + 256 * j); v[j] = v[j] * rstd * gv + bv; }
    mean_o = mean; rstd_o = rstd;
}

__device__ __forceinline__ void phase0(const Ctx& C) {
    LAS float* scr = (LAS float*)(C.lds + C.wave * 16384);
    const int gw = C.wg * NWAVES + C.wave, NGW = C.G * NWAVES, lane = C.lane;
    bf16* WINT = (bf16*)(C.ws + WS_WINT); bf16* WGLU = (bf16*)(C.ws + WS_WGLU); bf16* WBR = (bf16*)(C.ws + WS_WBR); bf16* WOUT = (bf16*)(C.ws + WS_WOUT); bf16* WRT = (bf16*)(C.ws + WS_WRT);
    constexpr int I_IN = 16 * 145, I_GLU = 8 * 16, I_BR = 8 * 32, I_OUT = 16 * 32, I_RG = 16, I_RE = 32;
    constexpr int NITEMS = I_IN + I_GLU + 2 * I_BR + I_OUT + I_RG + I_RE;
    for (int it = gw; it < NITEMS; it += NGW) {
        int r = it;
        if (r < I_IN) { transpose_item<false>(C.in[4], 1024, INW, WINT, 0, 0, 0, scr, r, lane); continue; } r -= I_IN;
        if (r < I_GLU) { transpose_item<false>(C.in[17], 512, 512, WGLU, 0, 0, 0, scr, r, lane); continue; } r -= I_GLU;
        if (r < I_BR) { transpose_item<false>(C.in[19], 512, 1024, WBR, 0, 0, 0, scr, r, lane); continue; } r -= I_BR;
        if (r < I_BR) { transpose_item<false>(C.in[19] + 512 * 1024, 512, 1024, WBR + 1024 * 512, 0, 0, 0, scr, r, lane); continue; } r -= I_BR;
        if (r < I_OUT) { transpose_item<false>(C.in[20], 1024, 1024, WOUT, 0, 0, 0, scr, r, lane); continue; } r -= I_OUT;
        if (r < I_RG) { transpose_item<false>(C.in[23], 1024, 8, WRT, 0, 0, 0, scr, r, lane); continue; } r -= I_RG;
        transpose_item<false>(C.in[25], 1024, 64, WRT, 0, 8, 0, scr, r, lane);
    }
    for (int it = gw; it < (INWP - INW) + 8; it += NGW) { bf16* rowp = (it < INWP - INW) ? WINT + (size_t)(INW + it) * 1024 : WRT + (size_t)(72 + it - (INWP - INW)) * 1024;
        GAS v4u* o = (GAS v4u*)rowp + lane; o[0] = (v4u){0u, 0u, 0u, 0u}; o[64] = (v4u){0u, 0u, 0u, 0u}; }
    bf16* H0B = (bf16*)(C.ws + WS_H0B); float* stats = (float*)(C.ws + WS_STATS);
    const float* x = C.in[0]; const float* meta = C.in[1]; const float* g = C.in[2]; const float* b = C.in[3];
    for (int rp0 = gw * 2; rp0 < MP; rp0 += NGW * 2) {
        f32x4 v[2][4]; int kind[2];
#pragma unroll
        for (int rr = 0; rr < 2; ++rr) { const int rp = rp0 + rr, bb = rp / LP, i = rp % LP; kind[rr] = i < PADF ? 0 : (i < 64 ? 1 : 2);
            const float* src = (i < PADF) ? x : ((i < 64) ? meta + (size_t)(i - PADF) * D : x + ((size_t)bb * SEQ + (i - 64)) * D);
#pragma unroll
            for (int j = 0; j < 4; ++j) v[rr][j] = *(const f32x4*)(src + 4 * lane + 256 * j); }
#pragma unroll
        for (int rr = 0; rr < 2; ++rr) { const int rp = rp0 + rr, bb = rp / LP, i = rp % LP;
            GAS unsigned long long* o8 = (GAS unsigned long long*)(H0B + (size_t)rp * D) + lane;
            if (kind[rr] == 0) {
#pragma unroll
                for (int j = 0; j < 4; ++j) o8[64 * j] = 0ull;
                continue; }
            float mean, rstd; ln_row(v[rr], g, b, lane, 1.f, mean, rstd);
            if (kind[rr] == 2 && lane == 0) { const int xr = bb * SEQ + (i - 64); stats[2 * xr] = mean; stats[2 * xr + 1] = rstd; }
#pragma unroll
            for (int j = 0; j < 4; ++j) o8[64 * j] = (unsigned long long)pk2(v[rr][j].x, v[rr][j].y) | ((unsigned long long)pk2(v[rr][j].z, v[rr][j].w) << 32); }
    }
}

__device__ __forceinline__ void phase2_elem(const Ctx& C) {
    const int gw = C.wg * NWAVES + C.wave, NGW = C.G * NWAVES, lane = C.lane;
    const bf16* qkv = (const bf16*)(C.ws + WS_QKV); const float* ab = (const float*)(C.ws + WS_AB);
    bf16* qn = (bf16*)((unsigned char*)C.out + DO_QN); bf16* kn = (bf16*)((unsigned char*)C.out + DO_KN); bf16* vn = (bf16*)((unsigned char*)C.out + DO_VN);
    float* beta = (float*)((unsigned char*)C.out + DO_BETA); float* alpha = (float*)((unsigned char*)C.out + DO_ALPHA);
    const float* cw = C.in[5]; const float* a_log = C.in[6]; const float* dt_bias = C.in[7];
    for (int it = gw; it < MP * NH; it += NGW) {
        const int rp = it >> 3, h = it & 7, i = rp % LP; const size_t o = (size_t)rp * 512 + h * 64 + lane;
        if (i < PADF) { qn[o] = 0; kn[o] = 0; vn[o] = 0; if (lane == 0) { beta[rp * 8 + h] = 0.f; alpha[rp * 8 + h] = 1.f; } continue; }
        float aq = 0.f, ak = 0.f, av = 0.f; const int ch = h * 64 + lane;
#pragma unroll
        for (int j = 0; j < 4; ++j) { const bf16* r = qkv + (size_t)(rp - 3 + j) * 1536 + ch;
            aq += cw[j * 1536 + ch] * bf2f(r[0]); ak += cw[j * 1536 + 512 + ch] * bf2f(r[512]); av += cw[j * 1536 + 1024 + ch] * bf2f(r[1024]); }
        float q = silu_(aq), k = silu_(ak), v = silu_(av);
        const float sq = wave_sum(q * q), sk = wave_sum(k * k);
        q *= (__builtin_amdgcn_rsqf(sq + NORM_EPS)) * 0.125f; k *= __builtin_amdgcn_rsqf(sk + NORM_EPS);
        qn[o] = (bf16)f2bf(q); kn[o] = (bf16)f2bf(k); vn[o] = (bf16)f2bf(v);
        if (lane == 0) { const float a = ab[rp * 16 + h], bb = ab[rp * 16 + 8 + h];
            beta[rp * 8 + h] = sigm(bb); alpha[rp * 8 + h] = expf(-expf(a_log[h]) * softplus_(a + dt_bias[h])); }
    }
}

__device__ __forceinline__ void dn_scan_naive(const Ctx& C, int b, int h) {
    if (C.wave != 0) return;
    const int lane = C.lane;
    LAS float* Kl = (LAS float*)C.lds; LAS float* Ql = Kl + 4096; LAS float* Vl = Ql + 4096; LAS float* Zl = Vl + 4096; LAS float* Bl = Zl + 4096; LAS float* Al = Bl + 64;
    const bf16* qn = (const bf16*)((unsigned char*)C.out + DO_QN); const bf16* kn = (const bf16*)((unsigned char*)C.out + DO_KN); const bf16* vn = (const bf16*)((unsigned char*)C.out + DO_VN);
    const float* beta = (const float*)((unsigned char*)C.out + DO_BETA); const float* alpha = (const float*)((unsigned char*)C.out + DO_ALPHA);
    const bf16* z = (const bf16*)(C.ws + WS_Z); bf16* oa = (bf16*)(C.ws + WS_OA);
    const float nw = C.in[8][lane];
    float S[64];
#pragma unroll
    for (int k = 0; k < 64; ++k) S[k] = 0.f;
    for (int n = 0; n < NCH; ++n) {
        const int base = b * LP + 64 * n;
#pragma unroll 8
        for (int i = 0; i < 64; ++i) { const size_t off = (size_t)(base + i) * 512 + h * 64 + lane;
            Kl[i * 64 + lane] = bf2f(kn[off]); Ql[i * 64 + lane] = bf2f(qn[off]); Vl[i * 64 + lane] = bf2f(vn[off]); Zl[i * 64 + lane] = bf2f(z[off]); }
        Bl[lane] = beta[(base + lane) * 8 + h]; Al[lane] = alpha[(base + lane) * 8 + h];
        asm volatile("s_waitcnt vmcnt(0) lgkmcnt(0)" ::: "memory");
#pragma unroll 1
        for (int i = 0; i < 64; ++i) {
            const LAS f32x4* kr = (const LAS f32x4*)(Kl + i * 64); const LAS f32x4* qr = (const LAS f32x4*)(Ql + i * 64);
            const float at = Al[i], bt = Bl[i], vt = Vl[i * 64 + lane];
            float d0 = 0.f, d1 = 0.f, d2 = 0.f, d3 = 0.f;
#pragma unroll
            for (int k4 = 0; k4 < 16; ++k4) { const f32x4 kk = kr[k4]; d0 += S[4 * k4] * kk.x; d1 += S[4 * k4 + 1] * kk.y; d2 += S[4 * k4 + 2] * kk.z; d3 += S[4 * k4 + 3] * kk.w; }
            const float vnew = bt * (vt - at * ((d0 + d1) + (d2 + d3)));
            float o0 = 0.f, o1 = 0.f, o2 = 0.f, o3 = 0.f;
#pragma unroll
            for (int k4 = 0; k4 < 16; ++k4) { const f32x4 kk = kr[k4], qq = qr[k4];
                S[4 * k4] = at * S[4 * k4] + kk.x * vnew; S[4 * k4 + 1] = at * S[4 * k4 + 1] + kk.y * vnew; S[4 * k4 + 2] = at * S[4 * k4 + 2] + kk.z * vnew; S[4 * k4 + 3] = at * S[4 * k4 + 3] + kk.w * vnew;
                o0 += S[4 * k4] * qq.x; o1 += S[4 * k4 + 1] * qq.y; o2 += S[4 * k4 + 2] * qq.z; o3 += S[4 * k4 + 3] * qq.w; }
            if (n >= 1) { const float o = (o0 + o1) + (o2 + o3); const float ss = wave_sum(o * o);
                const float on = o * (__builtin_amdgcn_rsqf(ss * (1.f / 64.f) + NORM_EPS)) * nw * silu_(Zl[i * 64 + lane]);
                oa[(size_t)(b * SEQ + 64 * (n - 1) + i) * 512 + h * 64 + lane] = (bf16)f2bf(on); }
        }
    }
}
__device__ __forceinline__ void s5_naive(const Ctx& C, int b, int g) {
    const int tid = C.tid, lane = C.lane;
    LAS float* uu = (LAS float*)C.lds; LAS float* hh = uu + 1024; LAS float* Cc = hh + 8192; LAS float* Dd = Cc + 2048;
    const bf16* u = (const bf16*)(C.ws + WS_U); bf16* yb = (bf16*)(C.ws + WS_YB);
    const float* c_re = C.in[14] + (size_t)g * 16 * 64; const float* c_im = C.in[15] + (size_t)g * 16 * 64;
    for (int e = tid; e < 1024; e += 512) { const int c = e >> 6, p = e & 63; Cc[c * 128 + p] = c_re[c * 64 + p]; Cc[c * 128 + 64 + p] = -c_im[c * 64 + p]; }
    if (tid < 16) Dd[tid] = C.in[16][g * 16 + tid];
    float ar = 0.f, ai = 0.f, Bbr[16], Bbi[16], hr = 0.f, hi = 0.f;
    if (C.wave == 0) {
        const float dt = expf(C.in[11][g]); const float a_r = C.in[9][g * 64 + lane], a_i = C.in[10][g * 64 + lane];
        const float mag = expf(dt * a_r); ar = mag * cosf(dt * a_i); ai = mag * sinf(dt * a_i);
        const float den = a_r * a_r + a_i * a_i, nr = ar - 1.f, ni = ai;
        const float f_re = (nr * a_r + ni * a_i) / den, f_im = (ni * a_r - nr * a_i) / den;
        const float* br = C.in[12] + ((size_t)g * 64 + lane) * 16; const float* bi = C.in[13] + ((size_t)g * 64 + lane) * 16;
#pragma unroll
        for (int c = 0; c < 16; ++c) { Bbr[c] = f_re * br[c] - f_im * bi[c]; Bbi[c] = f_re * bi[c] + f_im * br[c]; }
    }
    for (int n = 0; n < NCH; ++n) {
        const int base = b * LP + 64 * n;
        { const int row = tid >> 3, c2 = (tid & 7) * 2; const unsigned w = *(const unsigned*)(u + (size_t)(base + row) * 512 + g * 16 + c2); uu[row * 16 + c2] = bflo(w); uu[row * 16 + c2 + 1] = bfhi(w); }
        __syncthreads();
        if (C.wave == 0) {
#pragma unroll 4
            for (int t = 0; t < 64; ++t) { float bur = 0.f, bui = 0.f;
#pragma unroll
                for (int c4 = 0; c4 < 4; ++c4) { const f32x4 uv = *(const LAS f32x4*)(uu + t * 16 + 4 * c4);
                    bur += Bbr[4 * c4] * uv.x + Bbr[4 * c4 + 1] * uv.y + Bbr[4 * c4 + 2] * uv.z + Bbr[4 * c4 + 3] * uv.w;
                    bui += Bbi[4 * c4] * uv.x + Bbi[4 * c4 + 1] * uv.y + Bbi[4 * c4 + 2] * uv.z + Bbi[4 * c4 + 3] * uv.w; }
                const float nhr = ar * hr - ai * hi + bur, nhi = ar * hi + ai * hr + bui; hr = nhr; hi = nhi;
                hh[t * 128 + lane] = hr; hh[t * 128 + 64 + lane] = hi; }
        }
        __syncthreads();
        if (n >= 1) { const int t = tid >> 3;
#pragma unroll
            for (int cc = 0; cc < 2; ++cc) { const int c = (tid & 7) + 8 * cc; float a0 = 0.f, a1 = 0.f;
#pragma unroll 8
                for (int p4 = 0; p4 < 32; ++p4) { const f32x4 cv = *(const LAS f32x4*)(Cc + c * 128 + 4 * p4), hv = *(const LAS f32x4*)(hh + t * 128 + 4 * p4); a0 += cv.x * hv.x + cv.y * hv.y; a1 += cv.z * hv.z + cv.w * hv.w; }
                const float y = a0 + a1 + Dd[c] * uu[t * 16 + c];
                yb[(size_t)(b * SEQ + 64 * (n - 1) + t) * 512 + g * 16 + c] = (bf16)f2bf(gelu_tanh(y)); } }
        __syncthreads();
    }
}
constexpr int CW_CONV = 16640, CONV_SHARD = NE * 384 / 8;
__device__ __forceinline__ void convert_experts(const Ctx& C, int qi, unsigned first, unsigned limit) {
    (void)qi; (void)first; (void)limit;
    LAS float* scr = (LAS float*)(C.lds + C.wave * 16384);
    bf16* W13 = (bf16*)(C.ws + WS_W13); bf16* W2 = (bf16*)(C.ws + WS_W2);
#pragma unroll 1
    for (int q = 0; q < 8; ++q) { const int sh = (C.wg + q) & 7;
        for (;;) {
            unsigned li = 0; if (C.lane == 0) li = __hip_atomic_fetch_add(C.ctl + CW_CONV + 64 * sh, 1u, __ATOMIC_RELAXED, __HIP_MEMORY_SCOPE_AGENT);
            li = __builtin_amdgcn_readfirstlane(li); if (li >= (unsigned)CONV_SHARD) break;
            const int it = sh * CONV_SHARD + (int)li, e = it / 384, r = it % 384;
            if (r < 128) transpose_item<true>(C.in[27] + (size_t)e * 1024 * 256, 1024, 256, W13 + (size_t)e * 512 * 1024, 3, 0, 0, scr, r, C.lane);
            else if (r < 256) transpose_item<true>(C.in[28] + (size_t)e * 1024 * 256, 1024, 256, W13 + (size_t)e * 512 * 1024, 3, 0, 1, scr, r - 128, C.lane);
            else transpose_item<true>(C.in[29] + (size_t)e * 256 * 1024, 256, 1024, W2 + (size_t)e * 1024 * 256, 2, 0, 0, scr, r - 256, C.lane); }
    }
}
template <int MODE>
__device__ __forceinline__ void phase7_rows(const Ctx& C) {
    constexpr int RS = 2064, RB = 64;
    LAS unsigned char* Ht = C.lds; LAS float* Lg = (LAS float*)(C.lds + RB * RS);
    const bf16* pre = (const bf16*)(C.ws + WS_PRE); bf16* h1 = (bf16*)(C.ws + WS_H1); const bf16* WRT = (const bf16*)(C.ws + WS_WRT);
    const float* g1 = C.in[21]; const float* b1 = C.in[22]; const float* b_rg = C.in[24]; const float* b_re = C.in[26];
    int* route = (int*)(C.ws + WS_ROUTE); gu32* cnt = C.ctl + CW_CNT; int* inv2 = (int*)(C.ws + WS_INV2);
    const int lane = C.lane, wave = C.wave, fr = lane & 15, fq = lane >> 4;
    for (int blk = C.wg; blk < MX / RB; blk += C.G) {
#pragma unroll 1
        for (int hh = 0; hh < 2; ++hh) { f32x4 v[4][4];
#pragma unroll
            for (int rr = 0; rr < 4; ++rr)
#pragma unroll
                for (int j = 0; j < 4; ++j) { const mg::u32x2 pw = *(const mg::u32x2*)(pre + ((size_t)blk * RB + wave * 8 + hh * 4 + rr) * D + 4 * lane + 256 * j); v[rr][j] = (f32x4){bflo(pw.x), bfhi(pw.x), bflo(pw.y), bfhi(pw.y)}; }
#pragma unroll
            for (int rr = 0; rr < 4; ++rr) { const int r = wave * 8 + hh * 4 + rr; const size_t row = (size_t)blk * RB + r;
                float mean, rstd; ln_row(v[rr], g1, b1, lane, 1.f, mean, rstd);
                GAS unsigned long long* o8 = (GAS unsigned long long*)(h1 + row * D) + lane;
#pragma unroll
                for (int j = 0; j < 4; ++j) { const unsigned long long w = (unsigned long long)pk2(v[rr][j].x, v[rr][j].y) | ((unsigned long long)pk2(v[rr][j].z, v[rr][j].w) << 32);
                    if (MODE == 0) o8[64 * j] = w; *(LAS unsigned long long*)(Ht + r * RS + (4 * lane + 256 * j) * 2) = w; } } }
        __syncthreads();
        { const int kq = wave & 3, ch2 = wave >> 2, t0 = ch2 ? 3 : 0;
            bf16x8 wb[3][8];
            const bf16* w0 = WRT + (size_t)(16 * t0 + fr) * 1024 + kq * 256 + fq * 8;
#pragma unroll
            for (int t = 0; t < 3; ++t)
#pragma unroll
                for (int s8 = 0; s8 < 8; ++s8) if (t < 2 || !ch2) wb[t][s8] = *(const bf16x8*)(w0 + (size_t)t * 16 * 1024 + s8 * 32);
            f32x4 ac[4][3];
#pragma unroll
            for (int rg = 0; rg < 4; ++rg)
#pragma unroll
                for (int t = 0; t < 3; ++t) ac[rg][t] = (f32x4){0.f, 0.f, 0.f, 0.f};
#pragma unroll
            for (int s8 = 0; s8 < 8; ++s8)
#pragma unroll
                for (int rg = 0; rg < 4; ++rg) { const bf16x8 af = *(const LAS bf16x8*)(Ht + (16 * rg + fr) * RS + fq * 16 + (8 * kq + s8) * 64);
                    ac[rg][0] = __builtin_amdgcn_mfma_f32_16x16x32_bf16(wb[0][s8], af, ac[rg][0], 0, 0, 0);
                    ac[rg][1] = __builtin_amdgcn_mfma_f32_16x16x32_bf16(wb[1][s8], af, ac[rg][1], 0, 0, 0);
                    if (!ch2) ac[rg][2] = __builtin_amdgcn_mfma_f32_16x16x32_bf16(wb[2][s8], af, ac[rg][2], 0, 0, 0); }
            __syncthreads();
            LAS float* Pq = (LAS float*)Ht + kq * (RB * 80);
#pragma unroll
            for (int rg = 0; rg < 4; ++rg)
#pragma unroll
                for (int t = 0; t < 3; ++t) if (t < 2 || !ch2) *(LAS f32x4*)(Pq + (16 * rg + fr) * 80 + 16 * (t0 + t) + 4 * fq) = ac[rg][t];
            __syncthreads();
            for (int g4 = C.tid; g4 < RB * 80 / 4; g4 += NWAVES * 64) { const LAS f32x4* pp = (const LAS f32x4*)Ht + g4;
                const f32x4 p0 = pp[0], p1 = pp[RB * 80 / 4], p2 = pp[2 * (RB * 80 / 4)], p3 = pp[3 * (RB * 80 / 4)];
                const int col = (g4 * 4) % 80; f32x4 bv = (f32x4){0.f, 0.f, 0.f, 0.f};
                if (col < 8) bv = *(const f32x4*)(b_rg + col); else if (col < 72) bv = *(const f32x4*)(b_re + col - 8);
                ((LAS f32x4*)Lg)[g4] = ((p0 + p1) + (p2 + p3)) + bv; } }
        __syncthreads();
        LAS unsigned* hist = (LAS unsigned*)Ht;
        if (C.tid < NE) hist[C.tid] = 0u;
        __syncthreads();
        int e0 = 0, e1 = 0, l0 = 0, l1 = 0; float gw0 = 0.f, gw1 = 0.f;
        if (C.tid < RB) { const LAS float* L = Lg + C.tid * 80;
            float lg[8]; float mx = -3.0e38f; int gi = 0;
#pragma unroll
            for (int j = 0; j < 8; ++j) { lg[j] = L[j]; if (lg[j] > mx) { mx = lg[j]; gi = j; } }
            float se = 0.f;
#pragma unroll
            for (int j = 0; j < 8; ++j) se += __expf(lg[j] - mx);
            const float gp = 1.f / se;
            float t0 = -3.0e38f, t1 = -3.0e38f; int i0 = 0, i1 = 0;
#pragma unroll
            for (int j = 0; j < 8; ++j) { const float le = L[8 + gi * 8 + j];
                if (le > t0) { t1 = t0; i1 = i0; t0 = le; i0 = j; } else if (le > t1) { t1 = le; i1 = j; } }
            const float w0 = 1.f / (1.f + __expf(t1 - t0)), w1 = 1.f - w0;
            e0 = gi * 8 + i0; e1 = gi * 8 + i1; gw0 = w0 * gp; gw1 = w1 * gp;
            if (MODE == 0) { l0 = (int)__hip_atomic_fetch_add((unsigned*)(hist + e0), 1u, __ATOMIC_RELAXED, __HIP_MEMORY_SCOPE_WORKGROUP); l1 = (int)__hip_atomic_fetch_add((unsigned*)(hist + e1), 1u, __ATOMIC_RELAXED, __HIP_MEMORY_SCOPE_WORKGROUP); } }
        __syncthreads();
        if (MODE == 0 && C.tid < NE) { const unsigned c = hist[C.tid]; unsigned base = 0u; if (c) base = __hip_atomic_fetch_add(cnt + C.tid * CNT_STRIDE, c, __ATOMIC_RELAXED, __HIP_MEMORY_SCOPE_AGENT); hist[64 + C.tid] = base; }
        __syncthreads();
        if (C.tid < RB) { const int tok = blk * RB + C.tid;
            if (MODE == 1) { asm volatile("" :: "v"(e0), "v"(e1), "v"(gw0), "v"(gw1)); } else {
            const int r0 = (int)hist[64 + e0] + l0, r1 = (int)hist[64 + e1] + l1;
            int* ro = route + (size_t)tok * 8; ro[0] = e0; ro[1] = e1; ro[2] = r0; ro[3] = r1; ((float*)ro)[4] = gw0; ((float*)ro)[5] = gw1;
            inv2[(size_t)e0 * 16384 + r0] = 2 * tok; inv2[(size_t)e1 * 16384 + r1] = 2 * tok + 1; } }
        __syncthreads();
    }
}
__device__ __forceinline__ void moe_table(const Ctx& C, LAS int* tst) {
    if (C.tid < NE) tst[80 + C.tid] = (int)__hip_atomic_load(C.ctl + CW_CNT + C.tid * CNT_STRIDE, RLX_AGENT);
    __syncthreads();
    if (C.tid == 0) { int acc = 0; for (int e = 0; e < NE; ++e) { tst[e] = acc; acc += (tst[80 + e] + 127) >> 7; } tst[NE] = acc; }
    __syncthreads();
}
__device__ __forceinline__ int moe_expert_of(const LAS int* tst, int t) { int e = 0;
#pragma unroll 1
    for (int j = 1; j < NE; ++j) if (tst[j] <= t) e = j;
    return e; }
__device__ __forceinline__ bool moe_unit(const LAS int* tst, int NT, int grp, int ngrp, int u, int& e, int& t, int& nt) {
#pragma unroll 1
    for (int ee = grp; ee < NE; ee += ngrp) { const int nu = (tst[ee + 1] - tst[ee]) * NT; if (u < nu) { e = ee; t = tst[ee] + u / NT; nt = u % NT; return true; } u -= nu; }
    return false;
}
struct UpRow { const bf16* h1; const int* lst; int l0, cnt;
    __device__ __forceinline__ const bf16* operator()(int r) const { const int p = (l0 + r < cnt) ? lst[l0 + r] : -1; return h1 + (size_t)(p < 0 ? 0 : (p >> 1)) * D; } };
struct UpEpi { bf16* hid; int pos0, hc0;
    __device__ __forceinline__ void operator()(const f32x4 (&acc)[4][4], int wr, int wc, int fr, int fq) const {
#pragma unroll
        for (int m = 0; m < 4; ++m) { const int row = pos0 + 64 * wr + 16 * m + fr;
#pragma unroll
            for (int n2 = 0; n2 < 2; ++n2) { const f32x4 a = acc[m][2 * n2], b = acc[m][2 * n2 + 1]; const int hc = hc0 + 32 * wc + 16 * n2 + 4 * fq;
                mg::u32x2 w; w.x = pk2(silu_(a[0]) * b[0], silu_(a[1]) * b[1]); w.y = pk2(silu_(a[2]) * b[2], silu_(a[3]) * b[3]);
                *(mg::u32x2*)(hid + (size_t)row * 256 + hc) = w; } }
    } };
__device__ __forceinline__ int moe_group_units(const LAS int* tst, int NT, int grp, int ngrp) { int n = 0;
#pragma unroll 1
    for (int ee = grp; ee < NE; ee += ngrp) n += (tst[ee + 1] - tst[ee]) * NT;
    return n; }
constexpr int MOE_TAB_OFF = 150528, MOE_BATCH = 8;
__device__ __forceinline__ void phase9_up(const Ctx& C) {
    LAS int* tst = (LAS int*)(C.lds + 149504); moe_table(C, tst);
    LAS int* tab = (LAS int*)(C.lds + MOE_TAB_OFF);
    const int ngrp = (C.G % 8 == 0) ? 8 : 1, grp = C.wg % ngrp, gsz = C.G / ngrp;
    const int total = moe_group_units(tst, 2, grp, ngrp), first = C.wg / ngrp, nmine = total > first ? (total - first + gsz - 1) / gsz : 0;
    const int lr = C.tid >> 3, ch = ((C.lane & 7) ^ ((C.lane >> 3) & 7)) * 8;
    const bf16* h1 = (const bf16*)(C.ws + WS_H1); const bf16* W13 = (const bf16*)(C.ws + WS_W13); const int* inv2 = (const int*)(C.ws + WS_INV2);
    int sbase = 0;
    for (int b0 = 0; b0 < nmine; b0 += MOE_BATCH) { const int nu = nmine - b0 < MOE_BATCH ? nmine - b0 : MOE_BATCH;
        __syncthreads();
        int pv[2];
#pragma unroll
        for (int ps = 0; ps < 2; ++ps) { const int u = ps * 4 + (C.tid >> 7), row = C.tid & 127; int e, t, nt; pv[ps] = -1;
            if (u < nu && moe_unit(tst, 2, grp, ngrp, first + (b0 + u) * gsz, e, t, nt)) { const int li = 128 * (t - tst[e]) + row; if (li < tst[80 + e]) pv[ps] = inv2[(size_t)e * 16384 + li]; } }
#pragma unroll
        for (int ps = 0; ps < 2; ++ps) { const int u = ps * 4 + (C.tid >> 7), row = C.tid & 127; tab[u * 128 + row] = pv[ps] < 0 ? 0 : (pv[ps] >> 1); }
        __syncthreads();
        mg::Src cur, nxt; int e, t, nt;
        (void)moe_unit(tst, 2, grp, ngrp, first + b0 * gsz, e, t, nt);
        cur.pa0 = h1 + (size_t)tab[lr] * D + ch; cur.pa1 = h1 + (size_t)tab[64 + lr] * D + ch; cur.pb = W13 + (size_t)e * 524288 + (size_t)nt * 16 * 16384 + (size_t)lr * 64 + ch;
#pragma unroll 1
        for (int i = 0; i < nu; ++i) { const bool has_next = i + 1 < nu; int e2 = e, t2 = t, nt2 = nt; nxt = cur;
            if (has_next) { (void)moe_unit(tst, 2, grp, ngrp, first + (b0 + i + 1) * gsz, e2, t2, nt2);
                nxt.pa0 = h1 + (size_t)tab[(i + 1) * 128 + lr] * D + ch; nxt.pa1 = h1 + (size_t)tab[(i + 1) * 128 + 64 + lr] * D + ch; nxt.pb = W13 + (size_t)e2 * 524288 + (size_t)nt2 * 16 * 16384 + (size_t)lr * 64 + ch; }
            UpEpi ep{(bf16*)(C.ws + WS_HID), 128 * t, 128 * nt};
            mg::tile_pipe(C.lds, cur, 16, i == 0, has_next, nxt, sbase, ep);
            cur = nxt; e = e2; t = t2; nt = nt2; }
    }
}
struct DnRow { const bf16* hid; int pos0; __device__ __forceinline__ const bf16* operator()(int r) const { return hid + (size_t)(pos0 + r) * 256; } };
struct DnEpi { bf16* slots; const int* lst; const int* route; int l0, cnt, c0;
    __device__ __forceinline__ void operator()(const f32x4 (&acc)[4][4], int wr, int wc, int fr, int fq) const {
#pragma unroll
        for (int m = 0; m < 4; ++m) { const int li = l0 + 64 * wr + 16 * m + fr; if (li >= cnt) continue; const int p = lst[li];
            const float gt = ((const float*)route)[(size_t)(p >> 1) * 8 + 4 + (p & 1)];
#pragma unroll
            for (int n = 0; n < 4; ++n) { const f32x4 a = acc[m][n] * gt; mg::u32x2 w; w.x = pk2(a[0], a[1]); w.y = pk2(a[2], a[3]);
                *(mg::u32x2*)(slots + (size_t)p * D + c0 + 64 * wc + 16 * n + 4 * fq) = w; } }
    } };
struct DnEpi2 { bf16* slots; const LAS int* tab; int c0;
    __device__ __forceinline__ void operator()(const f32x4 (&acc)[4][4], int wr, int wc, int fr, int fq) const {
#pragma unroll
        for (int m = 0; m < 4; ++m) { const mg::u32x2 pg = *(const LAS mg::u32x2*)(tab + 2 * (64 * wr + 16 * m + fr)); const int p = (int)pg.x; if (p < 0) continue;
            const float gt = __uint_as_float(pg.y);
#pragma unroll
            for (int n = 0; n < 4; ++n) { const f32x4 a = acc[m][n] * gt; mg::u32x2 w; w.x = pk2(a[0], a[1]); w.y = pk2(a[2], a[3]);
                *(mg::u32x2*)(slots + (size_t)p * D + c0 + 64 * wc + 16 * n + 4 * fq) = w; } }
    } };
__device__ __forceinline__ void phase10_down(const Ctx& C, bool have_table) {
    LAS int* tst = (LAS int*)(C.lds + 149504); if (!have_table) moe_table(C, tst);
    LAS int* tab = (LAS int*)(C.lds + MOE_TAB_OFF);
    const int ngrp = (C.G % 8 == 0) ? 8 : 1, grp = C.wg % ngrp, gsz = C.G / ngrp;
    const int total = moe_group_units(tst, 4, grp, ngrp), first = C.wg / ngrp, nmine = total > first ? (total - first + gsz - 1) / gsz : 0;
    const int lr = C.tid >> 3, ch = ((C.lane & 7) ^ ((C.lane >> 3) & 7)) * 8;
    const bf16* hid = (const bf16*)(C.ws + WS_HID); const bf16* W2 = (const bf16*)(C.ws + WS_W2); const int* inv2 = (const int*)(C.ws + WS_INV2); const float* route = (const float*)(C.ws + WS_ROUTE);
    int sbase = 0;
    for (int b0 = 0; b0 < nmine; b0 += MOE_BATCH) { const int nu = nmine - b0 < MOE_BATCH ? nmine - b0 : MOE_BATCH;
        __syncthreads();
        int pv[2]; float gv[2];
#pragma unroll
        for (int ps = 0; ps < 2; ++ps) { const int u = ps * 4 + (C.tid >> 7), row = C.tid & 127; int e, t, nt; pv[ps] = -1;
            if (u < nu && moe_unit(tst, 4, grp, ngrp, first + (b0 + u) * gsz, e, t, nt)) { const int li = 128 * (t - tst[e]) + row; if (li < tst[80 + e]) pv[ps] = inv2[(size_t)e * 16384 + li]; } }
#pragma unroll
        for (int ps = 0; ps < 2; ++ps) gv[ps] = pv[ps] >= 0 ? route[(size_t)(pv[ps] >> 1) * 8 + 4 + (pv[ps] & 1)] : 0.f;
#pragma unroll
        for (int ps = 0; ps < 2; ++ps) { const int u = ps * 4 + (C.tid >> 7), row = C.tid & 127; mg::u32x2 w; w.x = (unsigned)pv[ps]; w.y = __float_as_uint(gv[ps]); *(LAS mg::u32x2*)(tab + 2 * (u * 128 + row)) = w; }
        __syncthreads();
        mg::Src cur, nxt; int e, t, nt;
        (void)moe_unit(tst, 4, grp, ngrp, first + b0 * gsz, e, t, nt);
        cur.pa0 = hid + (size_t)(128 * t + lr) * 256 + ch; cur.pa1 = cur.pa0 + 64 * 256; cur.pb = W2 + (size_t)e * 262144 + (size_t)nt * 4 * 16384 + (size_t)lr * 64 + ch;
#pragma unroll 1
        for (int i = 0; i < nu; ++i) { const bool has_next = i + 1 < nu; int e2 = e, t2 = t, nt2 = nt; nxt = cur;
            if (has_next) { (void)moe_unit(tst, 4, grp, ngrp, first + (b0 + i + 1) * gsz, e2, t2, nt2);
                nxt.pa0 = hid + (size_t)(128 * t2 + lr) * 256 + ch; nxt.pa1 = nxt.pa0 + 64 * 256; nxt.pb = W2 + (size_t)e2 * 262144 + (size_t)nt2 * 4 * 16384 + (size_t)lr * 64 + ch; }
            DnEpi2 ep{(bf16*)C.out, tab + 2 * (i * 128), 256 * nt};
            mg::tile_pipe(C.lds, cur, 4, i == 0, has_next, nxt, sbase, ep);
            cur = nxt; e = e2; t = t2; nt = nt2; }
    }
}
constexpr int CW_TRDY = 24576;
struct MoeEpi { int up; bf16* hid; int pos0, hc0; bf16* slots; const LAS int* tab; int c0;
    __device__ __forceinline__ void operator()(const f32x4 (&acc)[4][4], int wr, int wc, int fr, int fq) const {
        if (up) {
#pragma unroll
            for (int m = 0; m < 4; ++m) { const int row = pos0 + 64 * wr + 16 * m + fr;
#pragma unroll
                for (int n2 = 0; n2 < 2; ++n2) { const f32x4 a = acc[m][2 * n2], b = acc[m][2 * n2 + 1]; const int hc = hc0 + 32 * wc + 16 * n2 + 4 * fq;
                    mg::u32x2 w; w.x = pk2(silu_(a[0]) * b[0], silu_(a[1]) * b[1]); w.y = pk2(silu_(a[2]) * b[2], silu_(a[3]) * b[3]);
                    asm volatile("global_store_dwordx2 %0, %1, off sc0 sc1" :: "v"(hid + (size_t)row * 256 + hc), "v"(w) : "memory"); } }
        } else {
#pragma unroll
            for (int m = 0; m < 4; ++m) { const mg::u32x2 pg = *(const LAS mg::u32x2*)(tab + 2 * (64 * wr + 16 * m + fr)); const int p = (int)pg.x; if (p < 0) continue;
                const float gt = __uint_as_float(pg.y);
#pragma unroll
                for (int n = 0; n < 4; ++n) { const f32x4 a = acc[m][n] * gt; mg::u32x2 w; w.x = pk2(a[0], a[1]); w.y = pk2(a[2], a[3]);
                    *(mg::u32x2*)(slots + (size_t)p * D + c0 + 64 * wc + 16 * n + 4 * fq) = w; } }
        }
    } };
__device__ __forceinline__ void phase_moe(const Ctx& C) {
    LAS int* tst = (LAS int*)(C.lds + 149504); moe_table(C, tst);
    LAS int* tab = (LAS int*)(C.lds + MOE_TAB_OFF);
    volatile LAS int* flg = (volatile LAS int*)(C.lds + MOE_TAB_OFF + MOE_BATCH * 1024);
    const int ngrp = (C.G % 8 == 0) ? 8 : 1, grp = C.wg % ngrp, gsz = C.G / ngrp, first = C.wg / ngrp;
    const int U8 = moe_group_units(tst, 2, grp, ngrp), U9 = 2 * U8;
    const int n8 = U8 > first ? (U8 - first + gsz - 1) / gsz : 0;
    const int r8 = U8 % gsz, light = (r8 != 0 && first >= r8) ? 1 : 0;
    const int B = r8 ? 2 * (gsz - r8) : 0;
    int nb = 0; if (light) { const int v0 = 2 * (first - r8); nb = v0 + 1 < U9 ? 2 : (v0 < U9 ? 1 : 0); }
    const int nreg = U9 > B + first ? (U9 - B - first + gsz - 1) / gsz : 0;
    const int nall = n8 + nb + nreg;
#define MOE_DECODE(i_, up_, e_, t_, nt_) do { const int ii_ = (i_); up_ = ii_ < n8; int v_; if (up_) v_ = first + ii_ * gsz; else if (ii_ - n8 < nb) v_ = 2 * (first - r8) + (ii_ - n8); else v_ = B + first + (ii_ - n8 - nb) * gsz; \
        (void)moe_unit(tst, up_ ? 2 : 4, grp, ngrp, v_, e_, t_, nt_); } while (0)
    const int lr = C.tid >> 3, ch = ((C.lane & 7) ^ ((C.lane >> 3) & 7)) * 8;
    const bf16* h1 = (const bf16*)(C.ws + WS_H1); const bf16* hid = (const bf16*)(C.ws + WS_HID); const bf16* W13 = (const bf16*)(C.ws + WS_W13); const bf16* W2 = (const bf16*)(C.ws + WS_W2);
    const int* inv2 = (const int*)(C.ws + WS_INV2); const float* route = (const float*)(C.ws + WS_ROUTE); unsigned* trdy = (unsigned*)(C.ctl + CW_TRDY);
    int sbase = 0; unsigned* pend = nullptr; bool prefetched = false;
#define MOE_SRC(S_, up_, e_, t_, nt_, ui_) do { if (up_) { (S_).pa0 = h1 + (size_t)tab[2 * ((ui_) * 128 + lr)] * D + ch; (S_).pa1 = h1 + (size_t)tab[2 * ((ui_) * 128 + 64 + lr)] * D + ch; \
            (S_).pb = W13 + (size_t)(e_) * 524288 + (size_t)(nt_) * 16 * 16384 + (size_t)lr * 64 + ch; } \
        else { (S_).pa0 = hid + (size_t)(128 * (t_) + lr) * 256 + ch; (S_).pa1 = (S_).pa0 + 64 * 256; (S_).pb = W2 + (size_t)(e_) * 262144 + (size_t)(nt_) * 4 * 16384 + (size_t)lr * 64 + ch; } } while (0)
    for (int b0 = 0; b0 < nall; b0 += MOE_BATCH) { const int nu = nall - b0 < MOE_BATCH ? nall - b0 : MOE_BATCH;
        __syncthreads();
        int pv[2]; float gv[2];
#pragma unroll
        for (int ps = 0; ps < 2; ++ps) { const int u = ps * 4 + (C.tid >> 7), row = C.tid & 127; pv[ps] = -1;
            if (u < nu) { int up, e, t, nt; MOE_DECODE(b0 + u, up, e, t, nt); const int li = 128 * (t - tst[e]) + row; if (li < tst[80 + e]) pv[ps] = inv2[(size_t)e * 16384 + li]; } }
#pragma unroll
        for (int ps = 0; ps < 2; ++ps) gv[ps] = pv[ps] >= 0 ? route[(size_t)(pv[ps] >> 1) * 8 + 4 + (pv[ps] & 1)] : 0.f;
#pragma unroll
        for (int ps = 0; ps < 2; ++ps) { const int u = ps * 4 + (C.tid >> 7), row = C.tid & 127; const bool isup = b0 + u < n8;
            mg::u32x2 w; w.x = isup ? (unsigned)(pv[ps] < 0 ? 0 : (pv[ps] >> 1)) : (unsigned)pv[ps]; w.y = __float_as_uint(gv[ps]); *(LAS mg::u32x2*)(tab + 2 * (u * 128 + row)) = w; }
        __syncthreads();
        prefetched = false;
        int up, e, t, nt; MOE_DECODE(b0, up, e, t, nt);
        mg::Src cur, nxt; MOE_SRC(cur, up, e, t, nt, 0);
#pragma unroll 1
        for (int i = 0; i < nu; ++i) {
            if (!up && !prefetched) {
                if (pend) { asm volatile("s_waitcnt vmcnt(0)" ::: "memory"); __syncthreads(); if (C.tid == 0) (void)__hip_atomic_fetch_add(pend, 1u, RLX_AGENT); pend = nullptr; }
                if (C.tid == 0) { unsigned sp = 0; while (__hip_atomic_load(trdy + t, RLX_AGENT) < 2u) { __builtin_amdgcn_s_sleep(2); if (++sp > (1u << 22)) break; } }
                __syncthreads(); }
            const bool has_next = i + 1 < nu; int up2 = up, e2 = e, t2 = t, nt2 = nt; nxt = cur; bool can = has_next;
            if (has_next) { MOE_DECODE(b0 + i + 1, up2, e2, t2, nt2);
                if (!up2) {
                    if (C.tid == 0) flg[i & 1] = __hip_atomic_load(trdy + t2, RLX_AGENT) >= 2u ? 1 : 0;
                    __syncthreads(); can = flg[i & 1] != 0; }
                if (can) MOE_SRC(nxt, up2, e2, t2, nt2, i + 1); }
            MoeEpi ep{up, (bf16*)(C.ws + WS_HID), 128 * t, 128 * nt, (bf16*)C.out, tab + 2 * (i * 128), 256 * nt};
            mg::tile_pipe(C.lds, cur, up ? 16 : 4, !prefetched, can, nxt, sbase, ep, pend);
            pend = up ? trdy + t : nullptr; prefetched = can;
            if (has_next) { if (!can) MOE_SRC(nxt, up2, e2, t2, nt2, i + 1); cur = nxt; up = up2; e = e2; t = t2; nt = nt2; } }
    }
    if (pend) { asm volatile("s_waitcnt vmcnt(0)" ::: "memory"); __syncthreads(); if (C.tid == 0) (void)__hip_atomic_fetch_add(pend, 1u, RLX_AGENT); }
    asm volatile("s_waitcnt vmcnt(0)" ::: "memory"); __syncthreads();
#undef MOE_DECODE
#undef MOE_SRC
}
template <int MODE>
__device__ __forceinline__ void phase11_final(const Ctx& C) {
    const int gw = C.wg * NWAVES + C.wave, NGW = C.G * NWAVES, lane = C.lane;
    const bf16* h1 = (const bf16*)(C.ws + WS_H1); const bf16* slots = (const bf16*)C.out; const float* g2 = C.in[30]; const float* b2 = C.in[31];
    for (int row0 = gw * 4; row0 < MX; row0 += NGW * 4) {
        f32x4 v[4][4];
#pragma unroll
        for (int rr = 0; rr < 4; ++rr)
#pragma unroll
            for (int j = 0; j < 4; ++j) { const int c = 4 * lane + 256 * j; const int row = row0 + rr;
                const mg::u32x2 hw = __builtin_nontemporal_load((const mg::u32x2*)(h1 + (size_t)row * D + c)), s0 = __builtin_nontemporal_load((const mg::u32x2*)(slots + (size_t)(2 * row) * D + c)), s1 = __builtin_nontemporal_load((const mg::u32x2*)(slots + (size_t)(2 * row + 1) * D + c));
                v[rr][j].x = ALPHA * bflo(hw.x) + bflo(s0.x) + bflo(s1.x); v[rr][j].y = ALPHA * bfhi(hw.x) + bfhi(s0.x) + bfhi(s1.x);
                v[rr][j].z = ALPHA * bflo(hw.y) + bflo(s0.y) + bflo(s1.y); v[rr][j].w = ALPHA * bfhi(hw.y) + bfhi(s0.y) + bfhi(s1.y); }
        float mean, rstd;
#pragma unroll
        for (int rr = 0; rr < 4; ++rr) ln_row(v[rr], g2, b2, lane, 1.f, mean, rstd);
#pragma unroll
        for (int rr = 0; rr < 4; ++rr)
#pragma unroll
            for (int j = 0; j < 4; ++j) { if (MODE == 0) __builtin_nontemporal_store(v[rr][j], (f32x4*)(C.out + (size_t)(row0 + rr) * D + 4 * lane + 256 * j)); else asm volatile("" :: "v"(v[rr][j])); }
    }
}

constexpr int DN_ITEM_BYTES = 41 * 1024, DN_ITEMS = NB * NH * NCH, DN_IN_OUT = (int)((64 * MiB) / DN_ITEM_BYTES);
constexpr size_t WS_DNX = WS_MERGED;
static_assert((size_t)(DN_ITEMS - DN_IN_OUT) * DN_ITEM_BYTES <= 32 * MiB, "dn overflow");
constexpr size_t WS_ORAW = WS_OA;
__device__ __forceinline__ unsigned char* dn_item_ptr(float* out, unsigned char* ws, int item) {
    return item < DN_IN_OUT ? (unsigned char*)out + (size_t)item * DN_ITEM_BYTES : ws + WS_DNX + (size_t)(item - DN_IN_OUT) * DN_ITEM_BYTES; }
typedef unsigned u32x2_t __attribute__((ext_vector_type(2)));
__device__ __forceinline__ v4u pack8(const f32x4 a, const f32x4 b) { v4u w; w.x = pk2(a[0], a[1]); w.y = pk2(a[2], a[3]); w.z = pk2(b[0], b[1]); w.w = pk2(b[2], b[3]); return w; }
__device__ __forceinline__ bf16x8 as_bf16x8(const v4u w) { return __builtin_bit_cast(bf16x8, w); }

constexpr int SLOT_BYTES = 29312, SL_Q = 0, SL_K = 9216, SL_V = 18432, SL_SC = 27648, SL_HALO = 28160, SROW = 144, DN_SLOTS = 4;
constexpr int CW_LATE = 17920;
constexpr int DN_EARLY = NB * NH * 64;

__device__ __forceinline__ void chunk_prep(const Ctx& C, bool late, int wg0) {
    const int slot = C.wave >> 1, wsl = C.wave & 1;
    LAS unsigned char* const SL0 = C.lds + slot * SLOT_BYTES;
#define DN_REBASE() int lane = C.lane; asm volatile("" : "+v"(lane)); const int rr = lane & 15, qq = lane >> 4, st = lane + 64 * wsl; (void)rr; (void)qq; (void)st; LAS unsigned char* const SL = SL0; LAS float* const SC = (LAS float*)(SL + SL_SC)
    const bf16* qkv = (const bf16*)(C.ws + WS_QKV); const float* ab = (const float*)(C.ws + WS_AB);
    const float* cw = C.in[5]; const float* a_log = C.in[6]; const float* dt_bias = C.in[7];
    const int total = late ? NB * NH : DN_EARLY, nround = late ? 1 : (DN_EARLY + C.G * DN_SLOTS - 1) / (C.G * DN_SLOTS);
    for (int rd = 0; rd < nround; ++rd) {
        int wi = late ? (C.wg - wg0) * DN_SLOTS + slot : (rd * C.G + C.wg) * DN_SLOTS + slot; if (wi >= total) wi = total - 1;
        const int bh = late ? wi : (wi >> 6), n = late ? 64 : (wi & 63), h = bh & 7, b = bh >> 3;
        unsigned char* dst = dn_item_ptr(C.out, C.ws, bh * NCH + n);
        { DN_REBASE();
            v4u rw[13];
#pragma unroll
            for (int i = 0; i < 13; ++i) { const int p = st + 128 * i, rm = p >> 3, c8 = p & 7, row = rm / 3 - 3, m = rm - 3 * (rm / 3), grow = 64 * n + row;
                rw[i] = (p < 1608 && grow >= 0) ? *(const v4u*)(qkv + (size_t)(b * LP + grow) * 1536 + m * 512 + h * 64 + c8 * 8) : (v4u){0u, 0u, 0u, 0u}; }
            if (wsl == 0) { const int gi = 64 * n + lane; float g = 0.f, be = 0.f;
                if (gi >= PADF) { const float* a2 = ab + (size_t)(b * LP + gi) * 16; be = sigm(a2[8 + h]); g = -expf(a_log[h]) * softplus_(a2[h] + dt_bias[h]); }
#pragma unroll
                for (int o = 1; o < 64; o <<= 1) { const float t = __shfl_up(g, o); if (lane >= o) g += t; }
                SC[lane] = g; SC[64 + lane] = be; }
#pragma unroll
            for (int i = 0; i < 13; ++i) { const int p = st + 128 * i, rm = p >> 3, c8 = p & 7, row = rm / 3 - 3, m = rm - 3 * (rm / 3);
                if (p < 1608) { LAS unsigned char* dp = row >= 0 ? SL + m * 9216 + row * SROW + c8 * 16 : SL + SL_HALO + ((row + 3) * 3 + m) * 128 + c8 * 16; *(LAS v4u*)dp = rw[i]; } }
        }
        __syncthreads();
        float cq0 = 0.f, cq1 = 0.f, cq2 = 0.f, ck0 = 0.f, ck1 = 0.f, ck2 = 0.f, cv0 = 0.f, cv1 = 0.f, cv2 = 0.f;
        { DN_REBASE(); const int d = lane;
            if (wsl == 0) { const LAS unsigned char* hp = SL + SL_HALO + d * 2;
                cq0 = bf2f(*(const LAS bf16*)(hp + 0 * 128)); ck0 = bf2f(*(const LAS bf16*)(hp + 1 * 128)); cv0 = bf2f(*(const LAS bf16*)(hp + 2 * 128));
                cq1 = bf2f(*(const LAS bf16*)(hp + 3 * 128)); ck1 = bf2f(*(const LAS bf16*)(hp + 4 * 128)); cv1 = bf2f(*(const LAS bf16*)(hp + 5 * 128));
                cq2 = bf2f(*(const LAS bf16*)(hp + 6 * 128)); ck2 = bf2f(*(const LAS bf16*)(hp + 7 * 128)); cv2 = bf2f(*(const LAS bf16*)(hp + 8 * 128));
            } else { const LAS unsigned char* mp = SL + 29 * SROW + d * 2;
                cq0 = bf2f(*(const LAS bf16*)(mp + SL_Q)); ck0 = bf2f(*(const LAS bf16*)(mp + SL_K)); cv0 = bf2f(*(const LAS bf16*)(mp + SL_V));
                cq1 = bf2f(*(const LAS bf16*)(mp + SL_Q + SROW)); ck1 = bf2f(*(const LAS bf16*)(mp + SL_K + SROW)); cv1 = bf2f(*(const LAS bf16*)(mp + SL_V + SROW));
                cq2 = bf2f(*(const LAS bf16*)(mp + SL_Q + 2 * SROW)); ck2 = bf2f(*(const LAS bf16*)(mp + SL_K + 2 * SROW)); cv2 = bf2f(*(const LAS bf16*)(mp + SL_V + 2 * SROW)); }
        }
        __syncthreads();
        { DN_REBASE(); const int d = lane, ch = h * 64 + d;
            float wq[4], wk[4], wv[4];
#pragma unroll
            for (int j = 0; j < 4; ++j) { wq[j] = cw[j * 1536 + ch]; wk[j] = cw[j * 1536 + 512 + ch]; wv[j] = cw[j * 1536 + 1024 + ch]; }
            LAS unsigned char* rp = SL + (32 * wsl) * SROW + d * 2;
#pragma unroll 8
            for (int r = 0; r < 32; ++r, rp += SROW) { const float q3 = bf2f(*(const LAS bf16*)(rp + SL_Q)), k3 = bf2f(*(const LAS bf16*)(rp + SL_K)), v3 = bf2f(*(const LAS bf16*)(rp + SL_V));
                const float q = silu_(wq[0] * cq0 + wq[1] * cq1 + wq[2] * cq2 + wq[3] * q3), k = silu_(wk[0] * ck0 + wk[1] * ck1 + wk[2] * ck2 + wk[3] * k3), v = silu_(wv[0] * cv0 + wv[1] * cv1 + wv[2] * cv2 + wv[3] * v3);
                cq0 = cq1; cq1 = cq2; cq2 = q3; ck0 = ck1; ck1 = ck2; ck2 = k3; cv0 = cv1; cv1 = cv2; cv2 = v3;
                *(LAS bf16*)(rp + SL_Q) = (bf16)f2bf(q); *(LAS bf16*)(rp + SL_K) = (bf16)f2bf(k); *(LAS bf16*)(rp + SL_V) = (bf16)f2bf(v); }
        }
        __syncthreads();
        { DN_REBASE(); LAS unsigned char* rp = SL + (wsl == 0 ? SL_Q : SL_K) + lane * SROW;
            v4u w[8]; float ss = 0.f;
#pragma unroll
            for (int c = 0; c < 8; ++c) { w[c] = *(const LAS v4u*)(rp + c * 16);
                ss += bflo(w[c].x) * bflo(w[c].x) + bfhi(w[c].x) * bfhi(w[c].x) + bflo(w[c].y) * bflo(w[c].y) + bfhi(w[c].y) * bfhi(w[c].y)
                    + bflo(w[c].z) * bflo(w[c].z) + bfhi(w[c].z) * bfhi(w[c].z) + bflo(w[c].w) * bflo(w[c].w) + bfhi(w[c].w) * bfhi(w[c].w); }
            const float sc = (__builtin_amdgcn_rsqf(ss + NORM_EPS)) * (wsl == 0 ? 0.125f : 1.f);
#pragma unroll
            for (int c = 0; c < 8; ++c) { v4u o; o.x = pk2(bflo(w[c].x) * sc, bfhi(w[c].x) * sc); o.y = pk2(bflo(w[c].y) * sc, bfhi(w[c].y) * sc); o.z = pk2(bflo(w[c].z) * sc, bfhi(w[c].z) * sc); o.w = pk2(bflo(w[c].w) * sc, bfhi(w[c].w) * sc);
                *(LAS v4u*)(rp + c * 16) = o; }
        }
        __syncthreads();
        float x[64]; f32x4 am[2][4];
        { DN_REBASE();
#pragma unroll
            for (int i = 0; i < 64; ++i) { const float be = SC[64 + i];
                if (wsl == 0) x[i] = be * bf2f(*(const LAS bf16*)(SL + SL_V + i * SROW + lane * 2)); else x[i] = be * __expf(SC[i]) * bf2f(*(const LAS bf16*)(SL + SL_K + i * SROW + lane * 2)); }
#pragma unroll
            for (int tix = 0; tix < 2; ++tix) { const int ti = wsl == 0 ? (tix == 0 ? 0 : 3) : (tix == 0 ? 1 : 2);
                bf16x8 kfi[2], qfi[2];
#pragma unroll
                for (int s = 0; s < 2; ++s) { kfi[s] = *(const LAS bf16x8*)(SL + SL_K + (16 * ti + rr) * SROW + s * 64 + qq * 16); qfi[s] = *(const LAS bf16x8*)(SL + SL_Q + (16 * ti + rr) * SROW + s * 64 + qq * 16); }
                const int i = 16 * ti + rr; const float gci = SC[i];
                f32x4 atv[4];
#pragma unroll
                for (int tj = 0; tj < 4; ++tj) {
                    f32x4 d1 = (f32x4){0.f, 0.f, 0.f, 0.f}, d2 = d1;
                    if (tj <= ti) {
#pragma unroll
                        for (int s = 0; s < 2; ++s) { const bf16x8 kfj = *(const LAS bf16x8*)(SL + SL_K + (16 * tj + rr) * SROW + s * 64 + qq * 16);
                            d1 = __builtin_amdgcn_mfma_f32_16x16x32_bf16(kfi[s], kfj, d1, 0, 0, 0);
                            d2 = __builtin_amdgcn_mfma_f32_16x16x32_bf16(kfj, qfi[s], d2, 0, 0, 0); }
                        const float gcj1 = SC[16 * tj + rr];
#pragma unroll
                        for (int r = 0; r < 4; ++r) { const int j = 16 * tj + 4 * qq + r; const float dec = __expf(gci - SC[j]); d2[r] = (j <= i) ? d2[r] * dec : 0.f;
                            const int i1 = 16 * ti + 4 * qq + r; d1[r] = (16 * tj + rr < i1) ? d1[r] * SC[64 + i1] * __expf(SC[i1] - gcj1) : 0.f; }
                    }
                    am[tix][tj] = d1; atv[tj] = d2;
                }
#pragma unroll
                for (int s = 0; s < 2; ++s) *(GAS v4u*)(dst + 16384 + ((ti * 2 + s) * 64 + lane) * 16) = pack8(atv[2 * s], atv[2 * s + 1]);
            }
            const float gcl = SC[63];
#pragma unroll
            for (int t2 = 0; t2 < 2; ++t2) { const int it = 2 * wsl + t2; const int i = 16 * it + rr; const float eg = __expf(SC[i]);
#pragma unroll
                for (int s = 0; s < 2; ++s) {
                    const u32x2_t a = *(const LAS u32x2_t*)(SL + SL_Q + i * SROW + (32 * s + 4 * qq) * 2), bq = *(const LAS u32x2_t*)(SL + SL_Q + i * SROW + (32 * s + 16 + 4 * qq) * 2);
                    v4u w; w.x = pk2(bflo(a.x) * eg, bfhi(a.x) * eg); w.y = pk2(bflo(a.y) * eg, bfhi(a.y) * eg); w.z = pk2(bflo(bq.x) * eg, bfhi(bq.x) * eg); w.w = pk2(bflo(bq.y) * eg, bfhi(bq.y) * eg);
                    *(GAS v4u*)(dst + 8192 + ((it * 2 + s) * 64 + lane) * 16) = w;
                    float kd[8];
#pragma unroll
                    for (int e = 0; e < 8; ++e) { const int ii = 32 * s + 16 * (e >> 2) + 4 * qq + (e & 3); kd[e] = bf2f(*(const LAS bf16*)(SL + SL_K + ii * SROW + (16 * it + rr) * 2)) * __expf(gcl - SC[ii]); }
                    v4u wk2; wk2.x = pk2(kd[0], kd[1]); wk2.y = pk2(kd[2], kd[3]); wk2.z = pk2(kd[4], kd[5]); wk2.w = pk2(kd[6], kd[7]);
                    *(GAS v4u*)(dst + 24576 + ((it * 2 + s) * 64 + lane) * 16) = wk2; } }
            if (wsl == 0) { const float gl = __expf(gcl); *(GAS f32x4*)(dst + 40960 + lane * 16) = (f32x4){gl, gl, gl, gl}; }
        }
        __syncthreads();
        { DN_REBASE();
#pragma unroll
            for (int tix = 0; tix < 2; ++tix) { const int ti = wsl == 0 ? (tix == 0 ? 0 : 3) : (tix == 0 ? 1 : 2);
#pragma unroll
                for (int tj = 0; tj < 4; ++tj) if (tj <= ti) *(LAS f32x4*)(SL + ((16 * tj + rr) * 64 + 16 * ti + 4 * qq) * 4) = am[tix][tj]; }
        }
        __syncthreads();
        { DN_REBASE();
            const LAS float* ATq = (const LAS float*)SL + (lane & 3);
            float cb[2][16];
#define QFMA(x_, a_, r_) asm("v_fmac_f32_dpp %0, %1, %2 quad_perm:[" #r_ "," #r_ "," #r_ "," #r_ "] row_mask:0xf bank_mask:0xf" : "+v"(x_) : "v"(a_), "v"(nxj))
#pragma unroll
            for (int m = 0; m < 16; ++m) cb[0][m] = ATq[4 * m];
#pragma unroll
            for (int j = 0; j < 63; ++j) { const float nxj = -x[j];
                if (j + 1 < 63) {
#pragma unroll
                    for (int m = (j + 2) >> 2; m < 16; ++m) cb[(j + 1) & 1][m] = ATq[(j + 1) * 64 + 4 * m]; }
#pragma unroll
                for (int m = (j + 1) >> 2; m < 16; ++m) { const float a = cb[j & 1][m];
                    if (4 * m > j) QFMA(x[4 * m], a, 0); if (4 * m + 1 > j) QFMA(x[4 * m + 1], a, 1); if (4 * m + 2 > j) QFMA(x[4 * m + 2], a, 2); QFMA(x[4 * m + 3], a, 3); }
                asm volatile("" : "+v"(x[j + 1]) :: "memory"); }
#undef QFMA
        }
        if (wsl == 0) { DN_REBASE(); const int vs = st >> 4, c = st & 15;
#pragma unroll
            for (int it = 0; it < 4; ++it)
#pragma unroll
                for (int q = 0; q < 4; ++q) { u32x2_t w; w.x = pk2(x[16 * it + 4 * q], x[16 * it + 4 * q + 1]); w.y = pk2(x[16 * it + 4 * q + 2], x[16 * it + 4 * q + 3]);
                    *(GAS u32x2_t*)(dst + 32768 + (((vs * 4 + it) * 64 + 16 * q + c) * 8)) = w; }
        } else { DN_REBASE();
#pragma unroll
            for (int i = 0; i < 64; ++i) *(LAS bf16*)(SL + SL_V + i * SROW + lane * 2) = (bf16)f2bf(-x[i]);
        }
        __syncthreads();
        { DN_REBASE();
#pragma unroll
        for (int t2 = 0; t2 < 2; ++t2) { const int it = 2 * wsl + t2; const int i = 16 * it + rr;
#pragma unroll
            for (int s = 0; s < 2; ++s) { const u32x2_t a = *(const LAS u32x2_t*)(SL + SL_V + i * SROW + (32 * s + 4 * qq) * 2), bq = *(const LAS u32x2_t*)(SL + SL_V + i * SROW + (32 * s + 16 + 4 * qq) * 2);
                v4u w; w.x = a.x; w.y = a.y; w.z = bq.x; w.w = bq.y; *(GAS v4u*)(dst + ((it * 2 + s) * 64 + lane) * 16) = w; } } }
        __syncthreads();
    }
#undef DN_REBASE
    if (late) {
        asm volatile("s_waitcnt vmcnt(0)" ::: "memory"); __syncthreads();
        if (C.tid == 0) { __builtin_amdgcn_fence(__ATOMIC_RELEASE, "agent"); asm volatile("s_waitcnt vmcnt(0)" ::: "memory");
            __hip_atomic_fetch_add(C.ctl + CW_LATE, (unsigned)DN_SLOTS, __ATOMIC_RELAXED, __HIP_MEMORY_SCOPE_AGENT); }
    }
}

__device__ __forceinline__ void dn_scan_mfma(const Ctx& C, int b, int h) {
    const int wave = C.wave, lane = C.lane;
    const int item0 = (b * NH + h) * NCH;
    bf16* oraw = (bf16*)(C.ws + WS_ORAW);
#define DN_ISSUE(n_) do { const unsigned char* src_ = dn_item_ptr(C.out, C.ws, item0 + (n_)); LAS unsigned char* ring_ = C.lds + ((n_) % 3) * DN_ITEM_BYTES; \
        for (int blk_ = wave - 4; blk_ < 41; blk_ += 4) __builtin_amdgcn_global_load_lds((const unsigned*)(src_ + blk_ * 1024 + lane * 16), (LAS unsigned*)(ring_ + blk_ * 1024), 16, 0, 0); } while (0)
    f32x4 S[4];
#pragma unroll
    for (int kt = 0; kt < 4; ++kt) S[kt] = (f32x4){0.f, 0.f, 0.f, 0.f};
    if (wave >= 4) { DN_ISSUE(0); DN_ISSUE(1); if (wave == 4) asm volatile("s_waitcnt vmcnt(11)" ::: "memory"); else asm volatile("s_waitcnt vmcnt(10)" ::: "memory"); }
    __builtin_amdgcn_s_barrier();
    for (int n = 0; n < NCH; ++n) {
        if (wave >= 4) {
            if (n + 2 == NCH - 1) {
                unsigned sp = 0; while (__hip_atomic_load(C.ctl + CW_LATE, RLX_AGENT) < (unsigned)(NB * NH)) { __builtin_amdgcn_s_sleep(4); if (++sp > (1u << 22)) break; }
                __builtin_amdgcn_fence(__ATOMIC_ACQUIRE, "agent"); }
            if (n + 2 < NCH) { DN_ISSUE(n + 2); if (wave == 4) asm volatile("s_waitcnt vmcnt(11)" ::: "memory"); else asm volatile("s_waitcnt vmcnt(10)" ::: "memory"); }
            else asm volatile("s_waitcnt vmcnt(0)" ::: "memory");
        } else {
            const LAS unsigned char* R = C.lds + (n % 3) * DN_ITEM_BYTES; const int vs = wave;
            const float gl = *(const LAS float*)(R + 40960);
            const bf16x8 Sb0 = as_bf16x8(pack8(S[0], S[1])), Sb1 = as_bf16x8(pack8(S[2], S[3]));
            f32x4 vn[4], o[4];
#pragma unroll
            for (int it = 0; it < 4; ++it) { const u32x2_t uc = *(const LAS u32x2_t*)(R + 32768 + ((vs * 4 + it) * 64 + lane) * 8);
                f32x4 a = (f32x4){bflo(uc.x), bfhi(uc.x), bflo(uc.y), bfhi(uc.y)};
                a = __builtin_amdgcn_mfma_f32_16x16x32_bf16(*(const LAS bf16x8*)(R + ((it * 2 + 0) * 64 + lane) * 16), Sb0, a, 0, 0, 0);
                a = __builtin_amdgcn_mfma_f32_16x16x32_bf16(*(const LAS bf16x8*)(R + ((it * 2 + 1) * 64 + lane) * 16), Sb1, a, 0, 0, 0);
                vn[it] = a;
                f32x4 oo = (f32x4){0.f, 0.f, 0.f, 0.f};
                oo = __builtin_amdgcn_mfma_f32_16x16x32_bf16(*(const LAS bf16x8*)(R + 8192 + ((it * 2 + 0) * 64 + lane) * 16), Sb0, oo, 0, 0, 0);
                oo = __builtin_amdgcn_mfma_f32_16x16x32_bf16(*(const LAS bf16x8*)(R + 8192 + ((it * 2 + 1) * 64 + lane) * 16), Sb1, oo, 0, 0, 0);
                o[it] = oo; }
            const bf16x8 Vb0 = as_bf16x8(pack8(vn[0], vn[1])), Vb1 = as_bf16x8(pack8(vn[2], vn[3]));
#pragma unroll
            for (int it = 0; it < 4; ++it) {
                o[it] = __builtin_amdgcn_mfma_f32_16x16x32_bf16(*(const LAS bf16x8*)(R + 16384 + ((it * 2 + 0) * 64 + lane) * 16), Vb0, o[it], 0, 0, 0);
                o[it] = __builtin_amdgcn_mfma_f32_16x16x32_bf16(*(const LAS bf16x8*)(R + 16384 + ((it * 2 + 1) * 64 + lane) * 16), Vb1, o[it], 0, 0, 0); }
#pragma unroll
            for (int kt = 0; kt < 4; ++kt) { f32x4 s = S[kt] * gl;
                s = __builtin_amdgcn_mfma_f32_16x16x32_bf16(*(const LAS bf16x8*)(R + 24576 + ((kt * 2 + 0) * 64 + lane) * 16), Vb0, s, 0, 0, 0);
                s = __builtin_amdgcn_mfma_f32_16x16x32_bf16(*(const LAS bf16x8*)(R + 24576 + ((kt * 2 + 1) * 64 + lane) * 16), Vb1, s, 0, 0, 0);
                S[kt] = s; }
            if (n >= 1) { const int q = lane >> 4, c = lane & 15; bf16* op = oraw + (size_t)(b * SEQ + 64 * (n - 1) + 4 * q) * 512 + h * 64 + 16 * vs + c;
#pragma unroll
                for (int it = 0; it < 4; ++it)
#pragma unroll
                    for (int r = 0; r < 4; ++r) op[(size_t)(16 * it + r) * 512] = (bf16)f2bf(o[it][r]); }
            asm volatile("s_waitcnt lgkmcnt(0)" ::: "memory");
        }
        __builtin_amdgcn_s_barrier();
    }
#undef DN_ISSUE
}
__device__ __forceinline__ void oa_postpass(const Ctx& C, int wg0, int nwg) {
    const int gw = (C.wg - wg0) * NWAVES + C.wave, NGW = nwg * NWAVES, lane = C.lane; if (C.wg < wg0) return;
    bf16* oa = (bf16*)(C.ws + WS_OA); const bf16* z = (const bf16*)(C.ws + WS_Z); const float* nw = C.in[8] + (lane & 7) * 8;
    float w8[8];
#pragma unroll
    for (int e = 0; e < 8; ++e) w8[e] = nw[e];
    for (int row = gw; row < MX; row += NGW) {
        const v4u r = *(const v4u*)(oa + (size_t)row * 512 + lane * 8), zz = *(const v4u*)(z + (size_t)prow_of(row) * 512 + lane * 8);
        float v[8] = {bflo(r.x), bfhi(r.x), bflo(r.y), bfhi(r.y), bflo(r.z), bfhi(r.z), bflo(r.w), bfhi(r.w)};
        const float zf[8] = {bflo(zz.x), bfhi(zz.x), bflo(zz.y), bfhi(zz.y), bflo(zz.z), bfhi(zz.z), bflo(zz.w), bfhi(zz.w)};
        float ss = 0.f;
#pragma unroll
        for (int e = 0; e < 8; ++e) ss += v[e] * v[e];
        ss += __shfl_xor(ss, 1); ss += __shfl_xor(ss, 2); ss += __shfl_xor(ss, 4);
        const float rs = __builtin_amdgcn_rsqf(ss * (1.f / 64.f) + NORM_EPS);
#pragma unroll
        for (int e = 0; e < 8; ++e) v[e] = v[e] * rs * w8[e] * silu_(zf[e]);
        v4u w; w.x = pk2(v[0], v[1]); w.y = pk2(v[2], v[3]); w.z = pk2(v[4], v[5]); w.w = pk2(v[6], v[7]);
        *(v4u*)(oa + (size_t)row * 512 + lane * 8) = w;
    }
}


constexpr size_t WS_KT = WS_MERGED + 20 * MiB;
constexpr size_t WS_M2 = WS_KT + 1 * MiB;
constexpr size_t WS_M3 = WS_OB;
static_assert(WS_M2 + 8 * MiB <= WS_END && (size_t)(DN_ITEMS - DN_IN_OUT) * DN_ITEM_BYTES <= 20 * MiB, "s5 tables");

__device__ __forceinline__ float gelu_fast(float x) { const float u2 = 1.5957691216057308f * (x + 0.044715f * x * x * x); return x * __builtin_amdgcn_rcpf(1.f + __expf(-u2)); }
struct S5P { float dt, ar, ai; };
__device__ __forceinline__ void s5_pow(const S5P& P, float d, float& re, float& im) { const float mag = expf(d * P.dt * P.ar); const float ang = d * P.dt * P.ai; re = mag * cosf(ang); im = mag * sinf(ang); }
__device__ __forceinline__ void s5_f(const S5P& P, float& fre, float& fim) { float are, aim; s5_pow(P, 1.f, are, aim); const float den = P.ar * P.ar + P.ai * P.ai, nr = are - 1.f, ni = aim;
    fre = (nr * P.ar + ni * P.ai) / den; fim = (ni * P.ar - nr * P.ai) / den; }

__device__ __forceinline__ void s5_tables(const Ctx& C) {
    const int gw = C.wg * NWAVES + C.wave, NGW = C.G * NWAVES, lane = C.lane, rr = lane & 15, kg = lane >> 4;
    LAS float* scr = (LAS float*)(C.lds + C.wave * 16384);
    const float* a_re = C.in[9]; const float* a_im = C.in[10]; const float* log_dt = C.in[11]; const float* b_re = C.in[12]; const float* b_im = C.in[13]; const float* c_re = C.in[14]; const float* c_im = C.in[15];
    bf16* KT = (bf16*)(C.ws + WS_KT); unsigned char* M2 = C.ws + WS_M2; unsigned char* M3 = C.ws + WS_M3;
    for (int it = gw; it < 2048 + 1024 + 2048; it += NGW) {
        if (it < 2048) {
            const int g = it >> 6, d = it & 63, p = lane; S5P P{expf(log_dt[g]), a_re[g * 64 + p], a_im[g * 64 + p]};
            float are, aim, fre, fim; s5_pow(P, (float)d, are, aim); s5_f(P, fre, fim);
            const float wr_ = are * fre - aim * fim, wi_ = are * fim + aim * fre;
            const float* br = b_re + ((size_t)g * 64 + p) * 16; const float* bi = b_im + ((size_t)g * 64 + p) * 16;
#pragma unroll
            for (int c = 0; c < 16; ++c) { scr[p * 32 + c] = wr_ * br[c] - wi_ * bi[c]; scr[p * 32 + 16 + c] = wr_ * bi[c] + wi_ * br[c]; }
            LDS_WAIT(); asm volatile("" ::: "memory");
            const int c = lane >> 2, c4 = (lane & 3) * 4; f32x4 acc = (f32x4){0.f, 0.f, 0.f, 0.f};
            const float* cr = c_re + ((size_t)g * 16 + c) * 64; const float* ci = c_im + ((size_t)g * 16 + c) * 64;
#pragma unroll 8
            for (int pp = 0; pp < 64; ++pp) { const f32x4 wre = *(const LAS f32x4*)(scr + pp * 32 + c4), wim = *(const LAS f32x4*)(scr + pp * 32 + 16 + c4); const float crv = cr[pp], civ = ci[pp];
                acc = acc + wre * crv - wim * civ; }
            u32x2_t w; w.x = pk2(acc[0], acc[1]); w.y = pk2(acc[2], acc[3]);
            *(GAS u32x2_t*)(KT + ((size_t)(g * 64 + d) * 256 + c * 16 + c4)) = w;
            LDS_WAIT(); asm volatile("" ::: "memory");
        } else if (it < 3072) {
            const int i2 = it - 2048, g = i2 >> 5, ks = i2 & 31, j = 2 * ks + (kg >> 1), ch = 8 * (kg & 1);
#pragma unroll 1
            for (int pq = 0; pq < 4; ++pq) { const int p = 16 * pq + rr; S5P P{expf(log_dt[g]), a_re[g * 64 + p], a_im[g * 64 + p]};
                float are, aim, fre, fim; s5_pow(P, (float)(63 - j), are, aim); s5_f(P, fre, fim);
                const float wr_ = are * fre - aim * fim, wi_ = are * fim + aim * fre;
                const float* br = b_re + ((size_t)g * 64 + p) * 16 + ch; const float* bi = b_im + ((size_t)g * 64 + p) * 16 + ch;
                float re[8], im[8];
#pragma unroll
                for (int e = 0; e < 8; ++e) { re[e] = wr_ * br[e] - wi_ * bi[e]; im[e] = wr_ * bi[e] + wi_ * br[e]; }
                v4u w; w.x = pk2(re[0], re[1]); w.y = pk2(re[2], re[3]); w.z = pk2(re[4], re[5]); w.w = pk2(re[6], re[7]);
                *(GAS v4u*)(M3 + (size_t)g * 262144 + ((size_t)((pq * 32 + ks) * 64 + lane)) * 16) = w;
                w.x = pk2(im[0], im[1]); w.y = pk2(im[2], im[3]); w.z = pk2(im[4], im[5]); w.w = pk2(im[6], im[7]);
                *(GAS v4u*)(M3 + (size_t)g * 262144 + ((size_t)(((4 + pq) * 32 + ks) * 64 + lane)) * 16) = w; }
        } else {
            const int i2 = it - 3072, g = i2 >> 6, t = i2 & 63, c = rr;
#pragma unroll 1
            for (int hf = 0; hf < 2; ++hf) { float vr[8], vi[8];
#pragma unroll
                for (int e = 0; e < 8; ++e) { const int p = 32 * hf + 8 * kg + e; S5P P{expf(log_dt[g]), a_re[g * 64 + p], a_im[g * 64 + p]};
                    float are, aim; s5_pow(P, (float)(t + 1), are, aim); const float crv = c_re[((size_t)g * 16 + c) * 64 + p], civ = c_im[((size_t)g * 16 + c) * 64 + p];
                    vr[e] = crv * are - civ * aim; vi[e] = -(crv * aim + civ * are); }
                v4u w; w.x = pk2(vr[0], vr[1]); w.y = pk2(vr[2], vr[3]); w.z = pk2(vr[4], vr[5]); w.w = pk2(vr[6], vr[7]);
                *(GAS v4u*)(M2 + (size_t)g * 262144 + ((size_t)((t * 4 + hf) * 64 + lane)) * 16) = w;
                w.x = pk2(vi[0], vi[1]); w.y = pk2(vi[2], vi[3]); w.z = pk2(vi[4], vi[5]); w.w = pk2(vi[6], vi[7]);
                *(GAS v4u*)(M2 + (size_t)g * 262144 + ((size_t)((t * 4 + 2 + hf) * 64 + lane)) * 16) = w; }
        }
    }
}

__device__ __forceinline__ void s5_mfma(const Ctx& C, int b, int g) {
    constexpr int UL_STRIDE = 2064, SLAB = 16 * UL_STRIDE;
    LAS unsigned char* KtL = C.lds; LAS unsigned char* B0 = C.lds + SLAB; LAS float* Hl = (LAS float*)(C.lds + 2 * SLAB);
    LAS unsigned char* Hin = (LAS unsigned char*)(Hl + 80 * 128);
    const int w = C.wave;
#define S5_RELANE() int tid = C.tid; asm volatile("" : "+v"(tid)); const int lane = tid & 63, cc = lane & 15, kg = lane >> 4; (void)cc; (void)kg
#define S5_SLAB_LOAD(nt_) do { S5_RELANE(); _Pragma("unroll") for (int i_ = 0; i_ < 4; ++i_) { const int pc = tid + 512 * i_, nl = pc >> 7, jj = (pc >> 1) & 63, hf = pc & 1; int n_ = 16 * (nt_) + nl; if (n_ > 64) n_ = 64; \
        sr[i_] = *(const v4u*)(u + ((size_t)g * MP + b * LP + 64 * n_ + jj) * 16 + 8 * hf); } } while (0)
#define S5_SLAB_STORE(buf_) do { S5_RELANE(); _Pragma("unroll") for (int i_ = 0; i_ < 4; ++i_) { const int pc = tid + 512 * i_, nl = pc >> 7, jj = (pc >> 1) & 63, hf = pc & 1; \
        *(LAS v4u*)((buf_) + nl * UL_STRIDE + jj * 32 + hf * 16) = sr[i_]; } } while (0)
    const bf16* u = (const bf16*)(C.ws + WS_U); bf16* yb = (bf16*)(C.ws + WS_YB);
    const unsigned char* M3g = C.ws + WS_M3 + (size_t)g * 262144; const unsigned char* M2g = C.ws + WS_M2 + (size_t)g * 262144;
    v4u sr[4];
    { bf16x8 m3f[32];
        S5_SLAB_LOAD(0);
        { S5_RELANE();
#pragma unroll
            for (int ks = 0; ks < 32; ++ks) m3f[ks] = *(const bf16x8*)(M3g + ((size_t)((w * 32 + ks) * 64 + lane)) * 16); }
        S5_SLAB_STORE(B0);
        __syncthreads();
#pragma unroll 1
        for (int nt = 0; nt < 5; ++nt) {
            LAS unsigned char* Ul = (nt & 1) ? KtL : B0; LAS unsigned char* Un = (nt & 1) ? B0 : KtL;
            if (nt + 1 < 5) S5_SLAB_LOAD(nt + 1);
            { S5_RELANE(); f32x4 h0 = (f32x4){0.f, 0.f, 0.f, 0.f}, h1 = h0;
#pragma unroll
                for (int ks = 0; ks < 32; ks += 2) {
                    h0 = __builtin_amdgcn_mfma_f32_16x16x32_bf16(m3f[ks], *(const LAS bf16x8*)(Ul + cc * UL_STRIDE + (2 * ks + (kg >> 1)) * 32 + (kg & 1) * 16), h0, 0, 0, 0);
                    h1 = __builtin_amdgcn_mfma_f32_16x16x32_bf16(m3f[ks + 1], *(const LAS bf16x8*)(Ul + cc * UL_STRIDE + (2 * ks + 2 + (kg >> 1)) * 32 + (kg & 1) * 16), h1, 0, 0, 0); }
                *(LAS f32x4*)(Hl + (16 * nt + cc) * 128 + 16 * w + 4 * kg) = h0 + h1; }
            if (nt + 1 < 5) S5_SLAB_STORE(Un);
            __syncthreads();
        }
    }
    S5_SLAB_LOAD(0);
    v4u kr[4];
    { S5_RELANE(); const v4u* src = (const v4u*)((const bf16*)(C.ws + WS_KT) + (size_t)g * 16384);
#pragma unroll
        for (int i = 0; i < 4; ++i) kr[i] = src[tid + 512 * i]; }
    if (w == 0) { S5_RELANE(); float a64r, a64i; { S5P P{expf(C.in[11][g]), C.in[9][g * 64 + lane], C.in[10][g * 64 + lane]}; s5_pow(P, 64.f, a64r, a64i); }
        float hre = 0.f, him = 0.f;
#pragma unroll 1
        for (int n0 = 0; n0 < 80; n0 += 16) { float er[16], ei[16];
#pragma unroll
            for (int nl = 0; nl < 16; ++nl) { er[nl] = Hl[(n0 + nl) * 128 + lane]; ei[nl] = Hl[(n0 + nl) * 128 + 64 + lane]; }
#pragma unroll
            for (int nl = 0; nl < 16; ++nl) { *(LAS bf16*)(Hin + (n0 + nl) * 272 + lane * 2) = (bf16)f2bf(hre); *(LAS bf16*)(Hin + (n0 + nl) * 272 + (64 + lane) * 2) = (bf16)f2bf(him);
                const float nr = a64r * hre - a64i * him + er[nl], ni = a64r * him + a64i * hre + ei[nl]; hre = nr; him = ni; } } }
    { S5_RELANE();
#pragma unroll
        for (int i = 0; i < 4; ++i) *(LAS v4u*)(KtL + (tid + 512 * i) * 16) = kr[i]; }
    S5_SLAB_STORE(B0);
    __syncthreads();
    { bf16x8 m2f[8][4];
        { S5_RELANE();
#pragma unroll
            for (int i = 0; i < 8; ++i)
#pragma unroll
                for (int k2 = 0; k2 < 4; ++k2) m2f[i][k2] = *(const bf16x8*)(M2g + ((size_t)(((w + 8 * i) * 4 + k2) * 64 + lane)) * 16); }
        const f32x4 dsk = *(const f32x4*)(C.in[16] + g * 16 + 4 * (C.lane >> 4));
#pragma unroll 1
        for (int nt = 0; nt < 5; ++nt) {
            LAS unsigned char* Ul = (nt & 1) ? (LAS unsigned char*)Hl : B0; LAS unsigned char* Un = (nt & 1) ? B0 : (LAS unsigned char*)Hl;
            if (nt + 1 < 5) S5_SLAB_LOAD(nt + 1);
            { S5_RELANE(); const int n = 16 * nt + cc;
                bf16x8 hb[4];
#pragma unroll
                for (int k2 = 0; k2 < 4; ++k2) hb[k2] = *(const LAS bf16x8*)(Hin + n * 272 + (32 * k2 + 8 * kg) * 2);
#pragma unroll
                for (int i = 0; i < 8; ++i) { const int t = w + 8 * i, nks = (t >> 1) + 1; f32x4 a0 = (f32x4){0.f, 0.f, 0.f, 0.f}, a1 = a0;
#pragma unroll
                    for (int k2 = 0; k2 < 4; k2 += 2) { a0 = __builtin_amdgcn_mfma_f32_16x16x32_bf16(m2f[i][k2], hb[k2], a0, 0, 0, 0); a1 = __builtin_amdgcn_mfma_f32_16x16x32_bf16(m2f[i][k2 + 1], hb[k2 + 1], a1, 0, 0, 0); }
#pragma unroll 1
                    for (int ks0 = 0; ks0 < nks; ks0 += 4) {
                        bf16x8 bq[4]; v4u av[4];
#pragma unroll
                        for (int uu = 0; uu < 4; ++uu) { const int j = 2 * (ks0 + uu) + (kg >> 1), lag = t - j, lagc = lag < 0 ? 0 : lag, jc = j > 63 ? 63 : j;
                            bq[uu] = *(const LAS bf16x8*)(Ul + cc * UL_STRIDE + jc * 32 + (kg & 1) * 16);
                            av[uu] = *(const LAS v4u*)(KtL + lagc * 512 + cc * 32 + (kg & 1) * 16); if (lag < 0) av[uu] = (v4u){0u, 0u, 0u, 0u}; }
                        a0 = __builtin_amdgcn_mfma_f32_16x16x32_bf16(as_bf16x8(av[0]), bq[0], a0, 0, 0, 0); a1 = __builtin_amdgcn_mfma_f32_16x16x32_bf16(as_bf16x8(av[1]), bq[1], a1, 0, 0, 0);
                        a0 = __builtin_amdgcn_mfma_f32_16x16x32_bf16(as_bf16x8(av[2]), bq[2], a0, 0, 0, 0); a1 = __builtin_amdgcn_mfma_f32_16x16x32_bf16(as_bf16x8(av[3]), bq[3], a1, 0, 0, 0); }
                    const f32x4 y = a0 + a1;
                    if (n >= 1 && n <= 64) { const u32x2_t uv = *(const LAS u32x2_t*)(Ul + cc * UL_STRIDE + t * 32 + kg * 8);
                        const float y0 = y[0] + dsk[0] * bflo(uv.x), y1 = y[1] + dsk[1] * bfhi(uv.x), y2 = y[2] + dsk[2] * bflo(uv.y), y3 = y[3] + dsk[3] * bfhi(uv.y);
                        u32x2_t o; o.x = pk2(gelu_fast(y0), gelu_fast(y1)); o.y = pk2(gelu_fast(y2), gelu_fast(y3));
                        *(GAS u32x2_t*)(yb + (size_t)(b * SEQ + 64 * (n - 1) + t) * 512 + g * 16 + 4 * kg) = o; } } }
            if (nt + 1 < 5) S5_SLAB_STORE(Un);
            __syncthreads();
        }
    }
#undef S5_SLAB_LOAD
#undef S5_SLAB_STORE
#undef S5_RELANE
}

constexpr unsigned CONV_ITEMS = NE * 384, CONV_P3_ITEMS = CONV_ITEMS;
__device__ __forceinline__ void phase3_v2(const Ctx& C, int parts = 7) {
    const int NSCAN = NB * NH + NB * SG;
    if (C.G > NSCAN) {
#ifndef DUP_SCAN
#define DUP_SCAN 0
#endif
        if (C.wg < NB * NH) { if (!(parts & 1)) return; dn_scan_mfma(C, C.wg >> 3, C.wg & 7); if (DUP_SCAN) { __syncthreads(); dn_scan_mfma(C, C.wg >> 3, C.wg & 7); } __syncthreads(); if (parts & 4) convert_experts(C, 0, 0u, CONV_P3_ITEMS); return; }
        { const int lw0 = C.G >= NSCAN + 8 ? NSCAN : NB * NH;
          if (C.wg >= lw0 && C.wg < lw0 + 8 && (parts & 1)) { chunk_prep(C, true, lw0); __syncthreads(); } }
        if (C.wg < NSCAN && (parts & 2)) { const int idx = C.wg - NB * NH, x8 = idx & 7, y = idx >> 3;
            s5_mfma(C, y >> 2, 4 * x8 + (y & 3)); __syncthreads(); }
        if (parts & 4) convert_experts(C, 0, 0u, CONV_P3_ITEMS);
    } else {
        if (C.wg < 8) { chunk_prep(C, true, 0); __syncthreads(); }
        for (int it = C.wg; it < NSCAN; it += C.G) { if (it < NB * NH) dn_scan_mfma(C, it >> 3, it & 7); else s5_mfma(C, (it - NB * NH) >> 5, (it - NB * NH) & 31); __syncthreads(); }
        convert_experts(C, 0, 0u, CONV_P3_ITEMS);
    }
}

__device__ __forceinline__ void phase5_branch(const Ctx& C) {
    unsigned char* ws = C.ws;
    pg8::Gemm2 g{(const bf16*)(ws + WS_OA), (const bf16*)(ws + WS_WBR), (const bf16*)(ws + WS_OB), (const bf16*)(ws + WS_WBR) + 1024 * 512, MX, 1024, 512};
    pg8::StaticOrder S; S.init(MX, 1024, C.G, C.wg);
    pg8::EpiBrFused E{(const bf16*)(ws + WS_GATES), (bf16*)(ws + WS_MERGED)};
    pg8::gemm_phase2seg<pg8::EpiBrFused, pg8::StaticOrder, true>(C.lds, g, S, E);
}

#ifndef MK_N_LAUNCHES
#define MK_N_LAUNCHES 1
#endif
constexpr int N_PHASES = 11;
struct Args { const float* in[32]; float* out; unsigned char* ws; int ph_lo, ph_hi; };
#ifndef PRE_MODE
#define PRE_MODE 0
#endif
__device__ __forceinline__ void run_phases(const Ctx& C, const XcdBarrier& bar, int lo, int hi) {
    const bool dry = PRE_MODE && hi < N_PHASES;
#define IN(k) (lo <= (k) && (k) < hi)
#define SEAM(k) do { if (IN(k) && IN((k) + 1)) xcd_barrier(bar); } while (0)
    unsigned char* ws = C.ws;
    if (IN(0)) { phase0(C); s5_tables(C); }
    SEAM(0);
    if (IN(1)) {
        pg8::Gemm g{(const bf16*)(ws + WS_H0B), (const bf16*)(ws + WS_WINT), MP, INWP, D}; pg8::StaticOrder S; S.init(MP, INWP, C.G, C.wg);
        pg8::EpiProj E{(bf16*)(ws + WS_QKV), (bf16*)(ws + WS_Z), (bf16*)(ws + WS_U), (bf16*)(ws + WS_GATES), (float*)(ws + WS_AB)};
        pg8::gemm_phase<pg8::EpiProj, pg8::StaticOrder, true, true>(C.lds, g, S, E);
    }
    SEAM(1);
    if (IN(2)) chunk_prep(C, false, 0);
    SEAM(2);
    if (IN(3)) phase3_v2(C, (dry && hi == 4) ? PRE_MODE : 7);
    SEAM(3);
    if (IN(4)) {
        { const int nglu = (MX / 256) * 2; if (C.G >= 2 * nglu) oa_postpass(C, nglu, C.G - nglu); else oa_postpass(C, 0, C.G); }
        pg8::Gemm g{(const bf16*)(ws + WS_YB), (const bf16*)(ws + WS_WGLU), MX, 512, 512}; pg8::StaticOrder S; S.init(MX, 512, C.G, C.wg);
        pg8::EpiGlu E{(const bf16*)(ws + WS_YB), C.in[18], (bf16*)(ws + WS_OB)};
        pg8::gemm_phase<pg8::EpiGlu, pg8::StaticOrder, true, true>(C.lds, g, S, E);
    }
    SEAM(4);
    if (IN(5)) phase5_branch(C);
    SEAM(5);
    if (IN(6)) {
        pg8::Gemm g{(const bf16*)(ws + WS_MERGED), (const bf16*)(ws + WS_WOUT), MX, 1024, 1024}; pg8::StaticOrder S; S.init(MX, 1024, C.G, C.wg);
        pg8::EpiOut E{C.in[0], (const float*)(ws + WS_STATS), C.in[2], C.in[3], (bf16*)(ws + WS_PRE)};
        pg8::gemm_phase<pg8::EpiOut, pg8::StaticOrder, true, true>(C.lds, g, S, E);
    }
    SEAM(6);
    if (IN(7)) { if (dry && hi == 8) phase7_rows<1>(C); else phase7_rows<0>(C); }
    SEAM(7);
    if (IN(8)) phase_moe(C);
    SEAM(9);
    if (IN(10)) { if (dry && hi == 11) phase11_final<1>(C); else phase11_final<0>(C); }
#undef IN
#undef SEAM
}
#ifndef PRE_K
#define PRE_K -1
#endif
__global__ void __launch_bounds__(NWAVES * 64, 2) mk_fwd(Args args) {
    extern __shared__ __attribute__((aligned(16))) unsigned char lds[];
    Ctx C;
    C.lds = (LAS unsigned char*)lds; C.tid = threadIdx.x; C.lane = C.tid & 63; C.wave = __builtin_amdgcn_readfirstlane(C.tid >> 6);
    C.wg = blockIdx.x; C.G = gridDim.x; C.in = args.in; C.out = args.out; C.ws = args.ws; C.ctl = (gu32*)(args.ws + WS_CTL);
    volatile LAS unsigned* MISC = (volatile LAS unsigned*)(C.lds + MISC_OFF);
    for (int u = C.tid; u < (LDS_BYTES - LDSCTL_OFF) / 4; u += NWAVES * 64) ((LAS unsigned*)(C.lds + LDSCTL_OFF))[u] = 0u;
    __syncthreads();
    XcdBarrier bar; bar.bar = (unsigned*)(C.ctl + CW_BAR); bar.x = 0; bar.st = nullptr;
    if (MK_N_LAUNCHES == 1) bar = xcd_barrier_post((unsigned*)(C.ctl + CW_BAR), MISC + 8);
    run_phases(C, bar, args.ph_lo, args.ph_hi);
}

extern "C" void kernel_launch(void* const* d_in, const int* in_sizes, int n_in, void* d_out, int out_size, void* d_ws, size_t ws_size, hipStream_t stream) {
    static int grid = 0;
    if (grid == 0) {
        if (n_in != 32 || in_sizes[0] != MX * D || out_size != MX * D || ws_size < WS_END) { fprintf(stderr, "kernel_launch: unexpected shapes (n_in %d, in0 %d, out %d, ws %zu < %zu); nothing launched\n", n_in, n_in > 0 ? in_sizes[0] : -1, out_size, ws_size, (size_t)WS_END); grid = -1; return; }
        int dev = 0, cus = 0, per_cu = 0;
        if (hipGetDevice(&dev) != hipSuccess || hipDeviceGetAttribute(&cus, hipDeviceAttributeMultiprocessorCount, dev) != hipSuccess) { grid = -1; return; }
        if (hipFuncSetAttribute((const void*)mk_fwd, hipFuncAttributeMaxDynamicSharedMemorySize, LDS_BYTES) != hipSuccess) { fprintf(stderr, "kernel_launch: hipFuncSetAttribute failed\n"); grid = -1; return; }
        if (hipOccupancyMaxActiveBlocksPerMultiprocessor(&per_cu, (const void*)mk_fwd, NWAVES * 64, LDS_BYTES) != hipSuccess || per_cu < 1) fprintf(stderr, "kernel_launch: occupancy query says %d\n", per_cu);
        (void)hipGetLastError();
        grid = cus;
    }
    if (grid < 0) return;
    if (hipMemsetAsync((char*)d_ws + WS_CTL, 0, CTL_ZERO_BYTES, stream) != hipSuccess) { fprintf(stderr, "kernel_launch: hipMemsetAsync failed\n"); return; }
    Args a{};
    for (int i = 0; i < 32; ++i) a.in[i] = (const float*)d_in[i];
    a.out = (float*)d_out; a.ws = (unsigned char*)d_ws;
#if MK_N_LAUNCHES == 1
    if (PRE_K >= 0) { a.ph_lo = 0; a.ph_hi = PRE_K + 1; hipLaunchKernelGGL(mk_fwd, dim3(grid), dim3(NWAVES * 64), LDS_BYTES, stream, a); (void)hipMemsetAsync((char*)d_ws + WS_CTL, 0, CTL_ZERO_BYTES, stream); }
    a.ph_lo = 0; a.ph_hi = N_PHASES;
    hipLaunchKernelGGL(mk_fwd, dim3(grid), dim3(NWAVES * 64), LDS_BYTES, stream, a);
#else
    for (int p = 0; p < N_PHASES; ++p) { a.ph_lo = p; a.ph_hi = p + 1; hipLaunchKernelGGL(mk_fwd, dim3(grid), dim3(NWAVES * 64), LDS_BYTES, stream, a); }
#endif
    const hipError_t le = hipPeekAtLastError();
    if (le != hipSuccess) fprintf(stderr, "kernel_launch: launch failed: %s\n", hipGetErrorName(le));
}
```

```cpp
#include <hip/hip_runtime.h>
#include <cstdio>
#include <cstdint>
namespace pg8 {
#define PG8_LAS __attribute__((address_space(3)))
typedef unsigned short bf16_t;
typedef short bf16x8 __attribute__((ext_vector_type(8)));
typedef float f32x4 __attribute__((ext_vector_type(4)));
typedef unsigned u32x4 __attribute__((ext_vector_type(4)));
constexpr int BM = 256, BK = 64, HALF = 128, HTB = HALF * BK * 2  , STAGE_BYTES = 8 * HTB, NXCD = 8, WGM = 8;

__host__ __device__ __forceinline__ int lds_byte(int r, int c) { const int st = (r >> 4) * 2 + (c >> 5), rr = r & 15, cc = c & 31, ob = rr * 64 + cc * 2; return st * 1024 + (ob ^ (((ob >> 9) & 1) << 5)); }
__host__ __device__ __forceinline__ void stage_rc(int b, int& R, int& C) { const int st = b / 1024, sb = b % 1024, swz = sb ^ (((sb >> 9) & 1) << 5); R = (st >> 1) * 16 + swz / 64; C = (st & 1) * 32 + (swz % 64) / 2; }
__host__ __device__ __forceinline__ int perm32(int rho) { const int n = rho >> 4, i = rho & 15; return 8 * (i >> 2) + 4 * n + (i & 3); }

struct Unit { int pm, pn; };
struct Gemm { const bf16_t* A; const bf16_t* Bt; int M, N, K; };

struct StaticOrder {
    int nM, nN, nwg, G, c;
    __host__ __device__ void init(int M, int N, int G_, int c_) { nM = M / BM; nN = N / BM; nwg = nM * nN; G = G_; c = c_; }
    __host__ __device__ bool next(int i, Unit& u) const {
        const long L = (long)i * G + c; if (L >= nwg) return false;
        int wgid = (int)L; { const int q = nwg / NXCD, r = nwg % NXCD, xcd = wgid % NXCD, off = wgid / NXCD; wgid = (xcd < r ? xcd * (q + 1) : r * (q + 1) + (xcd - r) * q) + off; }
        const int nig = WGM * nN, gid = wgid / nig, fm = gid * WGM, gsz = (nM - fm) < WGM ? (nM - fm) : WGM;
        u.pm = fm + ((wgid % nig) % gsz); u.pn = (wgid % nig) / gsz; return true;
    }
    __device__ __forceinline__ void a_ready(const Unit&) const {}
    __device__ __forceinline__ void done(const Unit&) const {}
};

__device__ __forceinline__ unsigned cvt_pk_bf16(float lo, float hi) { unsigned r; asm volatile("v_cvt_pk_bf16_f32 %0, %1, %2" : "=v"(r) : "v"(lo), "v"(hi)); return r; }
template <class P, class V> __device__ __forceinline__ void st_wt16(P* p, const V& w) { asm volatile("global_store_dwordx4 %0, %1, off sc0 sc1" :: "v"(p), "v"(w) : "memory"); }
template <class Epi, class Sched, bool ALIGN_EPI = false, bool SP2 = false>
__device__ __forceinline__ void gemm_phase(PG8_LAS unsigned char* lds, const Gemm g, const Sched& S, const Epi& E) {
    const int tid = threadIdx.x, wid = __builtin_amdgcn_readfirstlane(tid >> 6), lane = tid & 63, wr = wid >> 2, wc = wid & 3, fr = lane & 15, fq = lane >> 4;
    const int K = g.K, nt = K / BK;
    unsigned voffA[2], voffB[2];
#pragma unroll
    for (int i = 0; i < 2; ++i) { int R, C; stage_rc(tid * 16 + i * 8192, R, C); const int Rb = Epi::PERM ? ((R & ~31) + perm32(R & 31)) : R;
        voffA[i] = (unsigned)(R * K + C) * 2u; voffB[i] = (unsigned)(Rb * K + C) * 2u; }
    const size_t kstep = (size_t)(BK * 2);
    const size_t hstep = (size_t)HALF * K * 2;
    const size_t tstep = 2 * hstep;
    const unsigned ldsw = (unsigned)wid * 1024u;
    const int aoff = lds_byte(wr * 64 + fr, fq * 8), boff = lds_byte(wc * 32 + fr, fq * 8);
#define PG8_SA(b, h) (((b) * 2 + (h)) * HTB)
#define PG8_SB(b, h) ((4 + (b) * 2 + (h)) * HTB)
#define PG8_STAGE(bufoff, gbase, voff) do { _Pragma("unroll") for (int _i = 0; _i < 2; ++_i) \
        __builtin_amdgcn_global_load_lds((const unsigned*)((const char*)(gbase) + (voff)[_i]), (PG8_LAS unsigned*)(lds + (bufoff) + ldsw + _i * 8192), 16, 0, 0); } while (0)
#define PG8_LDA(dst, b, h) do { _Pragma("unroll") for (int m = 0; m < 4; ++m) _Pragma("unroll") for (int k = 0; k < 2; ++k) dst[m][k] = *(const PG8_LAS bf16x8*)(lds + PG8_SA(b, h) + aoff + m * 2048 + k * 1024); } while (0)
#define PG8_LDB(dst, b, h) do { _Pragma("unroll") for (int n = 0; n < 2; ++n) _Pragma("unroll") for (int k = 0; k < 2; ++k) dst[n][k] = *(const PG8_LAS bf16x8*)(lds + PG8_SB(b, h) + boff + n * 2048 + k * 1024); } while (0)
#define PG8_MMA(ai, bj, At, Bt) do { __builtin_amdgcn_s_setprio(1); _Pragma("unroll") for (int m = 0; m < 4; ++m) _Pragma("unroll") for (int n = 0; n < 2; ++n) _Pragma("unroll") for (int k = 0; k < 2; ++k) \
        acc[ai][bj][m][n] = __builtin_amdgcn_mfma_f32_16x16x32_bf16(Bt[n][k], At[m][k], acc[ai][bj][m][n], 0, 0, 0); __builtin_amdgcn_s_setprio(0); } while (0)
#define PG8_WAIT_V(n) asm volatile("s_waitcnt vmcnt(" #n ")" ::: "memory")
#define PG8_WAIT_L(n) asm volatile("s_waitcnt lgkmcnt(" #n ")" ::: "memory")
#define PG8_BAR __builtin_amdgcn_s_barrier()
#define PG8_SCHED __builtin_amdgcn_sched_barrier(0)
    Unit cur, nxt; int ui = 0;
    if (!S.next(0, cur)) return;
    f32x4 acc[2][2][4][2];
#pragma unroll
    for (int a = 0; a < 2; ++a)
#pragma unroll
        for (int b = 0; b < 2; ++b)
#pragma unroll
            for (int m = 0; m < 4; ++m)
#pragma unroll
                for (int n = 0; n < 2; ++n) acc[a][b][m][n] = (f32x4){0.f, 0.f, 0.f, 0.f};
    bf16x8 At[4][2], B0[2][2], B1[2][2];
    const char* cA = (const char*)g.A + (size_t)cur.pm * tstep; const char* cB = (const char*)g.Bt + (size_t)cur.pn * tstep;
    S.a_ready(cur);
    if constexpr (SP2) {
        PG8_STAGE(PG8_SB(0, 0), cB, voffB); PG8_STAGE(PG8_SB(0, 1), cB + hstep, voffB); PG8_STAGE(PG8_SA(0, 0), cA, voffA); PG8_STAGE(PG8_SA(0, 1), cA + hstep, voffA);
        if (wr == 1) PG8_BAR;
        PG8_WAIT_V(2); PG8_BAR;
        PG8_STAGE(PG8_SB(1, 0), cB + kstep, voffB); PG8_STAGE(PG8_SA(1, 0), cA + kstep, voffA); PG8_STAGE(PG8_SB(1, 1), cB + hstep + kstep, voffB);
        PG8_WAIT_V(6); PG8_BAR;
    } else {
        PG8_STAGE(PG8_SB(0, 0), cB, voffB); PG8_STAGE(PG8_SA(0, 0), cA, voffA); PG8_STAGE(PG8_SB(0, 1), cB + hstep, voffB); PG8_STAGE(PG8_SA(0, 1), cA + hstep, voffA);
        if (wr == 1) PG8_BAR;
        PG8_WAIT_V(4); PG8_BAR;
        PG8_STAGE(PG8_SB(1, 0), cB + kstep, voffB); PG8_STAGE(PG8_SA(1, 0), cA + kstep, voffA); PG8_STAGE(PG8_SB(1, 1), cB + hstep + kstep, voffB);
        PG8_WAIT_V(6); PG8_BAR;
    }
    for (;;) {
        const bool has_next = S.next(ui + 1, nxt);
        const char* nA = has_next ? (const char*)g.A + (size_t)nxt.pm * tstep : cA; const char* nB = has_next ? (const char*)g.Bt + (size_t)nxt.pn * tstep : cB;
        for (int t = 0; t < nt; t += 2) {
            const bool last = (t == nt - 2);
            const char* a1 = cA + (size_t)(t + 1) * kstep;
            const char* a2 = last ? nA : cA + (size_t)(t + 2) * kstep; const char* b2 = last ? nB : cB + (size_t)(t + 2) * kstep;
            const char* a3 = a2 + kstep; const char* b3 = b2 + kstep;
            if (last && has_next) S.a_ready(nxt);
            if constexpr (SP2) {
            PG8_LDB(B0, 0, 0); PG8_LDB(B1, 0, 1); PG8_SCHED; PG8_LDA(At, 0, 0); PG8_STAGE(PG8_SA(1, 1), a1 + hstep, voffA);
            PG8_WAIT_V(8); PG8_WAIT_L(0); PG8_BAR; PG8_MMA(0, 0, At, B0); PG8_MMA(0, 1, At, B1); PG8_BAR; PG8_SCHED;
            PG8_LDA(At, 0, 1); PG8_STAGE(PG8_SB(0, 0), b2, voffB); PG8_STAGE(PG8_SB(0, 1), b2 + hstep, voffB); PG8_STAGE(PG8_SA(0, 0), a2, voffA);
            PG8_WAIT_V(8); PG8_WAIT_L(0); PG8_BAR; PG8_MMA(1, 0, At, B0); PG8_MMA(1, 1, At, B1); PG8_BAR; PG8_SCHED;
            PG8_LDB(B0, 1, 0); PG8_LDB(B1, 1, 1); PG8_SCHED; PG8_LDA(At, 1, 0); PG8_STAGE(PG8_SA(0, 1), a2 + hstep, voffA);
            PG8_WAIT_V(8); PG8_WAIT_L(0); PG8_BAR; PG8_MMA(0, 0, At, B0); PG8_MMA(0, 1, At, B1); PG8_BAR; PG8_SCHED;
            PG8_LDA(At, 1, 1); PG8_STAGE(PG8_SB(1, 0), b3, voffB); PG8_STAGE(PG8_SB(1, 1), b3 + hstep, voffB); PG8_STAGE(PG8_SA(1, 0), a3, voffA);
            PG8_WAIT_V(8); PG8_WAIT_L(0); PG8_BAR; PG8_MMA(1, 0, At, B0); PG8_MMA(1, 1, At, B1); PG8_BAR; PG8_SCHED;
            } else {
            PG8_LDB(B0, 0, 0); PG8_SCHED; PG8_LDA(At, 0, 0); PG8_STAGE(PG8_SA(1, 1), a1 + hstep, voffA);
            PG8_WAIT_L(8); PG8_BAR; PG8_WAIT_L(0); PG8_MMA(0, 0, At, B0); PG8_BAR; PG8_SCHED;
            PG8_LDB(B1, 0, 1); PG8_STAGE(PG8_SB(0, 0), b2, voffB);
            PG8_BAR; PG8_WAIT_L(0); PG8_MMA(0, 1, At, B1); PG8_BAR;
            PG8_LDA(At, 0, 1); PG8_STAGE(PG8_SA(0, 0), a2, voffA);
            PG8_BAR; PG8_WAIT_L(0); PG8_MMA(1, 0, At, B0); PG8_BAR; PG8_SCHED;
            PG8_STAGE(PG8_SB(0, 1), b2 + hstep, voffB);
            PG8_WAIT_V(6); PG8_BAR; PG8_MMA(1, 1, At, B1); PG8_BAR;
            PG8_LDB(B0, 1, 0); PG8_SCHED; PG8_LDA(At, 1, 0); PG8_STAGE(PG8_SA(0, 1), a2 + hstep, voffA);
            PG8_WAIT_L(8); PG8_BAR; PG8_WAIT_L(0); PG8_MMA(0, 0, At, B0); PG8_BAR; PG8_SCHED;
            PG8_LDB(B1, 1, 1); PG8_STAGE(PG8_SB(1, 0), b3, voffB);
            PG8_BAR; PG8_WAIT_L(0); PG8_MMA(0, 1, At, B1); PG8_BAR;
            PG8_LDA(At, 1, 1); PG8_STAGE(PG8_SA(1, 0), a3, voffA);
            PG8_BAR; PG8_WAIT_L(0); PG8_MMA(1, 0, At, B0); PG8_BAR; PG8_SCHED;
            PG8_STAGE(PG8_SB(1, 1), b3 + hstep, voffB);
            PG8_WAIT_V(6); PG8_BAR; PG8_MMA(1, 1, At, B1); PG8_BAR;
            }
        }
        if constexpr (ALIGN_EPI) { if (wr == 0) PG8_BAR; }
        if constexpr (!Epi::AFTER_DRAIN) { E(acc, cur, wr, wc, fr, fq); S.done(cur); }
        if (!has_next) break;
#pragma unroll
        for (int a = 0; a < 2; ++a)
#pragma unroll
            for (int b = 0; b < 2; ++b)
#pragma unroll
                for (int m = 0; m < 4; ++m)
#pragma unroll
                    for (int n = 0; n < 2; ++n) acc[a][b][m][n] = (f32x4){0.f, 0.f, 0.f, 0.f};
        cur = nxt; cA = nA; cB = nB; ++ui;
        if constexpr (ALIGN_EPI) { if (wr == 1) PG8_BAR; }
    }
    PG8_WAIT_V(0);
    if constexpr (!ALIGN_EPI) { if (wr == 0) PG8_BAR; }
    PG8_BAR;
    if constexpr (Epi::AFTER_DRAIN) { E.fused(acc, cur, wr, wc, fr, fq, lds, wid, lane); S.done(cur); }
#undef PG8_SA
#undef PG8_SB
#undef PG8_STAGE
#undef PG8_LDA
#undef PG8_LDB
#undef PG8_MMA
#undef PG8_WAIT_V
#undef PG8_WAIT_L
#undef PG8_BAR
#undef PG8_SCHED
}
}
#define GAS __attribute__((address_space(1)))
#define LAS __attribute__((address_space(3)))
typedef unsigned short bf16;
typedef unsigned v4u __attribute__((ext_vector_type(4)));
typedef float f32x4 __attribute__((ext_vector_type(4)));
typedef short bf16x8 __attribute__((ext_vector_type(8)));
typedef GAS unsigned gu32;
typedef GAS unsigned long long gu64;
#define RLX_AGENT __ATOMIC_RELAXED, __HIP_MEMORY_SCOPE_AGENT
#define LDS_WAIT() asm volatile("s_waitcnt lgkmcnt(0)" ::: "memory")
#define VM_WAIT() asm volatile("s_waitcnt vmcnt(0)" ::: "memory")
__device__ __forceinline__ unsigned long long rt() { return __builtin_amdgcn_s_memrealtime(); }
typedef __bf16 hwbf16x2 __attribute__((ext_vector_type(2)));
typedef float hwf32x2 __attribute__((ext_vector_type(2)));
__device__ __forceinline__ unsigned pk2(float lo, float hi) { return __builtin_bit_cast(unsigned, __builtin_convertvector((hwf32x2){lo, hi}, hwbf16x2)); }
__device__ __forceinline__ unsigned f2bf(float f) { return pk2(f, 0.f) & 0xffffu; }

#define XB_TMO      128
#define XB_XCNT(j)  (256  + 64 * (j))
#define XB_XSUB(j)  (1280 + 64 * (j))
#define XB_XGEN(j)  (2304 + 64 * (j))
#define XB_TOP      3328
#define XB_TOPGEN   3392
#define XCD_BAR_WORDS 3456
#define XB_SPIN_CAP (1u << 18)

__device__ __forceinline__ unsigned xb_ld(unsigned* p)              { return __hip_atomic_load(p, __ATOMIC_RELAXED, __HIP_MEMORY_SCOPE_AGENT); }
__device__ __forceinline__ unsigned xb_add(unsigned* p, unsigned v) { return __hip_atomic_fetch_add(p, v, __ATOMIC_RELAXED, __HIP_MEMORY_SCOPE_AGENT); }
__device__ __forceinline__ unsigned xb_xcc_id() { return (unsigned)__builtin_amdgcn_s_getreg((3 << 11) | 20) & 0xFu; }
#define XB_SPIN(cond, bar) do { unsigned _sp = 0; while (cond) { __builtin_amdgcn_s_sleep(1); \
    if ((++_sp & 255u) == 0u) { if (xb_ld(&(bar)[XB_TMO])) break; if (_sp > XB_SPIN_CAP) { atomicAdd(&(bar)[XB_TMO], 1u); break; } } } } while (0)

struct XcdBarrier {
    unsigned* bar; unsigned x;
    volatile LAS unsigned* st;
};

__device__ __forceinline__ XcdBarrier xcd_barrier_post(unsigned* bar, volatile LAS unsigned* st) {
    XcdBarrier b; b.bar = bar; b.x = xb_xcc_id(); b.st = st;
    if (threadIdx.x == 0) (void)xb_add(&bar[XB_XCNT(b.x)], 1u);
    return b;
}
__device__ __forceinline__ void xcd_barrier_complete(unsigned* bar, unsigned x, unsigned& nloc, unsigned& nx) {
    const unsigned G = gridDim.x * gridDim.y * gridDim.z;
    unsigned sum, cnt, mine, sp = 0u;
    for (;;) {
        sum = 0u; cnt = 0u; mine = 0u;
#pragma unroll
        for (unsigned j = 0; j < 16; ++j) { const unsigned c = xb_ld(&bar[XB_XCNT(j)]); sum += c; cnt += (c > 0u) ? 1u : 0u; mine = (j == x) ? c : mine; }
        if (sum == G) break;
        __builtin_amdgcn_s_sleep(1);
        if ((++sp & 255u) == 0u) { if (xb_ld(&bar[XB_TMO])) break; if (sp > XB_SPIN_CAP) { atomicAdd(&bar[XB_TMO], 1u); break; } }
    }
    nloc = mine > 0u ? mine : 1u; nx = cnt > 0u ? cnt : 1u;
}

__device__ __forceinline__ void xcd_barrier(const XcdBarrier& b) {
    asm volatile("s_waitcnt vmcnt(0)" ::: "memory");
    __syncthreads();
    if (threadIdx.x == 0) {
        unsigned* bar = b.bar;
        __builtin_amdgcn_s_waitcnt(0);
        unsigned nloc = b.st[0], nx = b.st[1];
        if (nloc == 0u) { xcd_barrier_complete(bar, b.x, nloc, nx); b.st[0] = nloc; b.st[1] = nx; }
        const unsigned old = xb_add(&bar[XB_XSUB(b.x)], 1u);
        const unsigned gen = old / nloc;
        if (old + 1u == (gen + 1u) * nloc) {
            __builtin_amdgcn_fence(__ATOMIC_RELEASE, "agent");
            asm volatile("s_waitcnt vmcnt(0)" ::: "memory");
            const unsigned og = xb_add(&bar[XB_TOP], 1u);
            const unsigned tg = og / nx;
            if (og + 1u == (tg + 1u) * nx) xb_add(&bar[XB_TOPGEN], 1u);
            else XB_SPIN(xb_ld(&bar[XB_TOPGEN]) == tg, bar);
            __builtin_amdgcn_fence(__ATOMIC_ACQUIRE, "agent");
            xb_add(&bar[XB_XGEN(b.x)], 1u);
            asm volatile("s_waitcnt vmcnt(0)" ::: "memory");
        } else {
            XB_SPIN(xb_ld(&bar[XB_XGEN(b.x)]) == gen, bar);
            __builtin_amdgcn_fence(__ATOMIC_ACQUIRE, "agent");
            asm volatile("s_waitcnt vmcnt(0)" ::: "memory");
        }
    }
    __syncthreads();
}
namespace pg8 {
struct Gemm2 { const bf16_t* A1; const bf16_t* B1; const bf16_t* A2; const bf16_t* B2; int M, N, Kseg; };
template <class Epi, class Sched, bool ALIGN_EPI = false>
__device__ __forceinline__ void gemm_phase2seg(PG8_LAS unsigned char* lds, const Gemm2 g, const Sched& S, const Epi& E) {
    constexpr bool SP2 = true;
    const int tid = threadIdx.x, wid = __builtin_amdgcn_readfirstlane(tid >> 6), lane = tid & 63, wr = wid >> 2, wc = wid & 3, fr = lane & 15, fq = lane >> 4;
    const int K = g.Kseg, half = K / BK, nt = 2 * half;
    unsigned voffA[2], voffB[2];
#pragma unroll
    for (int i = 0; i < 2; ++i) { int R, C; stage_rc(tid * 16 + i * 8192, R, C); const int Rb = Epi::PERM ? ((R & ~31) + perm32(R & 31)) : R;
        voffA[i] = (unsigned)(R * K + C) * 2u; voffB[i] = (unsigned)(Rb * K + C) * 2u; }
    const size_t kstep = (size_t)(BK * 2);
    const size_t hstep = (size_t)HALF * K * 2;
    const size_t tstep = 2 * hstep;
    const unsigned ldsw = (unsigned)wid * 1024u;
    const int aoff = lds_byte(wr * 64 + fr, fq * 8), boff = lds_byte(wc * 32 + fr, fq * 8);
#define PG8_SA(b, h) (((b) * 2 + (h)) * HTB)
#define PG8_SB(b, h) ((4 + (b) * 2 + (h)) * HTB)
#define PG8_STAGE(bufoff, gbase, voff) do { _Pragma("unroll") for (int _i = 0; _i < 2; ++_i) \
        __builtin_amdgcn_global_load_lds((const unsigned*)((const char*)(gbase) + (voff)[_i]), (PG8_LAS unsigned*)(lds + (bufoff) + ldsw + _i * 8192), 16, 0, 0); } while (0)
#define PG8_LDA(dst, b, h) do { _Pragma("unroll") for (int m = 0; m < 4; ++m) _Pragma("unroll") for (int k = 0; k < 2; ++k) dst[m][k] = *(const PG8_LAS bf16x8*)(lds + PG8_SA(b, h) + aoff + m * 2048 + k * 1024); } while (0)
#define PG8_LDB(dst, b, h) do { _Pragma("unroll") for (int n = 0; n < 2; ++n) _Pragma("unroll") for (int k = 0; k < 2; ++k) dst[n][k] = *(const PG8_LAS bf16x8*)(lds + PG8_SB(b, h) + boff + n * 2048 + k * 1024); } while (0)
#define PG8_MMA(ai, bj, At, Bt) do { __builtin_amdgcn_s_setprio(1); _Pragma("unroll") for (int m = 0; m < 4; ++m) _Pragma("unroll") for (int n = 0; n < 2; ++n) _Pragma("unroll") for (int k = 0; k < 2; ++k) \
        acc[ai][bj][m][n] = __builtin_amdgcn_mfma_f32_16x16x32_bf16(Bt[n][k], At[m][k], acc[ai][bj][m][n], 0, 0, 0); __builtin_amdgcn_s_setprio(0); } while (0)
#define PG8_WAIT_V(n) asm volatile("s_waitcnt vmcnt(" #n ")" ::: "memory")
#define PG8_WAIT_L(n) asm volatile("s_waitcnt lgkmcnt(" #n ")" ::: "memory")
#define PG8_BAR __builtin_amdgcn_s_barrier()
#define PG8_SCHED __builtin_amdgcn_sched_barrier(0)
    Unit cur, nxt; int ui = 0;
    if (!S.next(0, cur)) return;
    f32x4 acc[2][2][4][2];
#pragma unroll
    for (int a = 0; a < 2; ++a)
#pragma unroll
        for (int b = 0; b < 2; ++b)
#pragma unroll
            for (int m = 0; m < 4; ++m)
#pragma unroll
                for (int n = 0; n < 2; ++n) acc[a][b][m][n] = (f32x4){0.f, 0.f, 0.f, 0.f};
    bf16x8 At[4][2], B0[2][2], B1[2][2];
    const char* cA = (const char*)g.A1 + (size_t)cur.pm * tstep; const char* cB = (const char*)g.B1 + (size_t)cur.pn * tstep;
    const char* cA2 = (const char*)g.A2 + (size_t)cur.pm * tstep; const char* cB2 = (const char*)g.B2 + (size_t)cur.pn * tstep;
    S.a_ready(cur);
    if constexpr (SP2) {
        PG8_STAGE(PG8_SB(0, 0), cB, voffB); PG8_STAGE(PG8_SB(0, 1), cB + hstep, voffB); PG8_STAGE(PG8_SA(0, 0), cA, voffA); PG8_STAGE(PG8_SA(0, 1), cA + hstep, voffA);
        if (wr == 1) PG8_BAR;
        PG8_WAIT_V(2); PG8_BAR;
        PG8_STAGE(PG8_SB(1, 0), cB + kstep, voffB); PG8_STAGE(PG8_SA(1, 0), cA + kstep, voffA); PG8_STAGE(PG8_SB(1, 1), cB + hstep + kstep, voffB);
        PG8_WAIT_V(6); PG8_BAR;
    } else {
        PG8_STAGE(PG8_SB(0, 0), cB, voffB); PG8_STAGE(PG8_SA(0, 0), cA, voffA); PG8_STAGE(PG8_SB(0, 1), cB + hstep, voffB); PG8_STAGE(PG8_SA(0, 1), cA + hstep, voffA);
        if (wr == 1) PG8_BAR;
        PG8_WAIT_V(4); PG8_BAR;
        PG8_STAGE(PG8_SB(1, 0), cB + kstep, voffB); PG8_STAGE(PG8_SA(1, 0), cA + kstep, voffA); PG8_STAGE(PG8_SB(1, 1), cB + hstep + kstep, voffB);
        PG8_WAIT_V(6); PG8_BAR;
    }
    for (;;) {
        const bool has_next = S.next(ui + 1, nxt);
        const char* nA = has_next ? (const char*)g.A1 + (size_t)nxt.pm * tstep : cA; const char* nB = has_next ? (const char*)g.B1 + (size_t)nxt.pn * tstep : cB;
        for (int t = 0; t < nt; t += 2) {
            const bool last = (t == nt - 2);
            if (t == half) E.mid(acc, cur, wr, wc, fr, fq);
            const char* a1 = (t + 1 < half) ? cA + (size_t)(t + 1) * kstep : cA2 + (size_t)(t + 1 - half) * kstep;
            const char* a2 = last ? nA : ((t + 2 < half) ? cA + (size_t)(t + 2) * kstep : cA2 + (size_t)(t + 2 - half) * kstep);
            const char* b2 = last ? nB : ((t + 2 < half) ? cB + (size_t)(t + 2) * kstep : cB2 + (size_t)(t + 2 - half) * kstep);
            const char* a3 = a2 + kstep; const char* b3 = b2 + kstep;
            if (last && has_next) S.a_ready(nxt);
            if constexpr (SP2) {
            PG8_LDB(B0, 0, 0); PG8_LDB(B1, 0, 1); PG8_SCHED; PG8_LDA(At, 0, 0); PG8_STAGE(PG8_SA(1, 1), a1 + hstep, voffA);
            PG8_WAIT_V(8); PG8_WAIT_L(0); PG8_BAR; PG8_MMA(0, 0, At, B0); PG8_MMA(0, 1, At, B1); PG8_BAR; PG8_SCHED;
            PG8_LDA(At, 0, 1); PG8_STAGE(PG8_SB(0, 0), b2, voffB); PG8_STAGE(PG8_SB(0, 1), b2 + hstep, voffB); PG8_STAGE(PG8_SA(0, 0), a2, voffA);
            PG8_WAIT_V(8); PG8_WAIT_L(0); PG8_BAR; PG8_MMA(1, 0, At, B0); PG8_MMA(1, 1, At, B1); PG8_BAR; PG8_SCHED;
            PG8_LDB(B0, 1, 0); PG8_LDB(B1, 1, 1); PG8_SCHED; PG8_LDA(At, 1, 0); PG8_STAGE(PG8_SA(0, 1), a2 + hstep, voffA);
            PG8_WAIT_V(8); PG8_WAIT_L(0); PG8_BAR; PG8_MMA(0, 0, At, B0); PG8_MMA(0, 1, At, B1); PG8_BAR; PG8_SCHED;
            PG8_LDA(At, 1, 1); PG8_STAGE(PG8_SB(1, 0), b3, voffB); PG8_STAGE(PG8_SB(1, 1), b3 + hstep, voffB); PG8_STAGE(PG8_SA(1, 0), a3, voffA);
            PG8_WAIT_V(8); PG8_WAIT_L(0); PG8_BAR; PG8_MMA(1, 0, At, B0); PG8_MMA(1, 1, At, B1); PG8_BAR; PG8_SCHED;
            } else {
            PG8_LDB(B0, 0, 0); PG8_SCHED; PG8_LDA(At, 0, 0); PG8_STAGE(PG8_SA(1, 1), a1 + hstep, voffA);
            PG8_WAIT_L(8); PG8_BAR; PG8_WAIT_L(0); PG8_MMA(0, 0, At, B0); PG8_BAR; PG8_SCHED;
            PG8_LDB(B1, 0, 1); PG8_STAGE(PG8_SB(0, 0), b2, voffB);
            PG8_BAR; PG8_WAIT_L(0); PG8_MMA(0, 1, At, B1); PG8_BAR;
            PG8_LDA(At, 0, 1); PG8_STAGE(PG8_SA(0, 0), a2, voffA);
            PG8_BAR; PG8_WAIT_L(0); PG8_MMA(1, 0, At, B0); PG8_BAR; PG8_SCHED;
            PG8_STAGE(PG8_SB(0, 1), b2 + hstep, voffB);
            PG8_WAIT_V(6); PG8_BAR; PG8_MMA(1, 1, At, B1); PG8_BAR;
            PG8_LDB(B0, 1, 0); PG8_SCHED; PG8_LDA(At, 1, 0); PG8_STAGE(PG8_SA(0, 1), a2 + hstep, voffA);
            PG8_WAIT_L(8); PG8_BAR; PG8_WAIT_L(0); PG8_MMA(0, 0, At, B0); PG8_BAR; PG8_SCHED;
            PG8_LDB(B1, 1, 1); PG8_STAGE(PG8_SB(1, 0), b3, voffB);
            PG8_BAR; PG8_WAIT_L(0); PG8_MMA(0, 1, At, B1); PG8_BAR;
            PG8_LDA(At, 1, 1); PG8_STAGE(PG8_SA(1, 0), a3, voffA);
            PG8_BAR; PG8_WAIT_L(0); PG8_MMA(1, 0, At, B0); PG8_BAR; PG8_SCHED;
            PG8_STAGE(PG8_SB(1, 1), b3 + hstep, voffB);
            PG8_WAIT_V(6); PG8_BAR; PG8_MMA(1, 1, At, B1); PG8_BAR;
            }
        }
        if constexpr (ALIGN_EPI) { if (wr == 0) PG8_BAR; }
        if constexpr (!Epi::AFTER_DRAIN) { E(acc, cur, wr, wc, fr, fq); S.done(cur); }
        if (!has_next) break;
#pragma unroll
        for (int a = 0; a < 2; ++a)
#pragma unroll
            for (int b = 0; b < 2; ++b)
#pragma unroll
                for (int m = 0; m < 4; ++m)
#pragma unroll
                    for (int n = 0; n < 2; ++n) acc[a][b][m][n] = (f32x4){0.f, 0.f, 0.f, 0.f};
        cur = nxt; cA = nA; cB = nB; cA2 = (const char*)g.A2 + (size_t)cur.pm * tstep; cB2 = (const char*)g.B2 + (size_t)cur.pn * tstep; ++ui;
        if constexpr (ALIGN_EPI) { if (wr == 1) PG8_BAR; }
    }
    PG8_WAIT_V(0);
    if constexpr (!ALIGN_EPI) { if (wr == 0) PG8_BAR; }
    PG8_BAR;
    if constexpr (Epi::AFTER_DRAIN) { E.fused(acc, cur, wr, wc, fr, fq, lds, wid, lane); S.done(cur); }
#undef PG8_SA
#undef PG8_SB
#undef PG8_STAGE
#undef PG8_LDA
#undef PG8_LDB
#undef PG8_MMA
#undef PG8_WAIT_V
#undef PG8_WAIT_L
#undef PG8_BAR
#undef PG8_SCHED
}
}

constexpr int NWAVES = 8;
constexpr int D = 1024, NB = 4, SEQ = 4096, PADF = 48, LP = 4160, NCH = 65, MP = NB * LP  , MX = NB * SEQ  ;
constexpr int INW = 4624, INWP = 4864, NH = 8, SG = 32;
constexpr int NE = 64;
constexpr float LN_EPS = 1e-5f, NORM_EPS = 1e-6f, ALPHA = 1.189207115002721f;

constexpr size_t MiB = 1u << 20;
constexpr size_t WS_CTL = 0, CTL_ZERO_BYTES = 512 * 1024;
constexpr size_t WS_STATS = 1 * MiB;
constexpr size_t WS_ROUTE = WS_STATS + 128 * 1024;
constexpr size_t WS_INV = WS_ROUTE + 512 * 1024;
constexpr size_t WS_WRT = WS_INV + 192 * 1024;
constexpr size_t WS_AB = 2 * MiB;
constexpr size_t WS_WGLU = 3 * MiB + 512 * 1024;
constexpr size_t WS_WBR = WS_WGLU + 512 * 1024;
constexpr size_t WS_WOUT = WS_WBR + 2 * MiB;
constexpr size_t WS_W13 = 8 * MiB;
constexpr size_t WS_W2 = WS_W13 + 64 * MiB;
constexpr size_t WS_WINT = 8 * MiB;
constexpr size_t WS_H0B = WS_WINT + (size_t)INWP * D * 2;
constexpr size_t WS_QKV = WS_H0B + (size_t)MP * D * 2;
static_assert(WS_QKV + (size_t)MP * 1536 * 2 <= 104 * MiB, "overlay");
constexpr size_t WS_Z = 104 * MiB;
constexpr size_t WS_U = WS_Z + (size_t)MP * 512 * 2;
constexpr size_t WS_GATES = WS_U + (size_t)MP * 512 * 2;
constexpr size_t WS_OA = WS_GATES + (size_t)MP * 2048 * 2;
constexpr size_t WS_YB = WS_OA + 16 * MiB;
constexpr size_t WS_OB = WS_YB + 16 * MiB;
constexpr size_t WS_MERGED = WS_OB + 16 * MiB;
constexpr size_t WS_END = WS_MERGED + 32 * MiB;
static_assert(WS_END <= 283 * MiB, "d_ws map");
constexpr size_t WS_TMP = WS_Z;
constexpr size_t WS_PRE = WS_GATES;
constexpr size_t WS_H1 = WS_Z;
constexpr size_t WS_INV2 = WS_YB;
constexpr size_t WS_HID = WS_OA;
static_assert(WS_TMP + 32 * MiB <= WS_GATES && WS_PRE + 64 * MiB <= WS_OA, "overlays");
constexpr size_t DO_QN = 0, DO_KN = (size_t)MP * 512 * 2, DO_VN = 2 * DO_KN, DO_BETA = 3 * DO_KN, DO_ALPHA = DO_BETA + (size_t)MP * 8 * 4;
constexpr int CW_BAR = 4096, CW_CNT = 65536, CNT_STRIDE = 1024;
constexpr int RING_BYTES = 131072, LDS_BYTES = 163840, LDSCTL_OFF = LDS_BYTES - 1024, MISC_OFF = LDSCTL_OFF + 320;

__device__ __forceinline__ float bf2f(unsigned short h) { return __builtin_bit_cast(float, (unsigned)h << 16); }
__device__ __forceinline__ float bflo(unsigned w) { return __builtin_bit_cast(float, w << 16); }
__device__ __forceinline__ float bfhi(unsigned w) { return __builtin_bit_cast(float, w & 0xffff0000u); }
__device__ __forceinline__ float sigm(float x) { return __builtin_amdgcn_rcpf(1.f + __expf(-x)); }
__device__ __forceinline__ float silu_(float x) { return x * sigm(x); }
__device__ __forceinline__ float softplus_(float x) { return x > 20.f ? x : log1pf(expf(x)); }
__device__ __forceinline__ float gelu_tanh(float x) { const float u = 0.7978845608028654f * (x + 0.044715f * x * x * x); return 0.5f * x * (1.f + tanhf(u)); }
__device__ __forceinline__ float wave_sum(float v) {
#pragma unroll
    for (int o = 1; o < 64; o <<= 1) v += __shfl_xor(v, o);
    return v;
}
__device__ __forceinline__ int prow_of(int xrow) { return (xrow >> 12) * LP + 64 + (xrow & 4095); }

namespace pg8 {
struct EpiProj {
    static constexpr bool PERM = true, AFTER_DRAIN = false;
    bf16_t *qkv, *z, *u, *gates; float* ab;
    __device__ __forceinline__ void operator()(const f32x4 (&acc)[2][2][4][2], const Unit& un, int wr, int wc, int fr, int fq) const {
        const int pn = un.pn; bf16_t* base; int ld, cb;
        if (pn < 6) { base = qkv; ld = 1536; cb = pn * 256; }
        else if (pn < 8) { base = z; ld = 512; cb = (pn - 6) * 256; }
        else if (pn < 10) {
            const int row0u = un.pm * BM + wr * 64 + fr, c0u = (pn - 8) * 256 + wc * 32 + 8 * fq;
#pragma unroll
            for (int ai = 0; ai < 2; ++ai)
#pragma unroll
                for (int m = 0; m < 4; ++m)
#pragma unroll
                    for (int bj = 0; bj < 2; ++bj) { const int col = c0u + bj * HALF, row = row0u + ai * HALF + m * 16; const f32x4 v0 = acc[ai][bj][m][0], v1 = acc[ai][bj][m][1]; u32x4 w;
                        w.x = cvt_pk_bf16(v0[0], v0[1]); w.y = cvt_pk_bf16(v0[2], v0[3]); w.z = cvt_pk_bf16(v1[0], v1[1]); w.w = cvt_pk_bf16(v1[2], v1[3]);
                        *(u32x4*)(u + ((size_t)(col >> 4) * MP + row) * 16 + (col & 15)) = w; }
            return; }
        else if (pn < 18) { base = gates; ld = 2048; cb = (pn - 10) * 256; }
        else {
            if (wc == 0 && fq < 2) {
#pragma unroll
                for (int ai = 0; ai < 2; ++ai)
#pragma unroll
                    for (int m = 0; m < 4; ++m) { const int row = un.pm * BM + ai * HALF + wr * 64 + m * 16 + fr; float* p = ab + (size_t)row * 16 + 8 * fq;
                        *(f32x4*)p = acc[ai][0][m][0]; *(f32x4*)(p + 4) = acc[ai][0][m][1]; }
            }
            return;
        }
        const int row0 = un.pm * BM + wr * 64 + fr, col0 = cb + wc * 32 + 8 * fq;
#pragma unroll
        for (int ai = 0; ai < 2; ++ai)
#pragma unroll
            for (int m = 0; m < 4; ++m) { bf16_t* rowp = base + (size_t)(row0 + ai * HALF + m * 16) * ld + col0;
#pragma unroll
                for (int bj = 0; bj < 2; ++bj) { const f32x4 v0 = acc[ai][bj][m][0], v1 = acc[ai][bj][m][1]; u32x4 w;
                    w.x = cvt_pk_bf16(v0[0], v0[1]); w.y = cvt_pk_bf16(v0[2], v0[3]); w.z = cvt_pk_bf16(v1[0], v1[1]); w.w = cvt_pk_bf16(v1[2], v1[3]);
                    *(u32x4*)(rowp + bj * HALF) = w; } }
    }
};
struct EpiGlu {
    static constexpr bool PERM = true, AFTER_DRAIN = false;
    const bf16_t* yb; const float* bglu; bf16_t* ob;
    __device__ __forceinline__ void operator()(const f32x4 (&acc)[2][2][4][2], const Unit& un, int wr, int wc, int fr, int fq) const {
        const int row0 = un.pm * BM + wr * 64 + fr, col0 = un.pn * BM + wc * 32 + 8 * fq;
#pragma unroll
        for (int bj = 0; bj < 2; ++bj) { const int col = col0 + bj * HALF; const f32x4 b0 = *(const f32x4*)(bglu + col), b1 = *(const f32x4*)(bglu + col + 4);
#pragma unroll
            for (int ai = 0; ai < 2; ++ai)
#pragma unroll
                for (int m = 0; m < 4; ++m) { const size_t off = (size_t)(row0 + ai * HALF + m * 16) * 512 + col; const u32x4 y = *(const u32x4*)(yb + off);
                    const f32x4 v0 = acc[ai][bj][m][0] + b0, v1 = acc[ai][bj][m][1] + b1; u32x4 w;
                    w.x = cvt_pk_bf16(bflo(y.x) * sigm(v0[0]), bfhi(y.x) * sigm(v0[1])); w.y = cvt_pk_bf16(bflo(y.y) * sigm(v0[2]), bfhi(y.y) * sigm(v0[3]));
                    w.z = cvt_pk_bf16(bflo(y.z) * sigm(v1[0]), bfhi(y.z) * sigm(v1[1])); w.w = cvt_pk_bf16(bflo(y.w) * sigm(v1[2]), bfhi(y.w) * sigm(v1[3]));
                    st_wt16(ob + off, w); } }
    }
};
template <bool SECOND> struct EpiBr {
    static constexpr bool PERM = true, AFTER_DRAIN = false;
    const bf16_t* gates; const bf16_t* tin; bf16_t* out;
    __device__ __forceinline__ void operator()(const f32x4 (&acc)[2][2][4][2], const Unit& un, int wr, int wc, int fr, int fq) const {
        const int row0 = un.pm * BM + wr * 64 + fr, col0 = un.pn * BM + wc * 32 + 8 * fq;
#pragma unroll
        for (int ai = 0; ai < 2; ++ai)
#pragma unroll
            for (int m = 0; m < 4; ++m) { const int row = row0 + ai * HALF + m * 16; const size_t goff = (size_t)prow_of(row) * 2048 + (SECOND ? 1024 : 0) + col0, off = (size_t)row * 1024 + col0;
#pragma unroll
                for (int bj = 0; bj < 2; ++bj) { const u32x4 g = *(const u32x4*)(gates + goff + bj * HALF); const f32x4 v0 = acc[ai][bj][m][0], v1 = acc[ai][bj][m][1];
                    float r[8] = { sigm(bflo(g.x)) * v0[0], sigm(bfhi(g.x)) * v0[1], sigm(bflo(g.y)) * v0[2], sigm(bfhi(g.y)) * v0[3],
                                   sigm(bflo(g.z)) * v1[0], sigm(bfhi(g.z)) * v1[1], sigm(bflo(g.w)) * v1[2], sigm(bfhi(g.w)) * v1[3] };
                    if (SECOND) { const u32x4 t = *(const u32x4*)(tin + off + bj * HALF);
                        r[0] += bflo(t.x); r[1] += bfhi(t.x); r[2] += bflo(t.y); r[3] += bfhi(t.y); r[4] += bflo(t.z); r[5] += bfhi(t.z); r[6] += bflo(t.w); r[7] += bfhi(t.w); }
                    u32x4 w; w.x = cvt_pk_bf16(r[0], r[1]); w.y = cvt_pk_bf16(r[2], r[3]); w.z = cvt_pk_bf16(r[4], r[5]); w.w = cvt_pk_bf16(r[6], r[7]);
                    st_wt16(out + off + bj * HALF, w); } }
    }
};
struct EpiBrFused {
    static constexpr bool PERM = true, AFTER_DRAIN = false;
    const bf16_t* gates; bf16_t* out;
    __device__ __forceinline__ void mid(f32x4 (&acc)[2][2][4][2], const Unit& un, int wr, int wc, int fr, int fq) const {
        const int row0 = un.pm * BM + wr * 64 + fr, col0 = un.pn * BM + wc * 32 + 8 * fq;
#pragma unroll
        for (int ai = 0; ai < 2; ++ai)
#pragma unroll
            for (int m = 0; m < 4; ++m) { const int row = row0 + ai * HALF + m * 16; const size_t goff = (size_t)prow_of(row) * 2048 + col0;
#pragma unroll
                for (int bj = 0; bj < 2; ++bj) { const u32x4 ga = *(const u32x4*)(gates + goff + bj * HALF), gb = *(const u32x4*)(gates + goff + 1024 + bj * HALF);
                    const float ea[8] = {bflo(ga.x), bfhi(ga.x), bflo(ga.y), bfhi(ga.y), bflo(ga.z), bfhi(ga.z), bflo(ga.w), bfhi(ga.w)};
                    const float eb[8] = {bflo(gb.x), bfhi(gb.x), bflo(gb.y), bfhi(gb.y), bflo(gb.z), bfhi(gb.z), bflo(gb.w), bfhi(gb.w)};
#pragma unroll
                    for (int e = 0; e < 8; ++e) { const float r = (1.f + __expf(-eb[e])) * __builtin_amdgcn_rcpf(1.f + __expf(-ea[e])); acc[ai][bj][m][e >> 2][e & 3] *= r; } } }
    }
    __device__ __forceinline__ void operator()(const f32x4 (&acc)[2][2][4][2], const Unit& un, int wr, int wc, int fr, int fq) const {
        const int row0 = un.pm * BM + wr * 64 + fr, col0 = un.pn * BM + wc * 32 + 8 * fq;
#pragma unroll
        for (int ai = 0; ai < 2; ++ai)
#pragma unroll
            for (int m = 0; m < 4; ++m) { const int row = row0 + ai * HALF + m * 16; const size_t goff = (size_t)prow_of(row) * 2048 + 1024 + col0, off = (size_t)row * 1024 + col0;
#pragma unroll
                for (int bj = 0; bj < 2; ++bj) { const u32x4 g = *(const u32x4*)(gates + goff + bj * HALF); const f32x4 v0 = acc[ai][bj][m][0], v1 = acc[ai][bj][m][1];
                    u32x4 w; w.x = cvt_pk_bf16(sigm(bflo(g.x)) * v0[0], sigm(bfhi(g.x)) * v0[1]); w.y = cvt_pk_bf16(sigm(bflo(g.y)) * v0[2], sigm(bfhi(g.y)) * v0[3]);
                    w.z = cvt_pk_bf16(sigm(bflo(g.z)) * v1[0], sigm(bfhi(g.z)) * v1[1]); w.w = cvt_pk_bf16(sigm(bflo(g.w)) * v1[2], sigm(bfhi(g.w)) * v1[3]);
                    st_wt16(out + off + bj * HALF, w); } }
    }
};
struct EpiOut {
    static constexpr bool PERM = true, AFTER_DRAIN = false;
    const float* x; const float* stats; const float* g; const float* b; bf16_t* pre;
    __device__ __forceinline__ void operator()(const f32x4 (&acc)[2][2][4][2], const Unit& un, int wr, int wc, int fr, int fq) const {
        const int row0 = un.pm * BM + wr * 64 + fr, col0 = un.pn * BM + wc * 32 + 8 * fq;
#pragma unroll
        for (int bj = 0; bj < 2; ++bj) { const int col = col0 + bj * HALF; const f32x4 g0 = *(const f32x4*)(g + col), g1 = *(const f32x4*)(g + col + 4), b0 = *(const f32x4*)(b + col), b1 = *(const f32x4*)(b + col + 4);
#pragma unroll
            for (int ai = 0; ai < 2; ++ai)
#pragma unroll
                for (int m = 0; m < 4; ++m) { const int row = row0 + ai * HALF + m * 16; const float mean = stats[2 * row], rstd = stats[2 * row + 1];
                    const f32x4 x0 = *(const f32x4*)(x + (size_t)row * 1024 + col), x1 = *(const f32x4*)(x + (size_t)row * 1024 + col + 4);
                    const f32x4 v0 = ((x0 - mean) * rstd * g0 + b0) * ALPHA + acc[ai][bj][m][0], v1 = ((x1 - mean) * rstd * g1 + b1) * ALPHA + acc[ai][bj][m][1];
                    u32x4 w; w.x = cvt_pk_bf16(v0[0], v0[1]); w.y = cvt_pk_bf16(v0[2], v0[3]); w.z = cvt_pk_bf16(v1[0], v1[1]); w.w = cvt_pk_bf16(v1[2], v1[3]);
                    st_wt16(pre + (size_t)row * 1024 + col, w); } }
    }
};
}

namespace mg {
typedef unsigned u32x2 __attribute__((ext_vector_type(2)));
constexpr int STG = 49152, NSTG = 3;
__device__ __forceinline__ int swz(int r, int c16) { return r * 128 + ((c16 ^ (r & 7)) << 4); }
template <class RowPtr, class Epi>
__device__ __forceinline__ void tile(LAS unsigned char* lds, const RowPtr& rowptr, const bf16* Bt, int K, const Epi& epi) {
    const int tid = threadIdx.x, wid = __builtin_amdgcn_readfirstlane(tid >> 6), lane = tid & 63, wr = wid >> 2, wc = wid & 3, fr = lane & 15, fq = lane >> 4;
    const int lr = tid >> 3, ch = ((lane & 7) ^ ((lane >> 3) & 7)) * 8;
    const bf16* pa0 = rowptr(lr) + ch; const bf16* pa1 = rowptr(lr + 64) + ch;
    const bf16* pb = Bt + (size_t)lr * 64 + ch;
    f32x4 acc[4][4];
#pragma unroll
    for (int m = 0; m < 4; ++m)
#pragma unroll
        for (int n = 0; n < 4; ++n) acc[m][n] = (f32x4){0.f, 0.f, 0.f, 0.f};
    const int nk = K / 64;
#define MG_ISSUE(kt_) do { LAS unsigned char* sa_ = lds + ((kt_) % NSTG) * STG + wid * 1024; const int k0_ = (kt_) * 64; \
        __builtin_amdgcn_global_load_lds((const unsigned*)(pa0 + k0_), (LAS unsigned*)(sa_), 16, 0, 0); \
        __builtin_amdgcn_global_load_lds((const unsigned*)(pa1 + k0_), (LAS unsigned*)(sa_ + 8192), 16, 0, 0); \
        _Pragma("unroll") for (int j_ = 0; j_ < 4; ++j_) __builtin_amdgcn_global_load_lds((const unsigned*)(pb + (size_t)(kt_) * 16384 + j_ * 4096), (LAS unsigned*)(sa_ + 16384 + j_ * 8192), 16, 0, 0); } while (0)
    asm volatile("s_waitcnt vmcnt(0)" ::: "memory");
    __builtin_amdgcn_s_barrier();
    MG_ISSUE(0); if (nk > 1) MG_ISSUE(1);
    for (int kt = 0; kt < nk; ++kt) {
        if (kt + 1 < nk) asm volatile("s_waitcnt vmcnt(6)" ::: "memory"); else asm volatile("s_waitcnt vmcnt(0)" ::: "memory");
        __builtin_amdgcn_s_barrier();
        if (kt + 2 < nk) MG_ISSUE(kt + 2);
        const LAS unsigned char* sa = lds + (kt % NSTG) * STG; const LAS unsigned char* sb = sa + 16384;
#pragma unroll
        for (int ks = 0; ks < 2; ++ks) {
            bf16x8 a[4], w[4];
#pragma unroll
            for (int m = 0; m < 4; ++m) a[m] = *(const LAS bf16x8*)(sa + swz(64 * wr + 16 * m + fr, ks * 4 + fq));
#pragma unroll
            for (int n = 0; n < 4; ++n) w[n] = *(const LAS bf16x8*)(sb + swz(64 * wc + 16 * n + fr, ks * 4 + fq));
            __builtin_amdgcn_s_setprio(1);
#pragma unroll
            for (int m = 0; m < 4; ++m)
#pragma unroll
                for (int n = 0; n < 4; ++n) acc[m][n] = __builtin_amdgcn_mfma_f32_16x16x32_bf16(w[n], a[m], acc[m][n], 0, 0, 0);
            __builtin_amdgcn_s_setprio(0);
        }
        asm volatile("s_waitcnt lgkmcnt(0)" ::: "memory");
    }
#undef MG_ISSUE
    epi(acc, wr, wc, fr, fq);
}

struct Src { const bf16* pa0; const bf16* pa1; const bf16* pb; };
template <class Epi>
__device__ __forceinline__ void tile_pipe(LAS unsigned char* lds, const Src& cur, int nk, bool first, bool has_next, const Src& nxt, int& sbase, const Epi& epi, unsigned* sig = nullptr) {
    const int tid = threadIdx.x, wid = __builtin_amdgcn_readfirstlane(tid >> 6), lane = tid & 63, wr = wid >> 2, wc = wid & 3, fr = lane & 15, fq = lane >> 4;
    f32x4 acc[4][4];
#pragma unroll
    for (int m = 0; m < 4; ++m)
#pragma unroll
        for (int n = 0; n < 4; ++n) acc[m][n] = (f32x4){0.f, 0.f, 0.f, 0.f};
#define MG_ISSUE2(S_, kt_, slot_) do { LAS unsigned char* sa_ = lds + (slot_) * STG + wid * 1024; const int k0_ = (kt_) * 64; \
        __builtin_amdgcn_global_load_lds((const unsigned*)((S_).pa0 + k0_), (LAS unsigned*)(sa_), 16, 0, 0); \
        __builtin_amdgcn_global_load_lds((const unsigned*)((S_).pa1 + k0_), (LAS unsigned*)(sa_ + 8192), 16, 0, 0); \
        _Pragma("unroll") for (int j_ = 0; j_ < 4; ++j_) __builtin_amdgcn_global_load_lds((const unsigned*)((S_).pb + (size_t)(kt_) * 16384 + j_ * 4096), (LAS unsigned*)(sa_ + 16384 + j_ * 8192), 16, 0, 0); } while (0)
    int slot = sbase;
    if (first) {
        asm volatile("s_waitcnt vmcnt(0)" ::: "memory");
        __builtin_amdgcn_s_barrier();
        MG_ISSUE2(cur, 0, slot); MG_ISSUE2(cur, 1, (slot + 1 >= NSTG ? slot + 1 - NSTG : slot + 1));
    }
    for (int kt = 0; kt < nk; ++kt) {
        if (kt == 0 && sig) asm volatile("s_waitcnt vmcnt(0)" ::: "memory"); else asm volatile("s_waitcnt vmcnt(6)" ::: "memory");
        __builtin_amdgcn_s_barrier();
        if (kt == 0 && sig && tid == 0) (void)__hip_atomic_fetch_add(sig, 1u, __ATOMIC_RELAXED, __HIP_MEMORY_SCOPE_AGENT);
        const LAS unsigned char* sa = lds + slot * STG; const LAS unsigned char* sb = sa + 16384;
        bf16x8 a0[4], w0[4], a1[4], w1[4];
#pragma unroll
        for (int m = 0; m < 4; ++m) a0[m] = *(const LAS bf16x8*)(sa + swz(64 * wr + 16 * m + fr, fq));
#pragma unroll
        for (int n = 0; n < 4; ++n) w0[n] = *(const LAS bf16x8*)(sb + swz(64 * wc + 16 * n + fr, fq));
        { const bool own = kt + 2 < nk; const int kk = own ? kt + 2 : kt + 2 - nk, s2 = slot + 2 >= NSTG ? slot + 2 - NSTG : slot + 2;
          Src S; S.pa0 = own ? cur.pa0 : nxt.pa0; S.pa1 = own ? cur.pa1 : nxt.pa1; S.pb = own ? cur.pb : nxt.pb;
          MG_ISSUE2(S, kk, s2); }
        __builtin_amdgcn_sched_barrier(0);
        __builtin_amdgcn_s_setprio(1);
#pragma unroll
        for (int n = 0; n < 4; ++n) acc[0][n] = __builtin_amdgcn_mfma_f32_16x16x32_bf16(w0[n], a0[0], acc[0][n], 0, 0, 0);
        __builtin_amdgcn_sched_barrier(0);
#pragma unroll
        for (int m = 0; m < 4; ++m) a1[m] = *(const LAS bf16x8*)(sa + swz(64 * wr + 16 * m + fr, 4 + fq));
        __builtin_amdgcn_sched_barrier(0);
#pragma unroll
        for (int n = 0; n < 4; ++n) acc[1][n] = __builtin_amdgcn_mfma_f32_16x16x32_bf16(w0[n], a0[1], acc[1][n], 0, 0, 0);
        __builtin_amdgcn_sched_barrier(0);
#pragma unroll
        for (int n = 0; n < 4; ++n) w1[n] = *(const LAS bf16x8*)(sb + swz(64 * wc + 16 * n + fr, 4 + fq));
        __builtin_amdgcn_sched_barrier(0);
#pragma unroll
        for (int m = 2; m < 4; ++m)
#pragma unroll
            for (int n = 0; n < 4; ++n) acc[m][n] = __builtin_amdgcn_mfma_f32_16x16x32_bf16(w0[n], a0[m], acc[m][n], 0, 0, 0);
        __builtin_amdgcn_sched_barrier(0);
#pragma unroll
        for (int m = 0; m < 4; ++m)
#pragma unroll
            for (int n = 0; n < 4; ++n) acc[m][n] = __builtin_amdgcn_mfma_f32_16x16x32_bf16(w1[n], a1[m], acc[m][n], 0, 0, 0);
        __builtin_amdgcn_s_setprio(0);
        asm volatile("s_waitcnt lgkmcnt(0)" ::: "memory");
        slot = slot + 1 >= NSTG ? slot + 1 - NSTG : slot + 1;
    }
#undef MG_ISSUE2
    sbase = slot;
    epi(acc, wr, wc, fr, fq);
}

template <class Epi>
__device__ __forceinline__ void down_unit(LAS unsigned char* lds, const bf16* A  , int ntiles, const bf16* Bt  , Epi& epi) {
    const int tid = threadIdx.x, wid = __builtin_amdgcn_readfirstlane(tid >> 6), lane = tid & 63, wr = wid >> 1, wc = wid & 1, fr = lane & 15, fq = lane >> 4;
    const int lr = tid >> 3;
    __syncthreads();
#pragma unroll
    for (int j = 0; j < 4; ++j)
#pragma unroll
        for (int kk = 0; kk < 4; ++kk) { const int r = lr + 64 * j, c = lane & 7;
            *(LAS v4u*)(lds + kk * 32768 + swz(r, c)) = *(const v4u*)(Bt + (size_t)r * 256 + kk * 64 + c * 8); }
    __syncthreads();
#pragma unroll 1
    for (int mt = 0; mt < ntiles; ++mt) {
        int fr_ = fr; asm volatile("" : "+v"(fr_));
        bf16x8 a[2][8];
#pragma unroll
        for (int m = 0; m < 2; ++m)
#pragma unroll
            for (int ks = 0; ks < 8; ++ks) a[m][ks] = *(const bf16x8*)(A + (size_t)(128 * mt + 32 * wr + 16 * m + fr) * 256 + 32 * ks + 8 * fq);
        epi.prepare(mt, wr, fr);
        f32x4 acc[2][8];
#pragma unroll
        for (int m = 0; m < 2; ++m)
#pragma unroll
            for (int n = 0; n < 8; ++n) acc[m][n] = (f32x4){0.f, 0.f, 0.f, 0.f};
#pragma unroll
        for (int ks = 0; ks < 8; ++ks) { bf16x8 w[8];
#pragma unroll
            for (int n = 0; n < 8; ++n) w[n] = *(const LAS bf16x8*)(lds + (ks >> 1) * 32768 + swz(128 * wc + 16 * n + fr_, (ks & 1) * 4 + fq));
#pragma unroll
            for (int m = 0; m < 2; ++m)
#pragma unroll
                for (int n = 0; n < 8; ++n) acc[m][n] = __builtin_amdgcn_mfma_f32_16x16x32_bf16(w[n], a[m][ks], acc[m][n], 0, 0, 0); }
        epi(acc, wr, wc, fr, fq);
    }
}
struct DownArgs { const bf16* A; int ntiles; const bf16* Bt; const int* lst; const float* route; int cnt; bf16* slots; int c0; };
template <int MODE>
__device__ __forceinline__ void down_unit(LAS unsigned char* lds, const DownArgs& U) {
    const int tid = threadIdx.x, wid = __builtin_amdgcn_readfirstlane(tid >> 6), lane = tid & 63, wr = wid >> 1, wc = wid & 1, fr = lane & 15, fq = lane >> 4;
    const int lr = tid >> 3;
    LAS int* PT = (LAS int*)(lds + 131072);
    __syncthreads();
#pragma unroll
    for (int j = 0; j < 4; ++j)
#pragma unroll
        for (int kk = 0; kk < 4; ++kk) { const int r = lr + 64 * j, c = lane & 7;
            *(LAS v4u*)(lds + kk * 32768 + swz(r, c)) = *(const v4u*)(U.Bt + (size_t)r * 256 + kk * 64 + c * 8); }
#define MGD_LOADA(dst_, mt_) do { _Pragma("unroll") for (int m_ = 0; m_ < 2; ++m_) _Pragma("unroll") for (int ks_ = 0; ks_ < 8; ++ks_) \
        dst_[m_][ks_] = *(const bf16x8*)(U.A + (size_t)(128 * (mt_) + 32 * wr + 16 * m_ + fr) * 256 + 32 * ks_ + 8 * fq); } while (0)
    bf16x8 a[2][8], an[2][8];
    MGD_LOADA(a, 0);
#pragma unroll 1
    for (int mt = 0; mt < U.ntiles; ++mt) {
        if ((mt & 3) == 0) {
            if (mt) __syncthreads();
            const int li = 128 * mt + tid; const int pp = li < U.cnt ? U.lst[li] : -1;
            PT[tid] = pp; PT[512 + tid] = pp < 0 ? 0 : __builtin_bit_cast(int, U.route[(size_t)(pp >> 1) * 8 + 4 + (pp & 1)]);
            __syncthreads();
        }
        if (mt + 1 < U.ntiles) MGD_LOADA(an, mt + 1);
        int fr_ = fr; asm volatile("" : "+v"(fr_));
        f32x4 acc[2][8];
#pragma unroll
        for (int m = 0; m < 2; ++m)
#pragma unroll
            for (int n = 0; n < 8; ++n) acc[m][n] = (f32x4){0.f, 0.f, 0.f, 0.f};
#pragma unroll
        for (int ks = 0; ks < 8; ++ks)
#pragma unroll
            for (int nh = 0; nh < 2; ++nh) { bf16x8 w[4];
#pragma unroll
                for (int n = 0; n < 4; ++n) w[n] = *(const LAS bf16x8*)(lds + (ks >> 1) * 32768 + swz(128 * wc + 16 * (4 * nh + n) + fr_, (ks & 1) * 4 + fq));
#pragma unroll
                for (int m = 0; m < 2; ++m)
#pragma unroll
                    for (int n = 0; n < 4; ++n) acc[m][4 * nh + n] = __builtin_amdgcn_mfma_f32_16x16x32_bf16(w[n], a[m][ks], acc[m][4 * nh + n], 0, 0, 0); }
#pragma unroll
        for (int m = 0; m < 2; ++m) { const int ti = 128 * (mt & 3) + 32 * wr + 16 * m + fr_; const int pp = PT[ti]; const float gt = __builtin_bit_cast(float, PT[512 + ti]);
            if (MODE == 1) { _Pragma("unroll") for (int n = 0; n < 8; ++n) asm volatile("" :: "v"(acc[m][n])); }
            else if (pp >= 0) {
#pragma unroll
                for (int n = 0; n < 8; ++n) { const f32x4 v = acc[m][n] * gt; u32x2 w2; w2.x = pk2(v[0], v[1]); w2.y = pk2(v[2], v[3]);
                    *(u32x2*)(U.slots + (size_t)pp * 1024 + U.c0 + 128 * wc + 16 * n + 4 * fq) = w2; } } }
#pragma unroll
        for (int m = 0; m < 2; ++m)
#pragma unroll
            for (int ks = 0; ks < 8; ++ks) a[m][ks] = an[m][ks];
    }
#undef MGD_LOADA
}
}

struct Ctx {
    LAS unsigned char* lds; int tid, lane, wave, wg, G;
    const float* const* in; float* out; unsigned char* ws; gu32* ctl;
};

template <bool NT>
__device__ __forceinline__ void transpose_item(const float* W, int K, int N, bf16* WT, int mode, int row_off, int s13, LAS float* scr, int item, int lane) {
    const int nblk = (N + 31) / 32, kb = item / nblk, nb = item % nblk, k0 = 64 * kb, n0 = 32 * nb;
    const int kk = lane >> 3, n4 = (lane & 7) * 4; const bool ok = n0 + n4 < N;
    f32x4 v[8];
#pragma unroll
    for (int i = 0; i < 8; ++i) { const f32x4* p = (const f32x4*)(W + (size_t)(k0 + 8 * i + kk) * N + n0 + n4);
        v[i] = ok ? (NT ? __builtin_nontemporal_load(p) : *p) : (f32x4){0.f, 0.f, 0.f, 0.f}; }
#pragma unroll
    for (int i = 0; i < 8; ++i) { LAS float* s = scr + (8 * i + kk) * 33 + n4; s[0] = v[i].x; s[1] = v[i].y; s[2] = v[i].z; s[3] = v[i].w; }
    LDS_WAIT(); asm volatile("" ::: "memory");
    const int c = lane & 7;
#pragma unroll
    for (int j = 0; j < 4; ++j) { const int n = (lane >> 3) + 8 * j; const LAS float* s = scr + (8 * c) * 33 + n;
        v4u o; o.x = pk2(s[0 * 33], s[1 * 33]); o.y = pk2(s[2 * 33], s[3 * 33]); o.z = pk2(s[4 * 33], s[5 * 33]); o.w = pk2(s[6 * 33], s[7 * 33]);
        const int orow = ((mode & 1) == 0) ? (row_off + n0 + n) : (row_off + 2 * n0 + n + (n >= 16 ? 16 : 0) + 16 * s13);
        if (n0 + n < N) { const size_t off = (mode & 2) ? ((size_t)((orow >> 8) * (K >> 6) + (k0 >> 6)) * 16384 + (size_t)(orow & 255) * 64 + 8 * c) : ((size_t)orow * K + k0 + 8 * c); *(GAS v4u*)(WT + off) = o; } }
    LDS_WAIT(); asm volatile("" ::: "memory");
}
__device__ __forceinline__ void ln_row(f32x4 (&v)[4], const float* g, const float* b, int lane, float scale_in, float& mean_o, float& rstd_o) {
    float s = 0.f;
#pragma unroll
    for (int j = 0; j < 4; ++j) { v[j] = v[j] * scale_in; s += (v[j].x + v[j].y) + (v[j].z + v[j].w); }
    const float mean = wave_sum(s) * (1.f / D); float s2 = 0.f;
#pragma unroll
    for (int j = 0; j < 4; ++j) { v[j] = v[j] - mean; s2 += (v[j].x * v[j].x + v[j].y * v[j].y) + (v[j].z * v[j].z + v[j].w * v[j].w); }
    const float rstd = __builtin_amdgcn_rsqf(wave_sum(s2) * (1.f / D) + LN_EPS);
#pragma unroll
    for (int j = 0; j < 4; ++j) { const f32x4 gv = *(const f32x4*)(g + 4 * lane + 256 * j), bv = *(const f32x4*)(b + 4 * lane + 256 * j); v[j] = v[j] * rstd * gv + bv; }
    mean_o = mean; rstd_o = rstd;
}

__device__ __forceinline__ void phase0(const Ctx& C) {
    LAS float* scr = (LAS float*)(C.lds + C.wave * 16384);
    const int gw = C.wg * NWAVES + C.wave, NGW = C.G * NWAVES, lane = C.lane;
    bf16* WINT = (bf16*)(C.ws + WS_WINT); bf16* WGLU = (bf16*)(C.ws + WS_WGLU); bf16* WBR = (bf16*)(C.ws + WS_WBR); bf16* WOUT = (bf16*)(C.ws + WS_WOUT); bf16* WRT = (bf16*)(C.ws + WS_WRT);
    constexpr int I_IN = 16 * 145, I_GLU = 8 * 16, I_BR = 8 * 32, I_OUT = 16 * 32, I_RG = 16, I_RE = 32;
    constexpr int NITEMS = I_IN + I_GLU + 2 * I_BR + I_OUT + I_RG + I_RE;
    for (int it = gw; it < NITEMS; it += NGW) {
        int r = it;
        if (r < I_IN) { transpose_item<false>(C.in[4], 1024, INW, WINT, 0, 0, 0, scr, r, lane); continue; } r -= I_IN;
        if (r < I_GLU) { transpose_item<false>(C.in[17], 512, 512, WGLU, 0, 0, 0, scr, r, lane); continue; } r -= I_GLU;
        if (r < I_BR) { transpose_item<false>(C.in[19], 512, 1024, WBR, 0, 0, 0, scr, r, lane); continue; } r -= I_BR;
        if (r < I_BR) { transpose_item<false>(C.in[19] + 512 * 1024, 512, 1024, WBR + 1024 * 512, 0, 0, 0, scr, r, lane); continue; } r -= I_BR;
        if (r < I_OUT) { transpose_item<false>(C.in[20], 1024, 1024, WOUT, 0, 0, 0, scr, r, lane); continue; } r -= I_OUT;
        if (r < I_RG) { transpose_item<false>(C.in[23], 1024, 8, WRT, 0, 0, 0, scr, r, lane); continue; } r -= I_RG;
        transpose_item<false>(C.in[25], 1024, 64, WRT, 0, 8, 0, scr, r, lane);
    }
    for (int it = gw; it < (INWP - INW) + 8; it += NGW) { bf16* rowp = (it < INWP - INW) ? WINT + (size_t)(INW + it) * 1024 : WRT + (size_t)(72 + it - (INWP - INW)) * 1024;
        GAS v4u* o = (GAS v4u*)rowp + lane; o[0] = (v4u){0u, 0u, 0u, 0u}; o[64] = (v4u){0u, 0u, 0u, 0u}; }
    bf16* H0B = (bf16*)(C.ws + WS_H0B); float* stats = (float*)(C.ws + WS_STATS);
    const float* x = C.in[0]; const float* meta = C.in[1]; const float* g = C.in[2]; const float* b = C.in[3];
    for (int rp0 = gw * 2; rp0 < MP; rp0 += NGW * 2) {
        f32x4 v[2][4]; int kind[2];
#pragma unroll
        for (int rr = 0; rr < 2; ++rr) { const int rp = rp0 + rr, bb = rp / LP, i = rp % LP; kind[rr] = i < PADF ? 0 : (i < 64 ? 1 : 2);
            const float* src = (i < PADF) ? x : ((i < 64) ? meta + (size_t)(i - PADF) * D : x + ((size_t)bb * SEQ + (i - 64)) * D);
#pragma unroll
            for (int j = 0; j < 4; ++j) v[rr][j] = *(const f32x4*)(src + 4 * lane + 256 * j); }
#pragma unroll
        for (int rr = 0; rr < 2; ++rr) { const int rp = rp0 + rr, bb = rp / LP, i = rp % LP;
            GAS unsigned long long* o8 = (GAS unsigned long long*)(H0B + (size_t)rp * D) + lane;
            if (kind[rr] == 0) {
#pragma unroll
                for (int j = 0; j < 4; ++j) o8[64 * j] = 0ull;
                continue; }
            float mean, rstd; ln_row(v[rr], g, b, lane, 1.f, mean, rstd);
            if (kind[rr] == 2 && lane == 0) { const int xr = bb * SEQ + (i - 64); stats[2 * xr] = mean; stats[2 * xr + 1] = rstd; }
#pragma unroll
            for (int j = 0; j < 4; ++j) o8[64 * j] = (unsigned long long)pk2(v[rr][j].x, v[rr][j].y) | ((unsigned long long)pk2(v[rr][j].z, v[rr][j].w) << 32); }
    }
}

__device__ __forceinline__ void phase2_elem(const Ctx& C) {
    const int gw = C.wg * NWAVES + C.wave, NGW = C.G * NWAVES, lane = C.lane;
    const bf16* qkv = (const bf16*)(C.ws + WS_QKV); const float* ab = (const float*)(C.ws + WS_AB);
    bf16* qn = (bf16*)((unsigned char*)C.out + DO_QN); bf16* kn = (bf16*)((unsigned char*)C.out + DO_KN); bf16* vn = (bf16*)((unsigned char*)C.out + DO_VN);
    float* beta = (float*)((unsigned char*)C.out + DO_BETA); float* alpha = (float*)((unsigned char*)C.out + DO_ALPHA);
    const float* cw = C.in[5]; const float* a_log = C.in[6]; const float* dt_bias = C.in[7];
    for (int it = gw; it < MP * NH; it += NGW) {
        const int rp = it >> 3, h = it & 7, i = rp % LP; const size_t o = (size_t)rp * 512 + h * 64 + lane;
        if (i < PADF) { qn[o] = 0; kn[o] = 0; vn[o] = 0; if (lane == 0) { beta[rp * 8 + h] = 0.f; alpha[rp * 8 + h] = 1.f; } continue; }
        float aq = 0.f, ak = 0.f, av = 0.f; const int ch = h * 64 + lane;
#pragma unroll
        for (int j = 0; j < 4; ++j) { const bf16* r = qkv + (size_t)(rp - 3 + j) * 1536 + ch;
            aq += cw[j * 1536 + ch] * bf2f(r[0]); ak += cw[j * 1536 + 512 + ch] * bf2f(r[512]); av += cw[j * 1536 + 1024 + ch] * bf2f(r[1024]); }
        float q = silu_(aq), k = silu_(ak), v = silu_(av);
        const float sq = wave_sum(q * q), sk = wave_sum(k * k);
        q *= (__builtin_amdgcn_rsqf(sq + NORM_EPS)) * 0.125f; k *= __builtin_amdgcn_rsqf(sk + NORM_EPS);
        qn[o] = (bf16)f2bf(q); kn[o] = (bf16)f2bf(k); vn[o] = (bf16)f2bf(v);
        if (lane == 0) { const float a = ab[rp * 16 + h], bb = ab[rp * 16 + 8 + h];
            beta[rp * 8 + h] = sigm(bb); alpha[rp * 8 + h] = expf(-expf(a_log[h]) * softplus_(a + dt_bias[h])); }
    }
}

__device__ __forceinline__ void dn_scan_naive(const Ctx& C, int b, int h) {
    if (C.wave != 0) return;
    const int lane = C.lane;
    LAS float* Kl = (LAS float*)C.lds; LAS float* Ql = Kl + 4096; LAS float* Vl = Ql + 4096; LAS float* Zl = Vl + 4096; LAS float* Bl = Zl + 4096; LAS float* Al = Bl + 64;
    const bf16* qn = (const bf16*)((unsigned char*)C.out + DO_QN); const bf16* kn = (const bf16*)((unsigned char*)C.out + DO_KN); const bf16* vn = (const bf16*)((unsigned char*)C.out + DO_VN);
    const float* beta = (const float*)((unsigned char*)C.out + DO_BETA); const float* alpha = (const float*)((unsigned char*)C.out + DO_ALPHA);
    const bf16* z = (const bf16*)(C.ws + WS_Z); bf16* oa = (bf16*)(C.ws + WS_OA);
    const float nw = C.in[8][lane];
    float S[64];
#pragma unroll
    for (int k = 0; k < 64; ++k) S[k] = 0.f;
    for (int n = 0; n < NCH; ++n) {
        const int base = b * LP + 64 * n;
#pragma unroll 8
        for (int i = 0; i < 64; ++i) { const size_t off = (size_t)(base + i) * 512 + h * 64 + lane;
            Kl[i * 64 + lane] = bf2f(kn[off]); Ql[i * 64 + lane] = bf2f(qn[off]); Vl[i * 64 + lane] = bf2f(vn[off]); Zl[i * 64 + lane] = bf2f(z[off]); }
        Bl[lane] = beta[(base + lane) * 8 + h]; Al[lane] = alpha[(base + lane) * 8 + h];
        asm volatile("s_waitcnt vmcnt(0) lgkmcnt(0)" ::: "memory");
#pragma unroll 1
        for (int i = 0; i < 64; ++i) {
            const LAS f32x4* kr = (const LAS f32x4*)(Kl + i * 64); const LAS f32x4* qr = (const LAS f32x4*)(Ql + i * 64);
            const float at = Al[i], bt = Bl[i], vt = Vl[i * 64 + lane];
            float d0 = 0.f, d1 = 0.f, d2 = 0.f, d3 = 0.f;
#pragma unroll
            for (int k4 = 0; k4 < 16; ++k4) { const f32x4 kk = kr[k4]; d0 += S[4 * k4] * kk.x; d1 += S[4 * k4 + 1] * kk.y; d2 += S[4 * k4 + 2] * kk.z; d3 += S[4 * k4 + 3] * kk.w; }
            const float vnew = bt * (vt - at * ((d0 + d1) + (d2 + d3)));
            float o0 = 0.f, o1 = 0.f, o2 = 0.f, o3 = 0.f;
#pragma unroll
            for (int k4 = 0; k4 < 16; ++k4) { const f32x4 kk = kr[k4], qq = qr[k4];
                S[4 * k4] = at * S[4 * k4] + kk.x * vnew; S[4 * k4 + 1] = at * S[4 * k4 + 1] + kk.y * vnew; S[4 * k4 + 2] = at * S[4 * k4 + 2] + kk.z * vnew; S[4 * k4 + 3] = at * S[4 * k4 + 3] + kk.w * vnew;
                o0 += S[4 * k4] * qq.x; o1 += S[4 * k4 + 1] * qq.y; o2 += S[4 * k4 + 2] * qq.z; o3 += S[4 * k4 + 3] * qq.w; }
            if (n >= 1) { const float o = (o0 + o1) + (o2 + o3); const float ss = wave_sum(o * o);
                const float on = o * (__builtin_amdgcn_rsqf(ss * (1.f / 64.f) + NORM_EPS)) * nw * silu_(Zl[i * 64 + lane]);
                oa[(size_t)(b * SEQ + 64 * (n - 1) + i) * 512 + h * 64 + lane] = (bf16)f2bf(on); }
        }
    }
}
__device__ __forceinline__ void s5_naive(const Ctx& C, int b, int g) {
    const int tid = C.tid, lane = C.lane;
    LAS float* uu = (LAS float*)C.lds; LAS float* hh = uu + 1024; LAS float* Cc = hh + 8192; LAS float* Dd = Cc + 2048;
    const bf16* u = (const bf16*)(C.ws + WS_U); bf16* yb = (bf16*)(C.ws + WS_YB);
    const float* c_re = C.in[14] + (size_t)g * 16 * 64; const float* c_im = C.in[15] + (size_t)g * 16 * 64;
    for (int e = tid; e < 1024; e += 512) { const int c = e >> 6, p = e & 63; Cc[c * 128 + p] = c_re[c * 64 + p]; Cc[c * 128 + 64 + p] = -c_im[c * 64 + p]; }
    if (tid < 16) Dd[tid] = C.in[16][g * 16 + tid];
    float ar = 0.f, ai = 0.f, Bbr[16], Bbi[16], hr = 0.f, hi = 0.f;
    if (C.wave == 0) {
        const float dt = expf(C.in[11][g]); const float a_r = C.in[9][g * 64 + lane], a_i = C.in[10][g * 64 + lane];
        const float mag = expf(dt * a_r); ar = mag * cosf(dt * a_i); ai = mag * sinf(dt * a_i);
        const float den = a_r * a_r + a_i * a_i, nr = ar - 1.f, ni = ai;
        const float f_re = (nr * a_r + ni * a_i) / den, f_im = (ni * a_r - nr * a_i) / den;
        const float* br = C.in[12] + ((size_t)g * 64 + lane) * 16; const float* bi = C.in[13] + ((size_t)g * 64 + lane) * 16;
#pragma unroll
        for (int c = 0; c < 16; ++c) { Bbr[c] = f_re * br[c] - f_im * bi[c]; Bbi[c] = f_re * bi[c] + f_im * br[c]; }
    }
    for (int n = 0; n < NCH; ++n) {
        const int base = b * LP + 64 * n;
        { const int row = tid >> 3, c2 = (tid & 7) * 2; const unsigned w = *(const unsigned*)(u + (size_t)(base + row) * 512 + g * 16 + c2); uu[row * 16 + c2] = bflo(w); uu[row * 16 + c2 + 1] = bfhi(w); }
        __syncthreads();
        if (C.wave == 0) {
#pragma unroll 4
            for (int t = 0; t < 64; ++t) { float bur = 0.f, bui = 0.f;
#pragma unroll
                for (int c4 = 0; c4 < 4; ++c4) { const f32x4 uv = *(const LAS f32x4*)(uu + t * 16 + 4 * c4);
                    bur += Bbr[4 * c4] * uv.x + Bbr[4 * c4 + 1] * uv.y + Bbr[4 * c4 + 2] * uv.z + Bbr[4 * c4 + 3] * uv.w;
                    bui += Bbi[4 * c4] * uv.x + Bbi[4 * c4 + 1] * uv.y + Bbi[4 * c4 + 2] * uv.z + Bbi[4 * c4 + 3] * uv.w; }
                const float nhr = ar * hr - ai * hi + bur, nhi = ar * hi + ai * hr + bui; hr = nhr; hi = nhi;
                hh[t * 128 + lane] = hr; hh[t * 128 + 64 + lane] = hi; }
        }
        __syncthreads();
        if (n >= 1) { const int t = tid >> 3;
#pragma unroll
            for (int cc = 0; cc < 2; ++cc) { const int c = (tid & 7) + 8 * cc; float a0 = 0.f, a1 = 0.f;
#pragma unroll 8
                for (int p4 = 0; p4 < 32; ++p4) { const f32x4 cv = *(const LAS f32x4*)(Cc + c * 128 + 4 * p4), hv = *(const LAS f32x4*)(hh + t * 128 + 4 * p4); a0 += cv.x * hv.x + cv.y * hv.y; a1 += cv.z * hv.z + cv.w * hv.w; }
                const float y = a0 + a1 + Dd[c] * uu[t * 16 + c];
                yb[(size_t)(b * SEQ + 64 * (n - 1) + t) * 512 + g * 16 + c] = (bf16)f2bf(gelu_tanh(y)); } }
        __syncthreads();
    }
}
constexpr int CW_CONV = 16640, CONV_SHARD = NE * 384 / 8;
__device__ __forceinline__ void convert_experts(const Ctx& C, int qi, unsigned first, unsigned limit) {
    (void)qi; (void)first; (void)limit;
    LAS float* scr = (LAS float*)(C.lds + C.wave * 16384);
    bf16* W13 = (bf16*)(C.ws + WS_W13); bf16* W2 = (bf16*)(C.ws + WS_W2);
#pragma unroll 1
    for (int q = 0; q < 8; ++q) { const int sh = (C.wg + q) & 7;
        for (;;) {
            unsigned li = 0; if (C.lane == 0) li = __hip_atomic_fetch_add(C.ctl + CW_CONV + 64 * sh, 1u, __ATOMIC_RELAXED, __HIP_MEMORY_SCOPE_AGENT);
            li = __builtin_amdgcn_readfirstlane(li); if (li >= (unsigned)CONV_SHARD) break;
            const int it = sh * CONV_SHARD + (int)li, e = it / 384, r = it % 384;
            if (r < 128) transpose_item<true>(C.in[27] + (size_t)e * 1024 * 256, 1024, 256, W13 + (size_t)e * 512 * 1024, 3, 0, 0, scr, r, C.lane);
            else if (r < 256) transpose_item<true>(C.in[28] + (size_t)e * 1024 * 256, 1024, 256, W13 + (size_t)e * 512 * 1024, 3, 0, 1, scr, r - 128, C.lane);
            else transpose_item<true>(C.in[29] + (size_t)e * 256 * 1024, 256, 1024, W2 + (size_t)e * 1024 * 256, 2, 0, 0, scr, r - 256, C.lane); }
    }
}
template <int MODE>
__device__ __forceinline__ void phase7_rows(const Ctx& C, int only_blk = -1) {
    constexpr int RS = 2064, RB = 64;
    LAS unsigned char* Ht = C.lds; LAS float* Lg = (LAS float*)(C.lds + RB * RS);
    const bf16* pre = (const bf16*)C.out; bf16* h1 = (bf16*)(C.ws + WS_H1);
    const bf16* WRT = (const bf16*)(C.ws + WS_WRT);
    const float* g1 = C.in[21]; const float* b1 = C.in[22]; const float* b_rg = C.in[24]; const float* b_re = C.in[26];
    int* route = (int*)(C.ws + WS_ROUTE); gu32* cnt = C.ctl + CW_CNT; int* inv2 = (int*)(C.ws + WS_INV2);
    const int lane = C.lane, wave = C.wave, fr = lane & 15, fq = lane >> 4;
    for (int blk = only_blk >= 0 ? only_blk : C.wg; blk < MX / RB; blk += (only_blk >= 0 ? MX : C.G)) {
#pragma unroll 1
        for (int hh = 0; hh < 2; ++hh) { f32x4 v[4][4];
#pragma unroll
            for (int rr = 0; rr < 4; ++rr)
#pragma unroll
                for (int j = 0; j < 4; ++j) { const mg::u32x2 pw = *(const mg::u32x2*)(pre + ((size_t)blk * RB + wave * 8 + hh * 4 + rr) * D + 4 * lane + 256 * j); v[rr][j] = (f32x4){bflo(pw.x), bfhi(pw.x), bflo(pw.y), bfhi(pw.y)}; }
#pragma unroll
            for (int rr = 0; rr < 4; ++rr) { const int r = wave * 8 + hh * 4 + rr; const size_t row = (size_t)blk * RB + r;
                float mean, rstd; ln_row(v[rr], g1, b1, lane, 1.f, mean, rstd);
                GAS unsigned long long* o8 = (GAS unsigned long long*)(h1 + row * D) + lane;
#pragma unroll
                for (int j = 0; j < 4; ++j) { const unsigned long long w = (unsigned long long)pk2(v[rr][j].x, v[rr][j].y) | ((unsigned long long)pk2(v[rr][j].z, v[rr][j].w) << 32);
                    if (MODE == 0) o8[64 * j] = w; *(LAS unsigned long long*)(Ht + r * RS + (4 * lane + 256 * j) * 2) = w; } } }
        __syncthreads();
        { const int kq = wave & 3, ch2 = wave >> 2, t0 = ch2 ? 3 : 0;
            bf16x8 wb[3][8];
            const bf16* w0 = WRT + (size_t)(16 * t0 + fr) * 1024 + kq * 256 + fq * 8;
#pragma unroll
            for (int t = 0; t < 3; ++t)
#pragma unroll
                for (int s8 = 0; s8 < 8; ++s8) if (t < 2 || !ch2) wb[t][s8] = *(const bf16x8*)(w0 + (size_t)t * 16 * 1024 + s8 * 32);
            f32x4 ac[4][3];
#pragma unroll
            for (int rg = 0; rg < 4; ++rg)
#pragma unroll
                for (int t = 0; t < 3; ++t) ac[rg][t] = (f32x4){0.f, 0.f, 0.f, 0.f};
#pragma unroll
            for (int s8 = 0; s8 < 8; ++s8)
#pragma unroll
                for (int rg = 0; rg < 4; ++rg) { const bf16x8 af = *(const LAS bf16x8*)(Ht + (16 * rg + fr) * RS + fq * 16 + (8 * kq + s8) * 64);
                    ac[rg][0] = __builtin_amdgcn_mfma_f32_16x16x32_bf16(wb[0][s8], af, ac[rg][0], 0, 0, 0);
                    ac[rg][1] = __builtin_amdgcn_mfma_f32_16x16x32_bf16(wb[1][s8], af, ac[rg][1], 0, 0, 0);
                    if (!ch2) ac[rg][2] = __builtin_amdgcn_mfma_f32_16x16x32_bf16(wb[2][s8], af, ac[rg][2], 0, 0, 0); }
            __syncthreads();
            LAS float* Pq = (LAS float*)Ht + kq * (RB * 80);
#pragma unroll
            for (int rg = 0; rg < 4; ++rg)
#pragma unroll
                for (int t = 0; t < 3; ++t) if (t < 2 || !ch2) *(LAS f32x4*)(Pq + (16 * rg + fr) * 80 + 16 * (t0 + t) + 4 * fq) = ac[rg][t];
            __syncthreads();
            for (int g4 = C.tid; g4 < RB * 80 / 4; g4 += NWAVES * 64) { const LAS f32x4* pp = (const LAS f32x4*)Ht + g4;
                const f32x4 p0 = pp[0], p1 = pp[RB * 80 / 4], p2 = pp[2 * (RB * 80 / 4)], p3 = pp[3 * (RB * 80 / 4)];
                ((LAS f32x4*)Lg)[g4] = (p0 + p1) + (p2 + p3); } }
        __syncthreads();
        LAS unsigned* hist = (LAS unsigned*)Ht;
        if (C.tid < NE) hist[C.tid] = 0u;
        __syncthreads();
        int e0 = 0, e1 = 0, l0 = 0, l1 = 0; float gw0 = 0.f, gw1 = 0.f;
        if (C.tid < RB) { const LAS float* L = Lg + C.tid * 80;
            float lg[8]; float mx = -3.0e38f; int gi = 0;
#pragma unroll
            for (int j = 0; j < 8; ++j) { lg[j] = L[j] + b_rg[j]; if (lg[j] > mx) { mx = lg[j]; gi = j; } }
            float se = 0.f;
#pragma unroll
            for (int j = 0; j < 8; ++j) se += __expf(lg[j] - mx);
            const float gp = 1.f / se;
            float t0 = -3.0e38f, t1 = -3.0e38f; int i0 = 0, i1 = 0;
#pragma unroll
            for (int j = 0; j < 8; ++j) { const float le = L[8 + gi * 8 + j] + b_re[gi * 8 + j];
                if (le > t0) { t1 = t0; i1 = i0; t0 = le; i0 = j; } else if (le > t1) { t1 = le; i1 = j; } }
            const float w0 = 1.f / (1.f + __expf(t1 - t0)), w1 = 1.f - w0;
            e0 = gi * 8 + i0; e1 = gi * 8 + i1; gw0 = w0 * gp; gw1 = w1 * gp;
            if (MODE == 0) { l0 = (int)__hip_atomic_fetch_add((unsigned*)(hist + e0), 1u, __ATOMIC_RELAXED, __HIP_MEMORY_SCOPE_WORKGROUP); l1 = (int)__hip_atomic_fetch_add((unsigned*)(hist + e1), 1u, __ATOMIC_RELAXED, __HIP_MEMORY_SCOPE_WORKGROUP); } }
        __syncthreads();
        if (MODE == 0 && C.tid < NE) { const unsigned c = hist[C.tid]; unsigned base = 0u; if (c) base = __hip_atomic_fetch_add(cnt + C.tid * CNT_STRIDE, c, __ATOMIC_RELAXED, __HIP_MEMORY_SCOPE_AGENT); hist[64 + C.tid] = base; }
        __syncthreads();
        if (C.tid < RB) { const int tok = blk * RB + C.tid;
            if (MODE == 1) { asm volatile("" :: "v"(e0), "v"(e1), "v"(gw0), "v"(gw1)); } else {
            const int r0 = (int)hist[64 + e0] + l0, r1 = (int)hist[64 + e1] + l1;
            int* ro = route + (size_t)tok * 8; ro[0] = e0; ro[1] = e1; ro[2] = r0; ro[3] = r1; ((float*)ro)[4] = gw0; ((float*)ro)[5] = gw1;
            inv2[(size_t)e0 * 16384 + r0] = 2 * tok; inv2[(size_t)e1 * 16384 + r1] = 2 * tok + 1; } }
        __syncthreads();
    }
}
__device__ __forceinline__ void moe_table(const Ctx& C, LAS int* tst) {
    if (C.tid < NE) tst[80 + C.tid] = (int)__hip_atomic_load(C.ctl + CW_CNT + C.tid * CNT_STRIDE, RLX_AGENT);
    __syncthreads();
    if (C.tid == 0) { int acc = 0; for (int e = 0; e < NE; ++e) { tst[e] = acc; acc += (tst[80 + e] + 127) >> 7; } tst[NE] = acc; }
    __syncthreads();
}
__device__ __forceinline__ int moe_expert_of(const LAS int* tst, int t) { int e = 0;
#pragma unroll 1
    for (int j = 1; j < NE; ++j) if (tst[j] <= t) e = j;
    return e; }
__device__ __forceinline__ bool moe_unit(const LAS int* tst, int NT, int grp, int ngrp, int u, int& e, int& t, int& nt) {
#pragma unroll 1
    for (int ee = grp; ee < NE; ee += ngrp) { const int nu = (tst[ee + 1] - tst[ee]) * NT; if (u < nu) { e = ee; t = tst[ee] + u / NT; nt = u % NT; return true; } u -= nu; }
    return false;
}
struct UpRow { const bf16* h1; const int* lst; int l0, cnt;
    __device__ __forceinline__ const bf16* operator()(int r) const { const int p = (l0 + r < cnt) ? lst[l0 + r] : -1; return h1 + (size_t)(p < 0 ? 0 : (p >> 1)) * D; } };
struct UpEpi { bf16* hid; int pos0, hc0;
    __device__ __forceinline__ void operator()(const f32x4 (&acc)[4][4], int wr, int wc, int fr, int fq) const {
#pragma unroll
        for (int m = 0; m < 4; ++m) { const int row = pos0 + 64 * wr + 16 * m + fr;
#pragma unroll
            for (int n2 = 0; n2 < 2; ++n2) { const f32x4 a = acc[m][2 * n2], b = acc[m][2 * n2 + 1]; const int hc = hc0 + 32 * wc + 16 * n2 + 4 * fq;
                mg::u32x2 w; w.x = pk2(silu_(a[0]) * b[0], silu_(a[1]) * b[1]); w.y = pk2(silu_(a[2]) * b[2], silu_(a[3]) * b[3]);
                *(mg::u32x2*)(hid + (size_t)row * 256 + hc) = w; } }
    } };
__device__ __forceinline__ int moe_group_units(const LAS int* tst, int NT, int grp, int ngrp) { int n = 0;
#pragma unroll 1
    for (int ee = grp; ee < NE; ee += ngrp) n += (tst[ee + 1] - tst[ee]) * NT;
    return n; }
constexpr int MOE_TAB_OFF = 150528, MOE_BATCH = 8;
__device__ __forceinline__ void phase9_up(const Ctx& C) {
    LAS int* tst = (LAS int*)(C.lds + 149504); moe_table(C, tst);
    LAS int* tab = (LAS int*)(C.lds + MOE_TAB_OFF);
    const int ngrp = (C.G % 8 == 0) ? 8 : 1, grp = C.wg % ngrp, gsz = C.G / ngrp;
    const int total = moe_group_units(tst, 2, grp, ngrp), first = C.wg / ngrp, nmine = total > first ? (total - first + gsz - 1) / gsz : 0;
    const int lr = C.tid >> 3, ch = ((C.lane & 7) ^ ((C.lane >> 3) & 7)) * 8;
    const bf16* h1 = (const bf16*)(C.ws + WS_H1); const bf16* W13 = (const bf16*)(C.ws + WS_W13); const int* inv2 = (const int*)(C.ws + WS_INV2);
    int sbase = 0;
    for (int b0 = 0; b0 < nmine; b0 += MOE_BATCH) { const int nu = nmine - b0 < MOE_BATCH ? nmine - b0 : MOE_BATCH;
        __syncthreads();
        int pv[2];
#pragma unroll
        for (int ps = 0; ps < 2; ++ps) { const int u = ps * 4 + (C.tid >> 7), row = C.tid & 127; int e, t, nt; pv[ps] = -1;
            if (u < nu && moe_unit(tst, 2, grp, ngrp, first + (b0 + u) * gsz, e, t, nt)) { const int li = 128 * (t - tst[e]) + row; if (li < tst[80 + e]) pv[ps] = inv2[(size_t)e * 16384 + li]; } }
#pragma unroll
        for (int ps = 0; ps < 2; ++ps) { const int u = ps * 4 + (C.tid >> 7), row = C.tid & 127; tab[u * 128 + row] = pv[ps] < 0 ? 0 : (pv[ps] >> 1); }
        __syncthreads();
        mg::Src cur, nxt; int e, t, nt;
        (void)moe_unit(tst, 2, grp, ngrp, first + b0 * gsz, e, t, nt);
        cur.pa0 = h1 + (size_t)tab[lr] * D + ch; cur.pa1 = h1 + (size_t)tab[64 + lr] * D + ch; cur.pb = W13 + (size_t)e * 524288 + (size_t)nt * 16 * 16384 + (size_t)lr * 64 + ch;
#pragma unroll 1
        for (int i = 0; i < nu; ++i) { const bool has_next = i + 1 < nu; int e2 = e, t2 = t, nt2 = nt; nxt = cur;
            if (has_next) { (void)moe_unit(tst, 2, grp, ngrp, first + (b0 + i + 1) * gsz, e2, t2, nt2);
                nxt.pa0 = h1 + (size_t)tab[(i + 1) * 128 + lr] * D + ch; nxt.pa1 = h1 + (size_t)tab[(i + 1) * 128 + 64 + lr] * D + ch; nxt.pb = W13 + (size_t)e2 * 524288 + (size_t)nt2 * 16 * 16384 + (size_t)lr * 64 + ch; }
            UpEpi ep{(bf16*)(C.ws + WS_HID), 128 * t, 128 * nt};
            mg::tile_pipe(C.lds, cur, 16, i == 0, has_next, nxt, sbase, ep);
            cur = nxt; e = e2; t = t2; nt = nt2; }
    }
}
struct DnRow { const bf16* hid; int pos0; __device__ __forceinline__ const bf16* operator()(int r) const { return hid + (size_t)(pos0 + r) * 256; } };
struct DnEpi { bf16* slots; const int* lst; const int* route; int l0, cnt, c0;
    __device__ __forceinline__ void operator()(const f32x4 (&acc)[4][4], int wr, int wc, int fr, int fq) const {
#pragma unroll
        for (int m = 0; m < 4; ++m) { const int li = l0 + 64 * wr + 16 * m + fr; if (li >= cnt) continue; const int p = lst[li];
            const float gt = ((const float*)route)[(size_t)(p >> 1) * 8 + 4 + (p & 1)];
#pragma unroll
            for (int n = 0; n < 4; ++n) { const f32x4 a = acc[m][n] * gt; mg::u32x2 w; w.x = pk2(a[0], a[1]); w.y = pk2(a[2], a[3]);
                *(mg::u32x2*)(slots + (size_t)p * D + c0 + 64 * wc + 16 * n + 4 * fq) = w; } }
    } };
struct DnEpi2 { bf16* slots; const LAS int* tab; int c0;
    __device__ __forceinline__ void operator()(const f32x4 (&acc)[4][4], int wr, int wc, int fr, int fq) const {
#pragma unroll
        for (int m = 0; m < 4; ++m) { const mg::u32x2 pg = *(const LAS mg::u32x2*)(tab + 2 * (64 * wr + 16 * m + fr)); const int p = (int)pg.x; if (p < 0) continue;
            const float gt = __uint_as_float(pg.y);
#pragma unroll
            for (int n = 0; n < 4; ++n) { const f32x4 a = acc[m][n] * gt; mg::u32x2 w; w.x = pk2(a[0], a[1]); w.y = pk2(a[2], a[3]);
                *(mg::u32x2*)(slots + (size_t)p * D + c0 + 64 * wc + 16 * n + 4 * fq) = w; } }
    } };
__device__ __forceinline__ void phase10_down(const Ctx& C, bool have_table) {
    LAS int* tst = (LAS int*)(C.lds + 149504); if (!have_table) moe_table(C, tst);
    LAS int* tab = (LAS int*)(C.lds + MOE_TAB_OFF);
    const int ngrp = (C.G % 8 == 0) ? 8 : 1, grp = C.wg % ngrp, gsz = C.G / ngrp;
    const int total = moe_group_units(tst, 4, grp, ngrp), first = C.wg / ngrp, nmine = total > first ? (total - first + gsz - 1) / gsz : 0;
    const int lr = C.tid >> 3, ch = ((C.lane & 7) ^ ((C.lane >> 3) & 7)) * 8;
    const bf16* hid = (const bf16*)(C.ws + WS_HID); const bf16* W2 = (const bf16*)(C.ws + WS_W2); const int* inv2 = (const int*)(C.ws + WS_INV2); const float* route = (const float*)(C.ws + WS_ROUTE);
    int sbase = 0;
    for (int b0 = 0; b0 < nmine; b0 += MOE_BATCH) { const int nu = nmine - b0 < MOE_BATCH ? nmine - b0 : MOE_BATCH;
        __syncthreads();
        int pv[2]; float gv[2];
#pragma unroll
        for (int ps = 0; ps < 2; ++ps) { const int u = ps * 4 + (C.tid >> 7), row = C.tid & 127; int e, t, nt; pv[ps] = -1;
            if (u < nu && moe_unit(tst, 4, grp, ngrp, first + (b0 + u) * gsz, e, t, nt)) { const int li = 128 * (t - tst[e]) + row; if (li < tst[80 + e]) pv[ps] = inv2[(size_t)e * 16384 + li]; } }
#pragma unroll
        for (int ps = 0; ps < 2; ++ps) gv[ps] = pv[ps] >= 0 ? route[(size_t)(pv[ps] >> 1) * 8 + 4 + (pv[ps] & 1)] : 0.f;
#pragma unroll
        for (int ps = 0; ps < 2; ++ps) { const int u = ps * 4 + (C.tid >> 7), row = C.tid & 127; mg::u32x2 w; w.x = (unsigned)pv[ps]; w.y = __float_as_uint(gv[ps]); *(LAS mg::u32x2*)(tab + 2 * (u * 128 + row)) = w; }
        __syncthreads();
        mg::Src cur, nxt; int e, t, nt;
        (void)moe_unit(tst, 4, grp, ngrp, first + b0 * gsz, e, t, nt);
        cur.pa0 = hid + (size_t)(128 * t + lr) * 256 + ch; cur.pa1 = cur.pa0 + 64 * 256; cur.pb = W2 + (size_t)e * 262144 + (size_t)nt * 4 * 16384 + (size_t)lr * 64 + ch;
#pragma unroll 1
        for (int i = 0; i < nu; ++i) { const bool has_next = i + 1 < nu; int e2 = e, t2 = t, nt2 = nt; nxt = cur;
            if (has_next) { (void)moe_unit(tst, 4, grp, ngrp, first + (b0 + i + 1) * gsz, e2, t2, nt2);
                nxt.pa0 = hid + (size_t)(128 * t2 + lr) * 256 + ch; nxt.pa1 = nxt.pa0 + 64 * 256; nxt.pb = W2 + (size_t)e2 * 262144 + (size_t)nt2 * 4 * 16384 + (size_t)lr * 64 + ch; }
            DnEpi2 ep{(bf16*)C.out, tab + 2 * (i * 128), 256 * nt};
            mg::tile_pipe(C.lds, cur, 4, i == 0, has_next, nxt, sbase, ep);
            cur = nxt; e = e2; t = t2; nt = nt2; }
    }
}
constexpr int CW_TRDY = 24576;
struct MoeEpi { int up; bf16* hid; int pos0, hc0; bf16* slots; const LAS int* tab; int c0;
    __device__ __forceinline__ void operator()(const f32x4 (&acc)[4][4], int wr, int wc, int fr, int fq) const {
        if (up) {
#pragma unroll
            for (int m = 0; m < 4; ++m) { const int row = pos0 + 64 * wr + 16 * m + fr;
#pragma unroll
                for (int n2 = 0; n2 < 2; ++n2) { const f32x4 a = acc[m][2 * n2], b = acc[m][2 * n2 + 1]; const int hc = hc0 + 32 * wc + 16 * n2 + 4 * fq;
                    mg::u32x2 w; w.x = pk2(silu_(a[0]) * b[0], silu_(a[1]) * b[1]); w.y = pk2(silu_(a[2]) * b[2], silu_(a[3]) * b[3]);
                    asm volatile("global_store_dwordx2 %0, %1, off sc0 sc1" :: "v"(hid + (size_t)row * 256 + hc), "v"(w) : "memory"); } }
        } else {
#pragma unroll
            for (int m = 0; m < 4; ++m) { const mg::u32x2 pg = *(const LAS mg::u32x2*)(tab + 2 * (64 * wr + 16 * m + fr)); const int p = (int)pg.x; if (p < 0) continue;
                const float gt = __uint_as_float(pg.y);
#pragma unroll
                for (int n = 0; n < 4; ++n) { const f32x4 a = acc[m][n] * gt; mg::u32x2 w; w.x = pk2(a[0], a[1]); w.y = pk2(a[2], a[3]);
                    *(mg::u32x2*)(slots + (size_t)p * D + c0 + 64 * wc + 16 * n + 4 * fq) = w; } }
        }
    } };
__device__ __forceinline__ void phase_moe(const Ctx& C) {
    LAS int* tst = (LAS int*)(C.lds + 149504); moe_table(C, tst);
    LAS int* tab = (LAS int*)(C.lds + MOE_TAB_OFF);
    volatile LAS int* flg = (volatile LAS int*)(C.lds + MOE_TAB_OFF + MOE_BATCH * 1024);
    const int ngrp = (C.G % 8 == 0) ? 8 : 1, grp = C.wg % ngrp, gsz = C.G / ngrp, first = C.wg / ngrp;
    const int U8 = moe_group_units(tst, 2, grp, ngrp), U9 = 2 * U8;
    const int n8 = U8 > first ? (U8 - first + gsz - 1) / gsz : 0;
    const int r8 = U8 % gsz, light = (r8 != 0 && first >= r8) ? 1 : 0;
    const int B = r8 ? 2 * (gsz - r8) : 0;
    int nb = 0; if (light) { const int v0 = 2 * (first - r8); nb = v0 + 1 < U9 ? 2 : (v0 < U9 ? 1 : 0); }
    const int nreg = U9 > B + first ? (U9 - B - first + gsz - 1) / gsz : 0;
    const int nall = n8 + nb + nreg;
#define MOE_DECODE(i_, up_, e_, t_, nt_) do { const int ii_ = (i_); up_ = ii_ < n8; int v_; if (up_) v_ = first + ii_ * gsz; else if (ii_ - n8 < nb) v_ = 2 * (first - r8) + (ii_ - n8); else v_ = B + first + (ii_ - n8 - nb) * gsz; \
        (void)moe_unit(tst, up_ ? 2 : 4, grp, ngrp, v_, e_, t_, nt_); } while (0)
    const int lr = C.tid >> 3, ch = ((C.lane & 7) ^ ((C.lane >> 3) & 7)) * 8;
    const bf16* h1 = (const bf16*)(C.ws + WS_H1); const bf16* hid = (const bf16*)(C.ws + WS_HID); const bf16* W13 = (const bf16*)(C.ws + WS_W13); const bf16* W2 = (const bf16*)(C.ws + WS_W2);
    const int* inv2 = (const int*)(C.ws + WS_INV2); const float* route = (const float*)(C.ws + WS_ROUTE); unsigned* trdy = (unsigned*)(C.ctl + CW_TRDY);
    int sbase = 0; unsigned* pend = nullptr; bool prefetched = false;
#define MOE_SRC(S_, up_, e_, t_, nt_, ui_) do { if (up_) { (S_).pa0 = h1 + (size_t)tab[2 * ((ui_) * 128 + lr)] * D + ch; (S_).pa1 = h1 + (size_t)tab[2 * ((ui_) * 128 + 64 + lr)] * D + ch; \
            (S_).pb = W13 + (size_t)(e_) * 524288 + (size_t)(nt_) * 16 * 16384 + (size_t)lr * 64 + ch; } \
        else { (S_).pa0 = hid + (size_t)(128 * (t_) + lr) * 256 + ch; (S_).pa1 = (S_).pa0 + 64 * 256; (S_).pb = W2 + (size_t)(e_) * 262144 + (size_t)(nt_) * 4 * 16384 + (size_t)lr * 64 + ch; } } while (0)
    for (int b0 = 0; b0 < nall; b0 += MOE_BATCH) { const int nu = nall - b0 < MOE_BATCH ? nall - b0 : MOE_BATCH;
        __syncthreads();
        int pv[2]; float gv[2];
#pragma unroll
        for (int ps = 0; ps < 2; ++ps) { const int u = ps * 4 + (C.tid >> 7), row = C.tid & 127; pv[ps] = -1;
            if (u < nu) { int up, e, t, nt; MOE_DECODE(b0 + u, up, e, t, nt); const int li = 128 * (t - tst[e]) + row; if (li < tst[80 + e]) pv[ps] = inv2[(size_t)e * 16384 + li]; } }
#pragma unroll
        for (int ps = 0; ps < 2; ++ps) gv[ps] = pv[ps] >= 0 ? route[(size_t)(pv[ps] >> 1) * 8 + 4 + (pv[ps] & 1)] : 0.f;
#pragma unroll
        for (int ps = 0; ps < 2; ++ps) { const int u = ps * 4 + (C.tid >> 7), row = C.tid & 127; const bool isup = b0 + u < n8;
            mg::u32x2 w; w.x = isup ? (unsigned)(pv[ps] < 0 ? 0 : (pv[ps] >> 1)) : (unsigned)pv[ps]; w.y = __float_as_uint(gv[ps]); *(LAS mg::u32x2*)(tab + 2 * (u * 128 + row)) = w; }
        __syncthreads();
        prefetched = false;
        int up, e, t, nt; MOE_DECODE(b0, up, e, t, nt);
        mg::Src cur, nxt; MOE_SRC(cur, up, e, t, nt, 0);
#pragma unroll 1
        for (int i = 0; i < nu; ++i) {
            if (!up && !prefetched) {
                if (pend) { asm volatile("s_waitcnt vmcnt(0)" ::: "memory"); __syncthreads(); if (C.tid == 0) (void)__hip_atomic_fetch_add(pend, 1u, RLX_AGENT); pend = nullptr; }
                if (C.tid == 0) { unsigned sp = 0; while (__hip_atomic_load(trdy + t, RLX_AGENT) < 2u) { __builtin_amdgcn_s_sleep(2); if (++sp > (1u << 22)) break; } }
                __syncthreads(); }
            const bool has_next = i + 1 < nu; int up2 = up, e2 = e, t2 = t, nt2 = nt; nxt = cur; bool can = has_next;
            if (has_next) { MOE_DECODE(b0 + i + 1, up2, e2, t2, nt2);
                if (!up2) {
                    if (C.tid == 0) flg[i & 1] = __hip_atomic_load(trdy + t2, RLX_AGENT) >= 2u ? 1 : 0;
                    __syncthreads(); can = flg[i & 1] != 0; }
                if (can) MOE_SRC(nxt, up2, e2, t2, nt2, i + 1); }
            MoeEpi ep{up, (bf16*)(C.ws + WS_HID), 128 * t, 128 * nt, (bf16*)C.out, tab + 2 * (i * 128), 256 * nt};
            mg::tile_pipe(C.lds, cur, up ? 16 : 4, !prefetched, can, nxt, sbase, ep, pend);
            pend = up ? trdy + t : nullptr; prefetched = can;
            if (has_next) { if (!can) MOE_SRC(nxt, up2, e2, t2, nt2, i + 1); cur = nxt; up = up2; e = e2; t = t2; nt = nt2; } }
    }
    if (pend) { asm volatile("s_waitcnt vmcnt(0)" ::: "memory"); __syncthreads(); if (C.tid == 0) (void)__hip_atomic_fetch_add(pend, 1u, RLX_AGENT); }
    asm volatile("s_waitcnt vmcnt(0)" ::: "memory"); __syncthreads();
#undef MOE_DECODE
#undef MOE_SRC
}
template <int MODE>
__device__ __forceinline__ void phase11_final(const Ctx& C) {
    const int gw = C.wg * NWAVES + C.wave, NGW = C.G * NWAVES, lane = C.lane;
    const bf16* h1 = (const bf16*)(C.ws + WS_H1); const bf16* slots = (const bf16*)C.out; const float* g2 = C.in[30]; const float* b2 = C.in[31];
    for (int row0 = gw * 4; row0 < MX; row0 += NGW * 4) {
        f32x4 v[4][4];
#pragma unroll
        for (int rr = 0; rr < 4; ++rr)
#pragma unroll
            for (int j = 0; j < 4; ++j) { const int c = 4 * lane + 256 * j; const int row = row0 + rr;
                const mg::u32x2 hw = __builtin_nontemporal_load((const mg::u32x2*)(h1 + (size_t)row * D + c)), s0 = __builtin_nontemporal_load((const mg::u32x2*)(slots + (size_t)(2 * row) * D + c)), s1 = __builtin_nontemporal_load((const mg::u32x2*)(slots + (size_t)(2 * row + 1) * D + c));
                v[rr][j].x = ALPHA * bflo(hw.x) + bflo(s0.x) + bflo(s1.x); v[rr][j].y = ALPHA * bfhi(hw.x) + bfhi(s0.x) + bfhi(s1.x);
                v[rr][j].z = ALPHA * bflo(hw.y) + bflo(s0.y) + bflo(s1.y); v[rr][j].w = ALPHA * bfhi(hw.y) + bfhi(s0.y) + bfhi(s1.y); }
        float mean, rstd;
#pragma unroll
        for (int rr = 0; rr < 4; ++rr) ln_row(v[rr], g2, b2, lane, 1.f, mean, rstd);
#pragma unroll
        for (int rr = 0; rr < 4; ++rr)
#pragma unroll
            for (int j = 0; j < 4; ++j) { if (MODE == 0) __builtin_nontemporal_store(v[rr][j], (f32x4*)(C.out + (size_t)(row0 + rr) * D + 4 * lane + 256 * j)); else asm volatile("" :: "v"(v[rr][j])); }
    }
}

constexpr int DN_ITEM_BYTES = 41 * 1024, DN_ITEMS = NB * NH * NCH, DN_IN_OUT = (int)((64 * MiB) / DN_ITEM_BYTES);
constexpr size_t WS_DNX = WS_MERGED;
static_assert((size_t)(DN_ITEMS - DN_IN_OUT) * DN_ITEM_BYTES <= 32 * MiB, "dn overflow");
constexpr size_t WS_ORAW = WS_OA;
__device__ __forceinline__ unsigned char* dn_item_ptr(float* out, unsigned char* ws, int item) {
    return item < DN_IN_OUT ? (unsigned char*)out + (size_t)item * DN_ITEM_BYTES : ws + WS_DNX + (size_t)(item - DN_IN_OUT) * DN_ITEM_BYTES; }
typedef unsigned u32x2_t __attribute__((ext_vector_type(2)));
__device__ __forceinline__ v4u pack8(const f32x4 a, const f32x4 b) { v4u w; w.x = pk2(a[0], a[1]); w.y = pk2(a[2], a[3]); w.z = pk2(b[0], b[1]); w.w = pk2(b[2], b[3]); return w; }
__device__ __forceinline__ bf16x8 as_bf16x8(const v4u w) { return __builtin_bit_cast(bf16x8, w); }

constexpr int SLOT_BYTES = 29312, SL_Q = 0, SL_K = 9216, SL_V = 18432, SL_SC = 27648, SL_HALO = 28160, SROW = 144, DN_SLOTS = 4;
constexpr int CW_LATE = 17920;
constexpr int DN_EARLY = NB * NH * 64;

__device__ __forceinline__ void chunk_prep(const Ctx& C, bool late, int wg0) {
    const int slot = C.wave >> 1, wsl = C.wave & 1;
    LAS unsigned char* const SL0 = C.lds + slot * SLOT_BYTES;
#define DN_REBASE() int lane = C.lane; asm volatile("" : "+v"(lane)); const int rr = lane & 15, qq = lane >> 4, st = lane + 64 * wsl; (void)rr; (void)qq; (void)st; LAS unsigned char* const SL = SL0; LAS float* const SC = (LAS float*)(SL + SL_SC)
    const bf16* qkv = (const bf16*)(C.ws + WS_QKV); const float* ab = (const float*)(C.ws + WS_AB);
    const float* cw = C.in[5]; const float* a_log = C.in[6]; const float* dt_bias = C.in[7];
    const int total = late ? NB * NH : DN_EARLY, nround = late ? 1 : (DN_EARLY + C.G * DN_SLOTS - 1) / (C.G * DN_SLOTS);
    for (int rd = 0; rd < nround; ++rd) {
        int wi = late ? (C.wg - wg0) * DN_SLOTS + slot : (rd * C.G + C.wg) * DN_SLOTS + slot; if (wi >= total) wi = total - 1;
        const int bh = late ? wi : (wi >> 6), n = late ? 64 : (wi & 63), h = bh & 7, b = bh >> 3;
        unsigned char* dst = dn_item_ptr(C.out, C.ws, bh * NCH + n);
        { DN_REBASE();
            v4u rw[13];
#pragma unroll
            for (int i = 0; i < 13; ++i) { const int p = st + 128 * i, rm = p >> 3, c8 = p & 7, row = rm / 3 - 3, m = rm - 3 * (rm / 3), grow = 64 * n + row;
                rw[i] = (p < 1608 && grow >= 0) ? *(const v4u*)(qkv + (size_t)(b * LP + grow) * 1536 + m * 512 + h * 64 + c8 * 8) : (v4u){0u, 0u, 0u, 0u}; }
            if (wsl == 0) { const int gi = 64 * n + lane; float g = 0.f, be = 0.f;
                if (gi >= PADF) { const float* a2 = ab + (size_t)(b * LP + gi) * 16; be = sigm(a2[8 + h]); g = -expf(a_log[h]) * softplus_(a2[h] + dt_bias[h]); }
#pragma unroll
                for (int o = 1; o < 64; o <<= 1) { const float t = __shfl_up(g, o); if (lane >= o) g += t; }
                SC[lane] = g; SC[64 + lane] = be; }
#pragma unroll
            for (int i = 0; i < 13; ++i) { const int p = st + 128 * i, rm = p >> 3, c8 = p & 7, row = rm / 3 - 3, m = rm - 3 * (rm / 3);
                if (p < 1608) { LAS unsigned char* dp = row >= 0 ? SL + m * 9216 + row * SROW + c8 * 16 : SL + SL_HALO + ((row + 3) * 3 + m) * 128 + c8 * 16; *(LAS v4u*)dp = rw[i]; } }
        }
        __syncthreads();
        float cq0 = 0.f, cq1 = 0.f, cq2 = 0.f, ck0 = 0.f, ck1 = 0.f, ck2 = 0.f, cv0 = 0.f, cv1 = 0.f, cv2 = 0.f;
        { DN_REBASE(); const int d = lane;
            if (wsl == 0) { const LAS unsigned char* hp = SL + SL_HALO + d * 2;
                cq0 = bf2f(*(const LAS bf16*)(hp + 0 * 128)); ck0 = bf2f(*(const LAS bf16*)(hp + 1 * 128)); cv0 = bf2f(*(const LAS bf16*)(hp + 2 * 128));
                cq1 = bf2f(*(const LAS bf16*)(hp + 3 * 128)); ck1 = bf2f(*(const LAS bf16*)(hp + 4 * 128)); cv1 = bf2f(*(const LAS bf16*)(hp + 5 * 128));
                cq2 = bf2f(*(const LAS bf16*)(hp + 6 * 128)); ck2 = bf2f(*(const LAS bf16*)(hp + 7 * 128)); cv2 = bf2f(*(const LAS bf16*)(hp + 8 * 128));
            } else { const LAS unsigned char* mp = SL + 29 * SROW + d * 2;
                cq0 = bf2f(*(const LAS bf16*)(mp + SL_Q)); ck0 = bf2f(*(const LAS bf16*)(mp + SL_K)); cv0 = bf2f(*(const LAS bf16*)(mp + SL_V));
                cq1 = bf2f(*(const LAS bf16*)(mp + SL_Q + SROW)); ck1 = bf2f(*(const LAS bf16*)(mp + SL_K + SROW)); cv1 = bf2f(*(const LAS bf16*)(mp + SL_V + SROW));
                cq2 = bf2f(*(const LAS bf16*)(mp + SL_Q + 2 * SROW)); ck2 = bf2f(*(const LAS bf16*)(mp + SL_K + 2 * SROW)); cv2 = bf2f(*(const LAS bf16*)(mp + SL_V + 2 * SROW)); }
        }
        __syncthreads();
        { DN_REBASE(); const int d = lane, ch = h * 64 + d;
            float wq[4], wk[4], wv[4];
#pragma unroll
            for (int j = 0; j < 4; ++j) { wq[j] = cw[j * 1536 + ch]; wk[j] = cw[j * 1536 + 512 + ch]; wv[j] = cw[j * 1536 + 1024 + ch]; }
            LAS unsigned char* rp = SL + (32 * wsl) * SROW + d * 2;
#pragma unroll 8
            for (int r = 0; r < 32; ++r, rp += SROW) { const float q3 = bf2f(*(const LAS bf16*)(rp + SL_Q)), k3 = bf2f(*(const LAS bf16*)(rp + SL_K)), v3 = bf2f(*(const LAS bf16*)(rp + SL_V));
                const float q = silu_(wq[0] * cq0 + wq[1] * cq1 + wq[2] * cq2 + wq[3] * q3), k = silu_(wk[0] * ck0 + wk[1] * ck1 + wk[2] * ck2 + wk[3] * k3), v = silu_(wv[0] * cv0 + wv[1] * cv1 + wv[2] * cv2 + wv[3] * v3);
                cq0 = cq1; cq1 = cq2; cq2 = q3; ck0 = ck1; ck1 = ck2; ck2 = k3; cv0 = cv1; cv1 = cv2; cv2 = v3;
                *(LAS bf16*)(rp + SL_Q) = (bf16)f2bf(q); *(LAS bf16*)(rp + SL_K) = (bf16)f2bf(k); *(LAS bf16*)(rp + SL_V) = (bf16)f2bf(v); }
        }
        __syncthreads();
        { DN_REBASE(); LAS unsigned char* rp = SL + (wsl == 0 ? SL_Q : SL_K) + lane * SROW;
            v4u w[8]; float ss = 0.f;
#pragma unroll
            for (int c = 0; c < 8; ++c) { w[c] = *(const LAS v4u*)(rp + c * 16);
                ss += bflo(w[c].x) * bflo(w[c].x) + bfhi(w[c].x) * bfhi(w[c].x) + bflo(w[c].y) * bflo(w[c].y) + bfhi(w[c].y) * bfhi(w[c].y)
                    + bflo(w[c].z) * bflo(w[c].z) + bfhi(w[c].z) * bfhi(w[c].z) + bflo(w[c].w) * bflo(w[c].w) + bfhi(w[c].w) * bfhi(w[c].w); }
            const float sc = (__builtin_amdgcn_rsqf(ss + NORM_EPS)) * (wsl == 0 ? 0.125f : 1.f);
#pragma unroll
            for (int c = 0; c < 8; ++c) { v4u o; o.x = pk2(bflo(w[c].x) * sc, bfhi(w[c].x) * sc); o.y = pk2(bflo(w[c].y) * sc, bfhi(w[c].y) * sc); o.z = pk2(bflo(w[c].z) * sc, bfhi(w[c].z) * sc); o.w = pk2(bflo(w[c].w) * sc, bfhi(w[c].w) * sc);
                *(LAS v4u*)(rp + c * 16) = o; }
        }
        __syncthreads();
        float x[64]; f32x4 am[2][4];
        { DN_REBASE();
#pragma unroll
            for (int i = 0; i < 64; ++i) { const float be = SC[64 + i];
                if (wsl == 0) x[i] = be * bf2f(*(const LAS bf16*)(SL + SL_V + i * SROW + lane * 2)); else x[i] = be * __expf(SC[i]) * bf2f(*(const LAS bf16*)(SL + SL_K + i * SROW + lane * 2)); }
#pragma unroll
            for (int tix = 0; tix < 2; ++tix) { const int ti = wsl == 0 ? (tix == 0 ? 0 : 3) : (tix == 0 ? 1 : 2);
                bf16x8 kfi[2], qfi[2];
#pragma unroll
                for (int s = 0; s < 2; ++s) { kfi[s] = *(const LAS bf16x8*)(SL + SL_K + (16 * ti + rr) * SROW + s * 64 + qq * 16); qfi[s] = *(const LAS bf16x8*)(SL + SL_Q + (16 * ti + rr) * SROW + s * 64 + qq * 16); }
                const int i = 16 * ti + rr; const float gci = SC[i];
                f32x4 atv[4];
#pragma unroll
                for (int tj = 0; tj < 4; ++tj) {
                    f32x4 d1 = (f32x4){0.f, 0.f, 0.f, 0.f}, d2 = d1;
                    if (tj <= ti) {
#pragma unroll
                        for (int s = 0; s < 2; ++s) { const bf16x8 kfj = *(const LAS bf16x8*)(SL + SL_K + (16 * tj + rr) * SROW + s * 64 + qq * 16);
                            d1 = __builtin_amdgcn_mfma_f32_16x16x32_bf16(kfi[s], kfj, d1, 0, 0, 0);
                            d2 = __builtin_amdgcn_mfma_f32_16x16x32_bf16(kfj, qfi[s], d2, 0, 0, 0); }
                        const float gcj1 = SC[16 * tj + rr];
#pragma unroll
                        for (int r = 0; r < 4; ++r) { const int j = 16 * tj + 4 * qq + r; const float dec = __expf(gci - SC[j]); d2[r] = (j <= i) ? d2[r] * dec : 0.f;
                            const int i1 = 16 * ti + 4 * qq + r; d1[r] = (16 * tj + rr < i1) ? d1[r] * SC[64 + i1] * __expf(SC[i1] - gcj1) : 0.f; }
                    }
                    am[tix][tj] = d1; atv[tj] = d2;
                }
#pragma unroll
                for (int s = 0; s < 2; ++s) *(GAS v4u*)(dst + 16384 + ((ti * 2 + s) * 64 + lane) * 16) = pack8(atv[2 * s], atv[2 * s + 1]);
            }
            const float gcl = SC[63];
#pragma unroll
            for (int t2 = 0; t2 < 2; ++t2) { const int it = 2 * wsl + t2; const int i = 16 * it + rr; const float eg = __expf(SC[i]);
#pragma unroll
                for (int s = 0; s < 2; ++s) {
                    const u32x2_t a = *(const LAS u32x2_t*)(SL + SL_Q + i * SROW + (32 * s + 4 * qq) * 2), bq = *(const LAS u32x2_t*)(SL + SL_Q + i * SROW + (32 * s + 16 + 4 * qq) * 2);
                    v4u w; w.x = pk2(bflo(a.x) * eg, bfhi(a.x) * eg); w.y = pk2(bflo(a.y) * eg, bfhi(a.y) * eg); w.z = pk2(bflo(bq.x) * eg, bfhi(bq.x) * eg); w.w = pk2(bflo(bq.y) * eg, bfhi(bq.y) * eg);
                    *(GAS v4u*)(dst + 8192 + ((it * 2 + s) * 64 + lane) * 16) = w;
                    float kd[8];
#pragma unroll
                    for (int e = 0; e < 8; ++e) { const int ii = 32 * s + 16 * (e >> 2) + 4 * qq + (e & 3); kd[e] = bf2f(*(const LAS bf16*)(SL + SL_K + ii * SROW + (16 * it + rr) * 2)) * __expf(gcl - SC[ii]); }
                    v4u wk2; wk2.x = pk2(kd[0], kd[1]); wk2.y = pk2(kd[2], kd[3]); wk2.z = pk2(kd[4], kd[5]); wk2.w = pk2(kd[6], kd[7]);
                    *(GAS v4u*)(dst + 24576 + ((it * 2 + s) * 64 + lane) * 16) = wk2; } }
            if (wsl == 0) { const float gl = __expf(gcl); *(GAS f32x4*)(dst + 40960 + lane * 16) = (f32x4){gl, gl, gl, gl}; }
        }
        __syncthreads();
        { DN_REBASE();
#pragma unroll
            for (int tix = 0; tix < 2; ++tix) { const int ti = wsl == 0 ? (tix == 0 ? 0 : 3) : (tix == 0 ? 1 : 2);
#pragma unroll
                for (int tj = 0; tj < 4; ++tj) if (tj <= ti) *(LAS f32x4*)(SL + ((16 * tj + rr) * 64 + 16 * ti + 4 * qq) * 4) = am[tix][tj]; }
        }
        __syncthreads();
        { DN_REBASE();
            const LAS float* ATq = (const LAS float*)SL + (lane & 3);
            float cb[2][16];
#define QFMA(x_, a_, r_) asm("v_fmac_f32_dpp %0, %1, %2 quad_perm:[" #r_ "," #r_ "," #r_ "," #r_ "] row_mask:0xf bank_mask:0xf" : "+v"(x_) : "v"(a_), "v"(nxj))
#pragma unroll
            for (int m = 0; m < 16; ++m) cb[0][m] = ATq[4 * m];
#pragma unroll
            for (int j = 0; j < 63; ++j) { const float nxj = -x[j];
                if (j + 1 < 63) {
#pragma unroll
                    for (int m = (j + 2) >> 2; m < 16; ++m) cb[(j + 1) & 1][m] = ATq[(j + 1) * 64 + 4 * m]; }
#pragma unroll
                for (int m = (j + 1) >> 2; m < 16; ++m) { const float a = cb[j & 1][m];
                    if (4 * m > j) QFMA(x[4 * m], a, 0); if (4 * m + 1 > j) QFMA(x[4 * m + 1], a, 1); if (4 * m + 2 > j) QFMA(x[4 * m + 2], a, 2); QFMA(x[4 * m + 3], a, 3); }
                asm volatile("" : "+v"(x[j + 1]) :: "memory"); }
#undef QFMA
        }
        if (wsl == 0) { DN_REBASE(); const int vs = st >> 4, c = st & 15;
#pragma unroll
            for (int it = 0; it < 4; ++it)
#pragma unroll
                for (int q = 0; q < 4; ++q) { u32x2_t w; w.x = pk2(x[16 * it + 4 * q], x[16 * it + 4 * q + 1]); w.y = pk2(x[16 * it + 4 * q + 2], x[16 * it + 4 * q + 3]);
                    *(GAS u32x2_t*)(dst + 32768 + (((vs * 4 + it) * 64 + 16 * q + c) * 8)) = w; }
        } else { DN_REBASE();
#pragma unroll
            for (int i = 0; i < 64; ++i) *(LAS bf16*)(SL + SL_V + i * SROW + lane * 2) = (bf16)f2bf(-x[i]);
        }
        __syncthreads();
        { DN_REBASE();
#pragma unroll
        for (int t2 = 0; t2 < 2; ++t2) { const int it = 2 * wsl + t2; const int i = 16 * it + rr;
#pragma unroll
            for (int s = 0; s < 2; ++s) { const u32x2_t a = *(const LAS u32x2_t*)(SL + SL_V + i * SROW + (32 * s + 4 * qq) * 2), bq = *(const LAS u32x2_t*)(SL + SL_V + i * SROW + (32 * s + 16 + 4 * qq) * 2);
                v4u w; w.x = a.x; w.y = a.y; w.z = bq.x; w.w = bq.y; *(GAS v4u*)(dst + ((it * 2 + s) * 64 + lane) * 16) = w; } } }
        __syncthreads();
    }
#undef DN_REBASE
    if (late) {
        asm volatile("s_waitcnt vmcnt(0)" ::: "memory"); __syncthreads();
        if (C.tid == 0) { __builtin_amdgcn_fence(__ATOMIC_RELEASE, "agent"); asm volatile("s_waitcnt vmcnt(0)" ::: "memory");
            __hip_atomic_fetch_add(C.ctl + CW_LATE, (unsigned)DN_SLOTS, __ATOMIC_RELAXED, __HIP_MEMORY_SCOPE_AGENT); }
    }
}

__device__ __forceinline__ void dn_scan_mfma(const Ctx& C, int b, int h) {
    const int wave = C.wave, lane = C.lane;
    const int item0 = (b * NH + h) * NCH;
    bf16* oraw = (bf16*)(C.ws + WS_ORAW);
#define DN_ISSUE(n_) do { const unsigned char* src_ = dn_item_ptr(C.out, C.ws, item0 + (n_)); LAS unsigned char* ring_ = C.lds + ((n_) % 3) * DN_ITEM_BYTES; \
        for (int blk_ = wave - 4; blk_ < 41; blk_ += 4) __builtin_amdgcn_global_load_lds((const unsigned*)(src_ + blk_ * 1024 + lane * 16), (LAS unsigned*)(ring_ + blk_ * 1024), 16, 0, 0); } while (0)
    f32x4 S[4];
#pragma unroll
    for (int kt = 0; kt < 4; ++kt) S[kt] = (f32x4){0.f, 0.f, 0.f, 0.f};
    if (wave >= 4) { DN_ISSUE(0); DN_ISSUE(1); if (wave == 4) asm volatile("s_waitcnt vmcnt(11)" ::: "memory"); else asm volatile("s_waitcnt vmcnt(10)" ::: "memory"); }
    __builtin_amdgcn_s_barrier();
    for (int n = 0; n < NCH; ++n) {
        if (wave >= 4) {
            if (n + 2 == NCH - 1) {
                unsigned sp = 0; while (__hip_atomic_load(C.ctl + CW_LATE, RLX_AGENT) < (unsigned)(NB * NH)) { __builtin_amdgcn_s_sleep(4); if (++sp > (1u << 22)) break; }
                __builtin_amdgcn_fence(__ATOMIC_ACQUIRE, "agent"); }
            if (n + 2 < NCH) { DN_ISSUE(n + 2); if (wave == 4) asm volatile("s_waitcnt vmcnt(11)" ::: "memory"); else asm volatile("s_waitcnt vmcnt(10)" ::: "memory"); }
            else asm volatile("s_waitcnt vmcnt(0)" ::: "memory");
        } else {
            const LAS unsigned char* R = C.lds + (n % 3) * DN_ITEM_BYTES; const int vs = wave;
            const float gl = *(const LAS float*)(R + 40960);
            const bf16x8 Sb0 = as_bf16x8(pack8(S[0], S[1])), Sb1 = as_bf16x8(pack8(S[2], S[3]));
            f32x4 vn[4], o[4];
#pragma unroll
            for (int it = 0; it < 4; ++it) { const u32x2_t uc = *(const LAS u32x2_t*)(R + 32768 + ((vs * 4 + it) * 64 + lane) * 8);
                f32x4 a = (f32x4){bflo(uc.x), bfhi(uc.x), bflo(uc.y), bfhi(uc.y)};
                a = __builtin_amdgcn_mfma_f32_16x16x32_bf16(*(const LAS bf16x8*)(R + ((it * 2 + 0) * 64 + lane) * 16), Sb0, a, 0, 0, 0);
                a = __builtin_amdgcn_mfma_f32_16x16x32_bf16(*(const LAS bf16x8*)(R + ((it * 2 + 1) * 64 + lane) * 16), Sb1, a, 0, 0, 0);
                vn[it] = a;
                f32x4 oo = (f32x4){0.f, 0.f, 0.f, 0.f};
                oo = __builtin_amdgcn_mfma_f32_16x16x32_bf16(*(const LAS bf16x8*)(R + 8192 + ((it * 2 + 0) * 64 + lane) * 16), Sb0, oo, 0, 0, 0);
                oo = __builtin_amdgcn_mfma_f32_16x16x32_bf16(*(const LAS bf16x8*)(R + 8192 + ((it * 2 + 1) * 64 + lane) * 16), Sb1, oo, 0, 0, 0);
                o[it] = oo; }
            const bf16x8 Vb0 = as_bf16x8(pack8(vn[0], vn[1])), Vb1 = as_bf16x8(pack8(vn[2], vn[3]));
#pragma unroll
            for (int it = 0; it < 4; ++it) {
                o[it] = __builtin_amdgcn_mfma_f32_16x16x32_bf16(*(const LAS bf16x8*)(R + 16384 + ((it * 2 + 0) * 64 + lane) * 16), Vb0, o[it], 0, 0, 0);
                o[it] = __builtin_amdgcn_mfma_f32_16x16x32_bf16(*(const LAS bf16x8*)(R + 16384 + ((it * 2 + 1) * 64 + lane) * 16), Vb1, o[it], 0, 0, 0); }
#pragma unroll
            for (int kt = 0; kt < 4; ++kt) { f32x4 s = S[kt] * gl;
                s = __builtin_amdgcn_mfma_f32_16x16x32_bf16(*(const LAS bf16x8*)(R + 24576 + ((kt * 2 + 0) * 64 + lane) * 16), Vb0, s, 0, 0, 0);
                s = __builtin_amdgcn_mfma_f32_16x16x32_bf16(*(const LAS bf16x8*)(R + 24576 + ((kt * 2 + 1) * 64 + lane) * 16), Vb1, s, 0, 0, 0);
                S[kt] = s; }
            if (n >= 1) { const int q = lane >> 4, c = lane & 15; bf16* op = oraw + (size_t)(b * SEQ + 64 * (n - 1) + 4 * q) * 512 + h * 64 + 16 * vs + c;
#pragma unroll
                for (int it = 0; it < 4; ++it)
#pragma unroll
                    for (int r = 0; r < 4; ++r) op[(size_t)(16 * it + r) * 512] = (bf16)f2bf(o[it][r]); }
            asm volatile("s_waitcnt lgkmcnt(0)" ::: "memory");
        }
        __builtin_amdgcn_s_barrier();
    }
#undef DN_ISSUE
}
__device__ __forceinline__ void oa_postpass(const Ctx& C, int wg0, int nwg) {
    const int gw = (C.wg - wg0) * NWAVES + C.wave, NGW = nwg * NWAVES, lane = C.lane; if (C.wg < wg0) return;
    bf16* oa = (bf16*)(C.ws + WS_OA); const bf16* z = (const bf16*)(C.ws + WS_Z); const float* nw = C.in[8] + (lane & 7) * 8;
    float w8[8];
#pragma unroll
    for (int e = 0; e < 8; ++e) w8[e] = nw[e];
    for (int row = gw; row < MX; row += NGW) {
        const v4u r = *(const v4u*)(oa + (size_t)row * 512 + lane * 8), zz = *(const v4u*)(z + (size_t)prow_of(row) * 512 + lane * 8);
        float v[8] = {bflo(r.x), bfhi(r.x), bflo(r.y), bfhi(r.y), bflo(r.z), bfhi(r.z), bflo(r.w), bfhi(r.w)};
        const float zf[8] = {bflo(zz.x), bfhi(zz.x), bflo(zz.y), bfhi(zz.y), bflo(zz.z), bfhi(zz.z), bflo(zz.w), bfhi(zz.w)};
        float ss = 0.f;
#pragma unroll
        for (int e = 0; e < 8; ++e) ss += v[e] * v[e];
        ss += __shfl_xor(ss, 1); ss += __shfl_xor(ss, 2); ss += __shfl_xor(ss, 4);
        const float rs = __builtin_amdgcn_rsqf(ss * (1.f / 64.f) + NORM_EPS);
#pragma unroll
        for (int e = 0; e < 8; ++e) v[e] = v[e] * rs * w8[e] * silu_(zf[e]);
        v4u w; w.x = pk2(v[0], v[1]); w.y = pk2(v[2], v[3]); w.z = pk2(v[4], v[5]); w.w = pk2(v[6], v[7]);
        *(v4u*)(oa + (size_t)row * 512 + lane * 8) = w;
    }
}


__device__ __forceinline__ void oa_postpass_rows(const Ctx& C, int row_base) {
    const int lane = C.lane;
    bf16* oa = (bf16*)(C.ws + WS_OA); const bf16* z = (const bf16*)(C.ws + WS_Z); const float* nw = C.in[8] + (lane & 7) * 8;
    float w8[8];
#pragma unroll
    for (int e = 0; e < 8; ++e) w8[e] = nw[e];
#pragma unroll 1
    for (int tr = 0; tr < 4; ++tr) { const int row0 = row_base + C.wave * 16 + tr * 4;
        v4u r[4], zz[4];
#pragma unroll
        for (int i = 0; i < 4; ++i) { r[i] = *(const v4u*)(oa + (size_t)(row0 + i) * 512 + lane * 8); zz[i] = *(const v4u*)(z + (size_t)prow_of(row0 + i) * 512 + lane * 8); }
#pragma unroll
        for (int i = 0; i < 4; ++i) {
            float v[8] = {bflo(r[i].x), bfhi(r[i].x), bflo(r[i].y), bfhi(r[i].y), bflo(r[i].z), bfhi(r[i].z), bflo(r[i].w), bfhi(r[i].w)};
            const float zf[8] = {bflo(zz[i].x), bfhi(zz[i].x), bflo(zz[i].y), bfhi(zz[i].y), bflo(zz[i].z), bfhi(zz[i].z), bflo(zz[i].w), bfhi(zz[i].w)};
            float ss = 0.f;
#pragma unroll
            for (int e = 0; e < 8; ++e) ss += v[e] * v[e];
            ss += __shfl_xor(ss, 1); ss += __shfl_xor(ss, 2); ss += __shfl_xor(ss, 4);
            const float rs = __builtin_amdgcn_rsqf(ss * (1.f / 64.f) + NORM_EPS);
#pragma unroll
            for (int e = 0; e < 8; ++e) v[e] = v[e] * rs * w8[e] * silu_(zf[e]);
            v4u w; w.x = pk2(v[0], v[1]); w.y = pk2(v[2], v[3]); w.z = pk2(v[4], v[5]); w.w = pk2(v[6], v[7]);
            asm volatile("global_store_dwordx4 %0, %1, off sc0 sc1" :: "v"(oa + (size_t)(row0 + i) * 512 + lane * 8), "v"(w) : "memory"); }
    }
}
constexpr int CW_GRP = 28672, CW_P4DONE = 28600;
__device__ __forceinline__ void group_barrier(const Ctx& C, unsigned target) {
    asm volatile("s_waitcnt vmcnt(0)" ::: "memory");
    __syncthreads();
    if (C.tid == 0) {
        unsigned* p = (unsigned*)(C.ctl + CW_GRP + (C.wg & 63) * 64);
        (void)__hip_atomic_fetch_add(p, 1u, RLX_AGENT);
        unsigned sp = 0; while (__hip_atomic_load(p, RLX_AGENT) < target) { __builtin_amdgcn_s_sleep(1); if (++sp > (1u << 22)) break; }
    }
    __syncthreads();
}

constexpr size_t WS_KT = WS_MERGED + 20 * MiB;
constexpr size_t WS_M2 = WS_KT + 1 * MiB;
constexpr size_t WS_M3 = WS_OB;
static_assert(WS_M2 + 8 * MiB <= WS_END && (size_t)(DN_ITEMS - DN_IN_OUT) * DN_ITEM_BYTES <= 20 * MiB, "s5 tables");

__device__ __forceinline__ float gelu_fast(float x) { const float u2 = 1.5957691216057308f * (x + 0.044715f * x * x * x); return x * __builtin_amdgcn_rcpf(1.f + __expf(-u2)); }
struct S5P { float dt, ar, ai; };
__device__ __forceinline__ void s5_pow(const S5P& P, float d, float& re, float& im) { const float mag = expf(d * P.dt * P.ar); const float ang = d * P.dt * P.ai; re = mag * cosf(ang); im = mag * sinf(ang); }
__device__ __forceinline__ void s5_f(const S5P& P, float& fre, float& fim) { float are, aim; s5_pow(P, 1.f, are, aim); const float den = P.ar * P.ar + P.ai * P.ai, nr = are - 1.f, ni = aim;
    fre = (nr * P.ar + ni * P.ai) / den; fim = (ni * P.ar - nr * P.ai) / den; }

__device__ __forceinline__ void s5_tables(const Ctx& C) {
    const int gw = C.wg * NWAVES + C.wave, NGW = C.G * NWAVES, lane = C.lane, rr = lane & 15, kg = lane >> 4;
    LAS float* scr = (LAS float*)(C.lds + C.wave * 16384);
    const float* a_re = C.in[9]; const float* a_im = C.in[10]; const float* log_dt = C.in[11]; const float* b_re = C.in[12]; const float* b_im = C.in[13]; const float* c_re = C.in[14]; const float* c_im = C.in[15];
    bf16* KT = (bf16*)(C.ws + WS_KT); unsigned char* M2 = C.ws + WS_M2; unsigned char* M3 = C.ws + WS_M3;
    for (int it = gw; it < 2048 + 1024 + 2048; it += NGW) {
        if (it < 2048) {
            const int g = it >> 6, d = it & 63, p = lane; S5P P{expf(log_dt[g]), a_re[g * 64 + p], a_im[g * 64 + p]};
            float are, aim, fre, fim; s5_pow(P, (float)d, are, aim); s5_f(P, fre, fim);
            const float wr_ = are * fre - aim * fim, wi_ = are * fim + aim * fre;
            const float* br = b_re + ((size_t)g * 64 + p) * 16; const float* bi = b_im + ((size_t)g * 64 + p) * 16;
#pragma unroll
            for (int c = 0; c < 16; ++c) { scr[p * 32 + c] = wr_ * br[c] - wi_ * bi[c]; scr[p * 32 + 16 + c] = wr_ * bi[c] + wi_ * br[c]; }
            LDS_WAIT(); asm volatile("" ::: "memory");
            const int c = lane >> 2, c4 = (lane & 3) * 4; f32x4 acc = (f32x4){0.f, 0.f, 0.f, 0.f};
            const float* cr = c_re + ((size_t)g * 16 + c) * 64; const float* ci = c_im + ((size_t)g * 16 + c) * 64;
#pragma unroll 8
            for (int pp = 0; pp < 64; ++pp) { const f32x4 wre = *(const LAS f32x4*)(scr + pp * 32 + c4), wim = *(const LAS f32x4*)(scr + pp * 32 + 16 + c4); const float crv = cr[pp], civ = ci[pp];
                acc = acc + wre * crv - wim * civ; }
            u32x2_t w; w.x = pk2(acc[0], acc[1]); w.y = pk2(acc[2], acc[3]);
            *(GAS u32x2_t*)(KT + ((size_t)(g * 64 + d) * 256 + c * 16 + c4)) = w;
            LDS_WAIT(); asm volatile("" ::: "memory");
        } else if (it < 3072) {
            const int i2 = it - 2048, g = i2 >> 5, ks = i2 & 31, j = 2 * ks + (kg >> 1), ch = 8 * (kg & 1);
#pragma unroll 1
            for (int pq = 0; pq < 4; ++pq) { const int p = 16 * pq + rr; S5P P{expf(log_dt[g]), a_re[g * 64 + p], a_im[g * 64 + p]};
                float are, aim, fre, fim; s5_pow(P, (float)(63 - j), are, aim); s5_f(P, fre, fim);
                const float wr_ = are * fre - aim * fim, wi_ = are * fim + aim * fre;
                const float* br = b_re + ((size_t)g * 64 + p) * 16 + ch; const float* bi = b_im + ((size_t)g * 64 + p) * 16 + ch;
                float re[8], im[8];
#pragma unroll
                for (int e = 0; e < 8; ++e) { re[e] = wr_ * br[e] - wi_ * bi[e]; im[e] = wr_ * bi[e] + wi_ * br[e]; }
                v4u w; w.x = pk2(re[0], re[1]); w.y = pk2(re[2], re[3]); w.z = pk2(re[4], re[5]); w.w = pk2(re[6], re[7]);
                *(GAS v4u*)(M3 + (size_t)g * 262144 + ((size_t)((pq * 32 + ks) * 64 + lane)) * 16) = w;
                w.x = pk2(im[0], im[1]); w.y = pk2(im[2], im[3]); w.z = pk2(im[4], im[5]); w.w = pk2(im[6], im[7]);
                *(GAS v4u*)(M3 + (size_t)g * 262144 + ((size_t)(((4 + pq) * 32 + ks) * 64 + lane)) * 16) = w; }
        } else {
            const int i2 = it - 3072, g = i2 >> 6, t = i2 & 63, c = rr;
#pragma unroll 1
            for (int hf = 0; hf < 2; ++hf) { float vr[8], vi[8];
#pragma unroll
                for (int e = 0; e < 8; ++e) { const int p = 32 * hf + 8 * kg + e; S5P P{expf(log_dt[g]), a_re[g * 64 + p], a_im[g * 64 + p]};
                    float are, aim; s5_pow(P, (float)(t + 1), are, aim); const float crv = c_re[((size_t)g * 16 + c) * 64 + p], civ = c_im[((size_t)g * 16 + c) * 64 + p];
                    vr[e] = crv * are - civ * aim; vi[e] = -(crv * aim + civ * are); }
                v4u w; w.x = pk2(vr[0], vr[1]); w.y = pk2(vr[2], vr[3]); w.z = pk2(vr[4], vr[5]); w.w = pk2(vr[6], vr[7]);
                *(GAS v4u*)(M2 + (size_t)g * 262144 + ((size_t)((t * 4 + hf) * 64 + lane)) * 16) = w;
                w.x = pk2(vi[0], vi[1]); w.y = pk2(vi[2], vi[3]); w.z = pk2(vi[4], vi[5]); w.w = pk2(vi[6], vi[7]);
                *(GAS v4u*)(M2 + (size_t)g * 262144 + ((size_t)((t * 4 + 2 + hf) * 64 + lane)) * 16) = w; }
        }
    }
}

__device__ __forceinline__ void s5_mfma(const Ctx& C, int b, int g) {
    constexpr int UL_STRIDE = 2064, SLAB = 16 * UL_STRIDE;
    LAS unsigned char* KtL = C.lds; LAS unsigned char* B0 = C.lds + SLAB; LAS float* Hl = (LAS float*)(C.lds + 2 * SLAB);
    LAS unsigned char* Hin = (LAS unsigned char*)(Hl + 80 * 128);
    const int w = C.wave;
#define S5_RELANE() int tid = C.tid; asm volatile("" : "+v"(tid)); const int lane = tid & 63, cc = lane & 15, kg = lane >> 4; (void)cc; (void)kg
#define S5_SLAB_LOAD(nt_) do { S5_RELANE(); _Pragma("unroll") for (int i_ = 0; i_ < 4; ++i_) { const int pc = tid + 512 * i_, nl = pc >> 7, jj = (pc >> 1) & 63, hf = pc & 1; int n_ = 16 * (nt_) + nl; if (n_ > 64) n_ = 64; \
        sr[i_] = *(const v4u*)(u + ((size_t)g * MP + b * LP + 64 * n_ + jj) * 16 + 8 * hf); } } while (0)
#define S5_SLAB_STORE(buf_) do { S5_RELANE(); _Pragma("unroll") for (int i_ = 0; i_ < 4; ++i_) { const int pc = tid + 512 * i_, nl = pc >> 7, jj = (pc >> 1) & 63, hf = pc & 1; \
        *(LAS v4u*)((buf_) + nl * UL_STRIDE + jj * 32 + hf * 16) = sr[i_]; } } while (0)
    const bf16* u = (const bf16*)(C.ws + WS_U); bf16* yb = (bf16*)(C.ws + WS_YB);
    const unsigned char* M3g = C.ws + WS_M3 + (size_t)g * 262144; const unsigned char* M2g = C.ws + WS_M2 + (size_t)g * 262144;
    v4u sr[4];
    { bf16x8 m3f[32];
        S5_SLAB_LOAD(0);
        { S5_RELANE();
#pragma unroll
            for (int ks = 0; ks < 32; ++ks) m3f[ks] = *(const bf16x8*)(M3g + ((size_t)((w * 32 + ks) * 64 + lane)) * 16); }
        S5_SLAB_STORE(B0);
        __syncthreads();
#pragma unroll 1
        for (int nt = 0; nt < 5; ++nt) {
            LAS unsigned char* Ul = (nt & 1) ? KtL : B0; LAS unsigned char* Un = (nt & 1) ? B0 : KtL;
            if (nt + 1 < 5) S5_SLAB_LOAD(nt + 1);
            { S5_RELANE(); f32x4 h0 = (f32x4){0.f, 0.f, 0.f, 0.f}, h1 = h0;
#pragma unroll
                for (int ks = 0; ks < 32; ks += 2) {
                    h0 = __builtin_amdgcn_mfma_f32_16x16x32_bf16(m3f[ks], *(const LAS bf16x8*)(Ul + cc * UL_STRIDE + (2 * ks + (kg >> 1)) * 32 + (kg & 1) * 16), h0, 0, 0, 0);
                    h1 = __builtin_amdgcn_mfma_f32_16x16x32_bf16(m3f[ks + 1], *(const LAS bf16x8*)(Ul + cc * UL_STRIDE + (2 * ks + 2 + (kg >> 1)) * 32 + (kg & 1) * 16), h1, 0, 0, 0); }
                *(LAS f32x4*)(Hl + (16 * nt + cc) * 128 + 16 * w + 4 * kg) = h0 + h1; }
            if (nt + 1 < 5) S5_SLAB_STORE(Un);
            __syncthreads();
        }
    }
    S5_SLAB_LOAD(0);
    v4u kr[4];
    { S5_RELANE(); const v4u* src = (const v4u*)((const bf16*)(C.ws + WS_KT) + (size_t)g * 16384);
#pragma unroll
        for (int i = 0; i < 4; ++i) kr[i] = src[tid + 512 * i]; }
    if (w == 0) { S5_RELANE(); float a64r, a64i; { S5P P{expf(C.in[11][g]), C.in[9][g * 64 + lane], C.in[10][g * 64 + lane]}; s5_pow(P, 64.f, a64r, a64i); }
        float hre = 0.f, him = 0.f;
#pragma unroll 1
        for (int n0 = 0; n0 < 80; n0 += 16) { float er[16], ei[16];
#pragma unroll
            for (int nl = 0; nl < 16; ++nl) { er[nl] = Hl[(n0 + nl) * 128 + lane]; ei[nl] = Hl[(n0 + nl) * 128 + 64 + lane]; }
#pragma unroll
            for (int nl = 0; nl < 16; ++nl) { *(LAS bf16*)(Hin + (n0 + nl) * 272 + lane * 2) = (bf16)f2bf(hre); *(LAS bf16*)(Hin + (n0 + nl) * 272 + (64 + lane) * 2) = (bf16)f2bf(him);
                const float nr = a64r * hre - a64i * him + er[nl], ni = a64r * him + a64i * hre + ei[nl]; hre = nr; him = ni; } } }
    { S5_RELANE();
#pragma unroll
        for (int i = 0; i < 4; ++i) *(LAS v4u*)(KtL + (tid + 512 * i) * 16) = kr[i]; }
    S5_SLAB_STORE(B0);
    __syncthreads();
    { bf16x8 m2f[8][4];
        { S5_RELANE();
#pragma unroll
            for (int i = 0; i < 8; ++i)
#pragma unroll
                for (int k2 = 0; k2 < 4; ++k2) m2f[i][k2] = *(const bf16x8*)(M2g + ((size_t)(((w + 8 * i) * 4 + k2) * 64 + lane)) * 16); }
        const f32x4 dsk = *(const f32x4*)(C.in[16] + g * 16 + 4 * (C.lane >> 4));
#pragma unroll 1
        for (int nt = 0; nt < 5; ++nt) {
            LAS unsigned char* Ul = (nt & 1) ? (LAS unsigned char*)Hl : B0; LAS unsigned char* Un = (nt & 1) ? B0 : (LAS unsigned char*)Hl;
            if (nt + 1 < 5) S5_SLAB_LOAD(nt + 1);
            { S5_RELANE(); const int n = 16 * nt + cc;
                bf16x8 hb[4];
#pragma unroll
                for (int k2 = 0; k2 < 4; ++k2) hb[k2] = *(const LAS bf16x8*)(Hin + n * 272 + (32 * k2 + 8 * kg) * 2);
#pragma unroll
                for (int i = 0; i < 8; ++i) { const int t = w + 8 * i, nks = (t >> 1) + 1; f32x4 a0 = (f32x4){0.f, 0.f, 0.f, 0.f}, a1 = a0;
#pragma unroll
                    for (int k2 = 0; k2 < 4; k2 += 2) { a0 = __builtin_amdgcn_mfma_f32_16x16x32_bf16(m2f[i][k2], hb[k2], a0, 0, 0, 0); a1 = __builtin_amdgcn_mfma_f32_16x16x32_bf16(m2f[i][k2 + 1], hb[k2 + 1], a1, 0, 0, 0); }
#pragma unroll 1
                    for (int ks0 = 0; ks0 < nks; ks0 += 4) {
                        bf16x8 bq[4]; v4u av[4];
#pragma unroll
                        for (int uu = 0; uu < 4; ++uu) { const int j = 2 * (ks0 + uu) + (kg >> 1), lag = t - j, lagc = lag < 0 ? 0 : lag, jc = j > 63 ? 63 : j;
                            bq[uu] = *(const LAS bf16x8*)(Ul + cc * UL_STRIDE + jc * 32 + (kg & 1) * 16);
                            av[uu] = *(const LAS v4u*)(KtL + lagc * 512 + cc * 32 + (kg & 1) * 16); if (lag < 0) av[uu] = (v4u){0u, 0u, 0u, 0u}; }
                        a0 = __builtin_amdgcn_mfma_f32_16x16x32_bf16(as_bf16x8(av[0]), bq[0], a0, 0, 0, 0); a1 = __builtin_amdgcn_mfma_f32_16x16x32_bf16(as_bf16x8(av[1]), bq[1], a1, 0, 0, 0);
                        a0 = __builtin_amdgcn_mfma_f32_16x16x32_bf16(as_bf16x8(av[2]), bq[2], a0, 0, 0, 0); a1 = __builtin_amdgcn_mfma_f32_16x16x32_bf16(as_bf16x8(av[3]), bq[3], a1, 0, 0, 0); }
                    const f32x4 y = a0 + a1;
                    if (n >= 1 && n <= 64) { const u32x2_t uv = *(const LAS u32x2_t*)(Ul + cc * UL_STRIDE + t * 32 + kg * 8);
                        const float y0 = y[0] + dsk[0] * bflo(uv.x), y1 = y[1] + dsk[1] * bfhi(uv.x), y2 = y[2] + dsk[2] * bflo(uv.y), y3 = y[3] + dsk[3] * bfhi(uv.y);
                        u32x2_t o; o.x = pk2(gelu_fast(y0), gelu_fast(y1)); o.y = pk2(gelu_fast(y2), gelu_fast(y3));
                        *(GAS u32x2_t*)(yb + (size_t)(b * SEQ + 64 * (n - 1) + t) * 512 + g * 16 + 4 * kg) = o; } } }
            if (nt + 1 < 5) S5_SLAB_STORE(Un);
            __syncthreads();
        }
    }
#undef S5_SLAB_LOAD
#undef S5_SLAB_STORE
#undef S5_RELANE
}

constexpr unsigned CONV_ITEMS = NE * 384, CONV_P3_ITEMS = CONV_ITEMS;
__device__ __forceinline__ void phase3_v2(const Ctx& C, int parts = 7) {
    const int NSCAN = NB * NH + NB * SG;
    if (C.G > NSCAN) {
#ifndef DUP_SCAN
#define DUP_SCAN 0
#endif
        if (C.wg < NB * NH) { if (!(parts & 1)) return; dn_scan_mfma(C, C.wg >> 3, C.wg & 7); if (DUP_SCAN) { __syncthreads(); dn_scan_mfma(C, C.wg >> 3, C.wg & 7); } __syncthreads(); if (parts & 4) convert_experts(C, 0, 0u, CONV_P3_ITEMS); return; }
        { const int lw0 = C.G >= NSCAN + 8 ? NSCAN : NB * NH;
          if (C.wg >= lw0 && C.wg < lw0 + 8 && (parts & 1)) { chunk_prep(C, true, lw0); __syncthreads(); } }
        if (C.wg < NSCAN && (parts & 2)) { const int idx = C.wg - NB * NH, x8 = idx & 7, y = idx >> 3;
            s5_mfma(C, y >> 2, 4 * x8 + (y & 3)); __syncthreads(); }
        if (parts & 4) convert_experts(C, 0, 0u, CONV_P3_ITEMS);
    } else {
        if (C.wg < 8) { chunk_prep(C, true, 0); __syncthreads(); }
        for (int it = C.wg; it < NSCAN; it += C.G) { if (it < NB * NH) dn_scan_mfma(C, it >> 3, it & 7); else s5_mfma(C, (it - NB * NH) >> 5, (it - NB * NH) & 31); __syncthreads(); }
        convert_experts(C, 0, 0u, CONV_P3_ITEMS);
    }
}

__device__ __forceinline__ void phase5_branch(const Ctx& C) {
    unsigned char* ws = C.ws;
    pg8::Gemm2 g{(const bf16*)(ws + WS_OA), (const bf16*)(ws + WS_WBR), (const bf16*)(ws + WS_OB), (const bf16*)(ws + WS_WBR) + 1024 * 512, MX, 1024, 512};
    pg8::StaticOrder S; S.init(MX, 1024, C.G, C.wg);
    pg8::EpiBrFused E{(const bf16*)(ws + WS_GATES), (bf16*)(ws + WS_MERGED)};
    pg8::gemm_phase2seg<pg8::EpiBrFused, pg8::StaticOrder, true>(C.lds, g, S, E);
}

#ifndef MK_N_LAUNCHES
#define MK_N_LAUNCHES 1
#endif
constexpr int N_PHASES = 11;
struct Args { const float* in[32]; float* out; unsigned char* ws; int ph_lo, ph_hi; };
#ifndef PRE_MODE
#define PRE_MODE 0
#endif
__device__ __forceinline__ void run_phases(const Ctx& C, const XcdBarrier& bar, int lo, int hi) {
    const bool dry = PRE_MODE && hi < N_PHASES;
#define IN(k) (lo <= (k) && (k) < hi)
#define SEAM(k) do { if (IN(k) && IN((k) + 1)) xcd_barrier(bar); } while (0)
#define GSEAM(k, tgt) do { if (IN(k) && IN((k) + 1)) { if (grouped) group_barrier(C, tgt); else xcd_barrier(bar); } } while (0)
    const bool grouped = C.G == 256;
    const int gpm = 8 * (C.wg & 7) + ((C.wg >> 3) & 7);
    unsigned char* ws = C.ws;
    if (IN(0)) { phase0(C); s5_tables(C); }
    SEAM(0);
    if (IN(1)) {
        pg8::Gemm g{(const bf16*)(ws + WS_H0B), (const bf16*)(ws + WS_WINT), MP, INWP, D}; pg8::StaticOrder S; S.init(MP, INWP, C.G, C.wg);
        pg8::EpiProj E{(bf16*)(ws + WS_QKV), (bf16*)(ws + WS_Z), (bf16*)(ws + WS_U), (bf16*)(ws + WS_GATES), (float*)(ws + WS_AB)};
        pg8::gemm_phase<pg8::EpiProj, pg8::StaticOrder, true, true>(C.lds, g, S, E);
    }
    SEAM(1);
    if (IN(2)) chunk_prep(C, false, 0);
    SEAM(2);
    if (IN(3)) phase3_v2(C, (dry && hi == 4) ? PRE_MODE : 7);
    SEAM(3);
    if (IN(4)) {
        if (grouped) { if (C.wg >= 128) oa_postpass_rows(C, 256 * gpm + 128 * ((C.wg >> 6) - 2)); }
        else { const int nglu = (MX / 256) * 2; if (C.G >= 2 * nglu) oa_postpass(C, nglu, C.G - nglu); else oa_postpass(C, 0, C.G); }
        pg8::Gemm g{(const bf16*)(ws + WS_YB), (const bf16*)(ws + WS_WGLU), MX, 512, 512}; pg8::StaticOrder S; S.init(MX, 512, C.G, C.wg);
        pg8::EpiGlu E{(const bf16*)(ws + WS_YB), C.in[18], (bf16*)(ws + WS_OB)};
        pg8::gemm_phase<pg8::EpiGlu, pg8::StaticOrder, true, true>(C.lds, g, S, E);
    }
    GSEAM(4, 4u);
    if (grouped && IN(4) && IN(7) && C.tid == 0) (void)__hip_atomic_fetch_add((unsigned*)(C.ctl + CW_P4DONE), 1u, RLX_AGENT);
    if (IN(5)) phase5_branch(C);
    GSEAM(5, 8u);
    if (IN(6)) {
        pg8::Gemm g{(const bf16*)(ws + WS_MERGED), (const bf16*)(ws + WS_WOUT), MX, 1024, 1024}; pg8::StaticOrder S; S.init(MX, 1024, C.G, C.wg);
        pg8::EpiOut E{C.in[0], (const float*)(ws + WS_STATS), C.in[2], C.in[3], (bf16*)C.out};
        pg8::gemm_phase<pg8::EpiOut, pg8::StaticOrder, true, true>(C.lds, g, S, E);
    }
    GSEAM(6, 12u);
    if (grouped && IN(4) && IN(7)) {
        if (C.tid == 0) { unsigned sp = 0; while (__hip_atomic_load((unsigned*)(C.ctl + CW_P4DONE), RLX_AGENT) < (unsigned)C.G) { __builtin_amdgcn_s_sleep(1); if (++sp > (1u << 22)) break; } }
        __syncthreads(); }
    if (IN(7)) { const int ob = grouped ? 4 * gpm + (C.wg >> 6) : -1; if (dry && hi == 8) phase7_rows<1>(C, ob); else phase7_rows<0>(C, ob); }
    SEAM(7);
    if (IN(8)) phase_moe(C);
    SEAM(9);
    if (IN(10)) { if (dry && hi == 11) phase11_final<1>(C); else phase11_final<0>(C); }
#undef IN
#undef SEAM
#undef GSEAM
}
#ifndef PRE_K
#define PRE_K -1
#endif
__global__ void __launch_bounds__(NWAVES * 64, 2) mk_fwd(Args args) {
    extern __shared__ __attribute__((aligned(16))) unsigned char lds[];
    Ctx C;
    C.lds = (LAS unsigned char*)lds; C.tid = threadIdx.x; C.lane = C.tid & 63; C.wave = __builtin_amdgcn_readfirstlane(C.tid >> 6);
    C.wg = blockIdx.x; C.G = gridDim.x; C.in = args.in; C.out = args.out; C.ws = args.ws; C.ctl = (gu32*)(args.ws + WS_CTL);
    volatile LAS unsigned* MISC = (volatile LAS unsigned*)(C.lds + MISC_OFF);
    for (int u = C.tid; u < (LDS_BYTES - LDSCTL_OFF) / 4; u += NWAVES * 64) ((LAS unsigned*)(C.lds + LDSCTL_OFF))[u] = 0u;
    __syncthreads();
    XcdBarrier bar; bar.bar = (unsigned*)(C.ctl + CW_BAR); bar.x = 0; bar.st = nullptr;
    if (MK_N_LAUNCHES == 1) bar = xcd_barrier_post((unsigned*)(C.ctl + CW_BAR), MISC + 8);
    run_phases(C, bar, args.ph_lo, args.ph_hi);
}

extern "C" void kernel_launch(void* const* d_in, const int* in_sizes, int n_in, void* d_out, int out_size, void* d_ws, size_t ws_size, hipStream_t stream) {
    static int grid = 0;
    if (grid == 0) {
        if (n_in != 32 || in_sizes[0] != MX * D || out_size != MX * D || ws_size < WS_END) { fprintf(stderr, "kernel_launch: unexpected shapes (n_in %d, in0 %d, out %d, ws %zu < %zu); nothing launched\n", n_in, n_in > 0 ? in_sizes[0] : -1, out_size, ws_size, (size_t)WS_END); grid = -1; return; }
        int dev = 0, cus = 0, per_cu = 0;
        if (hipGetDevice(&dev) != hipSuccess || hipDeviceGetAttribute(&cus, hipDeviceAttributeMultiprocessorCount, dev) != hipSuccess) { grid = -1; return; }
        if (hipFuncSetAttribute((const void*)mk_fwd, hipFuncAttributeMaxDynamicSharedMemorySize, LDS_BYTES) != hipSuccess) { fprintf(stderr, "kernel_launch: hipFuncSetAttribute failed\n"); grid = -1; return; }
        if (hipOccupancyMaxActiveBlocksPerMultiprocessor(&per_cu, (const void*)mk_fwd, NWAVES * 64, LDS_BYTES) != hipSuccess || per_cu < 1) fprintf(stderr, "kernel_launch: occupancy query says %d\n", per_cu);
        (void)hipGetLastError();
        grid = cus;
    }
    if (grid < 0) return;
    if (hipMemsetAsync((char*)d_ws + WS_CTL, 0, CTL_ZERO_BYTES, stream) != hipSuccess) { fprintf(stderr, "kernel_launch: hipMemsetAsync failed\n"); return; }
    Args a{};
    for (int i = 0; i < 32; ++i) a.in[i] = (const float*)d_in[i];
    a.out = (float*)d_out; a.ws = (unsigned char*)d_ws;
#if MK_N_LAUNCHES == 1
    if (PRE_K >= 0) { a.ph_lo = 0; a.ph_hi = PRE_K + 1; hipLaunchKernelGGL(mk_fwd, dim3(grid), dim3(NWAVES * 64), LDS_BYTES, stream, a); (void)hipMemsetAsync((char*)d_ws + WS_CTL, 0, CTL_ZERO_BYTES, stream); }
    a.ph_lo = 0; a.ph_hi = N_PHASES;
    hipLaunchKernelGGL(mk_fwd, dim3(grid), dim3(NWAVES * 64), LDS_BYTES, stream, a);
#else
    for (int p = 0; p < N_PHASES; ++p) { a.ph_lo = p; a.ph_hi = p + 1; hipLaunchKernelGGL(mk_fwd, dim3(grid), dim3(NWAVES * 64), LDS_BYTES, stream, a); }
#endif
    const hipError_t le = hipPeekAtLastError();
    if (le != hipSuccess) fprintf(stderr, "kernel_launch: launch failed: %s\n", hipGetErrorName(le));
}
```

```cpp
#include <hip/hip_runtime.h>
#include <cstdio>
#include <cstdint>
namespace pg8 {
#define PG8_LAS __attribute__((address_space(3)))
typedef unsigned short bf16_t;
typedef short bf16x8 __attribute__((ext_vector_type(8)));
typedef float f32x4 __attribute__((ext_vector_type(4)));
typedef unsigned u32x4 __attribute__((ext_vector_type(4)));
constexpr int BM = 256, BK = 64, HALF = 128, HTB = HALF * BK * 2  , STAGE_BYTES = 8 * HTB, NXCD = 8, WGM = 8;

__host__ __device__ __forceinline__ int lds_byte(int r, int c) { const int st = (r >> 4) * 2 + (c >> 5), rr = r & 15, cc = c & 31, ob = rr * 64 + cc * 2; return st * 1024 + (ob ^ (((ob >> 9) & 1) << 5)); }
__host__ __device__ __forceinline__ void stage_rc(int b, int& R, int& C) { const int st = b / 1024, sb = b % 1024, swz = sb ^ (((sb >> 9) & 1) << 5); R = (st >> 1) * 16 + swz / 64; C = (st & 1) * 32 + (swz % 64) / 2; }
__host__ __device__ __forceinline__ int perm32(int rho) { const int n = rho >> 4, i = rho & 15; return 8 * (i >> 2) + 4 * n + (i & 3); }

struct Unit { int pm, pn; };
struct Gemm { const bf16_t* A; const bf16_t* Bt; int M, N, K; };

struct StaticOrder {
    int nM, nN, nwg, G, c;
    __host__ __device__ void init(int M, int N, int G_, int c_) { nM = M / BM; nN = N / BM; nwg = nM * nN; G = G_; c = c_; }
    __host__ __device__ bool next(int i, Unit& u) const {
        const long L = (long)i * G + c; if (L >= nwg) return false;
        int wgid = (int)L; { const int q = nwg / NXCD, r = nwg % NXCD, xcd = wgid % NXCD, off = wgid / NXCD; wgid = (xcd < r ? xcd * (q + 1) : r * (q + 1) + (xcd - r) * q) + off; }
        const int nig = WGM * nN, gid = wgid / nig, fm = gid * WGM, gsz = (nM - fm) < WGM ? (nM - fm) : WGM;
        u.pm = fm + ((wgid % nig) % gsz); u.pn = (wgid % nig) / gsz; return true;
    }
    __device__ __forceinline__ void a_ready(const Unit&) const {}
    __device__ __forceinline__ void done(const Unit&) const {}
};

__device__ __forceinline__ unsigned cvt_pk_bf16(float lo, float hi) { unsigned r; asm volatile("v_cvt_pk_bf16_f32 %0, %1, %2" : "=v"(r) : "v"(lo), "v"(hi)); return r; }
template <class Epi, class Sched, bool ALIGN_EPI = false, bool SP2 = false>
__device__ __forceinline__ void gemm_phase(PG8_LAS unsigned char* lds, const Gemm g, const Sched& S, const Epi& E) {
    const int tid = threadIdx.x, wid = __builtin_amdgcn_readfirstlane(tid >> 6), lane = tid & 63, wr = wid >> 2, wc = wid & 3, fr = lane & 15, fq = lane >> 4;
    const int K = g.K, nt = K / BK;
    unsigned voffA[2], voffB[2];
#pragma unroll
    for (int i = 0; i < 2; ++i) { int R, C; stage_rc(tid * 16 + i * 8192, R, C); const int Rb = Epi::PERM ? ((R & ~31) + perm32(R & 31)) : R;
        voffA[i] = (unsigned)(R * K + C) * 2u; voffB[i] = (unsigned)(Rb * K + C) * 2u; }
    const size_t kstep = (size_t)(BK * 2);
    const size_t hstep = (size_t)HALF * K * 2;
    const size_t tstep = 2 * hstep;
    const unsigned ldsw = (unsigned)wid * 1024u;
    const int aoff = lds_byte(wr * 64 + fr, fq * 8), boff = lds_byte(wc * 32 + fr, fq * 8);
#define PG8_SA(b, h) (((b) * 2 + (h)) * HTB)
#define PG8_SB(b, h) ((4 + (b) * 2 + (h)) * HTB)
#define PG8_STAGE(bufoff, gbase, voff) do { _Pragma("unroll") for (int _i = 0; _i < 2; ++_i) \
        __builtin_amdgcn_global_load_lds((const unsigned*)((const char*)(gbase) + (voff)[_i]), (PG8_LAS unsigned*)(lds + (bufoff) + ldsw + _i * 8192), 16, 0, 0); } while (0)
#define PG8_LDA(dst, b, h) do { _Pragma("unroll") for (int m = 0; m < 4; ++m) _Pragma("unroll") for (int k = 0; k < 2; ++k) dst[m][k] = *(const PG8_LAS bf16x8*)(lds + PG8_SA(b, h) + aoff + m * 2048 + k * 1024); } while (0)
#define PG8_LDB(dst, b, h) do { _Pragma("unroll") for (int n = 0; n < 2; ++n) _Pragma("unroll") for (int k = 0; k < 2; ++k) dst[n][k] = *(const PG8_LAS bf16x8*)(lds + PG8_SB(b, h) + boff + n * 2048 + k * 1024); } while (0)
#define PG8_MMA(ai, bj, At, Bt) do { __builtin_amdgcn_s_setprio(1); _Pragma("unroll") for (int m = 0; m < 4; ++m) _Pragma("unroll") for (int n = 0; n < 2; ++n) _Pragma("unroll") for (int k = 0; k < 2; ++k) \
        acc[ai][bj][m][n] = __builtin_amdgcn_mfma_f32_16x16x32_bf16(Bt[n][k], At[m][k], acc[ai][bj][m][n], 0, 0, 0); __builtin_amdgcn_s_setprio(0); } while (0)
#define PG8_WAIT_V(n) asm volatile("s_waitcnt vmcnt(" #n ")" ::: "memory")
#define PG8_WAIT_L(n) asm volatile("s_waitcnt lgkmcnt(" #n ")" ::: "memory")
#define PG8_BAR __builtin_amdgcn_s_barrier()
#define PG8_SCHED __builtin_amdgcn_sched_barrier(0)
    Unit cur, nxt; int ui = 0;
    if (!S.next(0, cur)) return;
    f32x4 acc[2][2][4][2];
#pragma unroll
    for (int a = 0; a < 2; ++a)
#pragma unroll
        for (int b = 0; b < 2; ++b)
#pragma unroll
            for (int m = 0; m < 4; ++m)
#pragma unroll
                for (int n = 0; n < 2; ++n) acc[a][b][m][n] = (f32x4){0.f, 0.f, 0.f, 0.f};
    bf16x8 At[4][2], B0[2][2], B1[2][2];
    const char* cA = (const char*)g.A + (size_t)cur.pm * tstep; const char* cB = (const char*)g.Bt + (size_t)cur.pn * tstep;
    S.a_ready(cur);
    if constexpr (SP2) {
        PG8_STAGE(PG8_SB(0, 0), cB, voffB); PG8_STAGE(PG8_SB(0, 1), cB + hstep, voffB); PG8_STAGE(PG8_SA(0, 0), cA, voffA); PG8_STAGE(PG8_SA(0, 1), cA + hstep, voffA);
        if (wr == 1) PG8_BAR;
        PG8_WAIT_V(2); PG8_BAR;
        PG8_STAGE(PG8_SB(1, 0), cB + kstep, voffB); PG8_STAGE(PG8_SA(1, 0), cA + kstep, voffA); PG8_STAGE(PG8_SB(1, 1), cB + hstep + kstep, voffB);
        PG8_WAIT_V(6); PG8_BAR;
    } else {
        PG8_STAGE(PG8_SB(0, 0), cB, voffB); PG8_STAGE(PG8_SA(0, 0), cA, voffA); PG8_STAGE(PG8_SB(0, 1), cB + hstep, voffB); PG8_STAGE(PG8_SA(0, 1), cA + hstep, voffA);
        if (wr == 1) PG8_BAR;
        PG8_WAIT_V(4); PG8_BAR;
        PG8_STAGE(PG8_SB(1, 0), cB + kstep, voffB); PG8_STAGE(PG8_SA(1, 0), cA + kstep, voffA); PG8_STAGE(PG8_SB(1, 1), cB + hstep + kstep, voffB);
        PG8_WAIT_V(6); PG8_BAR;
    }
    for (;;) {
        const bool has_next = S.next(ui + 1, nxt);
        const char* nA = has_next ? (const char*)g.A + (size_t)nxt.pm * tstep : cA; const char* nB = has_next ? (const char*)g.Bt + (size_t)nxt.pn * tstep : cB;
        for (int t = 0; t < nt; t += 2) {
            const bool last = (t == nt - 2);
            const char* a1 = cA + (size_t)(t + 1) * kstep;
            const char* a2 = last ? nA : cA + (size_t)(t + 2) * kstep; const char* b2 = last ? nB : cB + (size_t)(t + 2) * kstep;
            const char* a3 = a2 + kstep; const char* b3 = b2 + kstep;
            if (last && has_next) S.a_ready(nxt);
            if constexpr (SP2) {
            PG8_LDB(B0, 0, 0); PG8_LDB(B1, 0, 1); PG8_SCHED; PG8_LDA(At, 0, 0); PG8_STAGE(PG8_SA(1, 1), a1 + hstep, voffA);
            PG8_WAIT_V(8); PG8_WAIT_L(0); PG8_BAR; PG8_MMA(0, 0, At, B0); PG8_MMA(0, 1, At, B1); PG8_BAR; PG8_SCHED;
            PG8_LDA(At, 0, 1); PG8_STAGE(PG8_SB(0, 0), b2, voffB); PG8_STAGE(PG8_SB(0, 1), b2 + hstep, voffB); PG8_STAGE(PG8_SA(0, 0), a2, voffA);
            PG8_WAIT_V(8); PG8_WAIT_L(0); PG8_BAR; PG8_MMA(1, 0, At, B0); PG8_MMA(1, 1, At, B1); PG8_BAR; PG8_SCHED;
            PG8_LDB(B0, 1, 0); PG8_LDB(B1, 1, 1); PG8_SCHED; PG8_LDA(At, 1, 0); PG8_STAGE(PG8_SA(0, 1), a2 + hstep, voffA);
            PG8_WAIT_V(8); PG8_WAIT_L(0); PG8_BAR; PG8_MMA(0, 0, At, B0); PG8_MMA(0, 1, At, B1); PG8_BAR; PG8_SCHED;
            PG8_LDA(At, 1, 1); PG8_STAGE(PG8_SB(1, 0), b3, voffB); PG8_STAGE(PG8_SB(1, 1), b3 + hstep, voffB); PG8_STAGE(PG8_SA(1, 0), a3, voffA);
            PG8_WAIT_V(8); PG8_WAIT_L(0); PG8_BAR; PG8_MMA(1, 0, At, B0); PG8_MMA(1, 1, At, B1); PG8_BAR; PG8_SCHED;
            } else {
            PG8_LDB(B0, 0, 0); PG8_SCHED; PG8_LDA(At, 0, 0); PG8_STAGE(PG8_SA(1, 1), a1 + hstep, voffA);
            PG8_WAIT_L(8); PG8_BAR; PG8_WAIT_L(0); PG8_MMA(0, 0, At, B0); PG8_BAR; PG8_SCHED;
            PG8_LDB(B1, 0, 1); PG8_STAGE(PG8_SB(0, 0), b2, voffB);
            PG8_BAR; PG8_WAIT_L(0); PG8_MMA(0, 1, At, B1); PG8_BAR;
            PG8_LDA(At, 0, 1); PG8_STAGE(PG8_SA(0, 0), a2, voffA);
            PG8_BAR; PG8_WAIT_L(0); PG8_MMA(1, 0, At, B0); PG8_BAR; PG8_SCHED;
            PG8_STAGE(PG8_SB(0, 1), b2 + hstep, voffB);
            PG8_WAIT_V(6); PG8_BAR; PG8_MMA(1, 1, At, B1); PG8_BAR;
            PG8_LDB(B0, 1, 0); PG8_SCHED; PG8_LDA(At, 1, 0); PG8_STAGE(PG8_SA(0, 1), a2 + hstep, voffA);
            PG8_WAIT_L(8); PG8_BAR; PG8_WAIT_L(0); PG8_MMA(0, 0, At, B0); PG8_BAR; PG8_SCHED;
            PG8_LDB(B1, 1, 1); PG8_STAGE(PG8_SB(1, 0), b3, voffB);
            PG8_BAR; PG8_WAIT_L(0); PG8_MMA(0, 1, At, B1); PG8_BAR;
            PG8_LDA(At, 1, 1); PG8_STAGE(PG8_SA(1, 0), a3, voffA);
            PG8_BAR; PG8_WAIT_L(0); PG8_MMA(1, 0, At, B0); PG8_BAR; PG8_SCHED;
            PG8_STAGE(PG8_SB(1, 1), b3 + hstep, voffB);
            PG8_WAIT_V(6); PG8_BAR; PG8_MMA(1, 1, At, B1); PG8_BAR;
            }
        }
        if constexpr (ALIGN_EPI) { if (wr == 0) PG8_BAR; }
        if constexpr (!Epi::AFTER_DRAIN) { E(acc, cur, wr, wc, fr, fq); S.done(cur); }
        if (!has_next) break;
#pragma unroll
        for (int a = 0; a < 2; ++a)
#pragma unroll
            for (int b = 0; b < 2; ++b)
#pragma unroll
                for (int m = 0; m < 4; ++m)
#pragma unroll
                    for (int n = 0; n < 2; ++n) acc[a][b][m][n] = (f32x4){0.f, 0.f, 0.f, 0.f};
        cur = nxt; cA = nA; cB = nB; ++ui;
        if constexpr (ALIGN_EPI) { if (wr == 1) PG8_BAR; }
    }
    PG8_WAIT_V(0);
    if constexpr (!ALIGN_EPI) { if (wr == 0) PG8_BAR; }
    PG8_BAR;
    if constexpr (Epi::AFTER_DRAIN) { E.fused(acc, cur, wr, wc, fr, fq, lds, wid, lane); S.done(cur); }
#undef PG8_SA
#undef PG8_SB
#undef PG8_STAGE
#undef PG8_LDA
#undef PG8_LDB
#undef PG8_MMA
#undef PG8_WAIT_V
#undef PG8_WAIT_L
#undef PG8_BAR
#undef PG8_SCHED
}
}
#define GAS __attribute__((address_space(1)))
#define LAS __attribute__((address_space(3)))
typedef unsigned short bf16;
typedef unsigned v4u __attribute__((ext_vector_type(4)));
typedef float f32x4 __attribute__((ext_vector_type(4)));
typedef short bf16x8 __attribute__((ext_vector_type(8)));
typedef GAS unsigned gu32;
typedef GAS unsigned long long gu64;
#define RLX_AGENT __ATOMIC_RELAXED, __HIP_MEMORY_SCOPE_AGENT
#define LDS_WAIT() asm volatile("s_waitcnt lgkmcnt(0)" ::: "memory")
#define VM_WAIT() asm volatile("s_waitcnt vmcnt(0)" ::: "memory")
__device__ __forceinline__ unsigned long long rt() { return __builtin_amdgcn_s_memrealtime(); }
typedef __bf16 hwbf16x2 __attribute__((ext_vector_type(2)));
typedef float hwf32x2 __attribute__((ext_vector_type(2)));
__device__ __forceinline__ unsigned pk2(float lo, float hi) { return __builtin_bit_cast(unsigned, __builtin_convertvector((hwf32x2){lo, hi}, hwbf16x2)); }
__device__ __forceinline__ unsigned f2bf(float f) { return pk2(f, 0.f) & 0xffffu; }

#define XB_TMO      128
#define XB_XCNT(j)  (256  + 64 * (j))
#define XB_XSUB(j)  (1280 + 64 * (j))
#define XB_XGEN(j)  (2304 + 64 * (j))
#define XB_TOP      3328
#define XB_TOPGEN   3392
#define XCD_BAR_WORDS 3456
#define XB_SPIN_CAP (1u << 18)

__device__ __forceinline__ unsigned xb_ld(unsigned* p)              { return __hip_atomic_load(p, __ATOMIC_RELAXED, __HIP_MEMORY_SCOPE_AGENT); }
__device__ __forceinline__ unsigned xb_add(unsigned* p, unsigned v) { return __hip_atomic_fetch_add(p, v, __ATOMIC_RELAXED, __HIP_MEMORY_SCOPE_AGENT); }
__device__ __forceinline__ unsigned xb_xcc_id() { return (unsigned)__builtin_amdgcn_s_getreg((3 << 11) | 20) & 0xFu; }
#define XB_SPIN(cond, bar) do { unsigned _sp = 0; while (cond) { __builtin_amdgcn_s_sleep(1); \
    if ((++_sp & 255u) == 0u) { if (xb_ld(&(bar)[XB_TMO])) break; if (_sp > XB_SPIN_CAP) { atomicAdd(&(bar)[XB_TMO], 1u); break; } } } } while (0)

struct XcdBarrier {
    unsigned* bar; unsigned x;
    volatile LAS unsigned* st;
};

__device__ __forceinline__ XcdBarrier xcd_barrier_post(unsigned* bar, volatile LAS unsigned* st) {
    XcdBarrier b; b.bar = bar; b.x = xb_xcc_id(); b.st = st;
    if (threadIdx.x == 0) (void)xb_add(&bar[XB_XCNT(b.x)], 1u);
    return b;
}
__device__ __forceinline__ void xcd_barrier_complete(unsigned* bar, unsigned x, unsigned& nloc, unsigned& nx) {
    const unsigned G = gridDim.x * gridDim.y * gridDim.z;
    unsigned sum, cnt, mine, sp = 0u;
    for (;;) {
        sum = 0u; cnt = 0u; mine = 0u;
#pragma unroll
        for (unsigned j = 0; j < 16; ++j) { const unsigned c = xb_ld(&bar[XB_XCNT(j)]); sum += c; cnt += (c > 0u) ? 1u : 0u; mine = (j == x) ? c : mine; }
        if (sum == G) break;
        __builtin_amdgcn_s_sleep(1);
        if ((++sp & 255u) == 0u) { if (xb_ld(&bar[XB_TMO])) break; if (sp > XB_SPIN_CAP) { atomicAdd(&bar[XB_TMO], 1u); break; } }
    }
    nloc = mine > 0u ? mine : 1u; nx = cnt > 0u ? cnt : 1u;
}

__device__ __forceinline__ void xcd_barrier(const XcdBarrier& b) {
    asm volatile("s_waitcnt vmcnt(0)" ::: "memory");
    __syncthreads();
    if (threadIdx.x == 0) {
        unsigned* bar = b.bar;
        __builtin_amdgcn_s_waitcnt(0);
        unsigned nloc = b.st[0], nx = b.st[1];
        if (nloc == 0u) { xcd_barrier_complete(bar, b.x, nloc, nx); b.st[0] = nloc; b.st[1] = nx; }
        const unsigned old = xb_add(&bar[XB_XSUB(b.x)], 1u);
        const unsigned gen = old / nloc;
        if (old + 1u == (gen + 1u) * nloc) {
            __builtin_amdgcn_fence(__ATOMIC_RELEASE, "agent");
            asm volatile("s_waitcnt vmcnt(0)" ::: "memory");
            const unsigned og = xb_add(&bar[XB_TOP], 1u);
            const unsigned tg = og / nx;
            if (og + 1u == (tg + 1u) * nx) xb_add(&bar[XB_TOPGEN], 1u);
            else XB_SPIN(xb_ld(&bar[XB_TOPGEN]) == tg, bar);
            __builtin_amdgcn_fence(__ATOMIC_ACQUIRE, "agent");
            xb_add(&bar[XB_XGEN(b.x)], 1u);
            asm volatile("s_waitcnt vmcnt(0)" ::: "memory");
        } else {
            XB_SPIN(xb_ld(&bar[XB_XGEN(b.x)]) == gen, bar);
            __builtin_amdgcn_fence(__ATOMIC_ACQUIRE, "agent");
            asm volatile("s_waitcnt vmcnt(0)" ::: "memory");
        }
    }
    __syncthreads();
}
namespace pg8 {
struct Gemm2 { const bf16_t* A1; const bf16_t* B1; const bf16_t* A2; const bf16_t* B2; int M, N, Kseg; };
template <class Epi, class Sched, bool ALIGN_EPI = false>
__device__ __forceinline__ void gemm_phase2seg(PG8_LAS unsigned char* lds, const Gemm2 g, const Sched& S, const Epi& E) {
    constexpr bool SP2 = true;
    const int tid = threadIdx.x, wid = __builtin_amdgcn_readfirstlane(tid >> 6), lane = tid & 63, wr = wid >> 2, wc = wid & 3, fr = lane & 15, fq = lane >> 4;
    const int K = g.Kseg, half = K / BK, nt = 2 * half;
    unsigned voffA[2], voffB[2];
#pragma unroll
    for (int i = 0; i < 2; ++i) { int R, C; stage_rc(tid * 16 + i * 8192, R, C); const int Rb = Epi::PERM ? ((R & ~31) + perm32(R & 31)) : R;
        voffA[i] = (unsigned)(R * K + C) * 2u; voffB[i] = (unsigned)(Rb * K + C) * 2u; }
    const size_t kstep = (size_t)(BK * 2);
    const size_t hstep = (size_t)HALF * K * 2;
    const size_t tstep = 2 * hstep;
    const unsigned ldsw = (unsigned)wid * 1024u;
    const int aoff = lds_byte(wr * 64 + fr, fq * 8), boff = lds_byte(wc * 32 + fr, fq * 8);
#define PG8_SA(b, h) (((b) * 2 + (h)) * HTB)
#define PG8_SB(b, h) ((4 + (b) * 2 + (h)) * HTB)
#define PG8_STAGE(bufoff, gbase, voff) do { _Pragma("unroll") for (int _i = 0; _i < 2; ++_i) \
        __builtin_amdgcn_global_load_lds((const unsigned*)((const char*)(gbase) + (voff)[_i]), (PG8_LAS unsigned*)(lds + (bufoff) + ldsw + _i * 8192), 16, 0, 0); } while (0)
#define PG8_LDA(dst, b, h) do { _Pragma("unroll") for (int m = 0; m < 4; ++m) _Pragma("unroll") for (int k = 0; k < 2; ++k) dst[m][k] = *(const PG8_LAS bf16x8*)(lds + PG8_SA(b, h) + aoff + m * 2048 + k * 1024); } while (0)
#define PG8_LDB(dst, b, h) do { _Pragma("unroll") for (int n = 0; n < 2; ++n) _Pragma("unroll") for (int k = 0; k < 2; ++k) dst[n][k] = *(const PG8_LAS bf16x8*)(lds + PG8_SB(b, h) + boff + n * 2048 + k * 1024); } while (0)
#define PG8_MMA(ai, bj, At, Bt) do { __builtin_amdgcn_s_setprio(1); _Pragma("unroll") for (int m = 0; m < 4; ++m) _Pragma("unroll") for (int n = 0; n < 2; ++n) _Pragma("unroll") for (int k = 0; k < 2; ++k) \
        acc[ai][bj][m][n] = __builtin_amdgcn_mfma_f32_16x16x32_bf16(Bt[n][k], At[m][k], acc[ai][bj][m][n], 0, 0, 0); __builtin_amdgcn_s_setprio(0); } while (0)
#define PG8_WAIT_V(n) asm volatile("s_waitcnt vmcnt(" #n ")" ::: "memory")
#define PG8_WAIT_L(n) asm volatile("s_waitcnt lgkmcnt(" #n ")" ::: "memory")
#define PG8_BAR __builtin_amdgcn_s_barrier()
#define PG8_SCHED __builtin_amdgcn_sched_barrier(0)
    Unit cur, nxt; int ui = 0;
    if (!S.next(0, cur)) return;
    f32x4 acc[2][2][4][2];
#pragma unroll
    for (int a = 0; a < 2; ++a)
#pragma unroll
        for (int b = 0; b < 2; ++b)
#pragma unroll
            for (int m = 0; m < 4; ++m)
#pragma unroll
                for (int n = 0; n < 2; ++n) acc[a][b][m][n] = (f32x4){0.f, 0.f, 0.f, 0.f};
    bf16x8 At[4][2], B0[2][2], B1[2][2];
    const char* cA = (const char*)g.A1 + (size_t)cur.pm * tstep; const char* cB = (const char*)g.B1 + (size_t)cur.pn * tstep;
    const char* cA2 = (const char*)g.A2 + (size_t)cur.pm * tstep; const char* cB2 = (const char*)g.B2 + (size_t)cur.pn * tstep;
    S.a_ready(cur);
    if constexpr (SP2) {
        PG8_STAGE(PG8_SB(0, 0), cB, voffB); PG8_STAGE(PG8_SB(0, 1), cB + hstep, voffB); PG8_STAGE(PG8_SA(0, 0), cA, voffA); PG8_STAGE(PG8_SA(0, 1), cA + hstep, voffA);
        if (wr == 1) PG8_BAR;
        PG8_WAIT_V(2); PG8_BAR;
        PG8_STAGE(PG8_SB(1, 0), cB + kstep, voffB); PG8_STAGE(PG8_SA(1, 0), cA + kstep, voffA); PG8_STAGE(PG8_SB(1, 1), cB + hstep + kstep, voffB);
        PG8_WAIT_V(6); PG8_BAR;
    } else {
        PG8_STAGE(PG8_SB(0, 0), cB, voffB); PG8_STAGE(PG8_SA(0, 0), cA, voffA); PG8_STAGE(PG8_SB(0, 1), cB + hstep, voffB); PG8_STAGE(PG8_SA(0, 1), cA + hstep, voffA);
        if (wr == 1) PG8_BAR;
        PG8_WAIT_V(4); PG8_BAR;
        PG8_STAGE(PG8_SB(1, 0), cB + kstep, voffB); PG8_STAGE(PG8_SA(1, 0), cA + kstep, voffA); PG8_STAGE(PG8_SB(1, 1), cB + hstep + kstep, voffB);
        PG8_WAIT_V(6); PG8_BAR;
    }
    for (;;) {
        const bool has_next = S.next(ui + 1, nxt);
        const char* nA = has_next ? (const char*)g.A1 + (size_t)nxt.pm * tstep : cA; const char* nB = has_next ? (const char*)g.B1 + (size_t)nxt.pn * tstep : cB;
        for (int t = 0; t < nt; t += 2) {
            const bool last = (t == nt - 2);
            if (t == half) E.mid(acc, cur, wr, wc, fr, fq);
            const char* a1 = (t + 1 < half) ? cA + (size_t)(t + 1) * kstep : cA2 + (size_t)(t + 1 - half) * kstep;
            const char* a2 = last ? nA : ((t + 2 < half) ? cA + (size_t)(t + 2) * kstep : cA2 + (size_t)(t + 2 - half) * kstep);
            const char* b2 = last ? nB : ((t + 2 < half) ? cB + (size_t)(t + 2) * kstep : cB2 + (size_t)(t + 2 - half) * kstep);
            const char* a3 = a2 + kstep; const char* b3 = b2 + kstep;
            if (last && has_next) S.a_ready(nxt);
            if constexpr (SP2) {
            PG8_LDB(B0, 0, 0); PG8_LDB(B1, 0, 1); PG8_SCHED; PG8_LDA(At, 0, 0); PG8_STAGE(PG8_SA(1, 1), a1 + hstep, voffA);
            PG8_WAIT_V(8); PG8_WAIT_L(0); PG8_BAR; PG8_MMA(0, 0, At, B0); PG8_MMA(0, 1, At, B1); PG8_BAR; PG8_SCHED;
            PG8_LDA(At, 0, 1); PG8_STAGE(PG8_SB(0, 0), b2, voffB); PG8_STAGE(PG8_SB(0, 1), b2 + hstep, voffB); PG8_STAGE(PG8_SA(0, 0), a2, voffA);
            PG8_WAIT_V(8); PG8_WAIT_L(0); PG8_BAR; PG8_MMA(1, 0, At, B0); PG8_MMA(1, 1, At, B1); PG8_BAR; PG8_SCHED;
            PG8_LDB(B0, 1, 0); PG8_LDB(B1, 1, 1); PG8_SCHED; PG8_LDA(At, 1, 0); PG8_STAGE(PG8_SA(0, 1), a2 + hstep, voffA);
            PG8_WAIT_V(8); PG8_WAIT_L(0); PG8_BAR; PG8_MMA(0, 0, At, B0); PG8_MMA(0, 1, At, B1); PG8_BAR; PG8_SCHED;
            PG8_LDA(At, 1, 1); PG8_STAGE(PG8_SB(1, 0), b3, voffB); PG8_STAGE(PG8_SB(1, 1), b3 + hstep, voffB); PG8_STAGE(PG8_SA(1, 0), a3, voffA);
            PG8_WAIT_V(8); PG8_WAIT_L(0); PG8_BAR; PG8_MMA(1, 0, At, B0); PG8_MMA(1, 1, At, B1); PG8_BAR; PG8_SCHED;
            } else {
            PG8_LDB(B0, 0, 0); PG8_SCHED; PG8_LDA(At, 0, 0); PG8_STAGE(PG8_SA(1, 1), a1 + hstep, voffA);
            PG8_WAIT_L(8); PG8_BAR; PG8_WAIT_L(0); PG8_MMA(0, 0, At, B0); PG8_BAR; PG8_SCHED;
            PG8_LDB(B1, 0, 1); PG8_STAGE(PG8_SB(0, 0), b2, voffB);
            PG8_BAR; PG8_WAIT_L(0); PG8_MMA(0, 1, At, B1); PG8_BAR;
            PG8_LDA(At, 0, 1); PG8_STAGE(PG8_SA(0, 0), a2, voffA);
            PG8_BAR; PG8_WAIT_L(0); PG8_MMA(1, 0, At, B0); PG8_BAR; PG8_SCHED;
            PG8_STAGE(PG8_SB(0, 1), b2 + hstep, voffB);
            PG8_WAIT_V(6); PG8_BAR; PG8_MMA(1, 1, At, B1); PG8_BAR;
            PG8_LDB(B0, 1, 0); PG8_SCHED; PG8_LDA(At, 1, 0); PG8_STAGE(PG8_SA(0, 1), a2 + hstep, voffA);
            PG8_WAIT_L(8); PG8_BAR; PG8_WAIT_L(0); PG8_MMA(0, 0, At, B0); PG8_BAR; PG8_SCHED;
            PG8_LDB(B1, 1, 1); PG8_STAGE(PG8_SB(1, 0), b3, voffB);
            PG8_BAR; PG8_WAIT_L(0); PG8_MMA(0, 1, At, B1); PG8_BAR;
            PG8_LDA(At, 1, 1); PG8_STAGE(PG8_SA(1, 0), a3, voffA);
            PG8_BAR; PG8_WAIT_L(0); PG8_MMA(1, 0, At, B0); PG8_BAR; PG8_SCHED;
            PG8_STAGE(PG8_SB(1, 1), b3 + hstep, voffB);
            PG8_WAIT_V(6); PG8_BAR; PG8_MMA(1, 1, At, B1); PG8_BAR;
            }
        }
        if constexpr (ALIGN_EPI) { if (wr == 0) PG8_BAR; }
        if constexpr (!Epi::AFTER_DRAIN) { E(acc, cur, wr, wc, fr, fq); S.done(cur); }
        if (!has_next) break;
#pragma unroll
        for (int a = 0; a < 2; ++a)
#pragma unroll
            for (int b = 0; b < 2; ++b)
#pragma unroll
                for (int m = 0; m < 4; ++m)
#pragma unroll
                    for (int n = 0; n < 2; ++n) acc[a][b][m][n] = (f32x4){0.f, 0.f, 0.f, 0.f};
        cur = nxt; cA = nA; cB = nB; cA2 = (const char*)g.A2 + (size_t)cur.pm * tstep; cB2 = (const char*)g.B2 + (size_t)cur.pn * tstep; ++ui;
        if constexpr (ALIGN_EPI) { if (wr == 1) PG8_BAR; }
    }
    PG8_WAIT_V(0);
    if constexpr (!ALIGN_EPI) { if (wr == 0) PG8_BAR; }
    PG8_BAR;
    if constexpr (Epi::AFTER_DRAIN) { E.fused(acc, cur, wr, wc, fr, fq, lds, wid, lane); S.done(cur); }
#undef PG8_SA
#undef PG8_SB
#undef PG8_STAGE
#undef PG8_LDA
#undef PG8_LDB
#undef PG8_MMA
#undef PG8_WAIT_V
#undef PG8_WAIT_L
#undef PG8_BAR
#undef PG8_SCHED
}
}

constexpr int NWAVES = 8;
constexpr int D = 1024, NB = 4, SEQ = 4096, PADF = 48, LP = 4160, NCH = 65, MP = NB * LP  , MX = NB * SEQ  ;
constexpr int INW = 4624, INWP = 4864, NH = 8, SG = 32;
constexpr int NE = 64;
constexpr float LN_EPS = 1e-5f, NORM_EPS = 1e-6f, ALPHA = 1.189207115002721f;

constexpr size_t MiB = 1u << 20;
constexpr size_t WS_CTL = 0, CTL_ZERO_BYTES = 512 * 1024;
constexpr size_t WS_STATS = 1 * MiB;
constexpr size_t WS_ROUTE = WS_STATS + 128 * 1024;
constexpr size_t WS_INV = WS_ROUTE + 512 * 1024;
constexpr size_t WS_WRT = WS_INV + 192 * 1024;
constexpr size_t WS_AB = 2 * MiB;
constexpr size_t WS_WGLU = 3 * MiB + 512 * 1024;
constexpr size_t WS_WBR = WS_WGLU + 512 * 1024;
constexpr size_t WS_WOUT = WS_WBR + 2 * MiB;
constexpr size_t WS_W13 = 8 * MiB;
constexpr size_t WS_W2 = WS_W13 + 64 * MiB;
constexpr size_t WS_WINT = 8 * MiB;
constexpr size_t WS_H0B = WS_WINT + (size_t)INWP * D * 2;
constexpr size_t WS_QKV = WS_H0B + (size_t)MP * D * 2;
static_assert(WS_QKV + (size_t)MP * 1536 * 2 <= 104 * MiB, "overlay");
constexpr size_t WS_Z = 104 * MiB;
constexpr size_t WS_U = WS_Z + (size_t)MP * 512 * 2;
constexpr size_t WS_GATES = WS_U + (size_t)MP * 512 * 2;
constexpr size_t WS_OA = WS_GATES + (size_t)MP * 2048 * 2;
constexpr size_t WS_YB = WS_OA + 16 * MiB;
constexpr size_t WS_OB = WS_YB + 16 * MiB;
constexpr size_t WS_MERGED = WS_OB + 16 * MiB;
constexpr size_t WS_END = WS_MERGED + 32 * MiB;
static_assert(WS_END <= 283 * MiB, "d_ws map");
constexpr size_t WS_TMP = WS_Z;
constexpr size_t WS_PRE = WS_GATES;
constexpr size_t WS_H1 = WS_Z;
constexpr size_t WS_INV2 = WS_OB;
constexpr size_t WS_HID = WS_OA;
static_assert(WS_TMP + 32 * MiB <= WS_GATES && WS_PRE + 64 * MiB <= WS_OA, "overlays");
constexpr size_t DO_QN = 0, DO_KN = (size_t)MP * 512 * 2, DO_VN = 2 * DO_KN, DO_BETA = 3 * DO_KN, DO_ALPHA = DO_BETA + (size_t)MP * 8 * 4;
constexpr int CW_BAR = 4096, CW_CNT = 65536, CNT_STRIDE = 1024;
constexpr int RING_BYTES = 131072, LDS_BYTES = 163840, LDSCTL_OFF = LDS_BYTES - 1024, MISC_OFF = LDSCTL_OFF + 320;

__device__ __forceinline__ float bf2f(unsigned short h) { return __builtin_bit_cast(float, (unsigned)h << 16); }
__device__ __forceinline__ float bflo(unsigned w) { return __builtin_bit_cast(float, w << 16); }
__device__ __forceinline__ float bfhi(unsigned w) { return __builtin_bit_cast(float, w & 0xffff0000u); }
__device__ __forceinline__ float sigm(float x) { return __builtin_amdgcn_rcpf(1.f + __expf(-x)); }
__device__ __forceinline__ float silu_(float x) { return x * sigm(x); }
__device__ __forceinline__ float softplus_(float x) { return x > 20.f ? x : log1pf(expf(x)); }
__device__ __forceinline__ float gelu_tanh(float x) { const float u = 0.7978845608028654f * (x + 0.044715f * x * x * x); return 0.5f * x * (1.f + tanhf(u)); }
__device__ __forceinline__ float wave_sum(float v) {
#pragma unroll
    for (int o = 1; o < 64; o <<= 1) v += __shfl_xor(v, o);
    return v;
}
__device__ __forceinline__ int prow_of(int xrow) { return (xrow >> 12) * LP + 64 + (xrow & 4095); }

namespace pg8 {
struct EpiProj {
    static constexpr bool PERM = true, AFTER_DRAIN = false;
    bf16_t *qkv, *z, *u, *gates; float* ab;
    __device__ __forceinline__ void operator()(const f32x4 (&acc)[2][2][4][2], const Unit& un, int wr, int wc, int fr, int fq) const {
        const int pn = un.pn; bf16_t* base; int ld, cb;
        if (pn < 6) { base = qkv; ld = 1536; cb = pn * 256; }
        else if (pn < 8) { base = z; ld = 512; cb = (pn - 6) * 256; }
        else if (pn < 10) {
            const int row0u = un.pm * BM + wr * 64 + fr, c0u = (pn - 8) * 256 + wc * 32 + 8 * fq;
#pragma unroll
            for (int ai = 0; ai < 2; ++ai)
#pragma unroll
                for (int m = 0; m < 4; ++m)
#pragma unroll
                    for (int bj = 0; bj < 2; ++bj) { const int col = c0u + bj * HALF, row = row0u + ai * HALF + m * 16; const f32x4 v0 = acc[ai][bj][m][0], v1 = acc[ai][bj][m][1]; u32x4 w;
                        w.x = cvt_pk_bf16(v0[0], v0[1]); w.y = cvt_pk_bf16(v0[2], v0[3]); w.z = cvt_pk_bf16(v1[0], v1[1]); w.w = cvt_pk_bf16(v1[2], v1[3]);
                        *(u32x4*)(u + ((size_t)(col >> 4) * MP + row) * 16 + (col & 15)) = w; }
            return; }
        else if (pn < 18) { base = gates; ld = 2048; cb = (pn - 10) * 256; }
        else {
            if (wc == 0 && fq < 2) {
#pragma unroll
                for (int ai = 0; ai < 2; ++ai)
#pragma unroll
                    for (int m = 0; m < 4; ++m) { const int row = un.pm * BM + ai * HALF + wr * 64 + m * 16 + fr; float* p = ab + (size_t)row * 16 + 8 * fq;
                        *(f32x4*)p = acc[ai][0][m][0]; *(f32x4*)(p + 4) = acc[ai][0][m][1]; }
            }
            return;
        }
        const int row0 = un.pm * BM + wr * 64 + fr, col0 = cb + wc * 32 + 8 * fq;
#pragma unroll
        for (int ai = 0; ai < 2; ++ai)
#pragma unroll
            for (int m = 0; m < 4; ++m) { bf16_t* rowp = base + (size_t)(row0 + ai * HALF + m * 16) * ld + col0;
#pragma unroll
                for (int bj = 0; bj < 2; ++bj) { const f32x4 v0 = acc[ai][bj][m][0], v1 = acc[ai][bj][m][1]; u32x4 w;
                    w.x = cvt_pk_bf16(v0[0], v0[1]); w.y = cvt_pk_bf16(v0[2], v0[3]); w.z = cvt_pk_bf16(v1[0], v1[1]); w.w = cvt_pk_bf16(v1[2], v1[3]);
                    *(u32x4*)(rowp + bj * HALF) = w; } }
    }
};
struct EpiGlu {
    static constexpr bool PERM = true, AFTER_DRAIN = false;
    const bf16_t* yb; const float* bglu; bf16_t* ob;
    __device__ __forceinline__ void operator()(const f32x4 (&acc)[2][2][4][2], const Unit& un, int wr, int wc, int fr, int fq) const {
        const int row0 = un.pm * BM + wr * 64 + fr, col0 = un.pn * BM + wc * 32 + 8 * fq;
#pragma unroll
        for (int bj = 0; bj < 2; ++bj) { const int col = col0 + bj * HALF; const f32x4 b0 = *(const f32x4*)(bglu + col), b1 = *(const f32x4*)(bglu + col + 4);
#pragma unroll
            for (int ai = 0; ai < 2; ++ai)
#pragma unroll
                for (int m = 0; m < 4; ++m) { const size_t off = (size_t)(row0 + ai * HALF + m * 16) * 512 + col; const u32x4 y = *(const u32x4*)(yb + off);
                    const f32x4 v0 = acc[ai][bj][m][0] + b0, v1 = acc[ai][bj][m][1] + b1; u32x4 w;
                    w.x = cvt_pk_bf16(bflo(y.x) * sigm(v0[0]), bfhi(y.x) * sigm(v0[1])); w.y = cvt_pk_bf16(bflo(y.y) * sigm(v0[2]), bfhi(y.y) * sigm(v0[3]));
                    w.z = cvt_pk_bf16(bflo(y.z) * sigm(v1[0]), bfhi(y.z) * sigm(v1[1])); w.w = cvt_pk_bf16(bflo(y.w) * sigm(v1[2]), bfhi(y.w) * sigm(v1[3]));
                    *(u32x4*)(ob + off) = w; } }
    }
};
template <bool SECOND> struct EpiBr {
    static constexpr bool PERM = true, AFTER_DRAIN = false;
    const bf16_t* gates; const bf16_t* tin; bf16_t* out;
    __device__ __forceinline__ void operator()(const f32x4 (&acc)[2][2][4][2], const Unit& un, int wr, int wc, int fr, int fq) const {
        const int row0 = un.pm * BM + wr * 64 + fr, col0 = un.pn * BM + wc * 32 + 8 * fq;
#pragma unroll
        for (int ai = 0; ai < 2; ++ai)
#pragma unroll
            for (int m = 0; m < 4; ++m) { const int row = row0 + ai * HALF + m * 16; const size_t goff = (size_t)prow_of(row) * 2048 + (SECOND ? 1024 : 0) + col0, off = (size_t)row * 1024 + col0;
#pragma unroll
                for (int bj = 0; bj < 2; ++bj) { const u32x4 g = *(const u32x4*)(gates + goff + bj * HALF); const f32x4 v0 = acc[ai][bj][m][0], v1 = acc[ai][bj][m][1];
                    float r[8] = { sigm(bflo(g.x)) * v0[0], sigm(bfhi(g.x)) * v0[1], sigm(bflo(g.y)) * v0[2], sigm(bfhi(g.y)) * v0[3],
                                   sigm(bflo(g.z)) * v1[0], sigm(bfhi(g.z)) * v1[1], sigm(bflo(g.w)) * v1[2], sigm(bfhi(g.w)) * v1[3] };
                    if (SECOND) { const u32x4 t = *(const u32x4*)(tin + off + bj * HALF);
                        r[0] += bflo(t.x); r[1] += bfhi(t.x); r[2] += bflo(t.y); r[3] += bfhi(t.y); r[4] += bflo(t.z); r[5] += bfhi(t.z); r[6] += bflo(t.w); r[7] += bfhi(t.w); }
                    u32x4 w; w.x = cvt_pk_bf16(r[0], r[1]); w.y = cvt_pk_bf16(r[2], r[3]); w.z = cvt_pk_bf16(r[4], r[5]); w.w = cvt_pk_bf16(r[6], r[7]);
                    *(u32x4*)(out + off + bj * HALF) = w; } }
    }
};
struct EpiBrFused {
    static constexpr bool PERM = true, AFTER_DRAIN = false;
    const bf16_t* gates; bf16_t* out;
    __device__ __forceinline__ void mid(f32x4 (&acc)[2][2][4][2], const Unit& un, int wr, int wc, int fr, int fq) const {
        const int row0 = un.pm * BM + wr * 64 + fr, col0 = un.pn * BM + wc * 32 + 8 * fq;
#pragma unroll
        for (int ai = 0; ai < 2; ++ai)
#pragma unroll
            for (int m = 0; m < 4; ++m) { const int row = row0 + ai * HALF + m * 16; const size_t goff = (size_t)prow_of(row) * 2048 + col0;
#pragma unroll
                for (int bj = 0; bj < 2; ++bj) { const u32x4 ga = *(const u32x4*)(gates + goff + bj * HALF), gb = *(const u32x4*)(gates + goff + 1024 + bj * HALF);
                    const float ea[8] = {bflo(ga.x), bfhi(ga.x), bflo(ga.y), bfhi(ga.y), bflo(ga.z), bfhi(ga.z), bflo(ga.w), bfhi(ga.w)};
                    const float eb[8] = {bflo(gb.x), bfhi(gb.x), bflo(gb.y), bfhi(gb.y), bflo(gb.z), bfhi(gb.z), bflo(gb.w), bfhi(gb.w)};
#pragma unroll
                    for (int e = 0; e < 8; ++e) { const float r = (1.f + __expf(-eb[e])) * __builtin_amdgcn_rcpf(1.f + __expf(-ea[e])); acc[ai][bj][m][e >> 2][e & 3] *= r; } } }
    }
    __device__ __forceinline__ void operator()(const f32x4 (&acc)[2][2][4][2], const Unit& un, int wr, int wc, int fr, int fq) const {
        const int row0 = un.pm * BM + wr * 64 + fr, col0 = un.pn * BM + wc * 32 + 8 * fq;
#pragma unroll
        for (int ai = 0; ai < 2; ++ai)
#pragma unroll
            for (int m = 0; m < 4; ++m) { const int row = row0 + ai * HALF + m * 16; const size_t goff = (size_t)prow_of(row) * 2048 + 1024 + col0, off = (size_t)row * 1024 + col0;
#pragma unroll
                for (int bj = 0; bj < 2; ++bj) { const u32x4 g = *(const u32x4*)(gates + goff + bj * HALF); const f32x4 v0 = acc[ai][bj][m][0], v1 = acc[ai][bj][m][1];
                    u32x4 w; w.x = cvt_pk_bf16(sigm(bflo(g.x)) * v0[0], sigm(bfhi(g.x)) * v0[1]); w.y = cvt_pk_bf16(sigm(bflo(g.y)) * v0[2], sigm(bfhi(g.y)) * v0[3]);
                    w.z = cvt_pk_bf16(sigm(bflo(g.z)) * v1[0], sigm(bfhi(g.z)) * v1[1]); w.w = cvt_pk_bf16(sigm(bflo(g.w)) * v1[2], sigm(bfhi(g.w)) * v1[3]);
                    *(u32x4*)(out + off + bj * HALF) = w; } }
    }
};
struct EpiOut {
    static constexpr bool PERM = true, AFTER_DRAIN = false;
    const float* x; const float* stats; const float* g; const float* b; bf16_t* pre;
    __device__ __forceinline__ void operator()(const f32x4 (&acc)[2][2][4][2], const Unit& un, int wr, int wc, int fr, int fq) const {
        const int row0 = un.pm * BM + wr * 64 + fr, col0 = un.pn * BM + wc * 32 + 8 * fq;
#pragma unroll
        for (int bj = 0; bj < 2; ++bj) { const int col = col0 + bj * HALF; const f32x4 g0 = *(const f32x4*)(g + col), g1 = *(const f32x4*)(g + col + 4), b0 = *(const f32x4*)(b + col), b1 = *(const f32x4*)(b + col + 4);
#pragma unroll
            for (int ai = 0; ai < 2; ++ai)
#pragma unroll
                for (int m = 0; m < 4; ++m) { const int row = row0 + ai * HALF + m * 16; const float mean = stats[2 * row], rstd = stats[2 * row + 1];
                    const f32x4 x0 = *(const f32x4*)(x + (size_t)row * 1024 + col), x1 = *(const f32x4*)(x + (size_t)row * 1024 + col + 4);
                    const f32x4 v0 = ((x0 - mean) * rstd * g0 + b0) * ALPHA + acc[ai][bj][m][0], v1 = ((x1 - mean) * rstd * g1 + b1) * ALPHA + acc[ai][bj][m][1];
                    u32x4 w; w.x = cvt_pk_bf16(v0[0], v0[1]); w.y = cvt_pk_bf16(v0[2], v0[3]); w.z = cvt_pk_bf16(v1[0], v1[1]); w.w = cvt_pk_bf16(v1[2], v1[3]);
                    *(u32x4*)(pre + (size_t)row * 1024 + col) = w; } }
    }
};
}

namespace mg {
typedef unsigned u32x2 __attribute__((ext_vector_type(2)));
constexpr int STG = 49152, NSTG = 3;
__device__ __forceinline__ int swz(int r, int c16) { return r * 128 + ((c16 ^ (r & 7)) << 4); }
template <class RowPtr, class Epi>
__device__ __forceinline__ void tile(LAS unsigned char* lds, const RowPtr& rowptr, const bf16* Bt, int K, const Epi& epi) {
    const int tid = threadIdx.x, wid = __builtin_amdgcn_readfirstlane(tid >> 6), lane = tid & 63, wr = wid >> 2, wc = wid & 3, fr = lane & 15, fq = lane >> 4;
    const int lr = tid >> 3, ch = ((lane & 7) ^ ((lane >> 3) & 7)) * 8;
    const bf16* pa0 = rowptr(lr) + ch; const bf16* pa1 = rowptr(lr + 64) + ch;
    const bf16* pb = Bt + (size_t)lr * 64 + ch;
    f32x4 acc[4][4];
#pragma unroll
    for (int m = 0; m < 4; ++m)
#pragma unroll
        for (int n = 0; n < 4; ++n) acc[m][n] = (f32x4){0.f, 0.f, 0.f, 0.f};
    const int nk = K / 64;
#define MG_ISSUE(kt_) do { LAS unsigned char* sa_ = lds + ((kt_) % NSTG) * STG + wid * 1024; const int k0_ = (kt_) * 64; \
        __builtin_amdgcn_global_load_lds((const unsigned*)(pa0 + k0_), (LAS unsigned*)(sa_), 16, 0, 0); \
        __builtin_amdgcn_global_load_lds((const unsigned*)(pa1 + k0_), (LAS unsigned*)(sa_ + 8192), 16, 0, 0); \
        _Pragma("unroll") for (int j_ = 0; j_ < 4; ++j_) __builtin_amdgcn_global_load_lds((const unsigned*)(pb + (size_t)(kt_) * 16384 + j_ * 4096), (LAS unsigned*)(sa_ + 16384 + j_ * 8192), 16, 0, 0); } while (0)
    asm volatile("s_waitcnt vmcnt(0)" ::: "memory");
    __builtin_amdgcn_s_barrier();
    MG_ISSUE(0); if (nk > 1) MG_ISSUE(1);
    for (int kt = 0; kt < nk; ++kt) {
        if (kt + 1 < nk) asm volatile("s_waitcnt vmcnt(6)" ::: "memory"); else asm volatile("s_waitcnt vmcnt(0)" ::: "memory");
        __builtin_amdgcn_s_barrier();
        if (kt + 2 < nk) MG_ISSUE(kt + 2);
        const LAS unsigned char* sa = lds + (kt % NSTG) * STG; const LAS unsigned char* sb = sa + 16384;
#pragma unroll
        for (int ks = 0; ks < 2; ++ks) {
            bf16x8 a[4], w[4];
#pragma unroll
            for (int m = 0; m < 4; ++m) a[m] = *(const LAS bf16x8*)(sa + swz(64 * wr + 16 * m + fr, ks * 4 + fq));
#pragma unroll
            for (int n = 0; n < 4; ++n) w[n] = *(const LAS bf16x8*)(sb + swz(64 * wc + 16 * n + fr, ks * 4 + fq));
            __builtin_amdgcn_s_setprio(1);
#pragma unroll
            for (int m = 0; m < 4; ++m)
#pragma unroll
                for (int n = 0; n < 4; ++n) acc[m][n] = __builtin_amdgcn_mfma_f32_16x16x32_bf16(w[n], a[m], acc[m][n], 0, 0, 0);
            __builtin_amdgcn_s_setprio(0);
        }
        asm volatile("s_waitcnt lgkmcnt(0)" ::: "memory");
    }
#undef MG_ISSUE
    epi(acc, wr, wc, fr, fq);
}

struct Src { const bf16* pa0; const bf16* pa1; const bf16* pb; };
template <class Epi>
__device__ __forceinline__ void tile_pipe(LAS unsigned char* lds, const Src& cur, int nk, bool first, bool has_next, const Src& nxt, int& sbase, const Epi& epi, unsigned* sig = nullptr) {
    const int tid = threadIdx.x, wid = __builtin_amdgcn_readfirstlane(tid >> 6), lane = tid & 63, wr = wid >> 2, wc = wid & 3, fr = lane & 15, fq = lane >> 4;
    f32x4 acc[4][4];
#pragma unroll
    for (int m = 0; m < 4; ++m)
#pragma unroll
        for (int n = 0; n < 4; ++n) acc[m][n] = (f32x4){0.f, 0.f, 0.f, 0.f};
#define MG_ISSUE2(S_, kt_, slot_) do { LAS unsigned char* sa_ = lds + (slot_) * STG + wid * 1024; const int k0_ = (kt_) * 64; \
        __builtin_amdgcn_global_load_lds((const unsigned*)((S_).pa0 + k0_), (LAS unsigned*)(sa_), 16, 0, 0); \
        __builtin_amdgcn_global_load_lds((const unsigned*)((S_).pa1 + k0_), (LAS unsigned*)(sa_ + 8192), 16, 0, 0); \
        _Pragma("unroll") for (int j_ = 0; j_ < 4; ++j_) __builtin_amdgcn_global_load_lds((const unsigned*)((S_).pb + (size_t)(kt_) * 16384 + j_ * 4096), (LAS unsigned*)(sa_ + 16384 + j_ * 8192), 16, 0, 0); } while (0)
    int slot = sbase;
    if (first) {
        asm volatile("s_waitcnt vmcnt(0)" ::: "memory");
        __builtin_amdgcn_s_barrier();
        MG_ISSUE2(cur, 0, slot); MG_ISSUE2(cur, 1, (slot + 1 >= NSTG ? slot + 1 - NSTG : slot + 1));
    }
    for (int kt = 0; kt < nk; ++kt) {
        if (kt == 0 && sig) asm volatile("s_waitcnt vmcnt(0)" ::: "memory"); else asm volatile("s_waitcnt vmcnt(6)" ::: "memory");
        __builtin_amdgcn_s_barrier();
        if (kt == 0 && sig && tid == 0) (void)__hip_atomic_fetch_add(sig, 1u, __ATOMIC_RELAXED, __HIP_MEMORY_SCOPE_AGENT);
        const LAS unsigned char* sa = lds + slot * STG; const LAS unsigned char* sb = sa + 16384;
        bf16x8 a0[4], w0[4], a1[4], w1[4];
#pragma unroll
        for (int m = 0; m < 4; ++m) a0[m] = *(const LAS bf16x8*)(sa + swz(64 * wr + 16 * m + fr, fq));
#pragma unroll
        for (int n = 0; n < 4; ++n) w0[n] = *(const LAS bf16x8*)(sb + swz(64 * wc + 16 * n + fr, fq));
        { const bool own = kt + 2 < nk; const int kk = own ? kt + 2 : kt + 2 - nk, s2 = slot + 2 >= NSTG ? slot + 2 - NSTG : slot + 2;
          Src S; S.pa0 = own ? cur.pa0 : nxt.pa0; S.pa1 = own ? cur.pa1 : nxt.pa1; S.pb = own ? cur.pb : nxt.pb;
          MG_ISSUE2(S, kk, s2); }
        __builtin_amdgcn_sched_barrier(0);
        __builtin_amdgcn_s_setprio(1);
#pragma unroll
        for (int n = 0; n < 4; ++n) acc[0][n] = __builtin_amdgcn_mfma_f32_16x16x32_bf16(w0[n], a0[0], acc[0][n], 0, 0, 0);
        __builtin_amdgcn_sched_barrier(0);
#pragma unroll
        for (int m = 0; m < 4; ++m) a1[m] = *(const LAS bf16x8*)(sa + swz(64 * wr + 16 * m + fr, 4 + fq));
        __builtin_amdgcn_sched_barrier(0);
#pragma unroll
        for (int n = 0; n < 4; ++n) acc[1][n] = __builtin_amdgcn_mfma_f32_16x16x32_bf16(w0[n], a0[1], acc[1][n], 0, 0, 0);
        __builtin_amdgcn_sched_barrier(0);
#pragma unroll
        for (int n = 0; n < 4; ++n) w1[n] = *(const LAS bf16x8*)(sb + swz(64 * wc + 16 * n + fr, 4 + fq));
        __builtin_amdgcn_sched_barrier(0);
#pragma unroll
        for (int m = 2; m < 4; ++m)
#pragma unroll
            for (int n = 0; n < 4; ++n) acc[m][n] = __builtin_amdgcn_mfma_f32_16x16x32_bf16(w0[n], a0[m], acc[m][n], 0, 0, 0);
        __builtin_amdgcn_sched_barrier(0);
#pragma unroll
        for (int m = 0; m < 4; ++m)
#pragma unroll
            for (int n = 0; n < 4; ++n) acc[m][n] = __builtin_amdgcn_mfma_f32_16x16x32_bf16(w1[n], a1[m], acc[m][n], 0, 0, 0);
        __builtin_amdgcn_s_setprio(0);
        asm volatile("s_waitcnt lgkmcnt(0)" ::: "memory");
        slot = slot + 1 >= NSTG ? slot + 1 - NSTG : slot + 1;
    }
#undef MG_ISSUE2
    sbase = slot;
    epi(acc, wr, wc, fr, fq);
}

template <class Epi>
__device__ __forceinline__ void down_unit(LAS unsigned char* lds, const bf16* A  , int ntiles, const bf16* Bt  , Epi& epi) {
    const int tid = threadIdx.x, wid = __builtin_amdgcn_readfirstlane(tid >> 6), lane = tid & 63, wr = wid >> 1, wc = wid & 1, fr = lane & 15, fq = lane >> 4;
    const int lr = tid >> 3;
    __syncthreads();
#pragma unroll
    for (int j = 0; j < 4; ++j)
#pragma unroll
        for (int kk = 0; kk < 4; ++kk) { const int r = lr + 64 * j, c = lane & 7;
            *(LAS v4u*)(lds + kk * 32768 + swz(r, c)) = *(const v4u*)(Bt + (size_t)r * 256 + kk * 64 + c * 8); }
    __syncthreads();
#pragma unroll 1
    for (int mt = 0; mt < ntiles; ++mt) {
        int fr_ = fr; asm volatile("" : "+v"(fr_));
        bf16x8 a[2][8];
#pragma unroll
        for (int m = 0; m < 2; ++m)
#pragma unroll
            for (int ks = 0; ks < 8; ++ks) a[m][ks] = *(const bf16x8*)(A + (size_t)(128 * mt + 32 * wr + 16 * m + fr) * 256 + 32 * ks + 8 * fq);
        epi.prepare(mt, wr, fr);
        f32x4 acc[2][8];
#pragma unroll
        for (int m = 0; m < 2; ++m)
#pragma unroll
            for (int n = 0; n < 8; ++n) acc[m][n] = (f32x4){0.f, 0.f, 0.f, 0.f};
#pragma unroll
        for (int ks = 0; ks < 8; ++ks) { bf16x8 w[8];
#pragma unroll
            for (int n = 0; n < 8; ++n) w[n] = *(const LAS bf16x8*)(lds + (ks >> 1) * 32768 + swz(128 * wc + 16 * n + fr_, (ks & 1) * 4 + fq));
#pragma unroll
            for (int m = 0; m < 2; ++m)
#pragma unroll
                for (int n = 0; n < 8; ++n) acc[m][n] = __builtin_amdgcn_mfma_f32_16x16x32_bf16(w[n], a[m][ks], acc[m][n], 0, 0, 0); }
        epi(acc, wr, wc, fr, fq);
    }
}
struct DownArgs { const bf16* A; int ntiles; const bf16* Bt; const int* lst; const float* route; int cnt; bf16* slots; int c0; };
template <int MODE>
__device__ __forceinline__ void down_unit(LAS unsigned char* lds, const DownArgs& U) {
    const int tid = threadIdx.x, wid = __builtin_amdgcn_readfirstlane(tid >> 6), lane = tid & 63, wr = wid >> 1, wc = wid & 1, fr = lane & 15, fq = lane >> 4;
    const int lr = tid >> 3;
    LAS int* PT = (LAS int*)(lds + 131072);
    __syncthreads();
#pragma unroll
    for (int j = 0; j < 4; ++j)
#pragma unroll
        for (int kk = 0; kk < 4; ++kk) { const int r = lr + 64 * j, c = lane & 7;
            *(LAS v4u*)(lds + kk * 32768 + swz(r, c)) = *(const v4u*)(U.Bt + (size_t)r * 256 + kk * 64 + c * 8); }
#define MGD_LOADA(dst_, mt_) do { _Pragma("unroll") for (int m_ = 0; m_ < 2; ++m_) _Pragma("unroll") for (int ks_ = 0; ks_ < 8; ++ks_) \
        dst_[m_][ks_] = *(const bf16x8*)(U.A + (size_t)(128 * (mt_) + 32 * wr + 16 * m_ + fr) * 256 + 32 * ks_ + 8 * fq); } while (0)
    bf16x8 a[2][8], an[2][8];
    MGD_LOADA(a, 0);
#pragma unroll 1
    for (int mt = 0; mt < U.ntiles; ++mt) {
        if ((mt & 3) == 0) {
            if (mt) __syncthreads();
            const int li = 128 * mt + tid; const int pp = li < U.cnt ? U.lst[li] : -1;
            PT[tid] = pp; PT[512 + tid] = pp < 0 ? 0 : __builtin_bit_cast(int, U.route[(size_t)(pp >> 1) * 8 + 4 + (pp & 1)]);
            __syncthreads();
        }
        if (mt + 1 < U.ntiles) MGD_LOADA(an, mt + 1);
        int fr_ = fr; asm volatile("" : "+v"(fr_));
        f32x4 acc[2][8];
#pragma unroll
        for (int m = 0; m < 2; ++m)
#pragma unroll
            for (int n = 0; n < 8; ++n) acc[m][n] = (f32x4){0.f, 0.f, 0.f, 0.f};
#pragma unroll
        for (int ks = 0; ks < 8; ++ks)
#pragma unroll
            for (int nh = 0; nh < 2; ++nh) { bf16x8 w[4];
#pragma unroll
                for (int n = 0; n < 4; ++n) w[n] = *(const LAS bf16x8*)(lds + (ks >> 1) * 32768 + swz(128 * wc + 16 * (4 * nh + n) + fr_, (ks & 1) * 4 + fq));
#pragma unroll
                for (int m = 0; m < 2; ++m)
#pragma unroll
                    for (int n = 0; n < 4; ++n) acc[m][4 * nh + n] = __builtin_amdgcn_mfma_f32_16x16x32_bf16(w[n], a[m][ks], acc[m][4 * nh + n], 0, 0, 0); }
#pragma unroll
        for (int m = 0; m < 2; ++m) { const int ti = 128 * (mt & 3) + 32 * wr + 16 * m + fr_; const int pp = PT[ti]; const float gt = __builtin_bit_cast(float, PT[512 + ti]);
            if (MODE == 1) { _Pragma("unroll") for (int n = 0; n < 8; ++n) asm volatile("" :: "v"(acc[m][n])); }
            else if (pp >= 0) {
#pragma unroll
                for (int n = 0; n < 8; ++n) { const f32x4 v = acc[m][n] * gt; u32x2 w2; w2.x = pk2(v[0], v[1]); w2.y = pk2(v[2], v[3]);
                    *(u32x2*)(U.slots + (size_t)pp * 1024 + U.c0 + 128 * wc + 16 * n + 4 * fq) = w2; } } }
#pragma unroll
        for (int m = 0; m < 2; ++m)
#pragma unroll
            for (int ks = 0; ks < 8; ++ks) a[m][ks] = an[m][ks];
    }
#undef MGD_LOADA
}
}

struct Ctx {
    LAS unsigned char* lds; int tid, lane, wave, wg, G;
    const float* const* in; float* out; unsigned char* ws; gu32* ctl;
};

template <bool NT>
__device__ __forceinline__ void transpose_item(const float* W, int K, int N, bf16* WT, int mode, int row_off, int s13, LAS float* scr, int item, int lane) {
    const int nblk = (N + 31) / 32, kb = item / nblk, nb = item % nblk, k0 = 64 * kb, n0 = 32 * nb;
    const int kk = lane >> 3, n4 = (lane & 7) * 4; const bool ok = n0 + n4 < N;
    f32x4 v[8];
#pragma unroll
    for (int i = 0; i < 8; ++i) { const f32x4* p = (const f32x4*)(W + (size_t)(k0 + 8 * i + kk) * N + n0 + n4);
        v[i] = ok ? (NT ? __builtin_nontemporal_load(p) : *p) : (f32x4){0.f, 0.f, 0.f, 0.f}; }
#pragma unroll
    for (int i = 0; i < 8; ++i) { LAS float* s = scr + (8 * i + kk) * 33 + n4; s[0] = v[i].x; s[1] = v[i].y; s[2] = v[i].z; s[3] = v[i].w; }
    LDS_WAIT(); asm volatile("" ::: "memory");
    const int c = lane & 7;
#pragma unroll
    for (int j = 0; j < 4; ++j) { const int n = (lane >> 3) + 8 * j; const LAS float* s = scr + (8 * c) * 33 + n;
        v4u o; o.x = pk2(s[0 * 33], s[1 * 33]); o.y = pk2(s[2 * 33], s[3 * 33]); o.z = pk2(s[4 * 33], s[5 * 33]); o.w = pk2(s[6 * 33], s[7 * 33]);
        const int orow = ((mode & 1) == 0) ? (row_off + n0 + n) : (row_off + 2 * n0 + n + (n >= 16 ? 16 : 0) + 16 * s13);
        if (n0 + n < N) { const size_t off = (mode & 2) ? ((size_t)((orow >> 8) * (K >> 6) + (k0 >> 6)) * 16384 + (size_t)(orow & 255) * 64 + 8 * c) : ((size_t)orow * K + k0 + 8 * c); *(GAS v4u*)(WT + off) = o; } }
    LDS_WAIT(); asm volatile("" ::: "memory");
}
__device__ __forceinline__ void ln_row(f32x4 (&v)[4], const float* g, const float* b, int lane, float scale_in, float& mean_o, float& rstd_o) {
    float s = 0.f;
#pragma unroll
    for (int j = 0; j < 4; ++j) { v[j] = v[j] * scale_in; s += (v[j].x + v[j].y) + (v[j].z + v[j].w); }
    const float mean = wave_sum(s) * (1.f / D); float s2 = 0.f;
#pragma unroll
    for (int j = 0; j < 4; ++j) { v[j] = v[j] - mean; s2 += (v[j].x * v[j].x + v[j].y * v[j].y) + (v[j].z * v[j].z + v[j].w * v[j].w); }
    const float rstd = __builtin_amdgcn_rsqf(wave_sum(s2) * (1.f / D) + LN_EPS);
#pragma unroll
    for (int j = 0; j < 4; ++j) { const f32x4 gv = *(const f32x4*)(g + 4 * lane + 256 * j), bv = *(const f32x4*)(b + 4 * lane + 256 * j); v[j] = v[j] * rstd * gv + bv; }
    mean_o = mean; rstd_o = rstd;
}

__device__ __forceinline__ void phase0(const Ctx& C) {
    LAS float* scr = (LAS float*)(C.lds + C.wave * 16384);
    const int gw = C.wg * NWAVES + C.wave, NGW = C.G * NWAVES, lane = C.lane;
    bf16* WINT = (bf16*)(C.ws + WS_WINT); bf16* WGLU = (bf16*)(C.ws + WS_WGLU); bf16* WBR = (bf16*)(C.ws + WS_WBR); bf16* WOUT = (bf16*)(C.ws + WS_WOUT); bf16* WRT = (bf16*)(C.ws + WS_WRT);
    constexpr int I_IN = 16 * 145, I_GLU = 8 * 16, I_BR = 8 * 32, I_OUT = 16 * 32, I_RG = 16, I_RE = 32;
    constexpr int NITEMS = I_IN + I_GLU + 2 * I_BR + I_OUT + I_RG + I_RE;
    for (int it = gw; it < NITEMS; it += NGW) {
        int r = it;
        if (r < I_IN) { transpose_item<false>(C.in[4], 1024, INW, WINT, 0, 0, 0, scr, r, lane); continue; } r -= I_IN;
        if (r < I_GLU) { transpose_item<false>(C.in[17], 512, 512, WGLU, 0, 0, 0, scr, r, lane); continue; } r -= I_GLU;
        if (r < I_BR) { transpose_item<false>(C.in[19], 512, 1024, WBR, 0, 0, 0, scr, r, lane); continue; } r -= I_BR;
        if (r < I_BR) { transpose_item<false>(C.in[19] + 512 * 1024, 512, 1024, WBR + 1024 * 512, 0, 0, 0, scr, r, lane); continue; } r -= I_BR;
        if (r < I_OUT) { transpose_item<false>(C.in[20], 1024, 1024, WOUT, 0, 0, 0, scr, r, lane); continue; } r -= I_OUT;
        if (r < I_RG) { transpose_item<false>(C.in[23], 1024, 8, WRT, 0, 0, 0, scr, r, lane); continue; } r -= I_RG;
        transpose_item<false>(C.in[25], 1024, 64, WRT, 0, 8, 0, scr, r, lane);
    }
    for (int it = gw; it < (INWP - INW) + 8; it += NGW) { bf16* rowp = (it < INWP - INW) ? WINT + (size_t)(INW + it) * 1024 : WRT + (size_t)(72 + it - (INWP - INW)) * 1024;
        GAS v4u* o = (GAS v4u*)rowp + lane; o[0] = (v4u){0u, 0u, 0u, 0u}; o[64] = (v4u){0u, 0u, 0u, 0u}; }
    bf16* H0B = (bf16*)(C.ws + WS_H0B); float* stats = (float*)(C.ws + WS_STATS);
    const float* x = C.in[0]; const float* meta = C.in[1]; const float* g = C.in[2]; const float* b = C.in[3];
    for (int rp0 = gw * 2; rp0 < MP; rp0 += NGW * 2) {
        f32x4 v[2][4]; int kind[2];
#pragma unroll
        for (int rr = 0; rr < 2; ++rr) { const int rp = rp0 + rr, bb = rp / LP, i = rp % LP; kind[rr] = i < PADF ? 0 : (i < 64 ? 1 : 2);
            const float* src = (i < PADF) ? x : ((i < 64) ? meta + (size_t)(i - PADF) * D : x + ((size_t)bb * SEQ + (i - 64)) * D);
#pragma unroll
            for (int j = 0; j < 4; ++j) v[rr][j] = *(const f32x4*)(src + 4 * lane + 256 * j); }
#pragma unroll
        for (int rr = 0; rr < 2; ++rr) { const int rp = rp0 + rr, bb = rp / LP, i = rp % LP;
            GAS unsigned long long* o8 = (GAS unsigned long long*)(H0B + (size_t)rp * D) + lane;
            if (kind[rr] == 0) {
#pragma unroll
                for (int j = 0; j < 4; ++j) o8[64 * j] = 0ull;
                continue; }
            float mean, rstd; ln_row(v[rr], g, b, lane, 1.f, mean, rstd);
            if (kind[rr] == 2 && lane == 0) { const int xr = bb * SEQ + (i - 64); stats[2 * xr] = mean; stats[2 * xr + 1] = rstd; }
#pragma unroll
            for (int j = 0; j < 4; ++j) o8[64 * j] = (unsigned long long)pk2(v[rr][j].x, v[rr][j].y) | ((unsigned long long)pk2(v[rr][j].z, v[rr][j].w) << 32); }
    }
}

__device__ __forceinline__ void phase2_elem(const Ctx& C) {
    const int gw = C.wg * NWAVES + C.wave, NGW = C.G * NWAVES, lane = C.lane;
    const bf16* qkv = (const bf16*)(C.ws + WS_QKV); const float* ab = (const float*)(C.ws + WS_AB);
    bf16* qn = (bf16*)((unsigned char*)C.out + DO_QN); bf16* kn = (bf16*)((unsigned char*)C.out + DO_KN); bf16* vn = (bf16*)((unsigned char*)C.out + DO_VN);
    float* beta = (float*)((unsigned char*)C.out + DO_BETA); float* alpha = (float*)((unsigned char*)C.out + DO_ALPHA);
    const float* cw = C.in[5]; const float* a_log = C.in[6]; const float* dt_bias = C.in[7];
    for (int it = gw; it < MP * NH; it += NGW) {
        const int rp = it >> 3, h = it & 7, i = rp % LP; const size_t o = (size_t)rp * 512 + h * 64 + lane;
        if (i < PADF) { qn[o] = 0; kn[o] = 0; vn[o] = 0; if (lane == 0) { beta[rp * 8 + h] = 0.f; alpha[rp * 8 + h] = 1.f; } continue; }
        float aq = 0.f, ak = 0.f, av = 0.f; const int ch = h * 64 + lane;
#pragma unroll
        for (int j = 0; j < 4; ++j) { const bf16* r = qkv + (size_t)(rp - 3 + j) * 1536 + ch;
            aq += cw[j * 1536 + ch] * bf2f(r[0]); ak += cw[j * 1536 + 512 + ch] * bf2f(r[512]); av += cw[j * 1536 + 1024 + ch] * bf2f(r[1024]); }
        float q = silu_(aq), k = silu_(ak), v = silu_(av);
        const float sq = wave_sum(q * q), sk = wave_sum(k * k);
        q *= (__builtin_amdgcn_rsqf(sq + NORM_EPS)) * 0.125f; k *= __builtin_amdgcn_rsqf(sk + NORM_EPS);
        qn[o] = (bf16)f2bf(q); kn[o] = (bf16)f2bf(k); vn[o] = (bf16)f2bf(v);
        if (lane == 0) { const float a = ab[rp * 16 + h], bb = ab[rp * 16 + 8 + h];
            beta[rp * 8 + h] = sigm(bb); alpha[rp * 8 + h] = expf(-expf(a_log[h]) * softplus_(a + dt_bias[h])); }
    }
}

__device__ __forceinline__ void dn_scan_naive(const Ctx& C, int b, int h) {
    if (C.wave != 0) return;
    const int lane = C.lane;
    LAS float* Kl = (LAS float*)C.lds; LAS float* Ql = Kl + 4096; LAS float* Vl = Ql + 4096; LAS float* Zl = Vl + 4096; LAS float* Bl = Zl + 4096; LAS float* Al = Bl + 64;
    const bf16* qn = (const bf16*)((unsigned char*)C.out + DO_QN); const bf16* kn = (const bf16*)((unsigned char*)C.out + DO_KN); const bf16* vn = (const bf16*)((unsigned char*)C.out + DO_VN);
    const float* beta = (const float*)((unsigned char*)C.out + DO_BETA); const float* alpha = (const float*)((unsigned char*)C.out + DO_ALPHA);
    const bf16* z = (const bf16*)(C.ws + WS_Z); bf16* oa = (bf16*)(C.ws + WS_OA);
    const float nw = C.in[8][lane];
    float S[64];
#pragma unroll
    for (int k = 0; k < 64; ++k) S[k] = 0.f;
    for (int n = 0; n < NCH; ++n) {
        const int base = b * LP + 64 * n;
#pragma unroll 8
        for (int i = 0; i < 64; ++i) { const size_t off = (size_t)(base + i) * 512 + h * 64 + lane;
            Kl[i * 64 + lane] = bf2f(kn[off]); Ql[i * 64 + lane] = bf2f(qn[off]); Vl[i * 64 + lane] = bf2f(vn[off]); Zl[i * 64 + lane] = bf2f(z[off]); }
        Bl[lane] = beta[(base + lane) * 8 + h]; Al[lane] = alpha[(base + lane) * 8 + h];
        asm volatile("s_waitcnt vmcnt(0) lgkmcnt(0)" ::: "memory");
#pragma unroll 1
        for (int i = 0; i < 64; ++i) {
            const LAS f32x4* kr = (const LAS f32x4*)(Kl + i * 64); const LAS f32x4* qr = (const LAS f32x4*)(Ql + i * 64);
            const float at = Al[i], bt = Bl[i], vt = Vl[i * 64 + lane];
            float d0 = 0.f, d1 = 0.f, d2 = 0.f, d3 = 0.f;
#pragma unroll
            for (int k4 = 0; k4 < 16; ++k4) { const f32x4 kk = kr[k4]; d0 += S[4 * k4] * kk.x; d1 += S[4 * k4 + 1] * kk.y; d2 += S[4 * k4 + 2] * kk.z; d3 += S[4 * k4 + 3] * kk.w; }
            const float vnew = bt * (vt - at * ((d0 + d1) + (d2 + d3)));
            float o0 = 0.f, o1 = 0.f, o2 = 0.f, o3 = 0.f;
#pragma unroll
            for (int k4 = 0; k4 < 16; ++k4) { const f32x4 kk = kr[k4], qq = qr[k4];
                S[4 * k4] = at * S[4 * k4] + kk.x * vnew; S[4 * k4 + 1] = at * S[4 * k4 + 1] + kk.y * vnew; S[4 * k4 + 2] = at * S[4 * k4 + 2] + kk.z * vnew; S[4 * k4 + 3] = at * S[4 * k4 + 3] + kk.w * vnew;
                o0 += S[4 * k4] * qq.x; o1 += S[4 * k4 + 1] * qq.y; o2 += S[4 * k4 + 2] * qq.z; o3 += S[4 * k4 + 3] * qq.w; }
            if (n >= 1) { const float o = (o0 + o1) + (o2 + o3); const float ss = wave_sum(o * o);
                const float on = o * (__builtin_amdgcn_rsqf(ss * (1.f / 64.f) + NORM_EPS)) * nw * silu_(Zl[i * 64 + lane]);
                oa[(size_t)(b * SEQ + 64 * (n - 1) + i) * 512 + h * 64 + lane] = (bf16)f2bf(on); }
        }
    }
}
__device__ __forceinline__ void s5_naive(const Ctx& C, int b, int g) {
    const int tid = C.tid, lane = C.lane;
    LAS float* uu = (LAS float*)C.lds; LAS float* hh = uu + 1024; LAS float* Cc = hh + 8192; LAS float* Dd = Cc + 2048;
    const bf16* u = (const bf16*)(C.ws + WS_U); bf16* yb = (bf16*)(C.ws + WS_YB);
    const float* c_re = C.in[14] + (size_t)g * 16 * 64; const float* c_im = C.in[15] + (size_t)g * 16 * 64;
    for (int e = tid; e < 1024; e += 512) { const int c = e >> 6, p = e & 63; Cc[c * 128 + p] = c_re[c * 64 + p]; Cc[c * 128 + 64 + p] = -c_im[c * 64 + p]; }
    if (tid < 16) Dd[tid] = C.in[16][g * 16 + tid];
    float ar = 0.f, ai = 0.f, Bbr[16], Bbi[16], hr = 0.f, hi = 0.f;
    if (C.wave == 0) {
        const float dt = expf(C.in[11][g]); const float a_r = C.in[9][g * 64 + lane], a_i = C.in[10][g * 64 + lane];
        const float mag = expf(dt * a_r); ar = mag * cosf(dt * a_i); ai = mag * sinf(dt * a_i);
        const float den = a_r * a_r + a_i * a_i, nr = ar - 1.f, ni = ai;
        const float f_re = (nr * a_r + ni * a_i) / den, f_im = (ni * a_r - nr * a_i) / den;
        const float* br = C.in[12] + ((size_t)g * 64 + lane) * 16; const float* bi = C.in[13] + ((size_t)g * 64 + lane) * 16;
#pragma unroll
        for (int c = 0; c < 16; ++c) { Bbr[c] = f_re * br[c] - f_im * bi[c]; Bbi[c] = f_re * bi[c] + f_im * br[c]; }
    }
    for (int n = 0; n < NCH; ++n) {
        const int base = b * LP + 64 * n;
        { const int row = tid >> 3, c2 = (tid & 7) * 2; const unsigned w = *(const unsigned*)(u + (size_t)(base + row) * 512 + g * 16 + c2); uu[row * 16 + c2] = bflo(w); uu[row * 16 + c2 + 1] = bfhi(w); }
        __syncthreads();
        if (C.wave == 0) {
#pragma unroll 4
            for (int t = 0; t < 64; ++t) { float bur = 0.f, bui = 0.f;
#pragma unroll
                for (int c4 = 0; c4 < 4; ++c4) { const f32x4 uv = *(const LAS f32x4*)(uu + t * 16 + 4 * c4);
                    bur += Bbr[4 * c4] * uv.x + Bbr[4 * c4 + 1] * uv.y + Bbr[4 * c4 + 2] * uv.z + Bbr[4 * c4 + 3] * uv.w;
                    bui += Bbi[4 * c4] * uv.x + Bbi[4 * c4 + 1] * uv.y + Bbi[4 * c4 + 2] * uv.z + Bbi[4 * c4 + 3] * uv.w; }
                const float nhr = ar * hr - ai * hi + bur, nhi = ar * hi + ai * hr + bui; hr = nhr; hi = nhi;
                hh[t * 128 + lane] = hr; hh[t * 128 + 64 + lane] = hi; }
        }
        __syncthreads();
        if (n >= 1) { const int t = tid >> 3;
#pragma unroll
            for (int cc = 0; cc < 2; ++cc) { const int c = (tid & 7) + 8 * cc; float a0 = 0.f, a1 = 0.f;
#pragma unroll 8
                for (int p4 = 0; p4 < 32; ++p4) { const f32x4 cv = *(const LAS f32x4*)(Cc + c * 128 + 4 * p4), hv = *(const LAS f32x4*)(hh + t * 128 + 4 * p4); a0 += cv.x * hv.x + cv.y * hv.y; a1 += cv.z * hv.z + cv.w * hv.w; }
                const float y = a0 + a1 + Dd[c] * uu[t * 16 + c];
                yb[(size_t)(b * SEQ + 64 * (n - 1) + t) * 512 + g * 16 + c] = (bf16)f2bf(gelu_tanh(y)); } }
        __syncthreads();
    }
}
constexpr int CW_CONV = 16640, CONV_SHARD = NE * 384 / 8;
__device__ __forceinline__ void convert_experts(const Ctx& C, int qi, unsigned first, unsigned limit) {
    (void)qi; (void)first; (void)limit;
    LAS float* scr = (LAS float*)(C.lds + C.wave * 16384);
    bf16* W13 = (bf16*)(C.ws + WS_W13); bf16* W2 = (bf16*)(C.ws + WS_W2);
    constexpr unsigned CCH = 4;
    static_assert(CONV_SHARD % CCH == 0 && 128 % CCH == 0, "conversion chunks");
#pragma unroll 1
    for (int q = 0; q < 8; ++q) { const int sh = (C.wg + q) & 7;
        unsigned li = 0; if (C.lane == 0) li = __hip_atomic_fetch_add(C.ctl + CW_CONV + 64 * sh, CCH, __ATOMIC_RELAXED, __HIP_MEMORY_SCOPE_AGENT);
        li = __builtin_amdgcn_readfirstlane(li);
#pragma unroll 1
        while (li < (unsigned)CONV_SHARD) {
            unsigned ln = 0; if (C.lane == 0) ln = __hip_atomic_fetch_add(C.ctl + CW_CONV + 64 * sh, CCH, __ATOMIC_RELAXED, __HIP_MEMORY_SCOPE_AGENT);
#pragma unroll 1
            for (unsigned k = 0; k < CCH; ++k) {
                const int it = sh * CONV_SHARD + (int)(li + k), e = it / 384, r = it % 384;
                if (r < 128) transpose_item<true>(C.in[27] + (size_t)e * 1024 * 256, 1024, 256, W13 + (size_t)e * 512 * 1024, 3, 0, 0, scr, r, C.lane);
                else if (r < 256) transpose_item<true>(C.in[28] + (size_t)e * 1024 * 256, 1024, 256, W13 + (size_t)e * 512 * 1024, 3, 0, 1, scr, r - 128, C.lane);
                else transpose_item<true>(C.in[29] + (size_t)e * 256 * 1024, 256, 1024, W2 + (size_t)e * 1024 * 256, 2, 0, 0, scr, r - 256, C.lane); }
            li = __builtin_amdgcn_readfirstlane(ln); }
    }
}
template <int MODE>
__device__ __forceinline__ void phase7_rows(const Ctx& C) {
    constexpr int RS = 2064, RB = 64;
    LAS unsigned char* Ht = C.lds; LAS float* Lg = (LAS float*)(C.lds + RB * RS);
    const bf16* pre = (const bf16*)(C.ws + WS_PRE); bf16* h1 = (bf16*)(C.ws + WS_H1); const bf16* WRT = (const bf16*)(C.ws + WS_WRT);
    const float* g1 = C.in[21]; const float* b1 = C.in[22]; const float* b_rg = C.in[24]; const float* b_re = C.in[26];
    int* route = (int*)(C.ws + WS_ROUTE); gu32* cnt = C.ctl + CW_CNT; int* inv2 = (int*)(C.ws + WS_INV2);
    const int lane = C.lane, wave = C.wave, fr = lane & 15, fq = lane >> 4;
    for (int blk = C.wg; blk < MX / RB; blk += C.G) {
#pragma unroll 1
        for (int hh = 0; hh < 2; ++hh) { f32x4 v[4][4];
#pragma unroll
            for (int rr = 0; rr < 4; ++rr)
#pragma unroll
                for (int j = 0; j < 4; ++j) { const mg::u32x2 pw = *(const mg::u32x2*)(pre + ((size_t)blk * RB + wave * 8 + hh * 4 + rr) * D + 4 * lane + 256 * j); v[rr][j] = (f32x4){bflo(pw.x), bfhi(pw.x), bflo(pw.y), bfhi(pw.y)}; }
#pragma unroll
            for (int rr = 0; rr < 4; ++rr) { const int r = wave * 8 + hh * 4 + rr; const size_t row = (size_t)blk * RB + r;
                float mean, rstd; ln_row(v[rr], g1, b1, lane, 1.f, mean, rstd);
                GAS unsigned long long* o8 = (GAS unsigned long long*)(h1 + row * D) + lane;
#pragma unroll
                for (int j = 0; j < 4; ++j) { const unsigned long long w = (unsigned long long)pk2(v[rr][j].x, v[rr][j].y) | ((unsigned long long)pk2(v[rr][j].z, v[rr][j].w) << 32);
                    if (MODE == 0) o8[64 * j] = w; *(LAS unsigned long long*)(Ht + r * RS + (4 * lane + 256 * j) * 2) = w; } } }
        __syncthreads();
        { const int kq = wave & 3, ch2 = wave >> 2, t0 = ch2 ? 3 : 0;
            bf16x8 wb[3][8];
            const bf16* w0 = WRT + (size_t)(16 * t0 + fr) * 1024 + kq * 256 + fq * 8;
#pragma unroll
            for (int t = 0; t < 3; ++t)
#pragma unroll
                for (int s8 = 0; s8 < 8; ++s8) if (t < 2 || !ch2) wb[t][s8] = *(const bf16x8*)(w0 + (size_t)t * 16 * 1024 + s8 * 32);
            f32x4 ac[4][3];
#pragma unroll
            for (int rg = 0; rg < 4; ++rg)
#pragma unroll
                for (int t = 0; t < 3; ++t) ac[rg][t] = (f32x4){0.f, 0.f, 0.f, 0.f};
#pragma unroll
            for (int s8 = 0; s8 < 8; ++s8)
#pragma unroll
                for (int rg = 0; rg < 4; ++rg) { const bf16x8 af = *(const LAS bf16x8*)(Ht + (16 * rg + fr) * RS + fq * 16 + (8 * kq + s8) * 64);
                    ac[rg][0] = __builtin_amdgcn_mfma_f32_16x16x32_bf16(wb[0][s8], af, ac[rg][0], 0, 0, 0);
                    ac[rg][1] = __builtin_amdgcn_mfma_f32_16x16x32_bf16(wb[1][s8], af, ac[rg][1], 0, 0, 0);
                    if (!ch2) ac[rg][2] = __builtin_amdgcn_mfma_f32_16x16x32_bf16(wb[2][s8], af, ac[rg][2], 0, 0, 0); }
            __syncthreads();
            LAS float* Pq = (LAS float*)Ht + kq * (RB * 80);
#pragma unroll
            for (int rg = 0; rg < 4; ++rg)
#pragma unroll
                for (int t = 0; t < 3; ++t) if (t < 2 || !ch2) *(LAS f32x4*)(Pq + (16 * rg + fr) * 80 + 16 * (t0 + t) + 4 * fq) = ac[rg][t];
            __syncthreads();
            for (int g4 = C.tid; g4 < RB * 80 / 4; g4 += NWAVES * 64) { const LAS f32x4* pp = (const LAS f32x4*)Ht + g4;
                const f32x4 p0 = pp[0], p1 = pp[RB * 80 / 4], p2 = pp[2 * (RB * 80 / 4)], p3 = pp[3 * (RB * 80 / 4)];
                ((LAS f32x4*)Lg)[g4] = (p0 + p1) + (p2 + p3); } }
        __syncthreads();
        LAS unsigned* hist = (LAS unsigned*)Ht;
        if (C.tid < NE) hist[C.tid] = 0u;
        __syncthreads();
        int e0 = 0, e1 = 0, l0 = 0, l1 = 0; float gw0 = 0.f, gw1 = 0.f;
        if (C.tid < RB) { const LAS float* L = Lg + C.tid * 80;
            float lg[8]; float mx = -3.0e38f; int gi = 0;
#pragma unroll
            for (int j = 0; j < 8; ++j) { lg[j] = L[j] + b_rg[j]; if (lg[j] > mx) { mx = lg[j]; gi = j; } }
            float se = 0.f;
#pragma unroll
            for (int j = 0; j < 8; ++j) se += __expf(lg[j] - mx);
            const float gp = 1.f / se;
            float t0 = -3.0e38f, t1 = -3.0e38f; int i0 = 0, i1 = 0;
#pragma unroll
            for (int j = 0; j < 8; ++j) { const float le = L[8 + gi * 8 + j] + b_re[gi * 8 + j];
                if (le > t0) { t1 = t0; i1 = i0; t0 = le; i0 = j; } else if (le > t1) { t1 = le; i1 = j; } }
            const float w0 = 1.f / (1.f + __expf(t1 - t0)), w1 = 1.f - w0;
            e0 = gi * 8 + i0; e1 = gi * 8 + i1; gw0 = w0 * gp; gw1 = w1 * gp;
            if (MODE == 0) { l0 = (int)__hip_atomic_fetch_add((unsigned*)(hist + e0), 1u, __ATOMIC_RELAXED, __HIP_MEMORY_SCOPE_WORKGROUP); l1 = (int)__hip_atomic_fetch_add((unsigned*)(hist + e1), 1u, __ATOMIC_RELAXED, __HIP_MEMORY_SCOPE_WORKGROUP); } }
        __syncthreads();
        if (MODE == 0 && C.tid < NE) { const unsigned c = hist[C.tid]; unsigned base = 0u; if (c) base = __hip_atomic_fetch_add(cnt + C.tid * CNT_STRIDE, c, __ATOMIC_RELAXED, __HIP_MEMORY_SCOPE_AGENT); hist[64 + C.tid] = base; }
        __syncthreads();
        if (C.tid < RB) { const int tok = blk * RB + C.tid;
            if (MODE == 1) { asm volatile("" :: "v"(e0), "v"(e1), "v"(gw0), "v"(gw1)); } else {
            const int r0 = (int)hist[64 + e0] + l0, r1 = (int)hist[64 + e1] + l1;
            int* ro = route + (size_t)tok * 8; ro[0] = e0; ro[1] = e1; ro[2] = r0; ro[3] = r1; ((float*)ro)[4] = gw0; ((float*)ro)[5] = gw1;
            inv2[(size_t)e0 * 16384 + r0] = 2 * tok; inv2[(size_t)e1 * 16384 + r1] = 2 * tok + 1; } }
        __syncthreads();
    }
}
__device__ __forceinline__ void moe_table(const Ctx& C, LAS int* tst) {
    if (C.tid < NE) tst[80 + C.tid] = (int)__hip_atomic_load(C.ctl + CW_CNT + C.tid * CNT_STRIDE, RLX_AGENT);
    __syncthreads();
    if (C.tid == 0) { int acc = 0; for (int e = 0; e < NE; ++e) { tst[e] = acc; acc += (tst[80 + e] + 127) >> 7; } tst[NE] = acc; }
    __syncthreads();
}
__device__ __forceinline__ int moe_expert_of(const LAS int* tst, int t) { int e = 0;
#pragma unroll 1
    for (int j = 1; j < NE; ++j) if (tst[j] <= t) e = j;
    return e; }
__device__ __forceinline__ bool moe_unit(const LAS int* tst, int NT, int grp, int ngrp, int u, int& e, int& t, int& nt) {
#pragma unroll 1
    for (int ee = grp; ee < NE; ee += ngrp) { const int nu = (tst[ee + 1] - tst[ee]) * NT; if (u < nu) { e = ee; t = tst[ee] + u / NT; nt = u % NT; return true; } u -= nu; }
    return false;
}
struct UpRow { const bf16* h1; const int* lst; int l0, cnt;
    __device__ __forceinline__ const bf16* operator()(int r) const { const int p = (l0 + r < cnt) ? lst[l0 + r] : -1; return h1 + (size_t)(p < 0 ? 0 : (p >> 1)) * D; } };
struct UpEpi { bf16* hid; int pos0, hc0;
    __device__ __forceinline__ void operator()(const f32x4 (&acc)[4][4], int wr, int wc, int fr, int fq) const {
#pragma unroll
        for (int m = 0; m < 4; ++m) { const int row = pos0 + 64 * wr + 16 * m + fr;
#pragma unroll
            for (int n2 = 0; n2 < 2; ++n2) { const f32x4 a = acc[m][2 * n2], b = acc[m][2 * n2 + 1]; const int hc = hc0 + 32 * wc + 16 * n2 + 4 * fq;
                mg::u32x2 w; w.x = pk2(silu_(a[0]) * b[0], silu_(a[1]) * b[1]); w.y = pk2(silu_(a[2]) * b[2], silu_(a[3]) * b[3]);
                *(mg::u32x2*)(hid + (size_t)row * 256 + hc) = w; } }
    } };
__device__ __forceinline__ int moe_group_units(const LAS int* tst, int NT, int grp, int ngrp) { int n = 0;
#pragma unroll 1
    for (int ee = grp; ee < NE; ee += ngrp) n += (tst[ee + 1] - tst[ee]) * NT;
    return n; }
constexpr int MOE_TAB_OFF = 150528, MOE_BATCH = 8;
__device__ __forceinline__ void phase9_up(const Ctx& C) {
    LAS int* tst = (LAS int*)(C.lds + 149504); moe_table(C, tst);
    LAS int* tab = (LAS int*)(C.lds + MOE_TAB_OFF);
    const int ngrp = (C.G % 8 == 0) ? 8 : 1, grp = C.wg % ngrp, gsz = C.G / ngrp;
    const int total = moe_group_units(tst, 2, grp, ngrp), first = C.wg / ngrp, nmine = total > first ? (total - first + gsz - 1) / gsz : 0;
    const int lr = C.tid >> 3, ch = ((C.lane & 7) ^ ((C.lane >> 3) & 7)) * 8;
    const bf16* h1 = (const bf16*)(C.ws + WS_H1); const bf16* W13 = (const bf16*)(C.ws + WS_W13); const int* inv2 = (const int*)(C.ws + WS_INV2);
    int sbase = 0;
    for (int b0 = 0; b0 < nmine; b0 += MOE_BATCH) { const int nu = nmine - b0 < MOE_BATCH ? nmine - b0 : MOE_BATCH;
        __syncthreads();
        int pv[2];
#pragma unroll
        for (int ps = 0; ps < 2; ++ps) { const int u = ps * 4 + (C.tid >> 7), row = C.tid & 127; int e, t, nt; pv[ps] = -1;
            if (u < nu && moe_unit(tst, 2, grp, ngrp, first + (b0 + u) * gsz, e, t, nt)) { const int li = 128 * (t - tst[e]) + row; if (li < tst[80 + e]) pv[ps] = inv2[(size_t)e * 16384 + li]; } }
#pragma unroll
        for (int ps = 0; ps < 2; ++ps) { const int u = ps * 4 + (C.tid >> 7), row = C.tid & 127; tab[u * 128 + row] = pv[ps] < 0 ? 0 : (pv[ps] >> 1); }
        __syncthreads();
        mg::Src cur, nxt; int e, t, nt;
        (void)moe_unit(tst, 2, grp, ngrp, first + b0 * gsz, e, t, nt);
        cur.pa0 = h1 + (size_t)tab[lr] * D + ch; cur.pa1 = h1 + (size_t)tab[64 + lr] * D + ch; cur.pb = W13 + (size_t)e * 524288 + (size_t)nt * 16 * 16384 + (size_t)lr * 64 + ch;
#pragma unroll 1
        for (int i = 0; i < nu; ++i) { const bool has_next = i + 1 < nu; int e2 = e, t2 = t, nt2 = nt; nxt = cur;
            if (has_next) { (void)moe_unit(tst, 2, grp, ngrp, first + (b0 + i + 1) * gsz, e2, t2, nt2);
                nxt.pa0 = h1 + (size_t)tab[(i + 1) * 128 + lr] * D + ch; nxt.pa1 = h1 + (size_t)tab[(i + 1) * 128 + 64 + lr] * D + ch; nxt.pb = W13 + (size_t)e2 * 524288 + (size_t)nt2 * 16 * 16384 + (size_t)lr * 64 + ch; }
            UpEpi ep{(bf16*)(C.ws + WS_HID), 128 * t, 128 * nt};
            mg::tile_pipe(C.lds, cur, 16, i == 0, has_next, nxt, sbase, ep);
            cur = nxt; e = e2; t = t2; nt = nt2; }
    }
}
struct DnRow { const bf16* hid; int pos0; __device__ __forceinline__ const bf16* operator()(int r) const { return hid + (size_t)(pos0 + r) * 256; } };
struct DnEpi { bf16* slots; const int* lst; const int* route; int l0, cnt, c0;
    __device__ __forceinline__ void operator()(const f32x4 (&acc)[4][4], int wr, int wc, int fr, int fq) const {
#pragma unroll
        for (int m = 0; m < 4; ++m) { const int li = l0 + 64 * wr + 16 * m + fr; if (li >= cnt) continue; const int p = lst[li];
            const float gt = ((const float*)route)[(size_t)(p >> 1) * 8 + 4 + (p & 1)];
#pragma unroll
            for (int n = 0; n < 4; ++n) { const f32x4 a = acc[m][n] * gt; mg::u32x2 w; w.x = pk2(a[0], a[1]); w.y = pk2(a[2], a[3]);
                *(mg::u32x2*)(slots + (size_t)p * D + c0 + 64 * wc + 16 * n + 4 * fq) = w; } }
    } };
struct DnEpi2 { bf16* slots; const LAS int* tab; int c0;
    __device__ __forceinline__ void operator()(const f32x4 (&acc)[4][4], int wr, int wc, int fr, int fq) const {
#pragma unroll
        for (int m = 0; m < 4; ++m) { const mg::u32x2 pg = *(const LAS mg::u32x2*)(tab + 2 * (64 * wr + 16 * m + fr)); const int p = (int)pg.x; if (p < 0) continue;
            const float gt = __uint_as_float(pg.y);
#pragma unroll
            for (int n = 0; n < 4; ++n) { const f32x4 a = acc[m][n] * gt; mg::u32x2 w; w.x = pk2(a[0], a[1]); w.y = pk2(a[2], a[3]);
                *(mg::u32x2*)(slots + (size_t)p * D + c0 + 64 * wc + 16 * n + 4 * fq) = w; } }
    } };
__device__ __forceinline__ void phase10_down(const Ctx& C, bool have_table) {
    LAS int* tst = (LAS int*)(C.lds + 149504); if (!have_table) moe_table(C, tst);
    LAS int* tab = (LAS int*)(C.lds + MOE_TAB_OFF);
    const int ngrp = (C.G % 8 == 0) ? 8 : 1, grp = C.wg % ngrp, gsz = C.G / ngrp;
    const int total = moe_group_units(tst, 4, grp, ngrp), first = C.wg / ngrp, nmine = total > first ? (total - first + gsz - 1) / gsz : 0;
    const int lr = C.tid >> 3, ch = ((C.lane & 7) ^ ((C.lane >> 3) & 7)) * 8;
    const bf16* hid = (const bf16*)(C.ws + WS_HID); const bf16* W2 = (const bf16*)(C.ws + WS_W2); const int* inv2 = (const int*)(C.ws + WS_INV2); const float* route = (const float*)(C.ws + WS_ROUTE);
    int sbase = 0;
    for (int b0 = 0; b0 < nmine; b0 += MOE_BATCH) { const int nu = nmine - b0 < MOE_BATCH ? nmine - b0 : MOE_BATCH;
        __syncthreads();
        int pv[2]; float gv[2];
#pragma unroll
        for (int ps = 0; ps < 2; ++ps) { const int u = ps * 4 + (C.tid >> 7), row = C.tid & 127; int e, t, nt; pv[ps] = -1;
            if (u < nu && moe_unit(tst, 4, grp, ngrp, first + (b0 + u) * gsz, e, t, nt)) { const int li = 128 * (t - tst[e]) + row; if (li < tst[80 + e]) pv[ps] = inv2[(size_t)e * 16384 + li]; } }
#pragma unroll
        for (int ps = 0; ps < 2; ++ps) gv[ps] = pv[ps] >= 0 ? route[(size_t)(pv[ps] >> 1) * 8 + 4 + (pv[ps] & 1)] : 0.f;
#pragma unroll
        for (int ps = 0; ps < 2; ++ps) { const int u = ps * 4 + (C.tid >> 7), row = C.tid & 127; mg::u32x2 w; w.x = (unsigned)pv[ps]; w.y = __float_as_uint(gv[ps]); *(LAS mg::u32x2*)(tab + 2 * (u * 128 + row)) = w; }
        __syncthreads();
        mg::Src cur, nxt; int e, t, nt;
        (void)moe_unit(tst, 4, grp, ngrp, first + b0 * gsz, e, t, nt);
        cur.pa0 = hid + (size_t)(128 * t + lr) * 256 + ch; cur.pa1 = cur.pa0 + 64 * 256; cur.pb = W2 + (size_t)e * 262144 + (size_t)nt * 4 * 16384 + (size_t)lr * 64 + ch;
#pragma unroll 1
        for (int i = 0; i < nu; ++i) { const bool has_next = i + 1 < nu; int e2 = e, t2 = t, nt2 = nt; nxt = cur;
            if (has_next) { (void)moe_unit(tst, 4, grp, ngrp, first + (b0 + i + 1) * gsz, e2, t2, nt2);
                nxt.pa0 = hid + (size_t)(128 * t2 + lr) * 256 + ch; nxt.pa1 = nxt.pa0 + 64 * 256; nxt.pb = W2 + (size_t)e2 * 262144 + (size_t)nt2 * 4 * 16384 + (size_t)lr * 64 + ch; }
            DnEpi2 ep{(bf16*)C.out, tab + 2 * (i * 128), 256 * nt};
            mg::tile_pipe(C.lds, cur, 4, i == 0, has_next, nxt, sbase, ep);
            cur = nxt; e = e2; t = t2; nt = nt2; }
    }
}
constexpr int CW_TRDY = 24576;
struct MoeEpi { int up; bf16* hid; int pos0, hc0; bf16* slots; const LAS int* tab; int c0;
    __device__ __forceinline__ void operator()(const f32x4 (&acc)[4][4], int wr, int wc, int fr, int fq) const {
        if (up) {
#pragma unroll
            for (int m = 0; m < 4; ++m) { const int row = pos0 + 64 * wr + 16 * m + fr;
#pragma unroll
                for (int n2 = 0; n2 < 2; ++n2) { const f32x4 a = acc[m][2 * n2], b = acc[m][2 * n2 + 1]; const int hc = hc0 + 32 * wc + 16 * n2 + 4 * fq;
                    mg::u32x2 w; w.x = pk2(silu_(a[0]) * b[0], silu_(a[1]) * b[1]); w.y = pk2(silu_(a[2]) * b[2], silu_(a[3]) * b[3]);
                    asm volatile("global_store_dwordx2 %0, %1, off sc0 sc1" :: "v"(hid + (size_t)row * 256 + hc), "v"(w) : "memory"); } }
        } else {
#pragma unroll
            for (int m = 0; m < 4; ++m) { const mg::u32x2 pg = *(const LAS mg::u32x2*)(tab + 2 * (64 * wr + 16 * m + fr)); const int p = (int)pg.x; if (p < 0) continue;
                const float gt = __uint_as_float(pg.y);
#pragma unroll
                for (int n = 0; n < 4; ++n) { const f32x4 a = acc[m][n] * gt; mg::u32x2 w; w.x = pk2(a[0], a[1]); w.y = pk2(a[2], a[3]);
                    *(mg::u32x2*)(slots + (size_t)p * D + c0 + 64 * wc + 16 * n + 4 * fq) = w; } }
        }
    } };
__device__ __forceinline__ void phase_moe(const Ctx& C) {
    LAS int* tst = (LAS int*)(C.lds + 149504); moe_table(C, tst);
    LAS int* tab = (LAS int*)(C.lds + MOE_TAB_OFF);
    volatile LAS int* flg = (volatile LAS int*)(C.lds + MOE_TAB_OFF + MOE_BATCH * 1024);
    const int ngrp = (C.G % 8 == 0) ? 8 : 1, grp = C.wg % ngrp, gsz = C.G / ngrp, first = C.wg / ngrp;
    const int U8 = moe_group_units(tst, 2, grp, ngrp), U9 = 2 * U8;
    const int n8 = U8 > first ? (U8 - first + gsz - 1) / gsz : 0;
    const int r8 = U8 % gsz, light = (r8 != 0 && first >= r8) ? 1 : 0;
    const int B = r8 ? 2 * (gsz - r8) : 0;
    int nb = 0; if (light) { const int v0 = 2 * (first - r8); nb = v0 + 1 < U9 ? 2 : (v0 < U9 ? 1 : 0); }
    const int nreg = U9 > B + first ? (U9 - B - first + gsz - 1) / gsz : 0;
    const int nall = n8 + nb + nreg;
#define MOE_DECODE(i_, up_, e_, t_, nt_) do { const int ii_ = (i_); up_ = ii_ < n8; int v_; if (up_) v_ = first + ii_ * gsz; else if (ii_ - n8 < nb) v_ = 2 * (first - r8) + (ii_ - n8); else v_ = B + first + (ii_ - n8 - nb) * gsz; \
        (void)moe_unit(tst, up_ ? 2 : 4, grp, ngrp, v_, e_, t_, nt_); } while (0)
    const int lr = C.tid >> 3, ch = ((C.lane & 7) ^ ((C.lane >> 3) & 7)) * 8;
    const bf16* h1 = (const bf16*)(C.ws + WS_H1); const bf16* hid = (const bf16*)(C.ws + WS_HID); const bf16* W13 = (const bf16*)(C.ws + WS_W13); const bf16* W2 = (const bf16*)(C.ws + WS_W2);
    const int* inv2 = (const int*)(C.ws + WS_INV2); const float* route = (const float*)(C.ws + WS_ROUTE); unsigned* trdy = (unsigned*)(C.ctl + CW_TRDY);
    int sbase = 0; unsigned* pend = nullptr; bool prefetched = false;
#define MOE_SRC(S_, up_, e_, t_, nt_, ui_) do { if (up_) { (S_).pa0 = h1 + (size_t)tab[2 * ((ui_) * 128 + lr)] * D + ch; (S_).pa1 = h1 + (size_t)tab[2 * ((ui_) * 128 + 64 + lr)] * D + ch; \
            (S_).pb = W13 + (size_t)(e_) * 524288 + (size_t)(nt_) * 16 * 16384 + (size_t)lr * 64 + ch; } \
        else { (S_).pa0 = hid + (size_t)(128 * (t_) + lr) * 256 + ch; (S_).pa1 = (S_).pa0 + 64 * 256; (S_).pb = W2 + (size_t)(e_) * 262144 + (size_t)(nt_) * 4 * 16384 + (size_t)lr * 64 + ch; } } while (0)
    for (int b0 = 0; b0 < nall; b0 += MOE_BATCH) { const int nu = nall - b0 < MOE_BATCH ? nall - b0 : MOE_BATCH;
        __syncthreads();
        int pv[2]; float gv[2];
#pragma unroll
        for (int ps = 0; ps < 2; ++ps) { const int u = ps * 4 + (C.tid >> 7), row = C.tid & 127; pv[ps] = -1;
            if (u < nu) { int up, e, t, nt; MOE_DECODE(b0 + u, up, e, t, nt); const int li = 128 * (t - tst[e]) + row; if (li < tst[80 + e]) pv[ps] = inv2[(size_t)e * 16384 + li]; } }
#pragma unroll
        for (int ps = 0; ps < 2; ++ps) gv[ps] = pv[ps] >= 0 ? route[(size_t)(pv[ps] >> 1) * 8 + 4 + (pv[ps] & 1)] : 0.f;
#pragma unroll
        for (int ps = 0; ps < 2; ++ps) { const int u = ps * 4 + (C.tid >> 7), row = C.tid & 127; const bool isup = b0 + u < n8;
            mg::u32x2 w; w.x = isup ? (unsigned)(pv[ps] < 0 ? 0 : (pv[ps] >> 1)) : (unsigned)pv[ps]; w.y = __float_as_uint(gv[ps]); *(LAS mg::u32x2*)(tab + 2 * (u * 128 + row)) = w; }
        __syncthreads();
        prefetched = false;
        int up, e, t, nt; MOE_DECODE(b0, up, e, t, nt);
        mg::Src cur, nxt; MOE_SRC(cur, up, e, t, nt, 0);
#pragma unroll 1
        for (int i = 0; i < nu; ++i) {
            if (!up && !prefetched) {
                if (pend) { asm volatile("s_waitcnt vmcnt(0)" ::: "memory"); __syncthreads(); if (C.tid == 0) (void)__hip_atomic_fetch_add(pend, 1u, RLX_AGENT); pend = nullptr; }
                if (C.tid == 0) { unsigned sp = 0; while (__hip_atomic_load(trdy + t, RLX_AGENT) < 2u) { __builtin_amdgcn_s_sleep(2); if (++sp > (1u << 22)) break; } }
                __syncthreads(); }
            const bool has_next = i + 1 < nu; int up2 = up, e2 = e, t2 = t, nt2 = nt; nxt = cur; bool can = has_next;
            if (has_next) { MOE_DECODE(b0 + i + 1, up2, e2, t2, nt2);
                if (!up2) {
                    if (C.tid == 0) flg[i & 1] = __hip_atomic_load(trdy + t2, RLX_AGENT) >= 2u ? 1 : 0;
                    __syncthreads(); can = flg[i & 1] != 0; }
                if (can) MOE_SRC(nxt, up2, e2, t2, nt2, i + 1); }
            MoeEpi ep{up, (bf16*)(C.ws + WS_HID), 128 * t, 128 * nt, (bf16*)C.out, tab + 2 * (i * 128), 256 * nt};
            mg::tile_pipe(C.lds, cur, up ? 16 : 4, !prefetched, can, nxt, sbase, ep, pend);
            pend = up ? trdy + t : nullptr; prefetched = can;
            if (has_next) { if (!can) MOE_SRC(nxt, up2, e2, t2, nt2, i + 1); cur = nxt; up = up2; e = e2; t = t2; nt = nt2; } }
    }
    if (pend) { asm volatile("s_waitcnt vmcnt(0)" ::: "memory"); __syncthreads(); if (C.tid == 0) (void)__hip_atomic_fetch_add(pend, 1u, RLX_AGENT); }
    asm volatile("s_waitcnt vmcnt(0)" ::: "memory"); __syncthreads();
#undef MOE_DECODE
#undef MOE_SRC
}
template <int MODE>
__device__ __forceinline__ void phase11_final(const Ctx& C) {
    const int gw = C.wg * NWAVES + C.wave, NGW = C.G * NWAVES, lane = C.lane;
    const bf16* h1 = (const bf16*)(C.ws + WS_H1); const bf16* slots = (const bf16*)C.out; const float* g2 = C.in[30]; const float* b2 = C.in[31];
    for (int row0 = gw * 4; row0 < MX; row0 += NGW * 4) {
        f32x4 v[4][4];
#pragma unroll
        for (int rr = 0; rr < 4; ++rr)
#pragma unroll
            for (int j = 0; j < 4; ++j) { const int c = 4 * lane + 256 * j; const int row = row0 + rr;
                const mg::u32x2 hw = __builtin_nontemporal_load((const mg::u32x2*)(h1 + (size_t)row * D + c)), s0 = __builtin_nontemporal_load((const mg::u32x2*)(slots + (size_t)(2 * row) * D + c)), s1 = __builtin_nontemporal_load((const mg::u32x2*)(slots + (size_t)(2 * row + 1) * D + c));
                v[rr][j].x = ALPHA * bflo(hw.x) + bflo(s0.x) + bflo(s1.x); v[rr][j].y = ALPHA * bfhi(hw.x) + bfhi(s0.x) + bfhi(s1.x);
                v[rr][j].z = ALPHA * bflo(hw.y) + bflo(s0.y) + bflo(s1.y); v[rr][j].w = ALPHA * bfhi(hw.y) + bfhi(s0.y) + bfhi(s1.y); }
        float mean, rstd;
#pragma unroll
        for (int rr = 0; rr < 4; ++rr) ln_row(v[rr], g2, b2, lane, 1.f, mean, rstd);
#pragma unroll
        for (int rr = 0; rr < 4; ++rr)
#pragma unroll
            for (int j = 0; j < 4; ++j) { if (MODE == 0) __builtin_nontemporal_store(v[rr][j], (f32x4*)(C.out + (size_t)(row0 + rr) * D + 4 * lane + 256 * j)); else asm volatile("" :: "v"(v[rr][j])); }
    }
}

constexpr int DN_ITEM_BYTES = 41 * 1024, DN_ITEMS = NB * NH * NCH, DN_IN_OUT = (int)((64 * MiB) / DN_ITEM_BYTES);
constexpr size_t WS_DNX = WS_MERGED;
static_assert((size_t)(DN_ITEMS - DN_IN_OUT) * DN_ITEM_BYTES <= 32 * MiB, "dn overflow");
constexpr size_t WS_ORAW = WS_OA;
__device__ __forceinline__ unsigned char* dn_item_ptr(float* out, unsigned char* ws, int item) {
    return item < DN_IN_OUT ? (unsigned char*)out + (size_t)item * DN_ITEM_BYTES : ws + WS_DNX + (size_t)(item - DN_IN_OUT) * DN_ITEM_BYTES; }
typedef unsigned u32x2_t __attribute__((ext_vector_type(2)));
__device__ __forceinline__ v4u pack8(const f32x4 a, const f32x4 b) { v4u w; w.x = pk2(a[0], a[1]); w.y = pk2(a[2], a[3]); w.z = pk2(b[0], b[1]); w.w = pk2(b[2], b[3]); return w; }
__device__ __forceinline__ bf16x8 as_bf16x8(const v4u w) { return __builtin_bit_cast(bf16x8, w); }

constexpr int SLOT_BYTES = 29312, SL_Q = 0, SL_K = 9216, SL_V = 18432, SL_SC = 27648, SL_HALO = 28160, SROW = 144, DN_SLOTS = 4;
constexpr int CW_LATE = 17920;
constexpr int DN_EARLY = NB * NH * 64;

__device__ __forceinline__ void chunk_prep(const Ctx& C, bool late, int wg0) {
    const int slot = C.wave >> 1, wsl = C.wave & 1;
    LAS unsigned char* const SL0 = C.lds + slot * SLOT_BYTES;
#define DN_REBASE() int lane = C.lane; asm volatile("" : "+v"(lane)); const int rr = lane & 15, qq = lane >> 4, st = lane + 64 * wsl; (void)rr; (void)qq; (void)st; LAS unsigned char* const SL = SL0; LAS float* const SC = (LAS float*)(SL + SL_SC)
    const bf16* qkv = (const bf16*)(C.ws + WS_QKV); const float* ab = (const float*)(C.ws + WS_AB);
    const float* cw = C.in[5]; const float* a_log = C.in[6]; const float* dt_bias = C.in[7];
    const int total = late ? NB * NH : DN_EARLY, nround = late ? 1 : (DN_EARLY + C.G * DN_SLOTS - 1) / (C.G * DN_SLOTS);
    for (int rd = 0; rd < nround; ++rd) {
        int wi = late ? (C.wg - wg0) * DN_SLOTS + slot : (rd * C.G + C.wg) * DN_SLOTS + slot; if (wi >= total) wi = total - 1;
        const int bh = late ? wi : (wi >> 6), n = late ? 64 : (wi & 63), h = bh & 7, b = bh >> 3;
        unsigned char* dst = dn_item_ptr(C.out, C.ws, bh * NCH + n);
        { DN_REBASE();
            v4u rw[13];
#pragma unroll
            for (int i = 0; i < 13; ++i) { const int p = st + 128 * i, rm = p >> 3, c8 = p & 7, row = rm / 3 - 3, m = rm - 3 * (rm / 3), grow = 64 * n + row;
                rw[i] = (p < 1608 && grow >= 0) ? *(const v4u*)(qkv + (size_t)(b * LP + grow) * 1536 + m * 512 + h * 64 + c8 * 8) : (v4u){0u, 0u, 0u, 0u}; }
            if (wsl == 0) { const int gi = 64 * n + lane; float g = 0.f, be = 0.f;
                if (gi >= PADF) { const float* a2 = ab + (size_t)(b * LP + gi) * 16; be = sigm(a2[8 + h]); g = -expf(a_log[h]) * softplus_(a2[h] + dt_bias[h]); }
#pragma unroll
                for (int o = 1; o < 64; o <<= 1) { const float t = __shfl_up(g, o); if (lane >= o) g += t; }
                SC[lane] = g; SC[64 + lane] = be; }
#pragma unroll
            for (int i = 0; i < 13; ++i) { const int p = st + 128 * i, rm = p >> 3, c8 = p & 7, row = rm / 3 - 3, m = rm - 3 * (rm / 3);
                if (p < 1608) { LAS unsigned char* dp = row >= 0 ? SL + m * 9216 + row * SROW + c8 * 16 : SL + SL_HALO + ((row + 3) * 3 + m) * 128 + c8 * 16; *(LAS v4u*)dp = rw[i]; } }
        }
        __syncthreads();
        float cq0 = 0.f, cq1 = 0.f, cq2 = 0.f, ck0 = 0.f, ck1 = 0.f, ck2 = 0.f, cv0 = 0.f, cv1 = 0.f, cv2 = 0.f;
        { DN_REBASE(); const int d = lane;
            if (wsl == 0) { const LAS unsigned char* hp = SL + SL_HALO + d * 2;
                cq0 = bf2f(*(const LAS bf16*)(hp + 0 * 128)); ck0 = bf2f(*(const LAS bf16*)(hp + 1 * 128)); cv0 = bf2f(*(const LAS bf16*)(hp + 2 * 128));
                cq1 = bf2f(*(const LAS bf16*)(hp + 3 * 128)); ck1 = bf2f(*(const LAS bf16*)(hp + 4 * 128)); cv1 = bf2f(*(const LAS bf16*)(hp + 5 * 128));
                cq2 = bf2f(*(const LAS bf16*)(hp + 6 * 128)); ck2 = bf2f(*(const LAS bf16*)(hp + 7 * 128)); cv2 = bf2f(*(const LAS bf16*)(hp + 8 * 128));
            } else { const LAS unsigned char* mp = SL + 29 * SROW + d * 2;
                cq0 = bf2f(*(const LAS bf16*)(mp + SL_Q)); ck0 = bf2f(*(const LAS bf16*)(mp + SL_K)); cv0 = bf2f(*(const LAS bf16*)(mp + SL_V));
                cq1 = bf2f(*(const LAS bf16*)(mp + SL_Q + SROW)); ck1 = bf2f(*(const LAS bf16*)(mp + SL_K + SROW)); cv1 = bf2f(*(const LAS bf16*)(mp + SL_V + SROW));
                cq2 = bf2f(*(const LAS bf16*)(mp + SL_Q + 2 * SROW)); ck2 = bf2f(*(const LAS bf16*)(mp + SL_K + 2 * SROW)); cv2 = bf2f(*(const LAS bf16*)(mp + SL_V + 2 * SROW)); }
        }
        __syncthreads();
        { DN_REBASE(); const int d = lane, ch = h * 64 + d;
            float wq[4], wk[4], wv[4];
#pragma unroll
            for (int j = 0; j < 4; ++j) { wq[j] = cw[j * 1536 + ch]; wk[j] = cw[j * 1536 + 512 + ch]; wv[j] = cw[j * 1536 + 1024 + ch]; }
            LAS unsigned char* rp = SL + (32 * wsl) * SROW + d * 2;
#pragma unroll 8
            for (int r = 0; r < 32; ++r, rp += SROW) { const float q3 = bf2f(*(const LAS bf16*)(rp + SL_Q)), k3 = bf2f(*(const LAS bf16*)(rp + SL_K)), v3 = bf2f(*(const LAS bf16*)(rp + SL_V));
                const float q = silu_(wq[0] * cq0 + wq[1] * cq1 + wq[2] * cq2 + wq[3] * q3), k = silu_(wk[0] * ck0 + wk[1] * ck1 + wk[2] * ck2 + wk[3] * k3), v = silu_(wv[0] * cv0 + wv[1] * cv1 + wv[2] * cv2 + wv[3] * v3);
                cq0 = cq1; cq1 = cq2; cq2 = q3; ck0 = ck1; ck1 = ck2; ck2 = k3; cv0 = cv1; cv1 = cv2; cv2 = v3;
                *(LAS bf16*)(rp + SL_Q) = (bf16)f2bf(q); *(LAS bf16*)(rp + SL_K) = (bf16)f2bf(k); *(LAS bf16*)(rp + SL_V) = (bf16)f2bf(v); }
        }
        __syncthreads();
        { DN_REBASE(); LAS unsigned char* rp = SL + (wsl == 0 ? SL_Q : SL_K) + lane * SROW;
            v4u w[8]; float ss = 0.f;
#pragma unroll
            for (int c = 0; c < 8; ++c) { w[c] = *(const LAS v4u*)(rp + c * 16);
                ss += bflo(w[c].x) * bflo(w[c].x) + bfhi(w[c].x) * bfhi(w[c].x) + bflo(w[c].y) * bflo(w[c].y) + bfhi(w[c].y) * bfhi(w[c].y)
                    + bflo(w[c].z) * bflo(w[c].z) + bfhi(w[c].z) * bfhi(w[c].z) + bflo(w[c].w) * bflo(w[c].w) + bfhi(w[c].w) * bfhi(w[c].w); }
            const float sc = (__builtin_amdgcn_rsqf(ss + NORM_EPS)) * (wsl == 0 ? 0.125f : 1.f);
#pragma unroll
            for (int c = 0; c < 8; ++c) { v4u o; o.x = pk2(bflo(w[c].x) * sc, bfhi(w[c].x) * sc); o.y = pk2(bflo(w[c].y) * sc, bfhi(w[c].y) * sc); o.z = pk2(bflo(w[c].z) * sc, bfhi(w[c].z) * sc); o.w = pk2(bflo(w[c].w) * sc, bfhi(w[c].w) * sc);
                *(LAS v4u*)(rp + c * 16) = o; }
        }
        __syncthreads();
        float x[64]; f32x4 am[2][4];
        { DN_REBASE();
#pragma unroll
            for (int i = 0; i < 64; ++i) { const float be = SC[64 + i];
                if (wsl == 0) x[i] = be * bf2f(*(const LAS bf16*)(SL + SL_V + i * SROW + lane * 2)); else x[i] = be * __expf(SC[i]) * bf2f(*(const LAS bf16*)(SL + SL_K + i * SROW + lane * 2)); }
#pragma unroll
            for (int tix = 0; tix < 2; ++tix) { const int ti = wsl == 0 ? (tix == 0 ? 0 : 3) : (tix == 0 ? 1 : 2);
                bf16x8 kfi[2], qfi[2];
#pragma unroll
                for (int s = 0; s < 2; ++s) { kfi[s] = *(const LAS bf16x8*)(SL + SL_K + (16 * ti + rr) * SROW + s * 64 + qq * 16); qfi[s] = *(const LAS bf16x8*)(SL + SL_Q + (16 * ti + rr) * SROW + s * 64 + qq * 16); }
                const int i = 16 * ti + rr; const float gci = SC[i];
                f32x4 atv[4];
#pragma unroll
                for (int tj = 0; tj < 4; ++tj) {
                    f32x4 d1 = (f32x4){0.f, 0.f, 0.f, 0.f}, d2 = d1;
                    if (tj <= ti) {
#pragma unroll
                        for (int s = 0; s < 2; ++s) { const bf16x8 kfj = *(const LAS bf16x8*)(SL + SL_K + (16 * tj + rr) * SROW + s * 64 + qq * 16);
                            d1 = __builtin_amdgcn_mfma_f32_16x16x32_bf16(kfi[s], kfj, d1, 0, 0, 0);
                            d2 = __builtin_amdgcn_mfma_f32_16x16x32_bf16(kfj, qfi[s], d2, 0, 0, 0); }
                        const float gcj1 = SC[16 * tj + rr];
#pragma unroll
                        for (int r = 0; r < 4; ++r) { const int j = 16 * tj + 4 * qq + r; const float dec = __expf(gci - SC[j]); d2[r] = (j <= i) ? d2[r] * dec : 0.f;
                            const int i1 = 16 * ti + 4 * qq + r; d1[r] = (16 * tj + rr < i1) ? d1[r] * SC[64 + i1] * __expf(SC[i1] - gcj1) : 0.f; }
                    }
                    am[tix][tj] = d1; atv[tj] = d2;
                }
#pragma unroll
                for (int s = 0; s < 2; ++s) *(GAS v4u*)(dst + 16384 + ((ti * 2 + s) * 64 + lane) * 16) = pack8(atv[2 * s], atv[2 * s + 1]);
            }
            const float gcl = SC[63];
#pragma unroll
            for (int t2 = 0; t2 < 2; ++t2) { const int it = 2 * wsl + t2; const int i = 16 * it + rr; const float eg = __expf(SC[i]);
#pragma unroll
                for (int s = 0; s < 2; ++s) {
                    const u32x2_t a = *(const LAS u32x2_t*)(SL + SL_Q + i * SROW + (32 * s + 4 * qq) * 2), bq = *(const LAS u32x2_t*)(SL + SL_Q + i * SROW + (32 * s + 16 + 4 * qq) * 2);
                    v4u w; w.x = pk2(bflo(a.x) * eg, bfhi(a.x) * eg); w.y = pk2(bflo(a.y) * eg, bfhi(a.y) * eg); w.z = pk2(bflo(bq.x) * eg, bfhi(bq.x) * eg); w.w = pk2(bflo(bq.y) * eg, bfhi(bq.y) * eg);
                    *(GAS v4u*)(dst + 8192 + ((it * 2 + s) * 64 + lane) * 16) = w;
                    float kd[8];
#pragma unroll
                    for (int e = 0; e < 8; ++e) { const int ii = 32 * s + 16 * (e >> 2) + 4 * qq + (e & 3); kd[e] = bf2f(*(const LAS bf16*)(SL + SL_K + ii * SROW + (16 * it + rr) * 2)) * __expf(gcl - SC[ii]); }
                    v4u wk2; wk2.x = pk2(kd[0], kd[1]); wk2.y = pk2(kd[2], kd[3]); wk2.z = pk2(kd[4], kd[5]); wk2.w = pk2(kd[6], kd[7]);
                    *(GAS v4u*)(dst + 24576 + ((it * 2 + s) * 64 + lane) * 16) = wk2; } }
            if (wsl == 0) { const float gl = __expf(gcl); *(GAS f32x4*)(dst + 40960 + lane * 16) = (f32x4){gl, gl, gl, gl}; }
        }
        __syncthreads();
        { DN_REBASE();
#pragma unroll
            for (int tix = 0; tix < 2; ++tix) { const int ti = wsl == 0 ? (tix == 0 ? 0 : 3) : (tix == 0 ? 1 : 2);
#pragma unroll
                for (int tj = 0; tj < 4; ++tj) if (tj <= ti) *(LAS f32x4*)(SL + ((16 * tj + rr) * 64 + 16 * ti + 4 * qq) * 4) = am[tix][tj]; }
        }
        __syncthreads();
        { DN_REBASE();
            const LAS float* ATq = (const LAS float*)SL + (lane & 3);
            float cb[2][16];
#define QFMA(x_, a_, r_) asm("v_fmac_f32_dpp %0, %1, %2 quad_perm:[" #r_ "," #r_ "," #r_ "," #r_ "] row_mask:0xf bank_mask:0xf" : "+v"(x_) : "v"(a_), "v"(nxj))
#pragma unroll
            for (int m = 0; m < 16; ++m) cb[0][m] = ATq[4 * m];
#pragma unroll
            for (int j = 0; j < 63; ++j) { const float nxj = -x[j];
                if (j + 1 < 63) {
#pragma unroll
                    for (int m = (j + 2) >> 2; m < 16; ++m) cb[(j + 1) & 1][m] = ATq[(j + 1) * 64 + 4 * m]; }
#pragma unroll
                for (int m = (j + 1) >> 2; m < 16; ++m) { const float a = cb[j & 1][m];
                    if (4 * m > j) QFMA(x[4 * m], a, 0); if (4 * m + 1 > j) QFMA(x[4 * m + 1], a, 1); if (4 * m + 2 > j) QFMA(x[4 * m + 2], a, 2); QFMA(x[4 * m + 3], a, 3); }
                asm volatile("" : "+v"(x[j + 1]) :: "memory"); }
#undef QFMA
        }
        if (wsl == 0) { DN_REBASE(); const int vs = st >> 4, c = st & 15;
#pragma unroll
            for (int it = 0; it < 4; ++it)
#pragma unroll
                for (int q = 0; q < 4; ++q) { u32x2_t w; w.x = pk2(x[16 * it + 4 * q], x[16 * it + 4 * q + 1]); w.y = pk2(x[16 * it + 4 * q + 2], x[16 * it + 4 * q + 3]);
                    *(GAS u32x2_t*)(dst + 32768 + (((vs * 4 + it) * 64 + 16 * q + c) * 8)) = w; }
        } else { DN_REBASE();
#pragma unroll
            for (int i = 0; i < 64; ++i) *(LAS bf16*)(SL + SL_V + i * SROW + lane * 2) = (bf16)f2bf(-x[i]);
        }
        __syncthreads();
        { DN_REBASE();
#pragma unroll
        for (int t2 = 0; t2 < 2; ++t2) { const int it = 2 * wsl + t2; const int i = 16 * it + rr;
#pragma unroll
            for (int s = 0; s < 2; ++s) { const u32x2_t a = *(const LAS u32x2_t*)(SL + SL_V + i * SROW + (32 * s + 4 * qq) * 2), bq = *(const LAS u32x2_t*)(SL + SL_V + i * SROW + (32 * s + 16 + 4 * qq) * 2);
                v4u w; w.x = a.x; w.y = a.y; w.z = bq.x; w.w = bq.y; *(GAS v4u*)(dst + ((it * 2 + s) * 64 + lane) * 16) = w; } } }
        __syncthreads();
    }
#undef DN_REBASE
    if (late) {
        asm volatile("s_waitcnt vmcnt(0)" ::: "memory"); __syncthreads();
        if (C.tid == 0) { __builtin_amdgcn_fence(__ATOMIC_RELEASE, "agent"); asm volatile("s_waitcnt vmcnt(0)" ::: "memory");
            __hip_atomic_fetch_add(C.ctl + CW_LATE, (unsigned)DN_SLOTS, __ATOMIC_RELAXED, __HIP_MEMORY_SCOPE_AGENT); }
    }
}

__device__ __forceinline__ void dn_scan_mfma(const Ctx& C, int b, int h) {
    const int wave = C.wave, lane = C.lane;
    const int item0 = (b * NH + h) * NCH;
    bf16* oraw = (bf16*)(C.ws + WS_ORAW);
#define DN_ISSUE(n_) do { const unsigned char* src_ = dn_item_ptr(C.out, C.ws, item0 + (n_)); LAS unsigned char* ring_ = C.lds + ((n_) % 3) * DN_ITEM_BYTES; \
        for (int blk_ = wave - 4; blk_ < 41; blk_ += 4) __builtin_amdgcn_global_load_lds((const unsigned*)(src_ + blk_ * 1024 + lane * 16), (LAS unsigned*)(ring_ + blk_ * 1024), 16, 0, 0); } while (0)
    f32x4 S[4];
#pragma unroll
    for (int kt = 0; kt < 4; ++kt) S[kt] = (f32x4){0.f, 0.f, 0.f, 0.f};
    if (wave >= 4) { DN_ISSUE(0); DN_ISSUE(1); if (wave == 4) asm volatile("s_waitcnt vmcnt(11)" ::: "memory"); else asm volatile("s_waitcnt vmcnt(10)" ::: "memory"); }
    __builtin_amdgcn_s_barrier();
    for (int n = 0; n < NCH; ++n) {
        if (wave >= 4) {
            if (n + 2 == NCH - 1) {
                unsigned sp = 0; while (__hip_atomic_load(C.ctl + CW_LATE, RLX_AGENT) < (unsigned)(NB * NH)) { __builtin_amdgcn_s_sleep(4); if (++sp > (1u << 22)) break; }
                __builtin_amdgcn_fence(__ATOMIC_ACQUIRE, "agent"); }
            if (n + 2 < NCH) { DN_ISSUE(n + 2); if (wave == 4) asm volatile("s_waitcnt vmcnt(11)" ::: "memory"); else asm volatile("s_waitcnt vmcnt(10)" ::: "memory"); }
            else asm volatile("s_waitcnt vmcnt(0)" ::: "memory");
        } else {
            const LAS unsigned char* R = C.lds + (n % 3) * DN_ITEM_BYTES; const int vs = wave;
            const float gl = *(const LAS float*)(R + 40960);
            const bf16x8 Sb0 = as_bf16x8(pack8(S[0], S[1])), Sb1 = as_bf16x8(pack8(S[2], S[3]));
            f32x4 vn[4], o[4];
#pragma unroll
            for (int it = 0; it < 4; ++it) { const u32x2_t uc = *(const LAS u32x2_t*)(R + 32768 + ((vs * 4 + it) * 64 + lane) * 8);
                f32x4 a = (f32x4){bflo(uc.x), bfhi(uc.x), bflo(uc.y), bfhi(uc.y)};
                a = __builtin_amdgcn_mfma_f32_16x16x32_bf16(*(const LAS bf16x8*)(R + ((it * 2 + 0) * 64 + lane) * 16), Sb0, a, 0, 0, 0);
                a = __builtin_amdgcn_mfma_f32_16x16x32_bf16(*(const LAS bf16x8*)(R + ((it * 2 + 1) * 64 + lane) * 16), Sb1, a, 0, 0, 0);
                vn[it] = a;
                f32x4 oo = (f32x4){0.f, 0.f, 0.f, 0.f};
                oo = __builtin_amdgcn_mfma_f32_16x16x32_bf16(*(const LAS bf16x8*)(R + 8192 + ((it * 2 + 0) * 64 + lane) * 16), Sb0, oo, 0, 0, 0);
                oo = __builtin_amdgcn_mfma_f32_16x16x32_bf16(*(const LAS bf16x8*)(R + 8192 + ((it * 2 + 1) * 64 + lane) * 16), Sb1, oo, 0, 0, 0);
                o[it] = oo; }
            const bf16x8 Vb0 = as_bf16x8(pack8(vn[0], vn[1])), Vb1 = as_bf16x8(pack8(vn[2], vn[3]));
#pragma unroll
            for (int it = 0; it < 4; ++it) {
                o[it] = __builtin_amdgcn_mfma_f32_16x16x32_bf16(*(const LAS bf16x8*)(R + 16384 + ((it * 2 + 0) * 64 + lane) * 16), Vb0, o[it], 0, 0, 0);
                o[it] = __builtin_amdgcn_mfma_f32_16x16x32_bf16(*(const LAS bf16x8*)(R + 16384 + ((it * 2 + 1) * 64 + lane) * 16), Vb1, o[it], 0, 0, 0); }
#pragma unroll
            for (int kt = 0; kt < 4; ++kt) { f32x4 s = S[kt] * gl;
                s = __builtin_amdgcn_mfma_f32_16x16x32_bf16(*(const LAS bf16x8*)(R + 24576 + ((kt * 2 + 0) * 64 + lane) * 16), Vb0, s, 0, 0, 0);
                s = __builtin_amdgcn_mfma_f32_16x16x32_bf16(*(const LAS bf16x8*)(R + 24576 + ((kt * 2 + 1) * 64 + lane) * 16), Vb1, s, 0, 0, 0);
                S[kt] = s; }
            if (n >= 1) { const int q = lane >> 4, c = lane & 15; bf16* op = oraw + (size_t)(b * SEQ + 64 * (n - 1) + 4 * q) * 512 + h * 64 + 16 * vs + c;
#pragma unroll
                for (int it = 0; it < 4; ++it)
#pragma unroll
                    for (int r = 0; r < 4; ++r) op[(size_t)(16 * it + r) * 512] = (bf16)f2bf(o[it][r]); }
            asm volatile("s_waitcnt lgkmcnt(0)" ::: "memory");
        }
        __builtin_amdgcn_s_barrier();
    }
#undef DN_ISSUE
}
__device__ __forceinline__ void oa_postpass(const Ctx& C, int wg0, int nwg) {
    const int gw = (C.wg - wg0) * NWAVES + C.wave, NGW = nwg * NWAVES, lane = C.lane; if (C.wg < wg0) return;
    bf16* oa = (bf16*)(C.ws + WS_OA); const bf16* z = (const bf16*)(C.ws + WS_Z); const float* nw = C.in[8] + (lane & 7) * 8;
    float w8[8];
#pragma unroll
    for (int e = 0; e < 8; ++e) w8[e] = nw[e];
    for (int row = gw; row < MX; row += NGW) {
        const v4u r = *(const v4u*)(oa + (size_t)row * 512 + lane * 8), zz = *(const v4u*)(z + (size_t)prow_of(row) * 512 + lane * 8);
        float v[8] = {bflo(r.x), bfhi(r.x), bflo(r.y), bfhi(r.y), bflo(r.z), bfhi(r.z), bflo(r.w), bfhi(r.w)};
        const float zf[8] = {bflo(zz.x), bfhi(zz.x), bflo(zz.y), bfhi(zz.y), bflo(zz.z), bfhi(zz.z), bflo(zz.w), bfhi(zz.w)};
        float ss = 0.f;
#pragma unroll
        for (int e = 0; e < 8; ++e) ss += v[e] * v[e];
        ss += __shfl_xor(ss, 1); ss += __shfl_xor(ss, 2); ss += __shfl_xor(ss, 4);
        const float rs = __builtin_amdgcn_rsqf(ss * (1.f / 64.f) + NORM_EPS);
#pragma unroll
        for (int e = 0; e < 8; ++e) v[e] = v[e] * rs * w8[e] * silu_(zf[e]);
        v4u w; w.x = pk2(v[0], v[1]); w.y = pk2(v[2], v[3]); w.z = pk2(v[4], v[5]); w.w = pk2(v[6], v[7]);
        *(v4u*)(oa + (size_t)row * 512 + lane * 8) = w;
    }
}


constexpr size_t WS_KT = WS_MERGED + 20 * MiB;
constexpr size_t WS_M2 = WS_KT + 1 * MiB;
constexpr size_t WS_M3 = WS_OB;
static_assert(WS_M2 + 8 * MiB <= WS_END && (size_t)(DN_ITEMS - DN_IN_OUT) * DN_ITEM_BYTES <= 20 * MiB, "s5 tables");

__device__ __forceinline__ float gelu_fast(float x) { const float u2 = 1.5957691216057308f * (x + 0.044715f * x * x * x); return x * __builtin_amdgcn_rcpf(1.f + __expf(-u2)); }
struct S5P { float dt, ar, ai; };
__device__ __forceinline__ void s5_pow(const S5P& P, float d, float& re, float& im) { const float mag = expf(d * P.dt * P.ar); const float ang = d * P.dt * P.ai; re = mag * cosf(ang); im = mag * sinf(ang); }
__device__ __forceinline__ void s5_f(const S5P& P, float& fre, float& fim) { float are, aim; s5_pow(P, 1.f, are, aim); const float den = P.ar * P.ar + P.ai * P.ai, nr = are - 1.f, ni = aim;
    fre = (nr * P.ar + ni * P.ai) / den; fim = (ni * P.ar - nr * P.ai) / den; }

__device__ __forceinline__ void s5_tables(const Ctx& C) {
    const int gw = C.wg * NWAVES + C.wave, NGW = C.G * NWAVES, lane = C.lane, rr = lane & 15, kg = lane >> 4;
    LAS float* scr = (LAS float*)(C.lds + C.wave * 16384);
    const float* a_re = C.in[9]; const float* a_im = C.in[10]; const float* log_dt = C.in[11]; const float* b_re = C.in[12]; const float* b_im = C.in[13]; const float* c_re = C.in[14]; const float* c_im = C.in[15];
    bf16* KT = (bf16*)(C.ws + WS_KT); unsigned char* M2 = C.ws + WS_M2; unsigned char* M3 = C.ws + WS_M3;
    for (int it = gw; it < 2048 + 1024 + 2048; it += NGW) {
        if (it < 2048) {
            const int g = it >> 6, d = it & 63, p = lane; S5P P{expf(log_dt[g]), a_re[g * 64 + p], a_im[g * 64 + p]};
            float are, aim, fre, fim; s5_pow(P, (float)d, are, aim); s5_f(P, fre, fim);
            const float wr_ = are * fre - aim * fim, wi_ = are * fim + aim * fre;
            const float* br = b_re + ((size_t)g * 64 + p) * 16; const float* bi = b_im + ((size_t)g * 64 + p) * 16;
#pragma unroll
            for (int c = 0; c < 16; ++c) { scr[p * 32 + c] = wr_ * br[c] - wi_ * bi[c]; scr[p * 32 + 16 + c] = wr_ * bi[c] + wi_ * br[c]; }
            LDS_WAIT(); asm volatile("" ::: "memory");
            const int c = lane >> 2, c4 = (lane & 3) * 4; f32x4 acc = (f32x4){0.f, 0.f, 0.f, 0.f};
            const float* cr = c_re + ((size_t)g * 16 + c) * 64; const float* ci = c_im + ((size_t)g * 16 + c) * 64;
#pragma unroll 8
            for (int pp = 0; pp < 64; ++pp) { const f32x4 wre = *(const LAS f32x4*)(scr + pp * 32 + c4), wim = *(const LAS f32x4*)(scr + pp * 32 + 16 + c4); const float crv = cr[pp], civ = ci[pp];
                acc = acc + wre * crv - wim * civ; }
            u32x2_t w; w.x = pk2(acc[0], acc[1]); w.y = pk2(acc[2], acc[3]);
            *(GAS u32x2_t*)(KT + ((size_t)(g * 64 + d) * 256 + c * 16 + c4)) = w;
            LDS_WAIT(); asm volatile("" ::: "memory");
        } else if (it < 3072) {
            const int i2 = it - 2048, g = i2 >> 5, ks = i2 & 31, j = 2 * ks + (kg >> 1), ch = 8 * (kg & 1);
#pragma unroll 1
            for (int pq = 0; pq < 4; ++pq) { const int p = 16 * pq + rr; S5P P{expf(log_dt[g]), a_re[g * 64 + p], a_im[g * 64 + p]};
                float are, aim, fre, fim; s5_pow(P, (float)(63 - j), are, aim); s5_f(P, fre, fim);
                const float wr_ = are * fre - aim * fim, wi_ = are * fim + aim * fre;
                const float* br = b_re + ((size_t)g * 64 + p) * 16 + ch; const float* bi = b_im + ((size_t)g * 64 + p) * 16 + ch;
                float re[8], im[8];
#pragma unroll
                for (int e = 0; e < 8; ++e) { re[e] = wr_ * br[e] - wi_ * bi[e]; im[e] = wr_ * bi[e] + wi_ * br[e]; }
                v4u w; w.x = pk2(re[0], re[1]); w.y = pk2(re[2], re[3]); w.z = pk2(re[4], re[5]); w.w = pk2(re[6], re[7]);
                *(GAS v4u*)(M3 + (size_t)g * 262144 + ((size_t)((pq * 32 + ks) * 64 + lane)) * 16) = w;
                w.x = pk2(im[0], im[1]); w.y = pk2(im[2], im[3]); w.z = pk2(im[4], im[5]); w.w = pk2(im[6], im[7]);
                *(GAS v4u*)(M3 + (size_t)g * 262144 + ((size_t)(((4 + pq) * 32 + ks) * 64 + lane)) * 16) = w; }
        } else {
            const int i2 = it - 3072, g = i2 >> 6, t = i2 & 63, c = rr;
#pragma unroll 1
            for (int hf = 0; hf < 2; ++hf) { float vr[8], vi[8];
#pragma unroll
                for (int e = 0; e < 8; ++e) { const int p = 32 * hf + 8 * kg + e; S5P P{expf(log_dt[g]), a_re[g * 64 + p], a_im[g * 64 + p]};
                    float are, aim; s5_pow(P, (float)(t + 1), are, aim); const float crv = c_re[((size_t)g * 16 + c) * 64 + p], civ = c_im[((size_t)g * 16 + c) * 64 + p];
                    vr[e] = crv * are - civ * aim; vi[e] = -(crv * aim + civ * are); }
                v4u w; w.x = pk2(vr[0], vr[1]); w.y = pk2(vr[2], vr[3]); w.z = pk2(vr[4], vr[5]); w.w = pk2(vr[6], vr[7]);
                *(GAS v4u*)(M2 + (size_t)g * 262144 + ((size_t)((t * 4 + hf) * 64 + lane)) * 16) = w;
                w.x = pk2(vi[0], vi[1]); w.y = pk2(vi[2], vi[3]); w.z = pk2(vi[4], vi[5]); w.w = pk2(vi[6], vi[7]);
                *(GAS v4u*)(M2 + (size_t)g * 262144 + ((size_t)((t * 4 + 2 + hf) * 64 + lane)) * 16) = w; }
        }
    }
}

__device__ __forceinline__ void s5_mfma(const Ctx& C, int b, int g) {
    constexpr int UL_STRIDE = 2064, SLAB = 16 * UL_STRIDE;
    LAS unsigned char* KtL = C.lds; LAS unsigned char* B0 = C.lds + SLAB; LAS float* Hl = (LAS float*)(C.lds + 2 * SLAB);
    LAS unsigned char* Hin = (LAS unsigned char*)(Hl + 80 * 128);
    const int w = C.wave;
#define S5_RELANE() int tid = C.tid; asm volatile("" : "+v"(tid)); const int lane = tid & 63, cc = lane & 15, kg = lane >> 4; (void)cc; (void)kg
#define S5_SLAB_LOAD(nt_) do { S5_RELANE(); _Pragma("unroll") for (int i_ = 0; i_ < 4; ++i_) { const int pc = tid + 512 * i_, nl = pc >> 7, jj = (pc >> 1) & 63, hf = pc & 1; int n_ = 16 * (nt_) + nl; if (n_ > 64) n_ = 64; \
        sr[i_] = *(const v4u*)(u + ((size_t)g * MP + b * LP + 64 * n_ + jj) * 16 + 8 * hf); } } while (0)
#define S5_SLAB_STORE(buf_) do { S5_RELANE(); _Pragma("unroll") for (int i_ = 0; i_ < 4; ++i_) { const int pc = tid + 512 * i_, nl = pc >> 7, jj = (pc >> 1) & 63, hf = pc & 1; \
        *(LAS v4u*)((buf_) + nl * UL_STRIDE + jj * 32 + hf * 16) = sr[i_]; } } while (0)
    const bf16* u = (const bf16*)(C.ws + WS_U); bf16* yb = (bf16*)(C.ws + WS_YB);
    const unsigned char* M3g = C.ws + WS_M3 + (size_t)g * 262144; const unsigned char* M2g = C.ws + WS_M2 + (size_t)g * 262144;
    v4u sr[4];
    { bf16x8 m3f[32];
        S5_SLAB_LOAD(0);
        { S5_RELANE();
#pragma unroll
            for (int ks = 0; ks < 32; ++ks) m3f[ks] = *(const bf16x8*)(M3g + ((size_t)((w * 32 + ks) * 64 + lane)) * 16); }
        S5_SLAB_STORE(B0);
        __syncthreads();
#pragma unroll 1
        for (int nt = 0; nt < 5; ++nt) {
            LAS unsigned char* Ul = (nt & 1) ? KtL : B0; LAS unsigned char* Un = (nt & 1) ? B0 : KtL;
            if (nt + 1 < 5) S5_SLAB_LOAD(nt + 1);
            { S5_RELANE(); f32x4 h0 = (f32x4){0.f, 0.f, 0.f, 0.f}, h1 = h0;
#pragma unroll
                for (int ks = 0; ks < 32; ks += 2) {
                    h0 = __builtin_amdgcn_mfma_f32_16x16x32_bf16(m3f[ks], *(const LAS bf16x8*)(Ul + cc * UL_STRIDE + (2 * ks + (kg >> 1)) * 32 + (kg & 1) * 16), h0, 0, 0, 0);
                    h1 = __builtin_amdgcn_mfma_f32_16x16x32_bf16(m3f[ks + 1], *(const LAS bf16x8*)(Ul + cc * UL_STRIDE + (2 * ks + 2 + (kg >> 1)) * 32 + (kg & 1) * 16), h1, 0, 0, 0); }
                *(LAS f32x4*)(Hl + (16 * nt + cc) * 128 + 16 * w + 4 * kg) = h0 + h1; }
            if (nt + 1 < 5) S5_SLAB_STORE(Un);
            __syncthreads();
        }
    }
    S5_SLAB_LOAD(0);
    v4u kr[4];
    { S5_RELANE(); const v4u* src = (const v4u*)((const bf16*)(C.ws + WS_KT) + (size_t)g * 16384);
#pragma unroll
        for (int i = 0; i < 4; ++i) kr[i] = src[tid + 512 * i]; }
    if (w == 0) { S5_RELANE(); float a64r, a64i; { S5P P{expf(C.in[11][g]), C.in[9][g * 64 + lane], C.in[10][g * 64 + lane]}; s5_pow(P, 64.f, a64r, a64i); }
        float hre = 0.f, him = 0.f;
#pragma unroll 1
        for (int n0 = 0; n0 < 80; n0 += 16) { float er[16], ei[16];
#pragma unroll
            for (int nl = 0; nl < 16; ++nl) { er[nl] = Hl[(n0 + nl) * 128 + lane]; ei[nl] = Hl[(n0 + nl) * 128 + 64 + lane]; }
#pragma unroll
            for (int nl = 0; nl < 16; ++nl) { *(LAS bf16*)(Hin + (n0 + nl) * 272 + lane * 2) = (bf16)f2bf(hre); *(LAS bf16*)(Hin + (n0 + nl) * 272 + (64 + lane) * 2) = (bf16)f2bf(him);
                const float nr = a64r * hre - a64i * him + er[nl], ni = a64r * him + a64i * hre + ei[nl]; hre = nr; him = ni; } } }
    { S5_RELANE();
#pragma unroll
        for (int i = 0; i < 4; ++i) *(LAS v4u*)(KtL + (tid + 512 * i) * 16) = kr[i]; }
    S5_SLAB_STORE(B0);
    __syncthreads();
    { bf16x8 m2f[8][4];
        { S5_RELANE();
#pragma unroll
            for (int i = 0; i < 8; ++i)
#pragma unroll
                for (int k2 = 0; k2 < 4; ++k2) m2f[i][k2] = *(const bf16x8*)(M2g + ((size_t)(((w + 8 * i) * 4 + k2) * 64 + lane)) * 16); }
        const f32x4 dsk = *(const f32x4*)(C.in[16] + g * 16 + 4 * (C.lane >> 4));
#pragma unroll 1
        for (int nt = 0; nt < 5; ++nt) {
            LAS unsigned char* Ul = (nt & 1) ? (LAS unsigned char*)Hl : B0; LAS unsigned char* Un = (nt & 1) ? B0 : (LAS unsigned char*)Hl;
            if (nt + 1 < 5) S5_SLAB_LOAD(nt + 1);
            { S5_RELANE(); const int n = 16 * nt + cc;
                bf16x8 hb[4];
#pragma unroll
                for (int k2 = 0; k2 < 4; ++k2) hb[k2] = *(const LAS bf16x8*)(Hin + n * 272 + (32 * k2 + 8 * kg) * 2);
#pragma unroll
                for (int i = 0; i < 8; ++i) { const int t = w + 8 * i, nks = (t >> 1) + 1; f32x4 a0 = (f32x4){0.f, 0.f, 0.f, 0.f}, a1 = a0;
#pragma unroll
                    for (int k2 = 0; k2 < 4; k2 += 2) { a0 = __builtin_amdgcn_mfma_f32_16x16x32_bf16(m2f[i][k2], hb[k2], a0, 0, 0, 0); a1 = __builtin_amdgcn_mfma_f32_16x16x32_bf16(m2f[i][k2 + 1], hb[k2 + 1], a1, 0, 0, 0); }
#pragma unroll 1
                    for (int ks0 = 0; ks0 < nks; ks0 += 4) {
                        bf16x8 bq[4]; v4u av[4];
#pragma unroll
                        for (int uu = 0; uu < 4; ++uu) { const int j = 2 * (ks0 + uu) + (kg >> 1), lag = t - j, lagc = lag < 0 ? 0 : lag, jc = j > 63 ? 63 : j;
                            bq[uu] = *(const LAS bf16x8*)(Ul + cc * UL_STRIDE + jc * 32 + (kg & 1) * 16);
                            av[uu] = *(const LAS v4u*)(KtL + lagc * 512 + cc * 32 + (kg & 1) * 16); if (lag < 0) av[uu] = (v4u){0u, 0u, 0u, 0u}; }
                        a0 = __builtin_amdgcn_mfma_f32_16x16x32_bf16(as_bf16x8(av[0]), bq[0], a0, 0, 0, 0); a1 = __builtin_amdgcn_mfma_f32_16x16x32_bf16(as_bf16x8(av[1]), bq[1], a1, 0, 0, 0);
                        a0 = __builtin_amdgcn_mfma_f32_16x16x32_bf16(as_bf16x8(av[2]), bq[2], a0, 0, 0, 0); a1 = __builtin_amdgcn_mfma_f32_16x16x32_bf16(as_bf16x8(av[3]), bq[3], a1, 0, 0, 0); }
                    const f32x4 y = a0 + a1;
                    if (n >= 1 && n <= 64) { const u32x2_t uv = *(const LAS u32x2_t*)(Ul + cc * UL_STRIDE + t * 32 + kg * 8);
                        const float y0 = y[0] + dsk[0] * bflo(uv.x), y1 = y[1] + dsk[1] * bfhi(uv.x), y2 = y[2] + dsk[2] * bflo(uv.y), y3 = y[3] + dsk[3] * bfhi(uv.y);
                        u32x2_t o; o.x = pk2(gelu_fast(y0), gelu_fast(y1)); o.y = pk2(gelu_fast(y2), gelu_fast(y3));
                        *(GAS u32x2_t*)(yb + (size_t)(b * SEQ + 64 * (n - 1) + t) * 512 + g * 16 + 4 * kg) = o; } } }
            if (nt + 1 < 5) S5_SLAB_STORE(Un);
            __syncthreads();
        }
    }
#undef S5_SLAB_LOAD
#undef S5_SLAB_STORE
#undef S5_RELANE
}

constexpr unsigned CONV_ITEMS = NE * 384, CONV_P3_ITEMS = CONV_ITEMS;
__device__ __forceinline__ void phase3_v2(const Ctx& C, int parts = 7) {
    const int NSCAN = NB * NH + NB * SG;
    if (C.G > NSCAN) {
#ifndef DUP_SCAN
#define DUP_SCAN 0
#endif
        if (C.wg < NB * NH) { if (!(parts & 1)) return; dn_scan_mfma(C, C.wg >> 3, C.wg & 7); if (DUP_SCAN) { __syncthreads(); dn_scan_mfma(C, C.wg >> 3, C.wg & 7); } __syncthreads(); if (parts & 4) convert_experts(C, 0, 0u, CONV_P3_ITEMS); return; }
        { const int lw0 = C.G >= NSCAN + 8 ? NSCAN : NB * NH;
          if (C.wg >= lw0 && C.wg < lw0 + 8 && (parts & 1)) { chunk_prep(C, true, lw0); __syncthreads(); } }
        if (C.wg < NSCAN && (parts & 2)) { const int idx = C.wg - NB * NH, x8 = idx & 7, y = idx >> 3;
            s5_mfma(C, y >> 2, 4 * x8 + (y & 3)); __syncthreads(); }
        if (parts & 4) convert_experts(C, 0, 0u, CONV_P3_ITEMS);
    } else {
        if (C.wg < 8) { chunk_prep(C, true, 0); __syncthreads(); }
        for (int it = C.wg; it < NSCAN; it += C.G) { if (it < NB * NH) dn_scan_mfma(C, it >> 3, it & 7); else s5_mfma(C, (it - NB * NH) >> 5, (it - NB * NH) & 31); __syncthreads(); }
        convert_experts(C, 0, 0u, CONV_P3_ITEMS);
    }
}

__device__ __forceinline__ void phase5_branch(const Ctx& C) {
    unsigned char* ws = C.ws;
    pg8::Gemm2 g{(const bf16*)(ws + WS_OA), (const bf16*)(ws + WS_WBR), (const bf16*)(ws + WS_OB), (const bf16*)(ws + WS_WBR) + 1024 * 512, MX, 1024, 512};
    pg8::StaticOrder S; S.init(MX, 1024, C.G, C.wg);
    pg8::EpiBrFused E{(const bf16*)(ws + WS_GATES), (bf16*)(ws + WS_MERGED)};
    pg8::gemm_phase2seg<pg8::EpiBrFused, pg8::StaticOrder, true>(C.lds, g, S, E);
}

#ifndef MK_N_LAUNCHES
#define MK_N_LAUNCHES 1
#endif
constexpr int N_PHASES = 11;
struct Args { const float* in[32]; float* out; unsigned char* ws; int ph_lo, ph_hi; };
#ifndef PRE_MODE
#define PRE_MODE 0
#endif
__device__ __forceinline__ void run_phases(const Ctx& C, const XcdBarrier& bar, int lo, int hi) {
    const bool dry = PRE_MODE && hi < N_PHASES;
#define IN(k) (lo <= (k) && (k) < hi)
#define SEAM(k) do { if (IN(k) && IN((k) + 1)) xcd_barrier(bar); } while (0)
    unsigned char* ws = C.ws;
    if (IN(0)) { phase0(C); s5_tables(C); }
    SEAM(0);
    if (IN(1)) {
        pg8::Gemm g{(const bf16*)(ws + WS_H0B), (const bf16*)(ws + WS_WINT), MP, INWP, D}; pg8::StaticOrder S; S.init(MP, INWP, C.G, C.wg);
        pg8::EpiProj E{(bf16*)(ws + WS_QKV), (bf16*)(ws + WS_Z), (bf16*)(ws + WS_U), (bf16*)(ws + WS_GATES), (float*)(ws + WS_AB)};
        pg8::gemm_phase<pg8::EpiProj, pg8::StaticOrder, true, true>(C.lds, g, S, E);
    }
    SEAM(1);
    if (IN(2)) chunk_prep(C, false, 0);
    SEAM(2);
    if (IN(3)) phase3_v2(C, (dry && hi == 4) ? PRE_MODE : 7);
    SEAM(3);
    if (IN(4)) {
        { const int nglu = (MX / 256) * 2; if (C.G >= 2 * nglu) oa_postpass(C, nglu, C.G - nglu); else oa_postpass(C, 0, C.G); }
        pg8::Gemm g{(const bf16*)(ws + WS_YB), (const bf16*)(ws + WS_WGLU), MX, 512, 512}; pg8::StaticOrder S; S.init(MX, 512, C.G, C.wg);
        pg8::EpiGlu E{(const bf16*)(ws + WS_YB), C.in[18], (bf16*)(ws + WS_OB)};
        pg8::gemm_phase<pg8::EpiGlu, pg8::StaticOrder, true, true>(C.lds, g, S, E);
    }
    SEAM(4);
    if (IN(5)) phase5_branch(C);
    SEAM(5);
    if (IN(6)) {
        pg8::Gemm g{(const bf16*)(ws + WS_MERGED), (const bf16*)(ws + WS_WOUT), MX, 1024, 1024}; pg8::StaticOrder S; S.init(MX, 1024, C.G, C.wg);
        pg8::EpiOut E{C.in[0], (const float*)(ws + WS_STATS), C.in[2], C.in[3], (bf16*)(ws + WS_PRE)};
        pg8::gemm_phase<pg8::EpiOut, pg8::StaticOrder, true, true>(C.lds, g, S, E);
    }
    SEAM(6);
    if (IN(7)) { if (dry && hi == 8) phase7_rows<1>(C); else phase7_rows<0>(C); }
    SEAM(7);
    if (IN(8)) phase_moe(C);
    SEAM(9);
    if (IN(10)) { if (dry && hi == 11) phase11_final<1>(C); else phase11_final<0>(C); }
#undef IN
#undef SEAM
}
#ifndef PRE_K
#define PRE_K -1
#endif
__global__ void __launch_bounds__(NWAVES * 64, 2) mk_fwd(Args args) {
    extern __shared__ __attribute__((aligned(16))) unsigned char lds[];
    Ctx C;
    C.lds = (LAS unsigned char*)lds; C.tid = threadIdx.x; C.lane = C.tid & 63; C.wave = __builtin_amdgcn_readfirstlane(C.tid >> 6);
    C.wg = blockIdx.x; C.G = gridDim.x; C.in = args.in; C.out = args.out; C.ws = args.ws; C.ctl = (gu32*)(args.ws + WS_CTL);
    volatile LAS unsigned* MISC = (volatile LAS unsigned*)(C.lds + MISC_OFF);
    for (int u = C.tid; u < (LDS_BYTES - LDSCTL_OFF) / 4; u += NWAVES * 64) ((LAS unsigned*)(C.lds + LDSCTL_OFF))[u] = 0u;
    __syncthreads();
    XcdBarrier bar; bar.bar = (unsigned*)(C.ctl + CW_BAR); bar.x = 0; bar.st = nullptr;
    if (MK_N_LAUNCHES == 1) bar = xcd_barrier_post((unsigned*)(C.ctl + CW_BAR), MISC + 8);
    run_phases(C, bar, args.ph_lo, args.ph_hi);
}

extern "C" void kernel_launch(void* const* d_in, const int* in_sizes, int n_in, void* d_out, int out_size, void* d_ws, size_t ws_size, hipStream_t stream) {
    static int grid = 0;
    if (grid == 0) {
        if (n_in != 32 || in_sizes[0] != MX * D || out_size != MX * D || ws_size < WS_END) { fprintf(stderr, "kernel_launch: unexpected shapes (n_in %d, in0 %d, out %d, ws %zu < %zu); nothing launched\n", n_in, n_in > 0 ? in_sizes[0] : -1, out_size, ws_size, (size_t)WS_END); grid = -1; return; }
        int dev = 0, cus = 0, per_cu = 0;
        if (hipGetDevice(&dev) != hipSuccess || hipDeviceGetAttribute(&cus, hipDeviceAttributeMultiprocessorCount, dev) != hipSuccess) { grid = -1; return; }
        if (hipFuncSetAttribute((const void*)mk_fwd, hipFuncAttributeMaxDynamicSharedMemorySize, LDS_BYTES) != hipSuccess) { fprintf(stderr, "kernel_launch: hipFuncSetAttribute failed\n"); grid = -1; return; }
        if (hipOccupancyMaxActiveBlocksPerMultiprocessor(&per_cu, (const void*)mk_fwd, NWAVES * 64, LDS_BYTES) != hipSuccess || per_cu < 1) fprintf(stderr, "kernel_launch: occupancy query says %d\n", per_cu);
        (void)hipGetLastError();
        grid = cus;
    }
    if (grid < 0) return;
    if (hipMemsetAsync((char*)d_ws + WS_CTL, 0, CTL_ZERO_BYTES, stream) != hipSuccess) { fprintf(stderr, "kernel_launch: hipMemsetAsync failed\n"); return; }
    Args a{};
    for (int i = 0; i < 32; ++i) a.in[i] = (const float*)d_in[i];
    a.out = (float*)d_out; a.ws = (unsigned char*)d_ws;
#if MK_N_LAUNCHES == 1
    if (PRE_K >= 0) { a.ph_lo = 0; a.ph_hi = PRE_K + 1; hipLaunchKernelGGL(mk_fwd, dim3(grid), dim3(NWAVES * 64), LDS_BYTES, stream, a); (void)hipMemsetAsync((char*)d_ws + WS_CTL, 0, CTL_ZERO_BYTES, stream); }
    a.ph_lo = 0; a.ph_hi = N_PHASES;
    hipLaunchKernelGGL(mk_fwd, dim3(grid), dim3(NWAVES * 64), LDS_BYTES, stream, a);
#else
    for (int p = 0; p < N_PHASES; ++p) { a.ph_lo = p; a.ph_hi = p + 1; hipLaunchKernelGGL(mk_fwd, dim3(grid), dim3(NWAVES * 64), LDS_BYTES, stream, a); }
#endif
    const hipError_t le = hipPeekAtLastError();
    if (le != hipSuccess) fprintf(stderr, "kernel_launch: launch failed: %s\n", hipGetErrorName(le));
}
```

```cpp
#include <hip/hip_runtime.h>
#include <cstdio>
#include <cstdint>
namespace pg8 {
#define PG8_LAS __attribute__((address_space(3)))
typedef unsigned short bf16_t;
typedef short bf16x8 __attribute__((ext_vector_type(8)));
typedef float f32x4 __attribute__((ext_vector_type(4)));
typedef unsigned u32x4 __attribute__((ext_vector_type(4)));
constexpr int BM = 256, BK = 64, HALF = 128, HTB = HALF * BK * 2  , STAGE_BYTES = 8 * HTB, NXCD = 8, WGM = 8;

__host__ __device__ __forceinline__ int lds_byte(int r, int c) { const int st = (r >> 4) * 2 + (c >> 5), rr = r & 15, cc = c & 31, ob = rr * 64 + cc * 2; return st * 1024 + (ob ^ (((ob >> 9) & 1) << 5)); }
__host__ __device__ __forceinline__ void stage_rc(int b, int& R, int& C) { const int st = b / 1024, sb = b % 1024, swz = sb ^ (((sb >> 9) & 1) << 5); R = (st >> 1) * 16 + swz / 64; C = (st & 1) * 32 + (swz % 64) / 2; }
__host__ __device__ __forceinline__ int perm32(int rho) { const int n = rho >> 4, i = rho & 15; return 8 * (i >> 2) + 4 * n + (i & 3); }

struct Unit { int pm, pn; };
struct Gemm { const bf16_t* A; const bf16_t* Bt; int M, N, K; };

struct StaticOrder {
    int nM, nN, nwg, G, c;
    __host__ __device__ void init(int M, int N, int G_, int c_) { nM = M / BM; nN = N / BM; nwg = nM * nN; G = G_; c = c_; }
    __host__ __device__ bool next(int i, Unit& u) const {
        const long L = (long)i * G + c; if (L >= nwg) return false;
        int wgid = (int)L; { const int q = nwg / NXCD, r = nwg % NXCD, xcd = wgid % NXCD, off = wgid / NXCD; wgid = (xcd < r ? xcd * (q + 1) : r * (q + 1) + (xcd - r) * q) + off; }
        const int nig = WGM * nN, gid = wgid / nig, fm = gid * WGM, gsz = (nM - fm) < WGM ? (nM - fm) : WGM;
        u.pm = fm + ((wgid % nig) % gsz); u.pn = (wgid % nig) / gsz; return true;
    }
    __device__ __forceinline__ void a_ready(const Unit&) const {}
    __device__ __forceinline__ void done(const Unit&) const {}
};

__device__ __forceinline__ unsigned cvt_pk_bf16(float lo, float hi) { unsigned r; asm volatile("v_cvt_pk_bf16_f32 %0, %1, %2" : "=v"(r) : "v"(lo), "v"(hi)); return r; }
template <class Epi, class Sched, bool ALIGN_EPI = false, bool SP2 = false>
__device__ __forceinline__ void gemm_phase(PG8_LAS unsigned char* lds, const Gemm g, const Sched& S, const Epi& E) {
    const int tid = threadIdx.x, wid = __builtin_amdgcn_readfirstlane(tid >> 6), lane = tid & 63, wr = wid >> 2, wc = wid & 3, fr = lane & 15, fq = lane >> 4;
    const int K = g.K, nt = K / BK;
    unsigned voffA[2], voffB[2];
#pragma unroll
    for (int i = 0; i < 2; ++i) { int R, C; stage_rc(tid * 16 + i * 8192, R, C); const int Rb = Epi::PERM ? ((R & ~31) + perm32(R & 31)) : R;
        voffA[i] = (unsigned)(R * K + C) * 2u; voffB[i] = (unsigned)(Rb * K + C) * 2u; }
    const size_t kstep = (size_t)(BK * 2);
    const size_t hstep = (size_t)HALF * K * 2;
    const size_t tstep = 2 * hstep;
    const unsigned ldsw = (unsigned)wid * 1024u;
    const int aoff = lds_byte(wr * 64 + fr, fq * 8), boff = lds_byte(wc * 32 + fr, fq * 8);
#define PG8_SA(b, h) (((b) * 2 + (h)) * HTB)
#define PG8_SB(b, h) ((4 + (b) * 2 + (h)) * HTB)
#define PG8_STAGE(bufoff, gbase, voff) do { _Pragma("unroll") for (int _i = 0; _i < 2; ++_i) \
        __builtin_amdgcn_global_load_lds((const unsigned*)((const char*)(gbase) + (voff)[_i]), (PG8_LAS unsigned*)(lds + (bufoff) + ldsw + _i * 8192), 16, 0, 0); } while (0)
#define PG8_LDA(dst, b, h) do { _Pragma("unroll") for (int m = 0; m < 4; ++m) _Pragma("unroll") for (int k = 0; k < 2; ++k) dst[m][k] = *(const PG8_LAS bf16x8*)(lds + PG8_SA(b, h) + aoff + m * 2048 + k * 1024); } while (0)
#define PG8_LDB(dst, b, h) do { _Pragma("unroll") for (int n = 0; n < 2; ++n) _Pragma("unroll") for (int k = 0; k < 2; ++k) dst[n][k] = *(const PG8_LAS bf16x8*)(lds + PG8_SB(b, h) + boff + n * 2048 + k * 1024); } while (0)
#define PG8_MMA(ai, bj, At, Bt) do { __builtin_amdgcn_s_setprio(1); _Pragma("unroll") for (int m = 0; m < 4; ++m) _Pragma("unroll") for (int n = 0; n < 2; ++n) _Pragma("unroll") for (int k = 0; k < 2; ++k) \
        acc[ai][bj][m][n] = __builtin_amdgcn_mfma_f32_16x16x32_bf16(Bt[n][k], At[m][k], acc[ai][bj][m][n], 0, 0, 0); __builtin_amdgcn_s_setprio(0); } while (0)
#define PG8_WAIT_V(n) asm volatile("s_waitcnt vmcnt(" #n ")" ::: "memory")
#define PG8_WAIT_L(n) asm volatile("s_waitcnt lgkmcnt(" #n ")" ::: "memory")
#define PG8_BAR __builtin_amdgcn_s_barrier()
#define PG8_SCHED __builtin_amdgcn_sched_barrier(0)
    Unit cur, nxt; int ui = 0;
    if (!S.next(0, cur)) return;
    f32x4 acc[2][2][4][2];
#pragma unroll
    for (int a = 0; a < 2; ++a)
#pragma unroll
        for (int b = 0; b < 2; ++b)
#pragma unroll
            for (int m = 0; m < 4; ++m)
#pragma unroll
                for (int n = 0; n < 2; ++n) acc[a][b][m][n] = (f32x4){0.f, 0.f, 0.f, 0.f};
    bf16x8 At[4][2], B0[2][2], B1[2][2];
    const char* cA = (const char*)g.A + (size_t)cur.pm * tstep; const char* cB = (const char*)g.Bt + (size_t)cur.pn * tstep;
    S.a_ready(cur);
    if constexpr (SP2) {
        PG8_STAGE(PG8_SB(0, 0), cB, voffB); PG8_STAGE(PG8_SB(0, 1), cB + hstep, voffB); PG8_STAGE(PG8_SA(0, 0), cA, voffA); PG8_STAGE(PG8_SA(0, 1), cA + hstep, voffA);
        if (wr == 1) PG8_BAR;
        PG8_WAIT_V(2); PG8_BAR;
        PG8_STAGE(PG8_SB(1, 0), cB + kstep, voffB); PG8_STAGE(PG8_SA(1, 0), cA + kstep, voffA); PG8_STAGE(PG8_SB(1, 1), cB + hstep + kstep, voffB);
        PG8_WAIT_V(6); PG8_BAR;
    } else {
        PG8_STAGE(PG8_SB(0, 0), cB, voffB); PG8_STAGE(PG8_SA(0, 0), cA, voffA); PG8_STAGE(PG8_SB(0, 1), cB + hstep, voffB); PG8_STAGE(PG8_SA(0, 1), cA + hstep, voffA);
        if (wr == 1) PG8_BAR;
        PG8_WAIT_V(4); PG8_BAR;
        PG8_STAGE(PG8_SB(1, 0), cB + kstep, voffB); PG8_STAGE(PG8_SA(1, 0), cA + kstep, voffA); PG8_STAGE(PG8_SB(1, 1), cB + hstep + kstep, voffB);
        PG8_WAIT_V(6); PG8_BAR;
    }
    for (;;) {
        const bool has_next = S.next(ui + 1, nxt);
        const char* nA = has_next ? (const char*)g.A + (size_t)nxt.pm * tstep : cA; const char* nB = has_next ? (const char*)g.Bt + (size_t)nxt.pn * tstep : cB;
        for (int t = 0; t < nt; t += 2) {
            const bool last = (t == nt - 2);
            const char* a1 = cA + (size_t)(t + 1) * kstep;
            const char* a2 = last ? nA : cA + (size_t)(t + 2) * kstep; const char* b2 = last ? nB : cB + (size_t)(t + 2) * kstep;
            const char* a3 = a2 + kstep; const char* b3 = b2 + kstep;
            if (last && has_next) S.a_ready(nxt);
            if constexpr (SP2) {
            PG8_LDB(B0, 0, 0); PG8_LDB(B1, 0, 1); PG8_SCHED; PG8_LDA(At, 0, 0); PG8_STAGE(PG8_SA(1, 1), a1 + hstep, voffA);
            PG8_WAIT_V(8); PG8_WAIT_L(0); PG8_BAR; PG8_MMA(0, 0, At, B0); PG8_MMA(0, 1, At, B1); PG8_BAR; PG8_SCHED;
            PG8_LDA(At, 0, 1); PG8_STAGE(PG8_SB(0, 0), b2, voffB); PG8_STAGE(PG8_SB(0, 1), b2 + hstep, voffB); PG8_STAGE(PG8_SA(0, 0), a2, voffA);
            PG8_WAIT_V(8); PG8_WAIT_L(0); PG8_BAR; PG8_MMA(1, 0, At, B0); PG8_MMA(1, 1, At, B1); PG8_BAR; PG8_SCHED;
            PG8_LDB(B0, 1, 0); PG8_LDB(B1, 1, 1); PG8_SCHED; PG8_LDA(At, 1, 0); PG8_STAGE(PG8_SA(0, 1), a2 + hstep, voffA);
            PG8_WAIT_V(8); PG8_WAIT_L(0); PG8_BAR; PG8_MMA(0, 0, At, B0); PG8_MMA(0, 1, At, B1); PG8_BAR; PG8_SCHED;
            PG8_LDA(At, 1, 1); PG8_STAGE(PG8_SB(1, 0), b3, voffB); PG8_STAGE(PG8_SB(1, 1), b3 + hstep, voffB); PG8_STAGE(PG8_SA(1, 0), a3, voffA);
            PG8_WAIT_V(8); PG8_WAIT_L(0); PG8_BAR; PG8_MMA(1, 0, At, B0); PG8_MMA(1, 1, At, B1); PG8_BAR; PG8_SCHED;
            } else {
            PG8_LDB(B0, 0, 0); PG8_SCHED; PG8_LDA(At, 0, 0); PG8_STAGE(PG8_SA(1, 1), a1 + hstep, voffA);
            PG8_WAIT_L(8); PG8_BAR; PG8_WAIT_L(0); PG8_MMA(0, 0, At, B0); PG8_BAR; PG8_SCHED;
            PG8_LDB(B1, 0, 1); PG8_STAGE(PG8_SB(0, 0), b2, voffB);
            PG8_BAR; PG8_WAIT_L(0); PG8_MMA(0, 1, At, B1); PG8_BAR;
            PG8_LDA(At, 0, 1); PG8_STAGE(PG8_SA(0, 0), a2, voffA);
            PG8_BAR; PG8_WAIT_L(0); PG8_MMA(1, 0, At, B0); PG8_BAR; PG8_SCHED;
            PG8_STAGE(PG8_SB(0, 1), b2 + hstep, voffB);
            PG8_WAIT_V(6); PG8_BAR; PG8_MMA(1, 1, At, B1); PG8_BAR;
            PG8_LDB(B0, 1, 0); PG8_SCHED; PG8_LDA(At, 1, 0); PG8_STAGE(PG8_SA(0, 1), a2 + hstep, voffA);
            PG8_WAIT_L(8); PG8_BAR; PG8_WAIT_L(0); PG8_MMA(0, 0, At, B0); PG8_BAR; PG8_SCHED;
            PG8_LDB(B1, 1, 1); PG8_STAGE(PG8_SB(1, 0), b3, voffB);
            PG8_BAR; PG8_WAIT_L(0); PG8_MMA(0, 1, At, B1); PG8_BAR;
            PG8_LDA(At, 1, 1); PG8_STAGE(PG8_SA(1, 0), a3, voffA);
            PG8_BAR; PG8_WAIT_L(0); PG8_MMA(1, 0, At, B0); PG8_BAR; PG8_SCHED;
            PG8_STAGE(PG8_SB(1, 1), b3 + hstep, voffB);
            PG8_WAIT_V(6); PG8_BAR; PG8_MMA(1, 1, At, B1); PG8_BAR;
            }
        }
        if constexpr (ALIGN_EPI) { if (wr == 0) PG8_BAR; }
        if constexpr (!Epi::AFTER_DRAIN) { E(acc, cur, wr, wc, fr, fq); S.done(cur); }
        if (!has_next) break;
#pragma unroll
        for (int a = 0; a < 2; ++a)
#pragma unroll
            for (int b = 0; b < 2; ++b)
#pragma unroll
                for (int m = 0; m < 4; ++m)
#pragma unroll
                    for (int n = 0; n < 2; ++n) acc[a][b][m][n] = (f32x4){0.f, 0.f, 0.f, 0.f};
        cur = nxt; cA = nA; cB = nB; ++ui;
        if constexpr (ALIGN_EPI) { if (wr == 1) PG8_BAR; }
    }
    PG8_WAIT_V(0);
    if constexpr (!ALIGN_EPI) { if (wr == 0) PG8_BAR; }
    PG8_BAR;
    if constexpr (Epi::AFTER_DRAIN) { E.fused(acc, cur, wr, wc, fr, fq, lds, wid, lane); S.done(cur); }
#undef PG8_SA
#undef PG8_SB
#undef PG8_STAGE
#undef PG8_LDA
#undef PG8_LDB
#undef PG8_MMA
#undef PG8_WAIT_V
#undef PG8_WAIT_L
#undef PG8_BAR
#undef PG8_SCHED
}
}
#define GAS __attribute__((address_space(1)))
#define LAS __attribute__((address_space(3)))
typedef unsigned short bf16;
typedef unsigned v4u __attribute__((ext_vector_type(4)));
typedef float f32x4 __attribute__((ext_vector_type(4)));
typedef short bf16x8 __attribute__((ext_vector_type(8)));
typedef GAS unsigned gu32;
typedef GAS unsigned long long gu64;
#define RLX_AGENT __ATOMIC_RELAXED, __HIP_MEMORY_SCOPE_AGENT
#define LDS_WAIT() asm volatile("s_waitcnt lgkmcnt(0)" ::: "memory")
#define VM_WAIT() asm volatile("s_waitcnt vmcnt(0)" ::: "memory")
__device__ __forceinline__ unsigned long long rt() { return __builtin_amdgcn_s_memrealtime(); }
typedef __bf16 hwbf16x2 __attribute__((ext_vector_type(2)));
typedef float hwf32x2 __attribute__((ext_vector_type(2)));
__device__ __forceinline__ unsigned pk2(float lo, float hi) { return __builtin_bit_cast(unsigned, __builtin_convertvector((hwf32x2){lo, hi}, hwbf16x2)); }
__device__ __forceinline__ unsigned f2bf(float f) { return pk2(f, 0.f) & 0xffffu; }

#define XB_TMO      128
#define XB_XCNT(j)  (256  + 64 * (j))
#define XB_XSUB(j)  (1280 + 64 * (j))
#define XB_XGEN(j)  (2304 + 64 * (j))
#define XB_TOP      3328
#define XB_TOPGEN   3392
#define XCD_BAR_WORDS 3456
#define XB_SPIN_CAP (1u << 18)

__device__ __forceinline__ unsigned xb_ld(unsigned* p)              { return __hip_atomic_load(p, __ATOMIC_RELAXED, __HIP_MEMORY_SCOPE_AGENT); }
__device__ __forceinline__ unsigned xb_add(unsigned* p, unsigned v) { return __hip_atomic_fetch_add(p, v, __ATOMIC_RELAXED, __HIP_MEMORY_SCOPE_AGENT); }
__device__ __forceinline__ unsigned xb_xcc_id() { return (unsigned)__builtin_amdgcn_s_getreg((3 << 11) | 20) & 0xFu; }
#define XB_SPIN(cond, bar) do { unsigned _sp = 0; while (cond) { __builtin_amdgcn_s_sleep(1); \
    if ((++_sp & 255u) == 0u) { if (xb_ld(&(bar)[XB_TMO])) break; if (_sp > XB_SPIN_CAP) { atomicAdd(&(bar)[XB_TMO], 1u); break; } } } } while (0)

struct XcdBarrier {
    unsigned* bar; unsigned x;
    volatile LAS unsigned* st;
};

__device__ __forceinline__ XcdBarrier xcd_barrier_post(unsigned* bar, volatile LAS unsigned* st) {
    XcdBarrier b; b.bar = bar; b.x = xb_xcc_id(); b.st = st;
    if (threadIdx.x == 0) (void)xb_add(&bar[XB_XCNT(b.x)], 1u);
    return b;
}
__device__ __forceinline__ void xcd_barrier_complete(unsigned* bar, unsigned x, unsigned& nloc, unsigned& nx) {
    const unsigned G = gridDim.x * gridDim.y * gridDim.z;
    unsigned sum, cnt, mine, sp = 0u;
    for (;;) {
        sum = 0u; cnt = 0u; mine = 0u;
#pragma unroll
        for (unsigned j = 0; j < 16; ++j) { const unsigned c = xb_ld(&bar[XB_XCNT(j)]); sum += c; cnt += (c > 0u) ? 1u : 0u; mine = (j == x) ? c : mine; }
        if (sum == G) break;
        __builtin_amdgcn_s_sleep(1);
        if ((++sp & 255u) == 0u) { if (xb_ld(&bar[XB_TMO])) break; if (sp > XB_SPIN_CAP) { atomicAdd(&bar[XB_TMO], 1u); break; } }
    }
    nloc = mine > 0u ? mine : 1u; nx = cnt > 0u ? cnt : 1u;
}

__device__ __forceinline__ void xcd_barrier(const XcdBarrier& b) {
    asm volatile("s_waitcnt vmcnt(0)" ::: "memory");
    __syncthreads();
    if (threadIdx.x == 0) {
        unsigned* bar = b.bar;
        __builtin_amdgcn_s_waitcnt(0);
        unsigned nloc = b.st[0], nx = b.st[1];
        if (nloc == 0u) { xcd_barrier_complete(bar, b.x, nloc, nx); b.st[0] = nloc; b.st[1] = nx; }
        const unsigned old = xb_add(&bar[XB_XSUB(b.x)], 1u);
        const unsigned gen = old / nloc;
        if (old + 1u == (gen + 1u) * nloc) {
            __builtin_amdgcn_fence(__ATOMIC_RELEASE, "agent");
            asm volatile("s_waitcnt vmcnt(0)" ::: "memory");
            const unsigned og = xb_add(&bar[XB_TOP], 1u);
            const unsigned tg = og / nx;
            if (og + 1u == (tg + 1u) * nx) xb_add(&bar[XB_TOPGEN], 1u);
            else XB_SPIN(xb_ld(&bar[XB_TOPGEN]) == tg, bar);
            __builtin_amdgcn_fence(__ATOMIC_ACQUIRE, "agent");
            xb_add(&bar[XB_XGEN(b.x)], 1u);
            asm volatile("s_waitcnt vmcnt(0)" ::: "memory");
        } else {
            XB_SPIN(xb_ld(&bar[XB_XGEN(b.x)]) == gen, bar);
            __builtin_amdgcn_fence(__ATOMIC_ACQUIRE, "agent");
            asm volatile("s_waitcnt vmcnt(0)" ::: "memory");
        }
    }
    __syncthreads();
}
namespace pg8 {
struct Gemm2 { const bf16_t* A1; const bf16_t* B1; const bf16_t* A2; const bf16_t* B2; int M, N, Kseg; };
template <class Epi, class Sched, bool ALIGN_EPI = false>
__device__ __forceinline__ void gemm_phase2seg(PG8_LAS unsigned char* lds, const Gemm2 g, const Sched& S, const Epi& E) {
    constexpr bool SP2 = true;
    const int tid = threadIdx.x, wid = __builtin_amdgcn_readfirstlane(tid >> 6), lane = tid & 63, wr = wid >> 2, wc = wid & 3, fr = lane & 15, fq = lane >> 4;
    const int K = g.Kseg, half = K / BK, nt = 2 * half;
    unsigned voffA[2], voffB[2];
#pragma unroll
    for (int i = 0; i < 2; ++i) { int R, C; stage_rc(tid * 16 + i * 8192, R, C); const int Rb = Epi::PERM ? ((R & ~31) + perm32(R & 31)) : R;
        voffA[i] = (unsigned)(R * K + C) * 2u; voffB[i] = (unsigned)(Rb * K + C) * 2u; }
    const size_t kstep = (size_t)(BK * 2);
    const size_t hstep = (size_t)HALF * K * 2;
    const size_t tstep = 2 * hstep;
    const unsigned ldsw = (unsigned)wid * 1024u;
    const int aoff = lds_byte(wr * 64 + fr, fq * 8), boff = lds_byte(wc * 32 + fr, fq * 8);
#define PG8_SA(b, h) (((b) * 2 + (h)) * HTB)
#define PG8_SB(b, h) ((4 + (b) * 2 + (h)) * HTB)
#define PG8_STAGE(bufoff, gbase, voff) do { _Pragma("unroll") for (int _i = 0; _i < 2; ++_i) \
        __builtin_amdgcn_global_load_lds((const unsigned*)((const char*)(gbase) + (voff)[_i]), (PG8_LAS unsigned*)(lds + (bufoff) + ldsw + _i * 8192), 16, 0, 0); } while (0)
#define PG8_LDA(dst, b, h) do { _Pragma("unroll") for (int m = 0; m < 4; ++m) _Pragma("unroll") for (int k = 0; k < 2; ++k) dst[m][k] = *(const PG8_LAS bf16x8*)(lds + PG8_SA(b, h) + aoff + m * 2048 + k * 1024); } while (0)
#define PG8_LDB(dst, b, h) do { _Pragma("unroll") for (int n = 0; n < 2; ++n) _Pragma("unroll") for (int k = 0; k < 2; ++k) dst[n][k] = *(const PG8_LAS bf16x8*)(lds + PG8_SB(b, h) + boff + n * 2048 + k * 1024); } while (0)
#define PG8_MMA(ai, bj, At, Bt) do { __builtin_amdgcn_s_setprio(1); _Pragma("unroll") for (int m = 0; m < 4; ++m) _Pragma("unroll") for (int n = 0; n < 2; ++n) _Pragma("unroll") for (int k = 0; k < 2; ++k) \
        acc[ai][bj][m][n] = __builtin_amdgcn_mfma_f32_16x16x32_bf16(Bt[n][k], At[m][k], acc[ai][bj][m][n], 0, 0, 0); __builtin_amdgcn_s_setprio(0); } while (0)
#define PG8_WAIT_V(n) asm volatile("s_waitcnt vmcnt(" #n ")" ::: "memory")
#define PG8_WAIT_L(n) asm volatile("s_waitcnt lgkmcnt(" #n ")" ::: "memory")
#define PG8_BAR __builtin_amdgcn_s_barrier()
#define PG8_SCHED __builtin_amdgcn_sched_barrier(0)
    Unit cur, nxt; int ui = 0;
    if (!S.next(0, cur)) return;
    f32x4 acc[2][2][4][2];
#pragma unroll
    for (int a = 0; a < 2; ++a)
#pragma unroll
        for (int b = 0; b < 2; ++b)
#pragma unroll
            for (int m = 0; m < 4; ++m)
#pragma unroll
                for (int n = 0; n < 2; ++n) acc[a][b][m][n] = (f32x4){0.f, 0.f, 0.f, 0.f};
    bf16x8 At[4][2], B0[2][2], B1[2][2];
    const char* cA = (const char*)g.A1 + (size_t)cur.pm * tstep; const char* cB = (const char*)g.B1 + (size_t)cur.pn * tstep;
    const char* cA2 = (const char*)g.A2 + (size_t)cur.pm * tstep; const char* cB2 = (const char*)g.B2 + (size_t)cur.pn * tstep;
    S.a_ready(cur);
    if constexpr (SP2) {
        PG8_STAGE(PG8_SB(0, 0), cB, voffB); PG8_STAGE(PG8_SB(0, 1), cB + hstep, voffB); PG8_STAGE(PG8_SA(0, 0), cA, voffA); PG8_STAGE(PG8_SA(0, 1), cA + hstep, voffA);
        if (wr == 1) PG8_BAR;
        PG8_WAIT_V(2); PG8_BAR;
        PG8_STAGE(PG8_SB(1, 0), cB + kstep, voffB); PG8_STAGE(PG8_SA(1, 0), cA + kstep, voffA); PG8_STAGE(PG8_SB(1, 1), cB + hstep + kstep, voffB);
        PG8_WAIT_V(6); PG8_BAR;
    } else {
        PG8_STAGE(PG8_SB(0, 0), cB, voffB); PG8_STAGE(PG8_SA(0, 0), cA, voffA); PG8_STAGE(PG8_SB(0, 1), cB + hstep, voffB); PG8_STAGE(PG8_SA(0, 1), cA + hstep, voffA);
        if (wr == 1) PG8_BAR;
        PG8_WAIT_V(4); PG8_BAR;
        PG8_STAGE(PG8_SB(1, 0), cB + kstep, voffB); PG8_STAGE(PG8_SA(1, 0), cA + kstep, voffA); PG8_STAGE(PG8_SB(1, 1), cB + hstep + kstep, voffB);
        PG8_WAIT_V(6); PG8_BAR;
    }
    for (;;) {
        const bool has_next = S.next(ui + 1, nxt);
        const char* nA = has_next ? (const char*)g.A1 + (size_t)nxt.pm * tstep : cA; const char* nB = has_next ? (const char*)g.B1 + (size_t)nxt.pn * tstep : cB;
        for (int t = 0; t < nt; t += 2) {
            const bool last = (t == nt - 2);
            if (t == half) E.mid(acc, cur, wr, wc, fr, fq);
            const char* a1 = (t + 1 < half) ? cA + (size_t)(t + 1) * kstep : cA2 + (size_t)(t + 1 - half) * kstep;
            const char* a2 = last ? nA : ((t + 2 < half) ? cA + (size_t)(t + 2) * kstep : cA2 + (size_t)(t + 2 - half) * kstep);
            const char* b2 = last ? nB : ((t + 2 < half) ? cB + (size_t)(t + 2) * kstep : cB2 + (size_t)(t + 2 - half) * kstep);
            const char* a3 = a2 + kstep; const char* b3 = b2 + kstep;
            if (last && has_next) S.a_ready(nxt);
            if constexpr (SP2) {
            PG8_LDB(B0, 0, 0); PG8_LDB(B1, 0, 1); PG8_SCHED; PG8_LDA(At, 0, 0); PG8_STAGE(PG8_SA(1, 1), a1 + hstep, voffA);
            PG8_WAIT_V(8); PG8_WAIT_L(0); PG8_BAR; PG8_MMA(0, 0, At, B0); PG8_MMA(0, 1, At, B1); PG8_BAR; PG8_SCHED;
            PG8_LDA(At, 0, 1); PG8_STAGE(PG8_SB(0, 0), b2, voffB); PG8_STAGE(PG8_SB(0, 1), b2 + hstep, voffB); PG8_STAGE(PG8_SA(0, 0), a2, voffA);
            PG8_WAIT_V(8); PG8_WAIT_L(0); PG8_BAR; PG8_MMA(1, 0, At, B0); PG8_MMA(1, 1, At, B1); PG8_BAR; PG8_SCHED;
            PG8_LDB(B0, 1, 0); PG8_LDB(B1, 1, 1); PG8_SCHED; PG8_LDA(At, 1, 0); PG8_STAGE(PG8_SA(0, 1), a2 + hstep, voffA);
            PG8_WAIT_V(8); PG8_WAIT_L(0); PG8_BAR; PG8_MMA(0, 0, At, B0); PG8_MMA(0, 1, At, B1); PG8_BAR; PG8_SCHED;
            PG8_LDA(At, 1, 1); PG8_STAGE(PG8_SB(1, 0), b3, voffB); PG8_STAGE(PG8_SB(1, 1), b3 + hstep, voffB); PG8_STAGE(PG8_SA(1, 0), a3, voffA);
            PG8_WAIT_V(8); PG8_WAIT_L(0); PG8_BAR; PG8_MMA(1, 0, At, B0); PG8_MMA(1, 1, At, B1); PG8_BAR; PG8_SCHED;
            } else {
            PG8_LDB(B0, 0, 0); PG8_SCHED; PG8_LDA(At, 0, 0); PG8_STAGE(PG8_SA(1, 1), a1 + hstep, voffA);
            PG8_WAIT_L(8); PG8_BAR; PG8_WAIT_L(0); PG8_MMA(0, 0, At, B0); PG8_BAR; PG8_SCHED;
            PG8_LDB(B1, 0, 1); PG8_STAGE(PG8_SB(0, 0), b2, voffB);
            PG8_BAR; PG8_WAIT_L(0); PG8_MMA(0, 1, At, B1); PG8_BAR;
            PG8_LDA(At, 0, 1); PG8_STAGE(PG8_SA(0, 0), a2, voffA);
            PG8_BAR; PG8_WAIT_L(0); PG8_MMA(1, 0, At, B0); PG8_BAR; PG8_SCHED;
            PG8_STAGE(PG8_SB(0, 1), b2 + hstep, voffB);
            PG8_WAIT_V(6); PG8_BAR; PG8_MMA(1, 1, At, B1); PG8_BAR;
            PG8_LDB(B0, 1, 0); PG8_SCHED; PG8_LDA(At, 1, 0); PG8_STAGE(PG8_SA(0, 1), a2 + hstep, voffA);
            PG8_WAIT_L(8); PG8_BAR; PG8_WAIT_L(0); PG8_MMA(0, 0, At, B0); PG8_BAR; PG8_SCHED;
            PG8_LDB(B1, 1, 1); PG8_STAGE(PG8_SB(1, 0), b3, voffB);
            PG8_BAR; PG8_WAIT_L(0); PG8_MMA(0, 1, At, B1); PG8_BAR;
            PG8_LDA(At, 1, 1); PG8_STAGE(PG8_SA(1, 0), a3, voffA);
            PG8_BAR; PG8_WAIT_L(0); PG8_MMA(1, 0, At, B0); PG8_BAR; PG8_SCHED;
            PG8_STAGE(PG8_SB(1, 1), b3 + hstep, voffB);
            PG8_WAIT_V(6); PG8_BAR; PG8_MMA(1, 1, At, B1); PG8_BAR;
            }
        }
        if constexpr (ALIGN_EPI) { if (wr == 0) PG8_BAR; }
        if constexpr (!Epi::AFTER_DRAIN) { E(acc, cur, wr, wc, fr, fq); S.done(cur); }
        if (!has_next) break;
#pragma unroll
        for (int a = 0; a < 2; ++a)
#pragma unroll
            for (int b = 0; b < 2; ++b)
#pragma unroll
                for (int m = 0; m < 4; ++m)
#pragma unroll
                    for (int n = 0; n < 2; ++n) acc[a][b][m][n] = (f32x4){0.f, 0.f, 0.f, 0.f};
        cur = nxt; cA = nA; cB = nB; cA2 = (const char*)g.A2 + (size_t)cur.pm * tstep; cB2 = (const char*)g.B2 + (size_t)cur.pn * tstep; ++ui;
        if constexpr (ALIGN_EPI) { if (wr == 1) PG8_BAR; }
    }
    PG8_WAIT_V(0);
    if constexpr (!ALIGN_EPI) { if (wr == 0) PG8_BAR; }
    PG8_BAR;
    if constexpr (Epi::AFTER_DRAIN) { E.fused(acc, cur, wr, wc, fr, fq, lds, wid, lane); S.done(cur); }
#undef PG8_SA
#undef PG8_SB
#undef PG8_STAGE
#undef PG8_LDA
#undef PG8_LDB
#undef PG8_MMA
#undef PG8_WAIT_V
#undef PG8_WAIT_L
#undef PG8_BAR
#undef PG8_SCHED
}
}

constexpr int NWAVES = 8;
constexpr int D = 1024, NB = 4, SEQ = 4096, PADF = 48, LP = 4160, NCH = 65, MP = NB * LP  , MX = NB * SEQ  ;
constexpr int INW = 4624, INWP = 4864, NH = 8, SG = 32;
constexpr int NE = 64;
constexpr float LN_EPS = 1e-5f, NORM_EPS = 1e-6f, ALPHA = 1.189207115002721f;

constexpr size_t MiB = 1u << 20;
constexpr size_t WS_CTL = 0, CTL_ZERO_BYTES = 512 * 1024;
constexpr size_t WS_STATS = 1 * MiB;
constexpr size_t WS_ROUTE = WS_STATS + 128 * 1024;
constexpr size_t WS_INV = WS_ROUTE + 512 * 1024;
constexpr size_t WS_WRT = WS_INV + 192 * 1024;
constexpr size_t WS_AB = 2 * MiB;
constexpr size_t WS_WGLU = 3 * MiB + 512 * 1024;
constexpr size_t WS_WBR = WS_WGLU + 512 * 1024;
constexpr size_t WS_WOUT = WS_WBR + 2 * MiB;
constexpr size_t WS_W13 = 8 * MiB;
constexpr size_t WS_W2 = WS_W13 + 64 * MiB;
constexpr size_t WS_WINT = 8 * MiB;
constexpr size_t WS_H0B = WS_WINT + (size_t)INWP * D * 2;
constexpr size_t WS_QKV = WS_H0B + (size_t)MP * D * 2;
static_assert(WS_QKV + (size_t)MP * 1536 * 2 <= 104 * MiB, "overlay");
constexpr size_t WS_Z = 104 * MiB;
constexpr size_t WS_U = WS_Z + (size_t)MP * 512 * 2;
constexpr size_t WS_GATES = WS_U + (size_t)MP * 512 * 2;
constexpr size_t WS_OA = WS_GATES + (size_t)MP * 2048 * 2;
constexpr size_t WS_YB = WS_OA + 16 * MiB;
constexpr size_t WS_OB = WS_YB + 16 * MiB;
constexpr size_t WS_MERGED = WS_OB + 16 * MiB;
constexpr size_t WS_END = WS_MERGED + 32 * MiB;
static_assert(WS_END <= 283 * MiB, "d_ws map");
constexpr size_t WS_TMP = WS_Z;
constexpr size_t WS_PRE = WS_GATES;
constexpr size_t WS_H1 = WS_Z;
constexpr size_t WS_INV2 = WS_OB;
constexpr size_t WS_HID = WS_OA;
static_assert(WS_TMP + 32 * MiB <= WS_GATES && WS_PRE + 64 * MiB <= WS_OA, "overlays");
constexpr size_t DO_QN = 0, DO_KN = (size_t)MP * 512 * 2, DO_VN = 2 * DO_KN, DO_BETA = 3 * DO_KN, DO_ALPHA = DO_BETA + (size_t)MP * 8 * 4;
constexpr int CW_BAR = 4096, CW_CNT = 65536, CNT_STRIDE = 1024;
constexpr int RING_BYTES = 131072, LDS_BYTES = 163840, LDSCTL_OFF = LDS_BYTES - 1024, MISC_OFF = LDSCTL_OFF + 320;

__device__ __forceinline__ float bf2f(unsigned short h) { return __builtin_bit_cast(float, (unsigned)h << 16); }
__device__ __forceinline__ float bflo(unsigned w) { return __builtin_bit_cast(float, w << 16); }
__device__ __forceinline__ float bfhi(unsigned w) { return __builtin_bit_cast(float, w & 0xffff0000u); }
__device__ __forceinline__ float sigm(float x) { return __builtin_amdgcn_rcpf(1.f + __expf(-x)); }
__device__ __forceinline__ float silu_(float x) { return x * sigm(x); }
__device__ __forceinline__ float softplus_(float x) { return x > 20.f ? x : log1pf(expf(x)); }
__device__ __forceinline__ float gelu_tanh(float x) { const float u = 0.7978845608028654f * (x + 0.044715f * x * x * x); return 0.5f * x * (1.f + tanhf(u)); }
__device__ __forceinline__ float wave_sum(float v) {
#define WS_DPP(ctrl_, rmask_) v += __int_as_float(__builtin_amdgcn_update_dpp(0, __float_as_int(v), ctrl_, rmask_, 0xf, true))
    WS_DPP(0x111, 0xf); WS_DPP(0x112, 0xf); WS_DPP(0x114, 0xf); WS_DPP(0x118, 0xf);
    WS_DPP(0x142, 0xa);
    WS_DPP(0x143, 0xc);
#undef WS_DPP
    return __int_as_float(__builtin_amdgcn_readlane(__float_as_int(v), 63));
}
__device__ __forceinline__ int prow_of(int xrow) { return (xrow >> 12) * LP + 64 + (xrow & 4095); }

namespace pg8 {
struct EpiProj {
    static constexpr bool PERM = true, AFTER_DRAIN = false;
    bf16_t *qkv, *z, *u, *gates; float* ab;
    __device__ __forceinline__ void operator()(const f32x4 (&acc)[2][2][4][2], const Unit& un, int wr, int wc, int fr, int fq) const {
        const int pn = un.pn; bf16_t* base; int ld, cb;
        if (pn < 6) { base = qkv; ld = 1536; cb = pn * 256; }
        else if (pn < 8) { base = z; ld = 512; cb = (pn - 6) * 256; }
        else if (pn < 10) {
            const int row0u = un.pm * BM + wr * 64 + fr, c0u = (pn - 8) * 256 + wc * 32 + 8 * fq;
#pragma unroll
            for (int ai = 0; ai < 2; ++ai)
#pragma unroll
                for (int m = 0; m < 4; ++m)
#pragma unroll
                    for (int bj = 0; bj < 2; ++bj) { const int col = c0u + bj * HALF, row = row0u + ai * HALF + m * 16; const f32x4 v0 = acc[ai][bj][m][0], v1 = acc[ai][bj][m][1]; u32x4 w;
                        w.x = cvt_pk_bf16(v0[0], v0[1]); w.y = cvt_pk_bf16(v0[2], v0[3]); w.z = cvt_pk_bf16(v1[0], v1[1]); w.w = cvt_pk_bf16(v1[2], v1[3]);
                        *(u32x4*)(u + ((size_t)(col >> 4) * MP + row) * 16 + (col & 15)) = w; }
            return; }
        else if (pn < 18) { base = gates; ld = 2048; cb = (pn - 10) * 256; }
        else {
            if (wc == 0 && fq < 2) {
#pragma unroll
                for (int ai = 0; ai < 2; ++ai)
#pragma unroll
                    for (int m = 0; m < 4; ++m) { const int row = un.pm * BM + ai * HALF + wr * 64 + m * 16 + fr; float* p = ab + (size_t)row * 16 + 8 * fq;
                        *(f32x4*)p = acc[ai][0][m][0]; *(f32x4*)(p + 4) = acc[ai][0][m][1]; }
            }
            return;
        }
        const int row0 = un.pm * BM + wr * 64 + fr, col0 = cb + wc * 32 + 8 * fq;
#pragma unroll
        for (int ai = 0; ai < 2; ++ai)
#pragma unroll
            for (int m = 0; m < 4; ++m) { bf16_t* rowp = base + (size_t)(row0 + ai * HALF + m * 16) * ld + col0;
#pragma unroll
                for (int bj = 0; bj < 2; ++bj) { const f32x4 v0 = acc[ai][bj][m][0], v1 = acc[ai][bj][m][1]; u32x4 w;
                    w.x = cvt_pk_bf16(v0[0], v0[1]); w.y = cvt_pk_bf16(v0[2], v0[3]); w.z = cvt_pk_bf16(v1[0], v1[1]); w.w = cvt_pk_bf16(v1[2], v1[3]);
                    if (pn >= 6) __builtin_nontemporal_store(w, (u32x4*)(rowp + bj * HALF)); else *(u32x4*)(rowp + bj * HALF) = w; } }
    }
};
struct EpiGlu {
    static constexpr bool PERM = true, AFTER_DRAIN = false;
    const bf16_t* yb; const float* bglu; bf16_t* ob;
    __device__ __forceinline__ void operator()(const f32x4 (&acc)[2][2][4][2], const Unit& un, int wr, int wc, int fr, int fq) const {
        const int row0 = un.pm * BM + wr * 64 + fr, col0 = un.pn * BM + wc * 32 + 8 * fq;
#pragma unroll
        for (int bj = 0; bj < 2; ++bj) { const int col = col0 + bj * HALF; const f32x4 b0 = *(const f32x4*)(bglu + col), b1 = *(const f32x4*)(bglu + col + 4);
#pragma unroll
            for (int ai = 0; ai < 2; ++ai)
#pragma unroll
                for (int m = 0; m < 4; ++m) { const size_t off = (size_t)(row0 + ai * HALF + m * 16) * 512 + col; const u32x4 y = *(const u32x4*)(yb + off);
                    const f32x4 v0 = acc[ai][bj][m][0] + b0, v1 = acc[ai][bj][m][1] + b1; u32x4 w;
                    w.x = cvt_pk_bf16(bflo(y.x) * sigm(v0[0]), bfhi(y.x) * sigm(v0[1])); w.y = cvt_pk_bf16(bflo(y.y) * sigm(v0[2]), bfhi(y.y) * sigm(v0[3]));
                    w.z = cvt_pk_bf16(bflo(y.z) * sigm(v1[0]), bfhi(y.z) * sigm(v1[1])); w.w = cvt_pk_bf16(bflo(y.w) * sigm(v1[2]), bfhi(y.w) * sigm(v1[3]));
                    *(u32x4*)(ob + off) = w; } }
    }
};
template <bool SECOND> struct EpiBr {
    static constexpr bool PERM = true, AFTER_DRAIN = false;
    const bf16_t* gates; const bf16_t* tin; bf16_t* out;
    __device__ __forceinline__ void operator()(const f32x4 (&acc)[2][2][4][2], const Unit& un, int wr, int wc, int fr, int fq) const {
        const int row0 = un.pm * BM + wr * 64 + fr, col0 = un.pn * BM + wc * 32 + 8 * fq;
#pragma unroll
        for (int ai = 0; ai < 2; ++ai)
#pragma unroll
            for (int m = 0; m < 4; ++m) { const int row = row0 + ai * HALF + m * 16; const size_t goff = (size_t)prow_of(row) * 2048 + (SECOND ? 1024 : 0) + col0, off = (size_t)row * 1024 + col0;
#pragma unroll
                for (int bj = 0; bj < 2; ++bj) { const u32x4 g = *(const u32x4*)(gates + goff + bj * HALF); const f32x4 v0 = acc[ai][bj][m][0], v1 = acc[ai][bj][m][1];
                    float r[8] = { sigm(bflo(g.x)) * v0[0], sigm(bfhi(g.x)) * v0[1], sigm(bflo(g.y)) * v0[2], sigm(bfhi(g.y)) * v0[3],
                                   sigm(bflo(g.z)) * v1[0], sigm(bfhi(g.z)) * v1[1], sigm(bflo(g.w)) * v1[2], sigm(bfhi(g.w)) * v1[3] };
                    if (SECOND) { const u32x4 t = *(const u32x4*)(tin + off + bj * HALF);
                        r[0] += bflo(t.x); r[1] += bfhi(t.x); r[2] += bflo(t.y); r[3] += bfhi(t.y); r[4] += bflo(t.z); r[5] += bfhi(t.z); r[6] += bflo(t.w); r[7] += bfhi(t.w); }
                    u32x4 w; w.x = cvt_pk_bf16(r[0], r[1]); w.y = cvt_pk_bf16(r[2], r[3]); w.z = cvt_pk_bf16(r[4], r[5]); w.w = cvt_pk_bf16(r[6], r[7]);
                    *(u32x4*)(out + off + bj * HALF) = w; } }
    }
};
struct EpiBrFused {
    static constexpr bool PERM = true, AFTER_DRAIN = false;
    const bf16_t* gates; bf16_t* out;
    __device__ __forceinline__ void mid(f32x4 (&acc)[2][2][4][2], const Unit& un, int wr, int wc, int fr, int fq) const {
        const int row0 = un.pm * BM + wr * 64 + fr, col0 = un.pn * BM + wc * 32 + 8 * fq;
#pragma unroll
        for (int ai = 0; ai < 2; ++ai)
#pragma unroll
            for (int m = 0; m < 4; ++m) { const int row = row0 + ai * HALF + m * 16; const size_t goff = (size_t)prow_of(row) * 2048 + col0;
#pragma unroll
                for (int bj = 0; bj < 2; ++bj) { const u32x4 ga = *(const u32x4*)(gates + goff + bj * HALF), gb = *(const u32x4*)(gates + goff + 1024 + bj * HALF);
                    const float ea[8] = {bflo(ga.x), bfhi(ga.x), bflo(ga.y), bfhi(ga.y), bflo(ga.z), bfhi(ga.z), bflo(ga.w), bfhi(ga.w)};
                    const float eb[8] = {bflo(gb.x), bfhi(gb.x), bflo(gb.y), bfhi(gb.y), bflo(gb.z), bfhi(gb.z), bflo(gb.w), bfhi(gb.w)};
#pragma unroll
                    for (int e = 0; e < 8; ++e) { const float r = (1.f + __expf(-eb[e])) * __builtin_amdgcn_rcpf(1.f + __expf(-ea[e])); acc[ai][bj][m][e >> 2][e & 3] *= r; } } }
    }
    __device__ __forceinline__ void operator()(const f32x4 (&acc)[2][2][4][2], const Unit& un, int wr, int wc, int fr, int fq) const {
        const int row0 = un.pm * BM + wr * 64 + fr, col0 = un.pn * BM + wc * 32 + 8 * fq;
#pragma unroll
        for (int ai = 0; ai < 2; ++ai)
#pragma unroll
            for (int m = 0; m < 4; ++m) { const int row = row0 + ai * HALF + m * 16; const size_t goff = (size_t)prow_of(row) * 2048 + 1024 + col0, off = (size_t)row * 1024 + col0;
#pragma unroll
                for (int bj = 0; bj < 2; ++bj) { const u32x4 g = *(const u32x4*)(gates + goff + bj * HALF); const f32x4 v0 = acc[ai][bj][m][0], v1 = acc[ai][bj][m][1];
                    u32x4 w; w.x = cvt_pk_bf16(sigm(bflo(g.x)) * v0[0], sigm(bfhi(g.x)) * v0[1]); w.y = cvt_pk_bf16(sigm(bflo(g.y)) * v0[2], sigm(bfhi(g.y)) * v0[3]);
                    w.z = cvt_pk_bf16(sigm(bflo(g.z)) * v1[0], sigm(bfhi(g.z)) * v1[1]); w.w = cvt_pk_bf16(sigm(bflo(g.w)) * v1[2], sigm(bfhi(g.w)) * v1[3]);
                    *(u32x4*)(out + off + bj * HALF) = w; } }
    }
};
struct EpiOut {
    static constexpr bool PERM = true, AFTER_DRAIN = false;
    const float* x; const float* stats; const float* g; const float* b; bf16_t* pre;
    __device__ __forceinline__ void operator()(const f32x4 (&acc)[2][2][4][2], const Unit& un, int wr, int wc, int fr, int fq) const {
        const int row0 = un.pm * BM + wr * 64 + fr, col0 = un.pn * BM + wc * 32 + 8 * fq;
#pragma unroll
        for (int bj = 0; bj < 2; ++bj) { const int col = col0 + bj * HALF; const f32x4 g0 = *(const f32x4*)(g + col), g1 = *(const f32x4*)(g + col + 4), b0 = *(const f32x4*)(b + col), b1 = *(const f32x4*)(b + col + 4);
#pragma unroll
            for (int ai = 0; ai < 2; ++ai)
#pragma unroll
                for (int m = 0; m < 4; ++m) { const int row = row0 + ai * HALF + m * 16; const float mean = stats[2 * row], rstd = stats[2 * row + 1];
                    const f32x4 x0 = *(const f32x4*)(x + (size_t)row * 1024 + col), x1 = *(const f32x4*)(x + (size_t)row * 1024 + col + 4);
                    const f32x4 v0 = ((x0 - mean) * rstd * g0 + b0) * ALPHA + acc[ai][bj][m][0], v1 = ((x1 - mean) * rstd * g1 + b1) * ALPHA + acc[ai][bj][m][1];
                    u32x4 w; w.x = cvt_pk_bf16(v0[0], v0[1]); w.y = cvt_pk_bf16(v0[2], v0[3]); w.z = cvt_pk_bf16(v1[0], v1[1]); w.w = cvt_pk_bf16(v1[2], v1[3]);
                    *(u32x4*)(pre + (size_t)row * 1024 + col) = w; } }
    }
};
}

namespace mg {
typedef unsigned u32x2 __attribute__((ext_vector_type(2)));
constexpr int STG = 49152, NSTG = 3;
__device__ __forceinline__ int swz(int r, int c16) { return r * 128 + ((c16 ^ (r & 7)) << 4); }
template <class RowPtr, class Epi>
__device__ __forceinline__ void tile(LAS unsigned char* lds, const RowPtr& rowptr, const bf16* Bt, int K, const Epi& epi) {
    const int tid = threadIdx.x, wid = __builtin_amdgcn_readfirstlane(tid >> 6), lane = tid & 63, wr = wid >> 2, wc = wid & 3, fr = lane & 15, fq = lane >> 4;
    const int lr = tid >> 3, ch = ((lane & 7) ^ ((lane >> 3) & 7)) * 8;
    const bf16* pa0 = rowptr(lr) + ch; const bf16* pa1 = rowptr(lr + 64) + ch;
    const bf16* pb = Bt + (size_t)lr * 64 + ch;
    f32x4 acc[4][4];
#pragma unroll
    for (int m = 0; m < 4; ++m)
#pragma unroll
        for (int n = 0; n < 4; ++n) acc[m][n] = (f32x4){0.f, 0.f, 0.f, 0.f};
    const int nk = K / 64;
#define MG_ISSUE(kt_) do { LAS unsigned char* sa_ = lds + ((kt_) % NSTG) * STG + wid * 1024; const int k0_ = (kt_) * 64; \
        __builtin_amdgcn_global_load_lds((const unsigned*)(pa0 + k0_), (LAS unsigned*)(sa_), 16, 0, 0); \
        __builtin_amdgcn_global_load_lds((const unsigned*)(pa1 + k0_), (LAS unsigned*)(sa_ + 8192), 16, 0, 0); \
        _Pragma("unroll") for (int j_ = 0; j_ < 4; ++j_) __builtin_amdgcn_global_load_lds((const unsigned*)(pb + (size_t)(kt_) * 16384 + j_ * 4096), (LAS unsigned*)(sa_ + 16384 + j_ * 8192), 16, 0, 0); } while (0)
    asm volatile("s_waitcnt vmcnt(0)" ::: "memory");
    __builtin_amdgcn_s_barrier();
    MG_ISSUE(0); if (nk > 1) MG_ISSUE(1);
    for (int kt = 0; kt < nk; ++kt) {
        if (kt + 1 < nk) asm volatile("s_waitcnt vmcnt(6)" ::: "memory"); else asm volatile("s_waitcnt vmcnt(0)" ::: "memory");
        __builtin_amdgcn_s_barrier();
        if (kt + 2 < nk) MG_ISSUE(kt + 2);
        const LAS unsigned char* sa = lds + (kt % NSTG) * STG; const LAS unsigned char* sb = sa + 16384;
#pragma unroll
        for (int ks = 0; ks < 2; ++ks) {
            bf16x8 a[4], w[4];
#pragma unroll
            for (int m = 0; m < 4; ++m) a[m] = *(const LAS bf16x8*)(sa + swz(64 * wr + 16 * m + fr, ks * 4 + fq));
#pragma unroll
            for (int n = 0; n < 4; ++n) w[n] = *(const LAS bf16x8*)(sb + swz(64 * wc + 16 * n + fr, ks * 4 + fq));
            __builtin_amdgcn_s_setprio(1);
#pragma unroll
            for (int m = 0; m < 4; ++m)
#pragma unroll
                for (int n = 0; n < 4; ++n) acc[m][n] = __builtin_amdgcn_mfma_f32_16x16x32_bf16(w[n], a[m], acc[m][n], 0, 0, 0);
            __builtin_amdgcn_s_setprio(0);
        }
        asm volatile("s_waitcnt lgkmcnt(0)" ::: "memory");
    }
#undef MG_ISSUE
    epi(acc, wr, wc, fr, fq);
}

struct Src { const bf16* pa0; const bf16* pa1; const bf16* pb; };
template <class Epi>
__device__ __forceinline__ void tile_pipe(LAS unsigned char* lds, const Src& cur, int nk, bool first, bool has_next, const Src& nxt, int& sbase, const Epi& epi, unsigned* sig = nullptr) {
    const int tid = threadIdx.x, wid = __builtin_amdgcn_readfirstlane(tid >> 6), lane = tid & 63, wr = wid >> 2, wc = wid & 3, fr = lane & 15, fq = lane >> 4;
    f32x4 acc[4][4];
#pragma unroll
    for (int m = 0; m < 4; ++m)
#pragma unroll
        for (int n = 0; n < 4; ++n) acc[m][n] = (f32x4){0.f, 0.f, 0.f, 0.f};
#define MG_ISSUE2(S_, kt_, slot_) do { LAS unsigned char* sa_ = lds + (slot_) * STG + wid * 1024; const int k0_ = (kt_) * 64; \
        __builtin_amdgcn_global_load_lds((const unsigned*)((S_).pa0 + k0_), (LAS unsigned*)(sa_), 16, 0, 0); \
        __builtin_amdgcn_global_load_lds((const unsigned*)((S_).pa1 + k0_), (LAS unsigned*)(sa_ + 8192), 16, 0, 0); \
        _Pragma("unroll") for (int j_ = 0; j_ < 4; ++j_) __builtin_amdgcn_global_load_lds((const unsigned*)((S_).pb + (size_t)(kt_) * 16384 + j_ * 4096), (LAS unsigned*)(sa_ + 16384 + j_ * 8192), 16, 0, 0); } while (0)
    int slot = sbase;
    if (first) {
        asm volatile("s_waitcnt vmcnt(0)" ::: "memory");
        __builtin_amdgcn_s_barrier();
        MG_ISSUE2(cur, 0, slot); MG_ISSUE2(cur, 1, (slot + 1 >= NSTG ? slot + 1 - NSTG : slot + 1));
    }
    for (int kt = 0; kt < nk; ++kt) {
        if (kt == 0 && sig) asm volatile("s_waitcnt vmcnt(0)" ::: "memory"); else asm volatile("s_waitcnt vmcnt(6)" ::: "memory");
        __builtin_amdgcn_s_barrier();
        if (kt == 0 && sig && tid == 0) (void)__hip_atomic_fetch_add(sig, 1u, __ATOMIC_RELAXED, __HIP_MEMORY_SCOPE_AGENT);
        const LAS unsigned char* sa = lds + slot * STG; const LAS unsigned char* sb = sa + 16384;
        bf16x8 a0[4], w0[4], a1[4], w1[4];
#pragma unroll
        for (int m = 0; m < 4; ++m) a0[m] = *(const LAS bf16x8*)(sa + swz(64 * wr + 16 * m + fr, fq));
#pragma unroll
        for (int n = 0; n < 4; ++n) w0[n] = *(const LAS bf16x8*)(sb + swz(64 * wc + 16 * n + fr, fq));
        { const bool own = kt + 2 < nk; const int kk = own ? kt + 2 : kt + 2 - nk, s2 = slot + 2 >= NSTG ? slot + 2 - NSTG : slot + 2;
          Src S; S.pa0 = own ? cur.pa0 : nxt.pa0; S.pa1 = own ? cur.pa1 : nxt.pa1; S.pb = own ? cur.pb : nxt.pb;
          MG_ISSUE2(S, kk, s2); }
        __builtin_amdgcn_sched_barrier(0);
        __builtin_amdgcn_s_setprio(1);
#pragma unroll
        for (int n = 0; n < 4; ++n) acc[0][n] = __builtin_amdgcn_mfma_f32_16x16x32_bf16(w0[n], a0[0], acc[0][n], 0, 0, 0);
        __builtin_amdgcn_sched_barrier(0);
#pragma unroll
        for (int m = 0; m < 4; ++m) a1[m] = *(const LAS bf16x8*)(sa + swz(64 * wr + 16 * m + fr, 4 + fq));
        __builtin_amdgcn_sched_barrier(0);
#pragma unroll
        for (int n = 0; n < 4; ++n) acc[1][n] = __builtin_amdgcn_mfma_f32_16x16x32_bf16(w0[n], a0[1], acc[1][n], 0, 0, 0);
        __builtin_amdgcn_sched_barrier(0);
#pragma unroll
        for (int n = 0; n < 4; ++n) w1[n] = *(const LAS bf16x8*)(sb + swz(64 * wc + 16 * n + fr, 4 + fq));
        __builtin_amdgcn_sched_barrier(0);
#pragma unroll
        for (int m = 2; m < 4; ++m)
#pragma unroll
            for (int n = 0; n < 4; ++n) acc[m][n] = __builtin_amdgcn_mfma_f32_16x16x32_bf16(w0[n], a0[m], acc[m][n], 0, 0, 0);
        __builtin_amdgcn_sched_barrier(0);
#pragma unroll
        for (int m = 0; m < 4; ++m)
#pragma unroll
            for (int n = 0; n < 4; ++n) acc[m][n] = __builtin_amdgcn_mfma_f32_16x16x32_bf16(w1[n], a1[m], acc[m][n], 0, 0, 0);
        __builtin_amdgcn_s_setprio(0);
        asm volatile("s_waitcnt lgkmcnt(0)" ::: "memory");
        slot = slot + 1 >= NSTG ? slot + 1 - NSTG : slot + 1;
    }
#undef MG_ISSUE2
    sbase = slot;
    epi(acc, wr, wc, fr, fq);
}

template <class Epi>
__device__ __forceinline__ void down_unit(LAS unsigned char* lds, const bf16* A  , int ntiles, const bf16* Bt  , Epi& epi) {
    const int tid = threadIdx.x, wid = __builtin_amdgcn_readfirstlane(tid >> 6), lane = tid & 63, wr = wid >> 1, wc = wid & 1, fr = lane & 15, fq = lane >> 4;
    const int lr = tid >> 3;
    __syncthreads();
#pragma unroll
    for (int j = 0; j < 4; ++j)
#pragma unroll
        for (int kk = 0; kk < 4; ++kk) { const int r = lr + 64 * j, c = lane & 7;
            *(LAS v4u*)(lds + kk * 32768 + swz(r, c)) = *(const v4u*)(Bt + (size_t)r * 256 + kk * 64 + c * 8); }
    __syncthreads();
#pragma unroll 1
    for (int mt = 0; mt < ntiles; ++mt) {
        int fr_ = fr; asm volatile("" : "+v"(fr_));
        bf16x8 a[2][8];
#pragma unroll
        for (int m = 0; m < 2; ++m)
#pragma unroll
            for (int ks = 0; ks < 8; ++ks) a[m][ks] = *(const bf16x8*)(A + (size_t)(128 * mt + 32 * wr + 16 * m + fr) * 256 + 32 * ks + 8 * fq);
        epi.prepare(mt, wr, fr);
        f32x4 acc[2][8];
#pragma unroll
        for (int m = 0; m < 2; ++m)
#pragma unroll
            for (int n = 0; n < 8; ++n) acc[m][n] = (f32x4){0.f, 0.f, 0.f, 0.f};
#pragma unroll
        for (int ks = 0; ks < 8; ++ks) { bf16x8 w[8];
#pragma unroll
            for (int n = 0; n < 8; ++n) w[n] = *(const LAS bf16x8*)(lds + (ks >> 1) * 32768 + swz(128 * wc + 16 * n + fr_, (ks & 1) * 4 + fq));
#pragma unroll
            for (int m = 0; m < 2; ++m)
#pragma unroll
                for (int n = 0; n < 8; ++n) acc[m][n] = __builtin_amdgcn_mfma_f32_16x16x32_bf16(w[n], a[m][ks], acc[m][n], 0, 0, 0); }
        epi(acc, wr, wc, fr, fq);
    }
}
struct DownArgs { const bf16* A; int ntiles; const bf16* Bt; const int* lst; const float* route; int cnt; bf16* slots; int c0; };
template <int MODE>
__device__ __forceinline__ void down_unit(LAS unsigned char* lds, const DownArgs& U) {
    const int tid = threadIdx.x, wid = __builtin_amdgcn_readfirstlane(tid >> 6), lane = tid & 63, wr = wid >> 1, wc = wid & 1, fr = lane & 15, fq = lane >> 4;
    const int lr = tid >> 3;
    LAS int* PT = (LAS int*)(lds + 131072);
    __syncthreads();
#pragma unroll
    for (int j = 0; j < 4; ++j)
#pragma unroll
        for (int kk = 0; kk < 4; ++kk) { const int r = lr + 64 * j, c = lane & 7;
            *(LAS v4u*)(lds + kk * 32768 + swz(r, c)) = *(const v4u*)(U.Bt + (size_t)r * 256 + kk * 64 + c * 8); }
#define MGD_LOADA(dst_, mt_) do { _Pragma("unroll") for (int m_ = 0; m_ < 2; ++m_) _Pragma("unroll") for (int ks_ = 0; ks_ < 8; ++ks_) \
        dst_[m_][ks_] = *(const bf16x8*)(U.A + (size_t)(128 * (mt_) + 32 * wr + 16 * m_ + fr) * 256 + 32 * ks_ + 8 * fq); } while (0)
    bf16x8 a[2][8], an[2][8];
    MGD_LOADA(a, 0);
#pragma unroll 1
    for (int mt = 0; mt < U.ntiles; ++mt) {
        if ((mt & 3) == 0) {
            if (mt) __syncthreads();
            const int li = 128 * mt + tid; const int pp = li < U.cnt ? U.lst[li] : -1;
            PT[tid] = pp; PT[512 + tid] = pp < 0 ? 0 : __builtin_bit_cast(int, U.route[(size_t)(pp >> 1) * 8 + 4 + (pp & 1)]);
            __syncthreads();
        }
        if (mt + 1 < U.ntiles) MGD_LOADA(an, mt + 1);
        int fr_ = fr; asm volatile("" : "+v"(fr_));
        f32x4 acc[2][8];
#pragma unroll
        for (int m = 0; m < 2; ++m)
#pragma unroll
            for (int n = 0; n < 8; ++n) acc[m][n] = (f32x4){0.f, 0.f, 0.f, 0.f};
#pragma unroll
        for (int ks = 0; ks < 8; ++ks)
#pragma unroll
            for (int nh = 0; nh < 2; ++nh) { bf16x8 w[4];
#pragma unroll
                for (int n = 0; n < 4; ++n) w[n] = *(const LAS bf16x8*)(lds + (ks >> 1) * 32768 + swz(128 * wc + 16 * (4 * nh + n) + fr_, (ks & 1) * 4 + fq));
#pragma unroll
                for (int m = 0; m < 2; ++m)
#pragma unroll
                    for (int n = 0; n < 4; ++n) acc[m][4 * nh + n] = __builtin_amdgcn_mfma_f32_16x16x32_bf16(w[n], a[m][ks], acc[m][4 * nh + n], 0, 0, 0); }
#pragma unroll
        for (int m = 0; m < 2; ++m) { const int ti = 128 * (mt & 3) + 32 * wr + 16 * m + fr_; const int pp = PT[ti]; const float gt = __builtin_bit_cast(float, PT[512 + ti]);
            if (MODE == 1) { _Pragma("unroll") for (int n = 0; n < 8; ++n) asm volatile("" :: "v"(acc[m][n])); }
            else if (pp >= 0) {
#pragma unroll
                for (int n = 0; n < 8; ++n) { const f32x4 v = acc[m][n] * gt; u32x2 w2; w2.x = pk2(v[0], v[1]); w2.y = pk2(v[2], v[3]);
                    *(u32x2*)(U.slots + (size_t)pp * 1024 + U.c0 + 128 * wc + 16 * n + 4 * fq) = w2; } } }
#pragma unroll
        for (int m = 0; m < 2; ++m)
#pragma unroll
            for (int ks = 0; ks < 8; ++ks) a[m][ks] = an[m][ks];
    }
#undef MGD_LOADA
}
}

struct Ctx {
    LAS unsigned char* lds; int tid, lane, wave, wg, G;
    const float* const* in; float* out; unsigned char* ws; gu32* ctl;
};

template <bool NT>
__device__ __forceinline__ void transpose_item(const float* W, int K, int N, bf16* WT, int mode, int row_off, int s13, LAS float* scr, int item, int lane) {
    const int nblk = (N + 31) / 32, kb = item / nblk, nb = item % nblk, k0 = 64 * kb, n0 = 32 * nb;
    const int kk = lane >> 3, n4 = (lane & 7) * 4; const bool ok = n0 + n4 < N;
    f32x4 v[8];
#pragma unroll
    for (int i = 0; i < 8; ++i) { const f32x4* p = (const f32x4*)(W + (size_t)(k0 + 8 * i + kk) * N + n0 + n4);
        v[i] = ok ? (NT ? __builtin_nontemporal_load(p) : *p) : (f32x4){0.f, 0.f, 0.f, 0.f}; }
#pragma unroll
    for (int i = 0; i < 8; ++i) { LAS float* s = scr + (8 * i + kk) * 33 + n4; s[0] = v[i].x; s[1] = v[i].y; s[2] = v[i].z; s[3] = v[i].w; }
    LDS_WAIT(); asm volatile("" ::: "memory");
    const int c = lane & 7;
#pragma unroll
    for (int j = 0; j < 4; ++j) { const int n = (lane >> 3) + 8 * j; const LAS float* s = scr + (8 * c) * 33 + n;
        v4u o; o.x = pk2(s[0 * 33], s[1 * 33]); o.y = pk2(s[2 * 33], s[3 * 33]); o.z = pk2(s[4 * 33], s[5 * 33]); o.w = pk2(s[6 * 33], s[7 * 33]);
        const int orow = ((mode & 1) == 0) ? (row_off + n0 + n) : (row_off + 2 * n0 + n + (n >= 16 ? 16 : 0) + 16 * s13);
        if (n0 + n < N) { const size_t off = (mode & 2) ? ((size_t)((orow >> 8) * (K >> 6) + (k0 >> 6)) * 16384 + (size_t)(orow & 255) * 64 + 8 * c) : ((size_t)orow * K + k0 + 8 * c); *(GAS v4u*)(WT + off) = o; } }
    LDS_WAIT(); asm volatile("" ::: "memory");
}
template <bool NT, int CCH>
__device__ __forceinline__ void transpose_chunk(const float* W, int K, int N, bf16* WT, int mode, int row_off, int s13, LAS float* scr, int item0, int lane) {
    const int nblk = (N + 31) / 32, kk = lane >> 3, n4 = (lane & 7) * 4, c = lane & 7;
    f32x4 v[2][8];
#define TC_LOAD(buf_, it_) do { const int kb_ = (it_) / nblk, nb_ = (it_) % nblk, k0_ = 64 * kb_, n0_ = 32 * nb_; const bool ok_ = n0_ + n4 < N; \
        _Pragma("unroll") for (int i_ = 0; i_ < 8; ++i_) { const f32x4* p_ = (const f32x4*)(W + (size_t)(k0_ + 8 * i_ + kk) * N + n0_ + n4); \
            v[buf_][i_] = ok_ ? (NT ? __builtin_nontemporal_load(p_) : *p_) : (f32x4){0.f, 0.f, 0.f, 0.f}; } } while (0)
    TC_LOAD(0, item0);
#pragma unroll
    for (int k = 0; k < CCH; ++k) {
        if (k + 1 < CCH) TC_LOAD((k + 1) & 1, item0 + k + 1);
        const int it = item0 + k, kb = it / nblk, nb = it % nblk, k0 = 64 * kb, n0 = 32 * nb;
#pragma unroll
        for (int i = 0; i < 8; ++i) { LAS float* sp = scr + (8 * i + kk) * 33 + n4; sp[0] = v[k & 1][i].x; sp[1] = v[k & 1][i].y; sp[2] = v[k & 1][i].z; sp[3] = v[k & 1][i].w; }
        LDS_WAIT(); asm volatile("" ::: "memory");
#pragma unroll
        for (int j = 0; j < 4; ++j) { const int n = (lane >> 3) + 8 * j; const LAS float* sp = scr + (8 * c) * 33 + n;
            v4u o; o.x = pk2(sp[0 * 33], sp[1 * 33]); o.y = pk2(sp[2 * 33], sp[3 * 33]); o.z = pk2(sp[4 * 33], sp[5 * 33]); o.w = pk2(sp[6 * 33], sp[7 * 33]);
            const int ng = n0 + n, pr = 4 * ((ng >> 3) & 3) + (ng & 3), pb = (ng >> 2) & 1;
            const int orow = mode == 0 ? (row_off + ng) : mode == 2 ? (row_off + (ng & ~31) + 16 * pb + pr) : (row_off + 64 * (ng >> 5) + 32 * pb + 16 * s13 + pr);
            if (n0 + n < N) { const size_t off = (mode & 2) ? ((size_t)((orow >> 8) * (K >> 6) + (k0 >> 6)) * 16384 + (size_t)(orow & 255) * 64 + 8 * c) : ((size_t)orow * K + k0 + 8 * c); __builtin_nontemporal_store(o, (v4u*)(WT + off)); } }
        LDS_WAIT(); asm volatile("" ::: "memory");
    }
#undef TC_LOAD
}
__device__ __forceinline__ void ln_row(f32x4 (&v)[4], const float* g, const float* b, int lane, float scale_in, float& mean_o, float& rstd_o) {
    float s = 0.f;
#pragma unroll
    for (int j = 0; j < 4; ++j) { v[j] = v[j] * scale_in; s += (v[j].x + v[j].y) + (v[j].z + v[j].w); }
    const float mean = wave_sum(s) * (1.f / D); float s2 = 0.f;
#pragma unroll
    for (int j = 0; j < 4; ++j) { v[j] = v[j] - mean; s2 += (v[j].x * v[j].x + v[j].y * v[j].y) + (v[j].z * v[j].z + v[j].w * v[j].w); }
    const float rstd = __builtin_amdgcn_rsqf(wave_sum(s2) * (1.f / D) + LN_EPS);
#pragma unroll
    for (int j = 0; j < 4; ++j) { const f32x4 gv = *(const f32x4*)(g + 4 * lane + 256 * j), bv = *(const f32x4*)(b + 4 * lane + 256 * j); v[j] = v[j] * rstd * gv + bv; }
    mean_o = mean; rstd_o = rstd;
}

__device__ __forceinline__ void phase0(const Ctx& C) {
    LAS float* scr = (LAS float*)(C.lds + C.wave * 16384);
    const int gw = C.wg * NWAVES + C.wave, NGW = C.G * NWAVES, lane = C.lane;
    bf16* WINT = (bf16*)(C.ws + WS_WINT); bf16* WGLU = (bf16*)(C.ws + WS_WGLU); bf16* WBR = (bf16*)(C.ws + WS_WBR); bf16* WOUT = (bf16*)(C.ws + WS_WOUT); bf16* WRT = (bf16*)(C.ws + WS_WRT);
    constexpr int I_IN = 16 * 145, I_GLU = 8 * 16, I_BR = 8 * 32, I_OUT = 16 * 32, I_RG = 16, I_RE = 32;
    constexpr int NITEMS = I_IN + I_GLU + 2 * I_BR + I_OUT + I_RG + I_RE;
    for (int it = gw; it < NITEMS; it += NGW) {
        int r = it;
        if (r < I_IN) { transpose_item<true>(C.in[4], 1024, INW, WINT, 0, 0, 0, scr, r, lane); continue; } r -= I_IN;
        if (r < I_GLU) { transpose_item<true>(C.in[17], 512, 512, WGLU, 0, 0, 0, scr, r, lane); continue; } r -= I_GLU;
        if (r < I_BR) { transpose_item<true>(C.in[19], 512, 1024, WBR, 0, 0, 0, scr, r, lane); continue; } r -= I_BR;
        if (r < I_BR) { transpose_item<true>(C.in[19] + 512 * 1024, 512, 1024, WBR + 1024 * 512, 0, 0, 0, scr, r, lane); continue; } r -= I_BR;
        if (r < I_OUT) { transpose_item<true>(C.in[20], 1024, 1024, WOUT, 0, 0, 0, scr, r, lane); continue; } r -= I_OUT;
        if (r < I_RG) { transpose_item<true>(C.in[23], 1024, 8, WRT, 0, 0, 0, scr, r, lane); continue; } r -= I_RG;
        transpose_item<true>(C.in[25], 1024, 64, WRT, 0, 8, 0, scr, r, lane);
    }
    for (int it = gw; it < (INWP - INW) + 8; it += NGW) { bf16* rowp = (it < INWP - INW) ? WINT + (size_t)(INW + it) * 1024 : WRT + (size_t)(72 + it - (INWP - INW)) * 1024;
        GAS v4u* o = (GAS v4u*)rowp + lane; o[0] = (v4u){0u, 0u, 0u, 0u}; o[64] = (v4u){0u, 0u, 0u, 0u}; }
    bf16* H0B = (bf16*)(C.ws + WS_H0B); float* stats = (float*)(C.ws + WS_STATS);
    const float* x = C.in[0]; const float* meta = C.in[1]; const float* g = C.in[2]; const float* b = C.in[3];
    for (int rp0 = gw * 2; rp0 < MP; rp0 += NGW * 2) {
        f32x4 v[2][4]; int kind[2];
#pragma unroll
        for (int rr = 0; rr < 2; ++rr) { const int rp = rp0 + rr, bb = rp / LP, i = rp % LP; kind[rr] = i < PADF ? 0 : (i < 64 ? 1 : 2);
            const float* src = (i < PADF) ? x : ((i < 64) ? meta + (size_t)(i - PADF) * D : x + ((size_t)bb * SEQ + (i - 64)) * D);
#pragma unroll
            for (int j = 0; j < 4; ++j) v[rr][j] = __builtin_nontemporal_load((const f32x4*)(src + 4 * lane + 256 * j)); }
#pragma unroll
        for (int rr = 0; rr < 2; ++rr) { const int rp = rp0 + rr, bb = rp / LP, i = rp % LP;
            GAS unsigned long long* o8 = (GAS unsigned long long*)(H0B + (size_t)rp * D) + lane;
            if (kind[rr] == 0) {
#pragma unroll
                for (int j = 0; j < 4; ++j) o8[64 * j] = 0ull;
                continue; }
            float mean, rstd; ln_row(v[rr], g, b, lane, 1.f, mean, rstd);
            if (kind[rr] == 2 && lane == 0) { const int xr = bb * SEQ + (i - 64); stats[2 * xr] = mean; stats[2 * xr + 1] = rstd; }
#pragma unroll
            for (int j = 0; j < 4; ++j) o8[64 * j] = (unsigned long long)pk2(v[rr][j].x, v[rr][j].y) | ((unsigned long long)pk2(v[rr][j].z, v[rr][j].w) << 32); }
    }
}

__device__ __forceinline__ void phase2_elem(const Ctx& C) {
    const int gw = C.wg * NWAVES + C.wave, NGW = C.G * NWAVES, lane = C.lane;
    const bf16* qkv = (const bf16*)(C.ws + WS_QKV); const float* ab = (const float*)(C.ws + WS_AB);
    bf16* qn = (bf16*)((unsigned char*)C.out + DO_QN); bf16* kn = (bf16*)((unsigned char*)C.out + DO_KN); bf16* vn = (bf16*)((unsigned char*)C.out + DO_VN);
    float* beta = (float*)((unsigned char*)C.out + DO_BETA); float* alpha = (float*)((unsigned char*)C.out + DO_ALPHA);
    const float* cw = C.in[5]; const float* a_log = C.in[6]; const float* dt_bias = C.in[7];
    for (int it = gw; it < MP * NH; it += NGW) {
        const int rp = it >> 3, h = it & 7, i = rp % LP; const size_t o = (size_t)rp * 512 + h * 64 + lane;
        if (i < PADF) { qn[o] = 0; kn[o] = 0; vn[o] = 0; if (lane == 0) { beta[rp * 8 + h] = 0.f; alpha[rp * 8 + h] = 1.f; } continue; }
        float aq = 0.f, ak = 0.f, av = 0.f; const int ch = h * 64 + lane;
#pragma unroll
        for (int j = 0; j < 4; ++j) { const bf16* r = qkv + (size_t)(rp - 3 + j) * 1536 + ch;
            aq += cw[j * 1536 + ch] * bf2f(r[0]); ak += cw[j * 1536 + 512 + ch] * bf2f(r[512]); av += cw[j * 1536 + 1024 + ch] * bf2f(r[1024]); }
        float q = silu_(aq), k = silu_(ak), v = silu_(av);
        const float sq = wave_sum(q * q), sk = wave_sum(k * k);
        q *= (__builtin_amdgcn_rsqf(sq + NORM_EPS)) * 0.125f; k *= __builtin_amdgcn_rsqf(sk + NORM_EPS);
        qn[o] = (bf16)f2bf(q); kn[o] = (bf16)f2bf(k); vn[o] = (bf16)f2bf(v);
        if (lane == 0) { const float a = ab[rp * 16 + h], bb = ab[rp * 16 + 8 + h];
            beta[rp * 8 + h] = sigm(bb); alpha[rp * 8 + h] = expf(-expf(a_log[h]) * softplus_(a + dt_bias[h])); }
    }
}

__device__ __forceinline__ void dn_scan_naive(const Ctx& C, int b, int h) {
    if (C.wave != 0) return;
    const int lane = C.lane;
    LAS float* Kl = (LAS float*)C.lds; LAS float* Ql = Kl + 4096; LAS float* Vl = Ql + 4096; LAS float* Zl = Vl + 4096; LAS float* Bl = Zl + 4096; LAS float* Al = Bl + 64;
    const bf16* qn = (const bf16*)((unsigned char*)C.out + DO_QN); const bf16* kn = (const bf16*)((unsigned char*)C.out + DO_KN); const bf16* vn = (const bf16*)((unsigned char*)C.out + DO_VN);
    const float* beta = (const float*)((unsigned char*)C.out + DO_BETA); const float* alpha = (const float*)((unsigned char*)C.out + DO_ALPHA);
    const bf16* z = (const bf16*)(C.ws + WS_Z); bf16* oa = (bf16*)(C.ws + WS_OA);
    const float nw = C.in[8][lane];
    float S[64];
#pragma unroll
    for (int k = 0; k < 64; ++k) S[k] = 0.f;
    for (int n = 0; n < NCH; ++n) {
        const int base = b * LP + 64 * n;
#pragma unroll 8
        for (int i = 0; i < 64; ++i) { const size_t off = (size_t)(base + i) * 512 + h * 64 + lane;
            Kl[i * 64 + lane] = bf2f(kn[off]); Ql[i * 64 + lane] = bf2f(qn[off]); Vl[i * 64 + lane] = bf2f(vn[off]); Zl[i * 64 + lane] = bf2f(z[off]); }
        Bl[lane] = beta[(base + lane) * 8 + h]; Al[lane] = alpha[(base + lane) * 8 + h];
        asm volatile("s_waitcnt vmcnt(0) lgkmcnt(0)" ::: "memory");
#pragma unroll 1
        for (int i = 0; i < 64; ++i) {
            const LAS f32x4* kr = (const LAS f32x4*)(Kl + i * 64); const LAS f32x4* qr = (const LAS f32x4*)(Ql + i * 64);
            const float at = Al[i], bt = Bl[i], vt = Vl[i * 64 + lane];
            float d0 = 0.f, d1 = 0.f, d2 = 0.f, d3 = 0.f;
#pragma unroll
            for (int k4 = 0; k4 < 16; ++k4) { const f32x4 kk = kr[k4]; d0 += S[4 * k4] * kk.x; d1 += S[4 * k4 + 1] * kk.y; d2 += S[4 * k4 + 2] * kk.z; d3 += S[4 * k4 + 3] * kk.w; }
            const float vnew = bt * (vt - at * ((d0 + d1) + (d2 + d3)));
            float o0 = 0.f, o1 = 0.f, o2 = 0.f, o3 = 0.f;
#pragma unroll
            for (int k4 = 0; k4 < 16; ++k4) { const f32x4 kk = kr[k4], qq = qr[k4];
                S[4 * k4] = at * S[4 * k4] + kk.x * vnew; S[4 * k4 + 1] = at * S[4 * k4 + 1] + kk.y * vnew; S[4 * k4 + 2] = at * S[4 * k4 + 2] + kk.z * vnew; S[4 * k4 + 3] = at * S[4 * k4 + 3] + kk.w * vnew;
                o0 += S[4 * k4] * qq.x; o1 += S[4 * k4 + 1] * qq.y; o2 += S[4 * k4 + 2] * qq.z; o3 += S[4 * k4 + 3] * qq.w; }
            if (n >= 1) { const float o = (o0 + o1) + (o2 + o3); const float ss = wave_sum(o * o);
                const float on = o * (__builtin_amdgcn_rsqf(ss * (1.f / 64.f) + NORM_EPS)) * nw * silu_(Zl[i * 64 + lane]);
                oa[(size_t)(b * SEQ + 64 * (n - 1) + i) * 512 + h * 64 + lane] = (bf16)f2bf(on); }
        }
    }
}
__device__ __forceinline__ void s5_naive(const Ctx& C, int b, int g) {
    const int tid = C.tid, lane = C.lane;
    LAS float* uu = (LAS float*)C.lds; LAS float* hh = uu + 1024; LAS float* Cc = hh + 8192; LAS float* Dd = Cc + 2048;
    const bf16* u = (const bf16*)(C.ws + WS_U); bf16* yb = (bf16*)(C.ws + WS_YB);
    const float* c_re = C.in[14] + (size_t)g * 16 * 64; const float* c_im = C.in[15] + (size_t)g * 16 * 64;
    for (int e = tid; e < 1024; e += 512) { const int c = e >> 6, p = e & 63; Cc[c * 128 + p] = c_re[c * 64 + p]; Cc[c * 128 + 64 + p] = -c_im[c * 64 + p]; }
    if (tid < 16) Dd[tid] = C.in[16][g * 16 + tid];
    float ar = 0.f, ai = 0.f, Bbr[16], Bbi[16], hr = 0.f, hi = 0.f;
    if (C.wave == 0) {
        const float dt = expf(C.in[11][g]); const float a_r = C.in[9][g * 64 + lane], a_i = C.in[10][g * 64 + lane];
        const float mag = expf(dt * a_r); ar = mag * cosf(dt * a_i); ai = mag * sinf(dt * a_i);
        const float den = a_r * a_r + a_i * a_i, nr = ar - 1.f, ni = ai;
        const float f_re = (nr * a_r + ni * a_i) / den, f_im = (ni * a_r - nr * a_i) / den;
        const float* br = C.in[12] + ((size_t)g * 64 + lane) * 16; const float* bi = C.in[13] + ((size_t)g * 64 + lane) * 16;
#pragma unroll
        for (int c = 0; c < 16; ++c) { Bbr[c] = f_re * br[c] - f_im * bi[c]; Bbi[c] = f_re * bi[c] + f_im * br[c]; }
    }
    for (int n = 0; n < NCH; ++n) {
        const int base = b * LP + 64 * n;
        { const int row = tid >> 3, c2 = (tid & 7) * 2; const unsigned w = *(const unsigned*)(u + (size_t)(base + row) * 512 + g * 16 + c2); uu[row * 16 + c2] = bflo(w); uu[row * 16 + c2 + 1] = bfhi(w); }
        __syncthreads();
        if (C.wave == 0) {
#pragma unroll 4
            for (int t = 0; t < 64; ++t) { float bur = 0.f, bui = 0.f;
#pragma unroll
                for (int c4 = 0; c4 < 4; ++c4) { const f32x4 uv = *(const LAS f32x4*)(uu + t * 16 + 4 * c4);
                    bur += Bbr[4 * c4] * uv.x + Bbr[4 * c4 + 1] * uv.y + Bbr[4 * c4 + 2] * uv.z + Bbr[4 * c4 + 3] * uv.w;
                    bui += Bbi[4 * c4] * uv.x + Bbi[4 * c4 + 1] * uv.y + Bbi[4 * c4 + 2] * uv.z + Bbi[4 * c4 + 3] * uv.w; }
                const float nhr = ar * hr - ai * hi + bur, nhi = ar * hi + ai * hr + bui; hr = nhr; hi = nhi;
                hh[t * 128 + lane] = hr; hh[t * 128 + 64 + lane] = hi; }
        }
        __syncthreads();
        if (n >= 1) { const int t = tid >> 3;
#pragma unroll
            for (int cc = 0; cc < 2; ++cc) { const int c = (tid & 7) + 8 * cc; float a0 = 0.f, a1 = 0.f;
#pragma unroll 8
                for (int p4 = 0; p4 < 32; ++p4) { const f32x4 cv = *(const LAS f32x4*)(Cc + c * 128 + 4 * p4), hv = *(const LAS f32x4*)(hh + t * 128 + 4 * p4); a0 += cv.x * hv.x + cv.y * hv.y; a1 += cv.z * hv.z + cv.w * hv.w; }
                const float y = a0 + a1 + Dd[c] * uu[t * 16 + c];
                yb[(size_t)(b * SEQ + 64 * (n - 1) + t) * 512 + g * 16 + c] = (bf16)f2bf(gelu_tanh(y)); } }
        __syncthreads();
    }
}
constexpr int CW_CONV = 16640, CONV_SHARD = NE * 384 / 8, CONV_WAVES = 3;
__device__ __forceinline__ void convert_experts(const Ctx& C, int qi, unsigned first, unsigned limit) {
    (void)qi; (void)first; (void)limit;
    if (C.wave >= CONV_WAVES) return;
    LAS float* scr = (LAS float*)(C.lds + C.wave * 16384);
    bf16* W13 = (bf16*)(C.ws + WS_W13); bf16* W2 = (bf16*)(C.ws + WS_W2);
    constexpr unsigned CCH = 4;
    static_assert(CONV_SHARD % CCH == 0 && 128 % CCH == 0, "conversion chunks");
#pragma unroll 1
    for (int q = 0; q < 8; ++q) { const int sh = (C.wg + q) & 7;
        unsigned li = 0; if (C.lane == 0) li = __hip_atomic_fetch_add(C.ctl + CW_CONV + 64 * sh, CCH, __ATOMIC_RELAXED, __HIP_MEMORY_SCOPE_AGENT);
        li = __builtin_amdgcn_readfirstlane(li);
#pragma unroll 1
        while (li < (unsigned)CONV_SHARD) {
            unsigned ln = 0; if (C.lane == 0) ln = __hip_atomic_fetch_add(C.ctl + CW_CONV + 64 * sh, CCH, __ATOMIC_RELAXED, __HIP_MEMORY_SCOPE_AGENT);
            { const int it = sh * CONV_SHARD + (int)li, e = it / 384, r = it % 384;
                if (r < 128) transpose_chunk<true, (int)CCH>(C.in[27] + (size_t)e * 1024 * 256, 1024, 256, W13 + (size_t)e * 512 * 1024, 3, 0, 0, scr, r, C.lane);
                else if (r < 256) transpose_chunk<true, (int)CCH>(C.in[28] + (size_t)e * 1024 * 256, 1024, 256, W13 + (size_t)e * 512 * 1024, 3, 0, 1, scr, r - 128, C.lane);
                else transpose_chunk<true, (int)CCH>(C.in[29] + (size_t)e * 256 * 1024, 256, 1024, W2 + (size_t)e * 1024 * 256, 2, 0, 0, scr, r - 256, C.lane); }
            li = __builtin_amdgcn_readfirstlane(ln); }
    }
}
template <int MODE>
__device__ __forceinline__ void phase7_rows(const Ctx& C) {
    constexpr int RS = 2064, RB = 64;
    LAS unsigned char* Ht = C.lds; LAS float* Lg = (LAS float*)(C.lds + RB * RS);
    const bf16* pre = (const bf16*)(C.ws + WS_PRE); bf16* h1 = (bf16*)(C.ws + WS_H1); const bf16* WRT = (const bf16*)(C.ws + WS_WRT);
    const float* g1 = C.in[21]; const float* b1 = C.in[22]; const float* b_rg = C.in[24]; const float* b_re = C.in[26];
    int* route = (int*)(C.ws + WS_ROUTE); gu32* cnt = C.ctl + CW_CNT; int* inv2 = (int*)(C.ws + WS_INV2);
    const int lane = C.lane, wave = C.wave, fr = lane & 15, fq = lane >> 4;
    for (int blk = C.wg; blk < MX / RB; blk += C.G) {
#pragma unroll 1
        for (int hh = 0; hh < 2; ++hh) { f32x4 v[4][4];
#pragma unroll
            for (int rr = 0; rr < 4; ++rr)
#pragma unroll
                for (int j = 0; j < 4; ++j) { const mg::u32x2 pw = *(const mg::u32x2*)(pre + ((size_t)blk * RB + wave * 8 + hh * 4 + rr) * D + 4 * lane + 256 * j); v[rr][j] = (f32x4){bflo(pw.x), bfhi(pw.x), bflo(pw.y), bfhi(pw.y)}; }
#pragma unroll
            for (int rr = 0; rr < 4; ++rr) { const int r = wave * 8 + hh * 4 + rr; const size_t row = (size_t)blk * RB + r;
                float mean, rstd; ln_row(v[rr], g1, b1, lane, 1.f, mean, rstd);
                GAS unsigned long long* o8 = (GAS unsigned long long*)(h1 + row * D) + lane;
#pragma unroll
                for (int j = 0; j < 4; ++j) { const unsigned long long w = (unsigned long long)pk2(v[rr][j].x, v[rr][j].y) | ((unsigned long long)pk2(v[rr][j].z, v[rr][j].w) << 32);
                    if (MODE == 0) o8[64 * j] = w; *(LAS unsigned long long*)(Ht + r * RS + (4 * lane + 256 * j) * 2) = w; } } }
        __syncthreads();
        { const int kq = wave & 3, ch2 = wave >> 2, t0 = ch2 ? 3 : 0;
            bf16x8 wb[3][8];
            const bf16* w0 = WRT + (size_t)(16 * t0 + fr) * 1024 + kq * 256 + fq * 8;
#pragma unroll
            for (int t = 0; t < 3; ++t) { const bf16* wt = w0 + (size_t)t * 16 * 1024; asm volatile("" : "+v"(wt));
#pragma unroll
                for (int s8 = 0; s8 < 8; ++s8) if (t < 2 || !ch2) wb[t][s8] = *(const bf16x8*)(wt + s8 * 32); }
            f32x4 ac[4][3];
#pragma unroll
            for (int rg = 0; rg < 4; ++rg)
#pragma unroll
                for (int t = 0; t < 3; ++t) ac[rg][t] = (f32x4){0.f, 0.f, 0.f, 0.f};
#pragma unroll
            for (int s8 = 0; s8 < 8; ++s8)
#pragma unroll
                for (int rg = 0; rg < 4; ++rg) { const bf16x8 af = *(const LAS bf16x8*)(Ht + (16 * rg + fr) * RS + fq * 16 + (8 * kq + s8) * 64);
                    ac[rg][0] = __builtin_amdgcn_mfma_f32_16x16x32_bf16(wb[0][s8], af, ac[rg][0], 0, 0, 0);
                    ac[rg][1] = __builtin_amdgcn_mfma_f32_16x16x32_bf16(wb[1][s8], af, ac[rg][1], 0, 0, 0);
                    if (!ch2) ac[rg][2] = __builtin_amdgcn_mfma_f32_16x16x32_bf16(wb[2][s8], af, ac[rg][2], 0, 0, 0); }
            __syncthreads();
            LAS float* Pq = (LAS float*)Ht + kq * (RB * 80);
#pragma unroll
            for (int rg = 0; rg < 4; ++rg)
#pragma unroll
                for (int t = 0; t < 3; ++t) if (t < 2 || !ch2) *(LAS f32x4*)(Pq + (16 * rg + fr) * 80 + 16 * (t0 + t) + 4 * fq) = ac[rg][t];
            __syncthreads();
            for (int g4 = C.tid; g4 < RB * 80 / 4; g4 += NWAVES * 64) { const LAS f32x4* pp = (const LAS f32x4*)Ht + g4;
                const f32x4 p0 = pp[0], p1 = pp[RB * 80 / 4], p2 = pp[2 * (RB * 80 / 4)], p3 = pp[3 * (RB * 80 / 4)];
                ((LAS f32x4*)Lg)[g4] = (p0 + p1) + (p2 + p3); } }
        __syncthreads();
        LAS unsigned* hist = (LAS unsigned*)Ht;
        if (C.tid < NE) hist[C.tid] = 0u;
        __syncthreads();
        int e0 = 0, e1 = 0, l0 = 0, l1 = 0; float gw0 = 0.f, gw1 = 0.f;
        if (C.tid < RB) { const LAS float* L = Lg + C.tid * 80;
            float lg[8]; float mx = -3.0e38f; int gi = 0;
#pragma unroll
            for (int j = 0; j < 8; ++j) { lg[j] = L[j] + b_rg[j]; if (lg[j] > mx) { mx = lg[j]; gi = j; } }
            float se = 0.f;
#pragma unroll
            for (int j = 0; j < 8; ++j) se += __expf(lg[j] - mx);
            const float gp = 1.f / se;
            float t0 = -3.0e38f, t1 = -3.0e38f; int i0 = 0, i1 = 0;
#pragma unroll
            for (int j = 0; j < 8; ++j) { const float le = L[8 + gi * 8 + j] + b_re[gi * 8 + j];
                if (le > t0) { t1 = t0; i1 = i0; t0 = le; i0 = j; } else if (le > t1) { t1 = le; i1 = j; } }
            const float w0 = 1.f / (1.f + __expf(t1 - t0)), w1 = 1.f - w0;
            e0 = gi * 8 + i0; e1 = gi * 8 + i1; gw0 = w0 * gp; gw1 = w1 * gp;
            if (MODE == 0) { l0 = (int)__hip_atomic_fetch_add((unsigned*)(hist + e0), 1u, __ATOMIC_RELAXED, __HIP_MEMORY_SCOPE_WORKGROUP); l1 = (int)__hip_atomic_fetch_add((unsigned*)(hist + e1), 1u, __ATOMIC_RELAXED, __HIP_MEMORY_SCOPE_WORKGROUP); } }
        __syncthreads();
        if (MODE == 0 && C.tid < NE) { const unsigned c = hist[C.tid]; unsigned base = 0u; if (c) base = __hip_atomic_fetch_add(cnt + C.tid * CNT_STRIDE, c, __ATOMIC_RELAXED, __HIP_MEMORY_SCOPE_AGENT); hist[64 + C.tid] = base; }
        __syncthreads();
        if (C.tid < RB) { const int tok = blk * RB + C.tid;
            if (MODE == 1) { asm volatile("" :: "v"(e0), "v"(e1), "v"(gw0), "v"(gw1)); } else {
            const int r0 = (int)hist[64 + e0] + l0, r1 = (int)hist[64 + e1] + l1;
            int* ro = route + (size_t)tok * 8; ro[0] = e0; ro[1] = e1; ro[2] = r0; ro[3] = r1; ((float*)ro)[4] = gw0; ((float*)ro)[5] = gw1;
            inv2[(size_t)e0 * 16384 + r0] = 2 * tok; inv2[(size_t)e1 * 16384 + r1] = 2 * tok + 1; } }
        __syncthreads();
    }
}
__device__ __forceinline__ void moe_table(const Ctx& C, LAS int* tst) {
    if (C.tid < NE) tst[80 + C.tid] = (int)__hip_atomic_load(C.ctl + CW_CNT + C.tid * CNT_STRIDE, RLX_AGENT);
    __syncthreads();
    if (C.tid == 0) { int acc = 0; for (int e = 0; e < NE; ++e) { tst[e] = acc; acc += (tst[80 + e] + 127) >> 7; } tst[NE] = acc; }
    __syncthreads();
}
__device__ __forceinline__ int moe_expert_of(const LAS int* tst, int t) { int e = 0;
#pragma unroll 1
    for (int j = 1; j < NE; ++j) if (tst[j] <= t) e = j;
    return e; }
__device__ __forceinline__ bool moe_unit(const LAS int* tst, int NT, int grp, int ngrp, int u, int& e, int& t, int& nt) {
#pragma unroll 1
    for (int ee = grp; ee < NE; ee += ngrp) { const int nu = (tst[ee + 1] - tst[ee]) * NT; if (u < nu) { e = ee; t = tst[ee] + u / NT; nt = u % NT; return true; } u -= nu; }
    return false;
}
struct UpRow { const bf16* h1; const int* lst; int l0, cnt;
    __device__ __forceinline__ const bf16* operator()(int r) const { const int p = (l0 + r < cnt) ? lst[l0 + r] : -1; return h1 + (size_t)(p < 0 ? 0 : (p >> 1)) * D; } };
struct UpEpi { bf16* hid; int pos0, hc0;
    __device__ __forceinline__ void operator()(const f32x4 (&acc)[4][4], int wr, int wc, int fr, int fq) const {
#pragma unroll
        for (int m = 0; m < 4; ++m) { const int row = pos0 + 64 * wr + 16 * m + fr;
#pragma unroll
            for (int n2 = 0; n2 < 2; ++n2) { const f32x4 a = acc[m][2 * n2], b = acc[m][2 * n2 + 1]; const int hc = hc0 + 32 * wc + 16 * n2 + 4 * fq;
                mg::u32x2 w; w.x = pk2(silu_(a[0]) * b[0], silu_(a[1]) * b[1]); w.y = pk2(silu_(a[2]) * b[2], silu_(a[3]) * b[3]);
                *(mg::u32x2*)(hid + (size_t)row * 256 + hc) = w; } }
    } };
__device__ __forceinline__ int moe_group_units(const LAS int* tst, int NT, int grp, int ngrp) { int n = 0;
#pragma unroll 1
    for (int ee = grp; ee < NE; ee += ngrp) n += (tst[ee + 1] - tst[ee]) * NT;
    return n; }
constexpr int MOE_TAB_OFF = 150528, MOE_BATCH = 8;
__device__ __forceinline__ void phase9_up(const Ctx& C) {
    LAS int* tst = (LAS int*)(C.lds + 149504); moe_table(C, tst);
    LAS int* tab = (LAS int*)(C.lds + MOE_TAB_OFF);
    const int ngrp = (C.G % 8 == 0) ? 8 : 1, grp = C.wg % ngrp, gsz = C.G / ngrp;
    const int total = moe_group_units(tst, 2, grp, ngrp), first = C.wg / ngrp, nmine = total > first ? (total - first + gsz - 1) / gsz : 0;
    const int lr = C.tid >> 3, ch = ((C.lane & 7) ^ ((C.lane >> 3) & 7)) * 8;
    const bf16* h1 = (const bf16*)(C.ws + WS_H1); const bf16* W13 = (const bf16*)(C.ws + WS_W13); const int* inv2 = (const int*)(C.ws + WS_INV2);
    int sbase = 0;
    for (int b0 = 0; b0 < nmine; b0 += MOE_BATCH) { const int nu = nmine - b0 < MOE_BATCH ? nmine - b0 : MOE_BATCH;
        __syncthreads();
        int pv[2];
#pragma unroll
        for (int ps = 0; ps < 2; ++ps) { const int u = ps * 4 + (C.tid >> 7), row = C.tid & 127; int e, t, nt; pv[ps] = -1;
            if (u < nu && moe_unit(tst, 2, grp, ngrp, first + (b0 + u) * gsz, e, t, nt)) { const int li = 128 * (t - tst[e]) + row; if (li < tst[80 + e]) pv[ps] = inv2[(size_t)e * 16384 + li]; } }
#pragma unroll
        for (int ps = 0; ps < 2; ++ps) { const int u = ps * 4 + (C.tid >> 7), row = C.tid & 127; tab[u * 128 + row] = pv[ps] < 0 ? 0 : (pv[ps] >> 1); }
        __syncthreads();
        mg::Src cur, nxt; int e, t, nt;
        (void)moe_unit(tst, 2, grp, ngrp, first + b0 * gsz, e, t, nt);
        cur.pa0 = h1 + (size_t)tab[lr] * D + ch; cur.pa1 = h1 + (size_t)tab[64 + lr] * D + ch; cur.pb = W13 + (size_t)e * 524288 + (size_t)nt * 16 * 16384 + (size_t)lr * 64 + ch;
#pragma unroll 1
        for (int i = 0; i < nu; ++i) { const bool has_next = i + 1 < nu; int e2 = e, t2 = t, nt2 = nt; nxt = cur;
            if (has_next) { (void)moe_unit(tst, 2, grp, ngrp, first + (b0 + i + 1) * gsz, e2, t2, nt2);
                nxt.pa0 = h1 + (size_t)tab[(i + 1) * 128 + lr] * D + ch; nxt.pa1 = h1 + (size_t)tab[(i + 1) * 128 + 64 + lr] * D + ch; nxt.pb = W13 + (size_t)e2 * 524288 + (size_t)nt2 * 16 * 16384 + (size_t)lr * 64 + ch; }
            UpEpi ep{(bf16*)(C.ws + WS_HID), 128 * t, 128 * nt};
            mg::tile_pipe(C.lds, cur, 16, i == 0, has_next, nxt, sbase, ep);
            cur = nxt; e = e2; t = t2; nt = nt2; }
    }
}
struct DnRow { const bf16* hid; int pos0; __device__ __forceinline__ const bf16* operator()(int r) const { return hid + (size_t)(pos0 + r) * 256; } };
struct DnEpi { bf16* slots; const int* lst; const int* route; int l0, cnt, c0;
    __device__ __forceinline__ void operator()(const f32x4 (&acc)[4][4], int wr, int wc, int fr, int fq) const {
#pragma unroll
        for (int m = 0; m < 4; ++m) { const int li = l0 + 64 * wr + 16 * m + fr; if (li >= cnt) continue; const int p = lst[li];
            const float gt = ((const float*)route)[(size_t)(p >> 1) * 8 + 4 + (p & 1)];
#pragma unroll
            for (int n = 0; n < 4; ++n) { const f32x4 a = acc[m][n] * gt; mg::u32x2 w; w.x = pk2(a[0], a[1]); w.y = pk2(a[2], a[3]);
                *(mg::u32x2*)(slots + (size_t)p * D + c0 + 64 * wc + 16 * n + 4 * fq) = w; } }
    } };
struct DnEpi2 { bf16* slots; const LAS int* tab; int c0;
    __device__ __forceinline__ void operator()(const f32x4 (&acc)[4][4], int wr, int wc, int fr, int fq) const {
#pragma unroll
        for (int m = 0; m < 4; ++m) { const mg::u32x2 pg = *(const LAS mg::u32x2*)(tab + 2 * (64 * wr + 16 * m + fr)); const int p = (int)pg.x; if (p < 0) continue;
            const float gt = __uint_as_float(pg.y);
#pragma unroll
            for (int n = 0; n < 4; ++n) { const f32x4 a = acc[m][n] * gt; mg::u32x2 w; w.x = pk2(a[0], a[1]); w.y = pk2(a[2], a[3]);
                *(mg::u32x2*)(slots + (size_t)p * D + c0 + 64 * wc + 16 * n + 4 * fq) = w; } }
    } };
__device__ __forceinline__ void phase10_down(const Ctx& C, bool have_table) {
    LAS int* tst = (LAS int*)(C.lds + 149504); if (!have_table) moe_table(C, tst);
    LAS int* tab = (LAS int*)(C.lds + MOE_TAB_OFF);
    const int ngrp = (C.G % 8 == 0) ? 8 : 1, grp = C.wg % ngrp, gsz = C.G / ngrp;
    const int total = moe_group_units(tst, 4, grp, ngrp), first = C.wg / ngrp, nmine = total > first ? (total - first + gsz - 1) / gsz : 0;
    const int lr = C.tid >> 3, ch = ((C.lane & 7) ^ ((C.lane >> 3) & 7)) * 8;
    const bf16* hid = (const bf16*)(C.ws + WS_HID); const bf16* W2 = (const bf16*)(C.ws + WS_W2); const int* inv2 = (const int*)(C.ws + WS_INV2); const float* route = (const float*)(C.ws + WS_ROUTE);
    int sbase = 0;
    for (int b0 = 0; b0 < nmine; b0 += MOE_BATCH) { const int nu = nmine - b0 < MOE_BATCH ? nmine - b0 : MOE_BATCH;
        __syncthreads();
        int pv[2]; float gv[2];
#pragma unroll
        for (int ps = 0; ps < 2; ++ps) { const int u = ps * 4 + (C.tid >> 7), row = C.tid & 127; int e, t, nt; pv[ps] = -1;
            if (u < nu && moe_unit(tst, 4, grp, ngrp, first + (b0 + u) * gsz, e, t, nt)) { const int li = 128 * (t - tst[e]) + row; if (li < tst[80 + e]) pv[ps] = inv2[(size_t)e * 16384 + li]; } }
#pragma unroll
        for (int ps = 0; ps < 2; ++ps) gv[ps] = pv[ps] >= 0 ? route[(size_t)(pv[ps] >> 1) * 8 + 4 + (pv[ps] & 1)] : 0.f;
#pragma unroll
        for (int ps = 0; ps < 2; ++ps) { const int u = ps * 4 + (C.tid >> 7), row = C.tid & 127; mg::u32x2 w; w.x = (unsigned)pv[ps]; w.y = __float_as_uint(gv[ps]); *(LAS mg::u32x2*)(tab + 2 * (u * 128 + row)) = w; }
        __syncthreads();
        mg::Src cur, nxt; int e, t, nt;
        (void)moe_unit(tst, 4, grp, ngrp, first + b0 * gsz, e, t, nt);
        cur.pa0 = hid + (size_t)(128 * t + lr) * 256 + ch; cur.pa1 = cur.pa0 + 64 * 256; cur.pb = W2 + (size_t)e * 262144 + (size_t)nt * 4 * 16384 + (size_t)lr * 64 + ch;
#pragma unroll 1
        for (int i = 0; i < nu; ++i) { const bool has_next = i + 1 < nu; int e2 = e, t2 = t, nt2 = nt; nxt = cur;
            if (has_next) { (void)moe_unit(tst, 4, grp, ngrp, first + (b0 + i + 1) * gsz, e2, t2, nt2);
                nxt.pa0 = hid + (size_t)(128 * t2 + lr) * 256 + ch; nxt.pa1 = nxt.pa0 + 64 * 256; nxt.pb = W2 + (size_t)e2 * 262144 + (size_t)nt2 * 4 * 16384 + (size_t)lr * 64 + ch; }
            DnEpi2 ep{(bf16*)C.out, tab + 2 * (i * 128), 256 * nt};
            mg::tile_pipe(C.lds, cur, 4, i == 0, has_next, nxt, sbase, ep);
            cur = nxt; e = e2; t = t2; nt = nt2; }
    }
}
constexpr int CW_TRDY = 24576;
struct MoeEpi { int up; bf16* hid; int pos0, hc0; bf16* slots; const LAS int* tab; int c0;
    __device__ __forceinline__ void operator()(const f32x4 (&acc)[4][4], int wr, int wc, int fr, int fq) const {
        if (up) {
#pragma unroll
            for (int m = 0; m < 4; ++m) { const int row = pos0 + 64 * wr + 16 * m + fr;
                { const f32x4 a0 = acc[m][0], b0 = acc[m][1], a1 = acc[m][2], b1 = acc[m][3]; const int hc = hc0 + 32 * wc + 8 * fq;
                    v4u w; w.x = pk2(silu_(a0[0]) * b0[0], silu_(a0[1]) * b0[1]); w.y = pk2(silu_(a0[2]) * b0[2], silu_(a0[3]) * b0[3]);
                    w.z = pk2(silu_(a1[0]) * b1[0], silu_(a1[1]) * b1[1]); w.w = pk2(silu_(a1[2]) * b1[2], silu_(a1[3]) * b1[3]);
                    mg::u32x2 wl, wh; wl.x = w.x; wl.y = w.y; wh.x = w.z; wh.y = w.w;
                    asm volatile("global_store_dwordx2 %0, %1, off sc0 sc1" :: "v"(hid + (size_t)row * 256 + hc), "v"(wl) : "memory");
                    asm volatile("global_store_dwordx2 %0, %1, off sc0 sc1" :: "v"(hid + (size_t)row * 256 + hc + 4), "v"(wh) : "memory"); } }
        } else {
#pragma unroll
            for (int m = 0; m < 4; ++m) { const mg::u32x2 pg = *(const LAS mg::u32x2*)(tab + 2 * (64 * wr + 16 * m + fr)); const int p = (int)pg.x; if (p < 0) continue;
                const float gt = __uint_as_float(pg.y);
#pragma unroll
                for (int k2 = 0; k2 < 2; ++k2) { const f32x4 a = acc[m][2 * k2] * gt, b = acc[m][2 * k2 + 1] * gt; v4u w; w.x = pk2(a[0], a[1]); w.y = pk2(a[2], a[3]); w.z = pk2(b[0], b[1]); w.w = pk2(b[2], b[3]);
                    *(v4u*)(slots + (size_t)p * D + c0 + 64 * wc + 32 * k2 + 8 * fq) = w; } }
        }
    } };
__device__ __forceinline__ void phase_moe(const Ctx& C) {
    LAS int* tst = (LAS int*)(C.lds + 149504); moe_table(C, tst);
    LAS int* tab = (LAS int*)(C.lds + MOE_TAB_OFF);
    volatile LAS int* flg = (volatile LAS int*)(C.lds + MOE_TAB_OFF + MOE_BATCH * 1024);
    const int ngrp = (C.G % 8 == 0) ? 8 : 1, grp = C.wg % ngrp, gsz = C.G / ngrp, first = C.wg / ngrp;
    const int U8 = moe_group_units(tst, 2, grp, ngrp), U9 = 2 * U8;
    const int n8 = U8 > first ? (U8 - first + gsz - 1) / gsz : 0;
    const int r8 = U8 % gsz, light = (r8 != 0 && first >= r8) ? 1 : 0;
    const int B = r8 ? 2 * (gsz - r8) : 0;
    int nb = 0; if (light) { const int v0 = 2 * (first - r8); nb = v0 + 1 < U9 ? 2 : (v0 < U9 ? 1 : 0); }
    const int nreg = U9 > B + first ? (U9 - B - first + gsz - 1) / gsz : 0;
    const int nall = n8 + nb + nreg;
#define MOE_DECODE(i_, up_, e_, t_, nt_) do { const int ii_ = (i_); up_ = ii_ < n8; int v_; if (up_) v_ = first + ii_ * gsz; else if (ii_ - n8 < nb) v_ = 2 * (first - r8) + (ii_ - n8); else v_ = B + first + (ii_ - n8 - nb) * gsz; \
        (void)moe_unit(tst, up_ ? 2 : 4, grp, ngrp, v_, e_, t_, nt_); } while (0)
    const int lr = C.tid >> 3, ch = ((C.lane & 7) ^ ((C.lane >> 3) & 7)) * 8;
    const bf16* h1 = (const bf16*)(C.ws + WS_H1); const bf16* hid = (const bf16*)(C.ws + WS_HID); const bf16* W13 = (const bf16*)(C.ws + WS_W13); const bf16* W2 = (const bf16*)(C.ws + WS_W2);
    const int* inv2 = (const int*)(C.ws + WS_INV2); const float* route = (const float*)(C.ws + WS_ROUTE); unsigned* trdy = (unsigned*)(C.ctl + CW_TRDY);
    int sbase = 0; unsigned* pend = nullptr; bool prefetched = false;
#define MOE_SRC(S_, up_, e_, t_, nt_, ui_) do { if (up_) { (S_).pa0 = h1 + (size_t)tab[2 * ((ui_) * 128 + lr)] * D + ch; (S_).pa1 = h1 + (size_t)tab[2 * ((ui_) * 128 + 64 + lr)] * D + ch; \
            (S_).pb = W13 + (size_t)(e_) * 524288 + (size_t)(nt_) * 16 * 16384 + (size_t)lr * 64 + ch; } \
        else { (S_).pa0 = hid + (size_t)(128 * (t_) + lr) * 256 + ch; (S_).pa1 = (S_).pa0 + 64 * 256; (S_).pb = W2 + (size_t)(e_) * 262144 + (size_t)(nt_) * 4 * 16384 + (size_t)lr * 64 + ch; } } while (0)
    for (int b0 = 0; b0 < nall; b0 += MOE_BATCH) { const int nu = nall - b0 < MOE_BATCH ? nall - b0 : MOE_BATCH;
        __syncthreads();
        int pv[2]; float gv[2];
#pragma unroll
        for (int ps = 0; ps < 2; ++ps) { const int u = ps * 4 + (C.tid >> 7), row = C.tid & 127; pv[ps] = -1;
            if (u < nu) { int up, e, t, nt; MOE_DECODE(b0 + u, up, e, t, nt); const int li = 128 * (t - tst[e]) + row; if (li < tst[80 + e]) pv[ps] = inv2[(size_t)e * 16384 + li]; } }
#pragma unroll
        for (int ps = 0; ps < 2; ++ps) gv[ps] = pv[ps] >= 0 ? route[(size_t)(pv[ps] >> 1) * 8 + 4 + (pv[ps] & 1)] : 0.f;
#pragma unroll
        for (int ps = 0; ps < 2; ++ps) { const int u = ps * 4 + (C.tid >> 7), row = C.tid & 127; const bool isup = b0 + u < n8;
            mg::u32x2 w; w.x = isup ? (unsigned)(pv[ps] < 0 ? 0 : (pv[ps] >> 1)) : (unsigned)pv[ps]; w.y = __float_as_uint(gv[ps]); *(LAS mg::u32x2*)(tab + 2 * (u * 128 + row)) = w; }
        __syncthreads();
        prefetched = false;
        int up, e, t, nt; MOE_DECODE(b0, up, e, t, nt);
        mg::Src cur, nxt; MOE_SRC(cur, up, e, t, nt, 0);
#pragma unroll 1
        for (int i = 0; i < nu; ++i) {
            if (!up && !prefetched) {
                if (pend) { asm volatile("s_waitcnt vmcnt(0)" ::: "memory"); __syncthreads(); if (C.tid == 0) (void)__hip_atomic_fetch_add(pend, 1u, RLX_AGENT); pend = nullptr; }
                if (C.tid == 0) { unsigned sp = 0; while (__hip_atomic_load(trdy + t, RLX_AGENT) < 2u) { __builtin_amdgcn_s_sleep(2); if (++sp > (1u << 22)) break; } }
                __syncthreads(); }
            const bool has_next = i + 1 < nu; int up2 = up, e2 = e, t2 = t, nt2 = nt; nxt = cur; bool can = has_next;
            if (has_next) { MOE_DECODE(b0 + i + 1, up2, e2, t2, nt2);
                if (!up2) {
                    if (C.tid == 0) flg[i & 1] = __hip_atomic_load(trdy + t2, RLX_AGENT) >= 2u ? 1 : 0;
                    __syncthreads(); can = flg[i & 1] != 0; }
                if (can) MOE_SRC(nxt, up2, e2, t2, nt2, i + 1); }
            MoeEpi ep{up, (bf16*)(C.ws + WS_HID), 128 * t, 128 * nt, (bf16*)C.out, tab + 2 * (i * 128), 256 * nt};
            mg::tile_pipe(C.lds, cur, up ? 16 : 4, !prefetched, can, nxt, sbase, ep, pend);
            pend = up ? trdy + t : nullptr; prefetched = can;
            if (has_next) { if (!can) MOE_SRC(nxt, up2, e2, t2, nt2, i + 1); cur = nxt; up = up2; e = e2; t = t2; nt = nt2; } }
    }
    if (pend) { asm volatile("s_waitcnt vmcnt(0)" ::: "memory"); __syncthreads(); if (C.tid == 0) (void)__hip_atomic_fetch_add(pend, 1u, RLX_AGENT); }
    asm volatile("s_waitcnt vmcnt(0)" ::: "memory"); __syncthreads();
#undef MOE_DECODE
#undef MOE_SRC
}
template <int MODE>
__device__ __forceinline__ void phase11_final(const Ctx& C) {
    const int gw = C.wg * NWAVES + C.wave, NGW = C.G * NWAVES, lane = C.lane;
    const bf16* h1 = (const bf16*)(C.ws + WS_H1); const bf16* slots = (const bf16*)C.out; const float* g2 = C.in[30]; const float* b2 = C.in[31];
    for (int row0 = gw * 4; row0 < MX; row0 += NGW * 4) {
        f32x4 v[4][4];
#pragma unroll
        for (int rr = 0; rr < 4; ++rr)
#pragma unroll
            for (int j = 0; j < 4; ++j) { const int c = 4 * lane + 256 * j; const int row = row0 + rr;
                const mg::u32x2 hw = __builtin_nontemporal_load((const mg::u32x2*)(h1 + (size_t)row * D + c)), s0 = __builtin_nontemporal_load((const mg::u32x2*)(slots + (size_t)(2 * row) * D + c)), s1 = __builtin_nontemporal_load((const mg::u32x2*)(slots + (size_t)(2 * row + 1) * D + c));
                v[rr][j].x = ALPHA * bflo(hw.x) + bflo(s0.x) + bflo(s1.x); v[rr][j].y = ALPHA * bfhi(hw.x) + bfhi(s0.x) + bfhi(s1.x);
                v[rr][j].z = ALPHA * bflo(hw.y) + bflo(s0.y) + bflo(s1.y); v[rr][j].w = ALPHA * bfhi(hw.y) + bfhi(s0.y) + bfhi(s1.y); }
        float mean, rstd;
#pragma unroll
        for (int rr = 0; rr < 4; ++rr) ln_row(v[rr], g2, b2, lane, 1.f, mean, rstd);
#pragma unroll
        for (int rr = 0; rr < 4; ++rr)
#pragma unroll
            for (int j = 0; j < 4; ++j) { if (MODE == 0) __builtin_nontemporal_store(v[rr][j], (f32x4*)(C.out + (size_t)(row0 + rr) * D + 4 * lane + 256 * j)); else asm volatile("" :: "v"(v[rr][j])); }
    }
}

constexpr int DN_ITEM_BYTES = 41 * 1024, DN_ITEMS = NB * NH * NCH, DN_IN_OUT = (int)((64 * MiB) / DN_ITEM_BYTES);
constexpr int DN_OBUF = 3 * DN_ITEM_BYTES + 1024, DN_OBUF_BYTES = 64 * 144;
constexpr size_t WS_DNX = WS_MERGED;
static_assert((size_t)(DN_ITEMS - DN_IN_OUT) * DN_ITEM_BYTES <= 32 * MiB, "dn overflow");
constexpr size_t WS_ORAW = WS_OA;
__device__ __forceinline__ unsigned char* dn_item_ptr(float* out, unsigned char* ws, int item) {
    return item < DN_IN_OUT ? (unsigned char*)out + (size_t)item * DN_ITEM_BYTES : ws + WS_DNX + (size_t)(item - DN_IN_OUT) * DN_ITEM_BYTES; }
typedef unsigned u32x2_t __attribute__((ext_vector_type(2)));
__device__ __forceinline__ v4u pack8(const f32x4 a, const f32x4 b) { v4u w; w.x = pk2(a[0], a[1]); w.y = pk2(a[2], a[3]); w.z = pk2(b[0], b[1]); w.w = pk2(b[2], b[3]); return w; }
__device__ __forceinline__ bf16x8 as_bf16x8(const v4u w) { return __builtin_bit_cast(bf16x8, w); }

constexpr int SLOT_BYTES = 29312, SL_Q = 0, SL_K = 9216, SL_V = 18432, SL_SC = 27648, SL_HALO = 28160, SROW = 144, DN_SLOTS = 4;
constexpr int CW_LATE = 17920;
constexpr int DN_EARLY = NB * NH * 64;

__device__ __forceinline__ void chunk_prep(const Ctx& C, bool late, int wg0) {
    const int slot = C.wave >> 1, wsl = C.wave & 1;
    LAS unsigned char* const SL0 = C.lds + slot * SLOT_BYTES;
#define DN_REBASE() int lane = C.lane; asm volatile("" : "+v"(lane)); const int rr = lane & 15, qq = lane >> 4, st = lane + 64 * wsl; (void)rr; (void)qq; (void)st; LAS unsigned char* const SL = SL0; LAS float* const SC = (LAS float*)(SL + SL_SC)
    const bf16* qkv = (const bf16*)(C.ws + WS_QKV); const float* ab = (const float*)(C.ws + WS_AB);
    const float* cw = C.in[5]; const float* a_log = C.in[6]; const float* dt_bias = C.in[7];
    const int total = late ? NB * NH : DN_EARLY, nround = late ? 1 : (DN_EARLY + C.G * DN_SLOTS - 1) / (C.G * DN_SLOTS);
    for (int rd = 0; rd < nround; ++rd) {
        int wi = late ? (C.wg - wg0) * DN_SLOTS + slot : (rd * C.G + C.wg) * DN_SLOTS + slot; if (wi >= total) wi = total - 1;
        const int bh = late ? wi : (wi >> 6), n = late ? 64 : (wi & 63), h = bh & 7, b = bh >> 3;
        unsigned char* dst = dn_item_ptr(C.out, C.ws, bh * NCH + n);
        { DN_REBASE();
            v4u rw[13];
#pragma unroll
            for (int i = 0; i < 13; ++i) { const int p = st + 128 * i, rm = p >> 3, c8 = p & 7, row = rm / 3 - 3, m = rm - 3 * (rm / 3), grow = 64 * n + row;
                rw[i] = (p < 1608 && grow >= 0) ? *(const v4u*)(qkv + (size_t)(b * LP + grow) * 1536 + m * 512 + h * 64 + c8 * 8) : (v4u){0u, 0u, 0u, 0u}; }
            if (wsl == 0) { const int gi = 64 * n + lane; float g = 0.f, be = 0.f;
                if (gi >= PADF) { const float* a2 = ab + (size_t)(b * LP + gi) * 16; be = sigm(a2[8 + h]); g = -expf(a_log[h]) * softplus_(a2[h] + dt_bias[h]); }
#pragma unroll
                for (int o = 1; o < 64; o <<= 1) { const float t = __shfl_up(g, o); if (lane >= o) g += t; }
                SC[lane] = g; SC[64 + lane] = be; }
#pragma unroll
            for (int i = 0; i < 13; ++i) { const int p = st + 128 * i, rm = p >> 3, c8 = p & 7, row = rm / 3 - 3, m = rm - 3 * (rm / 3);
                if (p < 1608) { LAS unsigned char* dp = row >= 0 ? SL + m * 9216 + row * SROW + c8 * 16 : SL + SL_HALO + ((row + 3) * 3 + m) * 128 + c8 * 16; *(LAS v4u*)dp = rw[i]; } }
        }
        __syncthreads();
        float cq0 = 0.f, cq1 = 0.f, cq2 = 0.f, ck0 = 0.f, ck1 = 0.f, ck2 = 0.f, cv0 = 0.f, cv1 = 0.f, cv2 = 0.f;
        { DN_REBASE(); const int d = lane;
            if (wsl == 0) { const LAS unsigned char* hp = SL + SL_HALO + d * 2;
                cq0 = bf2f(*(const LAS bf16*)(hp + 0 * 128)); ck0 = bf2f(*(const LAS bf16*)(hp + 1 * 128)); cv0 = bf2f(*(const LAS bf16*)(hp + 2 * 128));
                cq1 = bf2f(*(const LAS bf16*)(hp + 3 * 128)); ck1 = bf2f(*(const LAS bf16*)(hp + 4 * 128)); cv1 = bf2f(*(const LAS bf16*)(hp + 5 * 128));
                cq2 = bf2f(*(const LAS bf16*)(hp + 6 * 128)); ck2 = bf2f(*(const LAS bf16*)(hp + 7 * 128)); cv2 = bf2f(*(const LAS bf16*)(hp + 8 * 128));
            } else { const LAS unsigned char* mp = SL + 29 * SROW + d * 2;
                cq0 = bf2f(*(const LAS bf16*)(mp + SL_Q)); ck0 = bf2f(*(const LAS bf16*)(mp + SL_K)); cv0 = bf2f(*(const LAS bf16*)(mp + SL_V));
                cq1 = bf2f(*(const LAS bf16*)(mp + SL_Q + SROW)); ck1 = bf2f(*(const LAS bf16*)(mp + SL_K + SROW)); cv1 = bf2f(*(const LAS bf16*)(mp + SL_V + SROW));
                cq2 = bf2f(*(const LAS bf16*)(mp + SL_Q + 2 * SROW)); ck2 = bf2f(*(const LAS bf16*)(mp + SL_K + 2 * SROW)); cv2 = bf2f(*(const LAS bf16*)(mp + SL_V + 2 * SROW)); }
        }
        __syncthreads();
        { DN_REBASE(); const int d = lane, ch = h * 64 + d;
            float wq[4], wk[4], wv[4];
#pragma unroll
            for (int j = 0; j < 4; ++j) { wq[j] = cw[j * 1536 + ch]; wk[j] = cw[j * 1536 + 512 + ch]; wv[j] = cw[j * 1536 + 1024 + ch]; }
            LAS unsigned char* rp = SL + (32 * wsl) * SROW + d * 2;
#pragma unroll 8
            for (int r = 0; r < 32; ++r, rp += SROW) { const float q3 = bf2f(*(const LAS bf16*)(rp + SL_Q)), k3 = bf2f(*(const LAS bf16*)(rp + SL_K)), v3 = bf2f(*(const LAS bf16*)(rp + SL_V));
                const float q = silu_(wq[0] * cq0 + wq[1] * cq1 + wq[2] * cq2 + wq[3] * q3), k = silu_(wk[0] * ck0 + wk[1] * ck1 + wk[2] * ck2 + wk[3] * k3), v = silu_(wv[0] * cv0 + wv[1] * cv1 + wv[2] * cv2 + wv[3] * v3);
                cq0 = cq1; cq1 = cq2; cq2 = q3; ck0 = ck1; ck1 = ck2; ck2 = k3; cv0 = cv1; cv1 = cv2; cv2 = v3;
                *(LAS bf16*)(rp + SL_Q) = (bf16)f2bf(q); *(LAS bf16*)(rp + SL_K) = (bf16)f2bf(k); *(LAS bf16*)(rp + SL_V) = (bf16)f2bf(v); }
        }
        __syncthreads();
        { DN_REBASE(); LAS unsigned char* rp = SL + (wsl == 0 ? SL_Q : SL_K) + lane * SROW;
            v4u w[8]; float ss = 0.f;
#pragma unroll
            for (int c = 0; c < 8; ++c) { w[c] = *(const LAS v4u*)(rp + c * 16);
                ss += bflo(w[c].x) * bflo(w[c].x) + bfhi(w[c].x) * bfhi(w[c].x) + bflo(w[c].y) * bflo(w[c].y) + bfhi(w[c].y) * bfhi(w[c].y)
                    + bflo(w[c].z) * bflo(w[c].z) + bfhi(w[c].z) * bfhi(w[c].z) + bflo(w[c].w) * bflo(w[c].w) + bfhi(w[c].w) * bfhi(w[c].w); }
            const float sc = (__builtin_amdgcn_rsqf(ss + NORM_EPS)) * (wsl == 0 ? 0.125f : 1.f);
#pragma unroll
            for (int c = 0; c < 8; ++c) { v4u o; o.x = pk2(bflo(w[c].x) * sc, bfhi(w[c].x) * sc); o.y = pk2(bflo(w[c].y) * sc, bfhi(w[c].y) * sc); o.z = pk2(bflo(w[c].z) * sc, bfhi(w[c].z) * sc); o.w = pk2(bflo(w[c].w) * sc, bfhi(w[c].w) * sc);
                *(LAS v4u*)(rp + c * 16) = o; }
        }
        __syncthreads();
        float x[64]; f32x4 am[2][4];
        { DN_REBASE();
#pragma unroll
            for (int i = 0; i < 64; ++i) { const float be = SC[64 + i];
                if (wsl == 0) x[i] = be * bf2f(*(const LAS bf16*)(SL + SL_V + i * SROW + lane * 2)); else x[i] = be * __expf(SC[i]) * bf2f(*(const LAS bf16*)(SL + SL_K + i * SROW + lane * 2)); }
#pragma unroll
            for (int tix = 0; tix < 2; ++tix) { const int ti = wsl == 0 ? (tix == 0 ? 0 : 3) : (tix == 0 ? 1 : 2);
                bf16x8 kfi[2], qfi[2];
#pragma unroll
                for (int s = 0; s < 2; ++s) { kfi[s] = *(const LAS bf16x8*)(SL + SL_K + (16 * ti + rr) * SROW + s * 64 + qq * 16); qfi[s] = *(const LAS bf16x8*)(SL + SL_Q + (16 * ti + rr) * SROW + s * 64 + qq * 16); }
                const int i = 16 * ti + rr; const float gci = SC[i];
                f32x4 atv[4];
#pragma unroll
                for (int tj = 0; tj < 4; ++tj) {
                    f32x4 d1 = (f32x4){0.f, 0.f, 0.f, 0.f}, d2 = d1;
                    if (tj <= ti) {
#pragma unroll
                        for (int s = 0; s < 2; ++s) { const bf16x8 kfj = *(const LAS bf16x8*)(SL + SL_K + (16 * tj + rr) * SROW + s * 64 + qq * 16);
                            d1 = __builtin_amdgcn_mfma_f32_16x16x32_bf16(kfi[s], kfj, d1, 0, 0, 0);
                            d2 = __builtin_amdgcn_mfma_f32_16x16x32_bf16(kfj, qfi[s], d2, 0, 0, 0); }
                        const float gcj1 = SC[16 * tj + rr];
#pragma unroll
                        for (int r = 0; r < 4; ++r) { const int j = 16 * tj + 4 * qq + r; const float dec = __expf(gci - SC[j]); d2[r] = (j <= i) ? d2[r] * dec : 0.f;
                            const int i1 = 16 * ti + 4 * qq + r; d1[r] = (16 * tj + rr < i1) ? d1[r] * SC[64 + i1] * __expf(SC[i1] - gcj1) : 0.f; }
                    }
                    am[tix][tj] = d1; atv[tj] = d2;
                }
#pragma unroll
                for (int s = 0; s < 2; ++s) __builtin_nontemporal_store(pack8(atv[2 * s], atv[2 * s + 1]), (v4u*)(dst + 16384 + ((ti * 2 + s) * 64 + lane) * 16));
            }
            const float gcl = SC[63];
#pragma unroll
            for (int t2 = 0; t2 < 2; ++t2) { const int it = 2 * wsl + t2; const int i = 16 * it + rr; const float eg = __expf(SC[i]);
#pragma unroll
                for (int s = 0; s < 2; ++s) {
                    const u32x2_t a = *(const LAS u32x2_t*)(SL + SL_Q + i * SROW + (32 * s + 4 * qq) * 2), bq = *(const LAS u32x2_t*)(SL + SL_Q + i * SROW + (32 * s + 16 + 4 * qq) * 2);
                    v4u w; w.x = pk2(bflo(a.x) * eg, bfhi(a.x) * eg); w.y = pk2(bflo(a.y) * eg, bfhi(a.y) * eg); w.z = pk2(bflo(bq.x) * eg, bfhi(bq.x) * eg); w.w = pk2(bflo(bq.y) * eg, bfhi(bq.y) * eg);
                    __builtin_nontemporal_store(w, (v4u*)(dst + 8192 + ((it * 2 + s) * 64 + lane) * 16));
                    float kd[8];
#pragma unroll
                    for (int e = 0; e < 8; ++e) { const int ii = 32 * s + 16 * (e >> 2) + 4 * qq + (e & 3); kd[e] = bf2f(*(const LAS bf16*)(SL + SL_K + ii * SROW + (16 * it + rr) * 2)) * __expf(gcl - SC[ii]); }
                    v4u wk2; wk2.x = pk2(kd[0], kd[1]); wk2.y = pk2(kd[2], kd[3]); wk2.z = pk2(kd[4], kd[5]); wk2.w = pk2(kd[6], kd[7]);
                    __builtin_nontemporal_store(wk2, (v4u*)(dst + 24576 + ((it * 2 + s) * 64 + lane) * 16)); } }
            if (wsl == 0) { const float gl = __expf(gcl); *(GAS f32x4*)(dst + 40960 + lane * 16) = (f32x4){gl, gl, gl, gl}; }
        }
        __syncthreads();
        { DN_REBASE();
#pragma unroll
            for (int tix = 0; tix < 2; ++tix) { const int ti = wsl == 0 ? (tix == 0 ? 0 : 3) : (tix == 0 ? 1 : 2);
#pragma unroll
                for (int tj = 0; tj < 4; ++tj) if (tj <= ti) *(LAS f32x4*)(SL + ((16 * tj + rr) * 64 + 16 * ti + 4 * qq) * 4) = am[tix][tj]; }
        }
        __syncthreads();
        { DN_REBASE();
            const LAS float* ATq = (const LAS float*)SL + (lane & 3);
            float cb[2][16];
#define QFMA(x_, a_, r_) asm("v_fmac_f32_dpp %0, %1, %2 quad_perm:[" #r_ "," #r_ "," #r_ "," #r_ "] row_mask:0xf bank_mask:0xf" : "+v"(x_) : "v"(a_), "v"(nxj))
#pragma unroll
            for (int m = 0; m < 16; ++m) cb[0][m] = ATq[4 * m];
#pragma unroll
            for (int j = 0; j < 63; ++j) { const float nxj = -x[j];
                if (j + 1 < 63) {
#pragma unroll
                    for (int m = (j + 2) >> 2; m < 16; ++m) cb[(j + 1) & 1][m] = ATq[(j + 1) * 64 + 4 * m]; }
#pragma unroll
                for (int m = (j + 1) >> 2; m < 16; ++m) { const float a = cb[j & 1][m];
                    if (4 * m > j) QFMA(x[4 * m], a, 0); if (4 * m + 1 > j) QFMA(x[4 * m + 1], a, 1); if (4 * m + 2 > j) QFMA(x[4 * m + 2], a, 2); QFMA(x[4 * m + 3], a, 3); }
                asm volatile("" : "+v"(x[j + 1]) :: "memory"); }
#undef QFMA
        }
        if (wsl == 0) { DN_REBASE(); const int vs = st >> 4, c = st & 15;
#pragma unroll
            for (int it = 0; it < 4; ++it)
#pragma unroll
                for (int q = 0; q < 4; ++q) { u32x2_t w; w.x = pk2(x[16 * it + 4 * q], x[16 * it + 4 * q + 1]); w.y = pk2(x[16 * it + 4 * q + 2], x[16 * it + 4 * q + 3]);
                    __builtin_nontemporal_store(w, (u32x2_t*)(dst + 32768 + (((vs * 4 + it) * 64 + 16 * q + c) * 8))); }
        } else { DN_REBASE();
#pragma unroll
            for (int i = 0; i < 64; ++i) *(LAS bf16*)(SL + SL_V + i * SROW + lane * 2) = (bf16)f2bf(-x[i]);
        }
        __syncthreads();
        { DN_REBASE();
#pragma unroll
        for (int t2 = 0; t2 < 2; ++t2) { const int it = 2 * wsl + t2; const int i = 16 * it + rr;
#pragma unroll
            for (int s = 0; s < 2; ++s) { const u32x2_t a = *(const LAS u32x2_t*)(SL + SL_V + i * SROW + (32 * s + 4 * qq) * 2), bq = *(const LAS u32x2_t*)(SL + SL_V + i * SROW + (32 * s + 16 + 4 * qq) * 2);
                v4u w; w.x = a.x; w.y = a.y; w.z = bq.x; w.w = bq.y; __builtin_nontemporal_store(w, (v4u*)(dst + ((it * 2 + s) * 64 + lane) * 16)); } } }
        __syncthreads();
    }
#undef DN_REBASE
    if (late) {
        asm volatile("s_waitcnt vmcnt(0)" ::: "memory"); __syncthreads();
        if (C.tid == 0) { __builtin_amdgcn_fence(__ATOMIC_RELEASE, "agent"); asm volatile("s_waitcnt vmcnt(0)" ::: "memory");
            __hip_atomic_fetch_add(C.ctl + CW_LATE, (unsigned)DN_SLOTS, __ATOMIC_RELAXED, __HIP_MEMORY_SCOPE_AGENT); }
    }
}

__device__ __forceinline__ void dn_scan_mfma(const Ctx& C, int b, int h) {
    const int wave = C.wave, lane = C.lane;
    const int item0 = (b * NH + h) * NCH;
    bf16* oraw = (bf16*)(C.ws + WS_ORAW);
#define DN_ISSUE(n_) do { const unsigned char* src_ = dn_item_ptr(C.out, C.ws, item0 + (n_)); LAS unsigned char* ring_ = C.lds + ((n_) % 3) * DN_ITEM_BYTES; \
        for (int blk_ = wave - 4; blk_ < 41; blk_ += 4) __builtin_amdgcn_global_load_lds((const unsigned*)(src_ + blk_ * 1024 + lane * 16), (LAS unsigned*)(ring_ + blk_ * 1024), 16, 0, 0); } while (0)
#define DN_DRAIN(m_) do { _Pragma("unroll") for (int j_ = 0; j_ < 2; ++j_) { const int id_ = j_ * 256 + (wave - 4) * 64 + lane, row_ = id_ >> 3, c8_ = id_ & 7; v4u x_; \
            const unsigned la_ = (unsigned)(size_t)(C.lds + DN_OBUF + ((m_) & 1) * DN_OBUF_BYTES + row_ * 144 + c8_ * 16); \
            asm volatile("ds_read_b128 %0, %1\n\ts_waitcnt lgkmcnt(0)" : "=&v"(x_) : "v"(la_) : "memory"); \
            __builtin_nontemporal_store(x_, (v4u*)(oraw + (size_t)(b * SEQ + 64 * ((m_) - 1) + row_) * 512 + h * 64 + c8_ * 8)); } } while (0)
    f32x4 S[4];
#pragma unroll
    for (int kt = 0; kt < 4; ++kt) S[kt] = (f32x4){0.f, 0.f, 0.f, 0.f};
    if (wave >= 4) { DN_ISSUE(0); DN_ISSUE(1); if (wave == 4) asm volatile("s_waitcnt vmcnt(11)" ::: "memory"); else asm volatile("s_waitcnt vmcnt(10)" ::: "memory"); }
    __builtin_amdgcn_s_barrier();
    for (int n = 0; n < NCH; ++n) {
        if (wave >= 4) {
            if (n + 2 == NCH - 1) {
                unsigned sp = 0; while (__hip_atomic_load(C.ctl + CW_LATE, RLX_AGENT) < (unsigned)(NB * NH)) { __builtin_amdgcn_s_sleep(4); if (++sp > (1u << 22)) break; }
                __builtin_amdgcn_fence(__ATOMIC_ACQUIRE, "agent"); }
            if (n + 2 < NCH) { DN_ISSUE(n + 2); if (wave == 4) asm volatile("s_waitcnt vmcnt(11)" ::: "memory"); else asm volatile("s_waitcnt vmcnt(10)" ::: "memory"); }
            else asm volatile("s_waitcnt vmcnt(0)" ::: "memory");
            if (n >= 2) DN_DRAIN(n - 1);
        } else {
            const LAS unsigned char* R = C.lds + (n % 3) * DN_ITEM_BYTES; const int vs = wave;
            const float gl = *(const LAS float*)(R + 40960);
            bf16x8 fw[8], fq[8], fa[8], fk[8]; u32x2_t ucv[4];
#pragma unroll
            for (int i = 0; i < 8; ++i) { fw[i] = *(const LAS bf16x8*)(R + (i * 64 + lane) * 16); fq[i] = *(const LAS bf16x8*)(R + 8192 + (i * 64 + lane) * 16); }
#pragma unroll
            for (int it = 0; it < 4; ++it) ucv[it] = *(const LAS u32x2_t*)(R + 32768 + ((vs * 4 + it) * 64 + lane) * 8);
            const bf16x8 Sb0 = as_bf16x8(pack8(S[0], S[1])), Sb1 = as_bf16x8(pack8(S[2], S[3]));
            __builtin_amdgcn_sched_barrier(0);
#pragma unroll
            for (int i = 0; i < 8; ++i) { fa[i] = *(const LAS bf16x8*)(R + 16384 + (i * 64 + lane) * 16); fk[i] = *(const LAS bf16x8*)(R + 24576 + (i * 64 + lane) * 16); }
            __builtin_amdgcn_sched_barrier(0);
            f32x4 vn[4], o[4];
#pragma unroll
            for (int it = 0; it < 4; ++it) { const u32x2_t uc = ucv[it];
                f32x4 a = (f32x4){bflo(uc.x), bfhi(uc.x), bflo(uc.y), bfhi(uc.y)};
                a = __builtin_amdgcn_mfma_f32_16x16x32_bf16(fw[it * 2 + 0], Sb0, a, 0, 0, 0);
                a = __builtin_amdgcn_mfma_f32_16x16x32_bf16(fw[it * 2 + 1], Sb1, a, 0, 0, 0);
                vn[it] = a;
                f32x4 oo = (f32x4){0.f, 0.f, 0.f, 0.f};
                oo = __builtin_amdgcn_mfma_f32_16x16x32_bf16(fq[it * 2 + 0], Sb0, oo, 0, 0, 0);
                oo = __builtin_amdgcn_mfma_f32_16x16x32_bf16(fq[it * 2 + 1], Sb1, oo, 0, 0, 0);
                o[it] = oo; }
            const bf16x8 Vb0 = as_bf16x8(pack8(vn[0], vn[1])), Vb1 = as_bf16x8(pack8(vn[2], vn[3]));
#pragma unroll
            for (int it = 0; it < 4; ++it) {
                o[it] = __builtin_amdgcn_mfma_f32_16x16x32_bf16(fa[it * 2 + 0], Vb0, o[it], 0, 0, 0);
                o[it] = __builtin_amdgcn_mfma_f32_16x16x32_bf16(fa[it * 2 + 1], Vb1, o[it], 0, 0, 0); }
#pragma unroll
            for (int kt = 0; kt < 4; ++kt) { f32x4 s = S[kt] * gl;
                s = __builtin_amdgcn_mfma_f32_16x16x32_bf16(fk[kt * 2 + 0], Vb0, s, 0, 0, 0);
                s = __builtin_amdgcn_mfma_f32_16x16x32_bf16(fk[kt * 2 + 1], Vb1, s, 0, 0, 0);
                S[kt] = s; }
            if (n >= 1) { const int q = lane >> 4, c = lane & 15; LAS unsigned char* ob = C.lds + DN_OBUF + (n & 1) * DN_OBUF_BYTES + (4 * q) * 144 + (16 * vs + c) * 2;
#pragma unroll
                for (int it = 0; it < 4; ++it)
#pragma unroll
                    for (int r = 0; r < 4; ++r) *(LAS bf16*)(ob + (16 * it + r) * 144) = (bf16)f2bf(o[it][r]); }
            asm volatile("s_waitcnt lgkmcnt(0)" ::: "memory");
        }
        __builtin_amdgcn_s_barrier();
    }
    if (wave >= 4) DN_DRAIN(NCH - 1);
#undef DN_ISSUE
#undef DN_DRAIN
}
__device__ __forceinline__ void oa_postpass(const Ctx& C, int wg0, int nwg) {
    const int gw = (C.wg - wg0) * NWAVES + C.wave, NGW = nwg * NWAVES, lane = C.lane; if (C.wg < wg0) return;
    bf16* oa = (bf16*)(C.ws + WS_OA); const bf16* z = (const bf16*)(C.ws + WS_Z); const float* nw = C.in[8] + (lane & 7) * 8;
    float w8[8];
#pragma unroll
    for (int e = 0; e < 8; ++e) w8[e] = nw[e];
    for (int row = gw; row < MX; row += NGW) {
        const v4u r = *(const v4u*)(oa + (size_t)row * 512 + lane * 8), zz = *(const v4u*)(z + (size_t)prow_of(row) * 512 + lane * 8);
        float v[8] = {bflo(r.x), bfhi(r.x), bflo(r.y), bfhi(r.y), bflo(r.z), bfhi(r.z), bflo(r.w), bfhi(r.w)};
        const float zf[8] = {bflo(zz.x), bfhi(zz.x), bflo(zz.y), bfhi(zz.y), bflo(zz.z), bfhi(zz.z), bflo(zz.w), bfhi(zz.w)};
        float ss = 0.f;
#pragma unroll
        for (int e = 0; e < 8; ++e) ss += v[e] * v[e];
        ss += __shfl_xor(ss, 1); ss += __shfl_xor(ss, 2); ss += __shfl_xor(ss, 4);
        const float rs = __builtin_amdgcn_rsqf(ss * (1.f / 64.f) + NORM_EPS);
#pragma unroll
        for (int e = 0; e < 8; ++e) v[e] = v[e] * rs * w8[e] * silu_(zf[e]);
        v4u w; w.x = pk2(v[0], v[1]); w.y = pk2(v[2], v[3]); w.z = pk2(v[4], v[5]); w.w = pk2(v[6], v[7]);
        *(v4u*)(oa + (size_t)row * 512 + lane * 8) = w;
    }
}


constexpr size_t WS_KT = WS_MERGED + 20 * MiB;
constexpr size_t WS_M2 = WS_KT + 1 * MiB;
constexpr size_t WS_M3 = WS_OB;
static_assert(WS_M2 + 8 * MiB <= WS_END && (size_t)(DN_ITEMS - DN_IN_OUT) * DN_ITEM_BYTES <= 20 * MiB, "s5 tables");

__device__ __forceinline__ float gelu_fast(float x) { const float u2 = 1.5957691216057308f * (x + 0.044715f * x * x * x); return x * __builtin_amdgcn_rcpf(1.f + __expf(-u2)); }
struct S5P { float dt, ar, ai; };
__device__ __forceinline__ void s5_pow(const S5P& P, float d, float& re, float& im) { const float mag = __expf(d * P.dt * P.ar); const float ang = d * P.dt * P.ai; re = mag * __cosf(ang); im = mag * __sinf(ang); }
__device__ __forceinline__ void s5_f(const S5P& P, float& fre, float& fim) { float are, aim; s5_pow(P, 1.f, are, aim); const float den = P.ar * P.ar + P.ai * P.ai, nr = are - 1.f, ni = aim;
    fre = (nr * P.ar + ni * P.ai) / den; fim = (ni * P.ar - nr * P.ai) / den; }

__device__ __forceinline__ void s5_tables(const Ctx& C) {
    const int gw = C.wg * NWAVES + C.wave, NGW = C.G * NWAVES, lane = C.lane, rr = lane & 15, kg = lane >> 4;
    LAS float* scr = (LAS float*)(C.lds + C.wave * 16384);
    const float* a_re = C.in[9]; const float* a_im = C.in[10]; const float* log_dt = C.in[11]; const float* b_re = C.in[12]; const float* b_im = C.in[13]; const float* c_re = C.in[14]; const float* c_im = C.in[15];
    bf16* KT = (bf16*)(C.ws + WS_KT); unsigned char* M2 = C.ws + WS_M2; unsigned char* M3 = C.ws + WS_M3;
    for (int it = gw; it < 2048 + 1024 + 2048; it += NGW) {
        if (it < 2048) {
            const int g = it >> 6, d = it & 63, p = lane; S5P P{expf(log_dt[g]), a_re[g * 64 + p], a_im[g * 64 + p]};
            float are, aim, fre, fim; s5_pow(P, (float)d, are, aim); s5_f(P, fre, fim);
            const float wr_ = are * fre - aim * fim, wi_ = are * fim + aim * fre;
            const float* br = b_re + ((size_t)g * 64 + p) * 16; const float* bi = b_im + ((size_t)g * 64 + p) * 16;
#pragma unroll
            for (int c = 0; c < 16; ++c) { scr[p * 32 + c] = wr_ * br[c] - wi_ * bi[c]; scr[p * 32 + 16 + c] = wr_ * bi[c] + wi_ * br[c]; }
            LDS_WAIT(); asm volatile("" ::: "memory");
            const int c = lane >> 2, c4 = (lane & 3) * 4; f32x4 acc = (f32x4){0.f, 0.f, 0.f, 0.f};
            const float* cr = c_re + ((size_t)g * 16 + c) * 64; const float* ci = c_im + ((size_t)g * 16 + c) * 64;
#pragma unroll 8
            for (int pp = 0; pp < 64; ++pp) { const f32x4 wre = *(const LAS f32x4*)(scr + pp * 32 + c4), wim = *(const LAS f32x4*)(scr + pp * 32 + 16 + c4); const float crv = cr[pp], civ = ci[pp];
                acc = acc + wre * crv - wim * civ; }
            u32x2_t w; w.x = pk2(acc[0], acc[1]); w.y = pk2(acc[2], acc[3]);
            *(GAS u32x2_t*)(KT + ((size_t)(g * 64 + d) * 256 + c * 16 + c4)) = w;
            LDS_WAIT(); asm volatile("" ::: "memory");
        } else if (it < 3072) {
            const int i2 = it - 2048, g = i2 >> 5, ks = i2 & 31, j = 2 * ks + (kg >> 1), ch = 8 * (kg & 1);
#pragma unroll 1
            for (int pq = 0; pq < 4; ++pq) { const int p = 16 * pq + rr; S5P P{expf(log_dt[g]), a_re[g * 64 + p], a_im[g * 64 + p]};
                float are, aim, fre, fim; s5_pow(P, (float)(63 - j), are, aim); s5_f(P, fre, fim);
                const float wr_ = are * fre - aim * fim, wi_ = are * fim + aim * fre;
                const float* br = b_re + ((size_t)g * 64 + p) * 16 + ch; const float* bi = b_im + ((size_t)g * 64 + p) * 16 + ch;
                float re[8], im[8];
#pragma unroll
                for (int e = 0; e < 8; ++e) { re[e] = wr_ * br[e] - wi_ * bi[e]; im[e] = wr_ * bi[e] + wi_ * br[e]; }
                v4u w; w.x = pk2(re[0], re[1]); w.y = pk2(re[2], re[3]); w.z = pk2(re[4], re[5]); w.w = pk2(re[6], re[7]);
                *(GAS v4u*)(M3 + (size_t)g * 262144 + ((size_t)((pq * 32 + ks) * 64 + lane)) * 16) = w;
                w.x = pk2(im[0], im[1]); w.y = pk2(im[2], im[3]); w.z = pk2(im[4], im[5]); w.w = pk2(im[6], im[7]);
                *(GAS v4u*)(M3 + (size_t)g * 262144 + ((size_t)(((4 + pq) * 32 + ks) * 64 + lane)) * 16) = w; }
        } else {
            const int i2 = it - 3072, g = i2 >> 6, t = i2 & 63, c = rr;
#pragma unroll 1
            for (int hf = 0; hf < 2; ++hf) { float vr[8], vi[8];
#pragma unroll
                for (int e = 0; e < 8; ++e) { const int p = 32 * hf + 8 * kg + e; S5P P{expf(log_dt[g]), a_re[g * 64 + p], a_im[g * 64 + p]};
                    float are, aim; s5_pow(P, (float)(t + 1), are, aim); const float crv = c_re[((size_t)g * 16 + c) * 64 + p], civ = c_im[((size_t)g * 16 + c) * 64 + p];
                    vr[e] = crv * are - civ * aim; vi[e] = -(crv * aim + civ * are); }
                v4u w; w.x = pk2(vr[0], vr[1]); w.y = pk2(vr[2], vr[3]); w.z = pk2(vr[4], vr[5]); w.w = pk2(vr[6], vr[7]);
                *(GAS v4u*)(M2 + (size_t)g * 262144 + ((size_t)((t * 4 + hf) * 64 + lane)) * 16) = w;
                w.x = pk2(vi[0], vi[1]); w.y = pk2(vi[2], vi[3]); w.z = pk2(vi[4], vi[5]); w.w = pk2(vi[6], vi[7]);
                *(GAS v4u*)(M2 + (size_t)g * 262144 + ((size_t)((t * 4 + 2 + hf) * 64 + lane)) * 16) = w; }
        }
    }
}

__device__ __forceinline__ void s5_mfma(const Ctx& C, int b, int g) {
    constexpr int UL_STRIDE = 2064, SLAB = 16 * UL_STRIDE;
    LAS unsigned char* KtL = C.lds; LAS unsigned char* B0 = C.lds + SLAB; LAS float* Hl = (LAS float*)(C.lds + 2 * SLAB);
    LAS unsigned char* Hin = (LAS unsigned char*)(Hl + 80 * 128);
    const int w = C.wave;
#define S5_RELANE() int tid = C.tid; asm volatile("" : "+v"(tid)); const int lane = tid & 63, cc = lane & 15, kg = lane >> 4; (void)cc; (void)kg
#define S5_SLAB_LOAD(nt_) do { S5_RELANE(); _Pragma("unroll") for (int i_ = 0; i_ < 4; ++i_) { const int pc = tid + 512 * i_, nl = pc >> 7, jj = (pc >> 1) & 63, hf = pc & 1; int n_ = 16 * (nt_) + nl; if (n_ > 64) n_ = 64; \
        sr[i_] = *(const v4u*)(u + ((size_t)g * MP + b * LP + 64 * n_ + jj) * 16 + 8 * hf); } } while (0)
#define S5_SLAB_STORE(buf_) do { S5_RELANE(); _Pragma("unroll") for (int i_ = 0; i_ < 4; ++i_) { const int pc = tid + 512 * i_, nl = pc >> 7, jj = (pc >> 1) & 63, hf = pc & 1; \
        *(LAS v4u*)((buf_) + nl * UL_STRIDE + jj * 32 + hf * 16) = sr[i_]; } } while (0)
    const bf16* u = (const bf16*)(C.ws + WS_U); bf16* yb = (bf16*)(C.ws + WS_YB);
    const unsigned char* M3g = C.ws + WS_M3 + (size_t)g * 262144; const unsigned char* M2g = C.ws + WS_M2 + (size_t)g * 262144;
    v4u sr[4];
    { bf16x8 m3f[32];
        S5_SLAB_LOAD(0);
        { S5_RELANE();
#pragma unroll
            for (int ks = 0; ks < 32; ++ks) m3f[ks] = *(const bf16x8*)(M3g + ((size_t)((w * 32 + ks) * 64 + lane)) * 16); }
        S5_SLAB_STORE(B0);
        __syncthreads();
#pragma unroll 1
        for (int nt = 0; nt < 5; ++nt) {
            LAS unsigned char* Ul = (nt & 1) ? KtL : B0; LAS unsigned char* Un = (nt & 1) ? B0 : KtL;
            if (nt + 1 < 5) S5_SLAB_LOAD(nt + 1);
            { S5_RELANE(); f32x4 h0 = (f32x4){0.f, 0.f, 0.f, 0.f}, h1 = h0;
#pragma unroll
                for (int ks = 0; ks < 32; ks += 2) {
                    h0 = __builtin_amdgcn_mfma_f32_16x16x32_bf16(m3f[ks], *(const LAS bf16x8*)(Ul + cc * UL_STRIDE + (2 * ks + (kg >> 1)) * 32 + (kg & 1) * 16), h0, 0, 0, 0);
                    h1 = __builtin_amdgcn_mfma_f32_16x16x32_bf16(m3f[ks + 1], *(const LAS bf16x8*)(Ul + cc * UL_STRIDE + (2 * ks + 2 + (kg >> 1)) * 32 + (kg & 1) * 16), h1, 0, 0, 0); }
                *(LAS f32x4*)(Hl + (16 * nt + cc) * 128 + 16 * w + 4 * kg) = h0 + h1; }
            if (nt + 1 < 5) S5_SLAB_STORE(Un);
            __syncthreads();
        }
    }
    S5_SLAB_LOAD(0);
    v4u kr[4];
    { S5_RELANE(); const v4u* src = (const v4u*)((const bf16*)(C.ws + WS_KT) + (size_t)g * 16384);
#pragma unroll
        for (int i = 0; i < 4; ++i) kr[i] = src[tid + 512 * i]; }
    if (w == 0) { S5_RELANE(); float a64r, a64i; { S5P P{expf(C.in[11][g]), C.in[9][g * 64 + lane], C.in[10][g * 64 + lane]}; s5_pow(P, 64.f, a64r, a64i); }
        float hre = 0.f, him = 0.f;
#pragma unroll 1
        for (int n0 = 0; n0 < 80; n0 += 16) { float er[16], ei[16];
#pragma unroll
            for (int nl = 0; nl < 16; ++nl) { er[nl] = Hl[(n0 + nl) * 128 + lane]; ei[nl] = Hl[(n0 + nl) * 128 + 64 + lane]; }
#pragma unroll
            for (int nl = 0; nl < 16; ++nl) { *(LAS bf16*)(Hin + (n0 + nl) * 272 + lane * 2) = (bf16)f2bf(hre); *(LAS bf16*)(Hin + (n0 + nl) * 272 + (64 + lane) * 2) = (bf16)f2bf(him);
                const float nr = a64r * hre - a64i * him + er[nl], ni = a64r * him + a64i * hre + ei[nl]; hre = nr; him = ni; } } }
    { S5_RELANE();
#pragma unroll
        for (int i = 0; i < 4; ++i) *(LAS v4u*)(KtL + (tid + 512 * i) * 16) = kr[i]; }
    S5_SLAB_STORE(B0);
    __syncthreads();
    { bf16x8 m2f[8][4];
        { S5_RELANE();
#pragma unroll
            for (int i = 0; i < 8; ++i)
#pragma unroll
                for (int k2 = 0; k2 < 4; ++k2) m2f[i][k2] = *(const bf16x8*)(M2g + ((size_t)(((w + 8 * i) * 4 + k2) * 64 + lane)) * 16); }
        const f32x4 dsk = *(const f32x4*)(C.in[16] + g * 16 + 4 * (C.lane >> 4));
#pragma unroll 1
        for (int nt = 0; nt < 5; ++nt) {
            LAS unsigned char* Ul = (nt & 1) ? (LAS unsigned char*)Hl : B0; LAS unsigned char* Un = (nt & 1) ? B0 : (LAS unsigned char*)Hl;
            if (nt + 1 < 5) S5_SLAB_LOAD(nt + 1);
            { S5_RELANE(); const int n = 16 * nt + cc;
                bf16x8 hb[4];
#pragma unroll
                for (int k2 = 0; k2 < 4; ++k2) hb[k2] = *(const LAS bf16x8*)(Hin + n * 272 + (32 * k2 + 8 * kg) * 2);
#pragma unroll
                for (int i = 0; i < 8; ++i) { const int t = w + 8 * i, nks = (t >> 1) + 1; f32x4 a0 = (f32x4){0.f, 0.f, 0.f, 0.f}, a1 = a0;
#pragma unroll
                    for (int k2 = 0; k2 < 4; k2 += 2) { a0 = __builtin_amdgcn_mfma_f32_16x16x32_bf16(m2f[i][k2], hb[k2], a0, 0, 0, 0); a1 = __builtin_amdgcn_mfma_f32_16x16x32_bf16(m2f[i][k2 + 1], hb[k2 + 1], a1, 0, 0, 0); }
#pragma unroll 1
                    for (int ks0 = 0; ks0 < nks; ks0 += 4) {
                        bf16x8 bq[4]; v4u av[4];
#pragma unroll
                        for (int uu = 0; uu < 4; ++uu) { const int j = 2 * (ks0 + uu) + (kg >> 1), lag = t - j, lagc = lag < 0 ? 0 : lag, jc = j > 63 ? 63 : j;
                            bq[uu] = *(const LAS bf16x8*)(Ul + cc * UL_STRIDE + jc * 32 + (kg & 1) * 16);
                            av[uu] = *(const LAS v4u*)(KtL + lagc * 512 + cc * 32 + (kg & 1) * 16); if (lag < 0) av[uu] = (v4u){0u, 0u, 0u, 0u}; }
                        a0 = __builtin_amdgcn_mfma_f32_16x16x32_bf16(as_bf16x8(av[0]), bq[0], a0, 0, 0, 0); a1 = __builtin_amdgcn_mfma_f32_16x16x32_bf16(as_bf16x8(av[1]), bq[1], a1, 0, 0, 0);
                        a0 = __builtin_amdgcn_mfma_f32_16x16x32_bf16(as_bf16x8(av[2]), bq[2], a0, 0, 0, 0); a1 = __builtin_amdgcn_mfma_f32_16x16x32_bf16(as_bf16x8(av[3]), bq[3], a1, 0, 0, 0); }
                    const f32x4 y = a0 + a1;
                    if (n >= 1 && n <= 64) { const u32x2_t uv = *(const LAS u32x2_t*)(Ul + cc * UL_STRIDE + t * 32 + kg * 8);
                        const float y0 = y[0] + dsk[0] * bflo(uv.x), y1 = y[1] + dsk[1] * bfhi(uv.x), y2 = y[2] + dsk[2] * bflo(uv.y), y3 = y[3] + dsk[3] * bfhi(uv.y);
                        u32x2_t o; o.x = pk2(gelu_fast(y0), gelu_fast(y1)); o.y = pk2(gelu_fast(y2), gelu_fast(y3));
                        *(GAS u32x2_t*)(yb + (size_t)(b * SEQ + 64 * (n - 1) + t) * 512 + g * 16 + 4 * kg) = o; } } }
            if (nt + 1 < 5) S5_SLAB_STORE(Un);
            __syncthreads();
        }
    }
#undef S5_SLAB_LOAD
#undef S5_SLAB_STORE
#undef S5_RELANE
}

constexpr unsigned CONV_ITEMS = NE * 384, CONV_P3_ITEMS = CONV_ITEMS;
__device__ __forceinline__ void phase3_v2(const Ctx& C, int parts = 7) {
    const int NSCAN = NB * NH + NB * SG;
    if (C.G > NSCAN) {
#ifndef DUP_SCAN
#define DUP_SCAN 0
#endif
        if (C.wg < NB * NH) { if (!(parts & 1)) return; dn_scan_mfma(C, C.wg >> 3, C.wg & 7); if (DUP_SCAN) { __syncthreads(); dn_scan_mfma(C, C.wg >> 3, C.wg & 7); } __syncthreads(); if (parts & 4) convert_experts(C, 0, 0u, CONV_P3_ITEMS); return; }
        { const int lw0 = C.G >= NSCAN + 8 ? NSCAN : NB * NH;
          if (C.wg >= lw0 && C.wg < lw0 + 8 && (parts & 1)) { chunk_prep(C, true, lw0); __syncthreads(); } }
        if (C.wg < NSCAN && (parts & 2)) { const int idx = C.wg - NB * NH, x8 = idx & 7, y = idx >> 3;
            s5_mfma(C, y >> 2, 4 * x8 + (y & 3)); __syncthreads(); }
        if (parts & 4) convert_experts(C, 0, 0u, CONV_P3_ITEMS);
    } else {
        if (C.wg < 8) { chunk_prep(C, true, 0); __syncthreads(); }
        for (int it = C.wg; it < NSCAN; it += C.G) { if (it < NB * NH) dn_scan_mfma(C, it >> 3, it & 7); else s5_mfma(C, (it - NB * NH) >> 5, (it - NB * NH) & 31); __syncthreads(); }
        convert_experts(C, 0, 0u, CONV_P3_ITEMS);
    }
}

__device__ __forceinline__ void phase5_branch(const Ctx& C) {
    unsigned char* ws = C.ws;
    pg8::Gemm2 g{(const bf16*)(ws + WS_OA), (const bf16*)(ws + WS_WBR), (const bf16*)(ws + WS_OB), (const bf16*)(ws + WS_WBR) + 1024 * 512, MX, 1024, 512};
    pg8::StaticOrder S; S.init(MX, 1024, C.G, C.wg);
    pg8::EpiBrFused E{(const bf16*)(ws + WS_GATES), (bf16*)(ws + WS_MERGED)};
    pg8::gemm_phase2seg<pg8::EpiBrFused, pg8::StaticOrder, true>(C.lds, g, S, E);
}

#ifndef MK_N_LAUNCHES
#define MK_N_LAUNCHES 1
#endif
constexpr int N_PHASES = 11;
struct Args { const float* in[32]; float* out; unsigned char* ws; int ph_lo, ph_hi; };
#ifndef PRE_MODE
#define PRE_MODE 0
#endif
__device__ __forceinline__ void run_phases(const Ctx& C, const XcdBarrier& bar, int lo, int hi) {
    const bool dry = PRE_MODE && hi < N_PHASES;
#define IN(k) (lo <= (k) && (k) < hi)
#define SEAM(k) do { if (IN(k) && IN((k) + 1)) xcd_barrier(bar); } while (0)
    unsigned char* ws = C.ws;
    if (IN(0)) { phase0(C); s5_tables(C); }
    SEAM(0);
    if (IN(1)) {
        pg8::Gemm g{(const bf16*)(ws + WS_H0B), (const bf16*)(ws + WS_WINT), MP, INWP, D}; pg8::StaticOrder S; S.init(MP, INWP, C.G, C.wg);
        pg8::EpiProj E{(bf16*)(ws + WS_QKV), (bf16*)(ws + WS_Z), (bf16*)(ws + WS_U), (bf16*)(ws + WS_GATES), (float*)(ws + WS_AB)};
        pg8::gemm_phase<pg8::EpiProj, pg8::StaticOrder, true, true>(C.lds, g, S, E);
    }
    SEAM(1);
    if (IN(2)) chunk_prep(C, false, 0);
    SEAM(2);
    if (IN(3)) phase3_v2(C, (dry && hi == 4) ? PRE_MODE : 7);
    SEAM(3);
    if (IN(4)) {
        { const int nglu = (MX / 256) * 2; if (C.G >= 2 * nglu) oa_postpass(C, nglu, C.G - nglu); else oa_postpass(C, 0, C.G); }
        pg8::Gemm g{(const bf16*)(ws + WS_YB), (const bf16*)(ws + WS_WGLU), MX, 512, 512}; pg8::StaticOrder S; S.init(MX, 512, C.G, C.wg);
        pg8::EpiGlu E{(const bf16*)(ws + WS_YB), C.in[18], (bf16*)(ws + WS_OB)};
        pg8::gemm_phase<pg8::EpiGlu, pg8::StaticOrder, true, true>(C.lds, g, S, E);
    }
    SEAM(4);
    if (IN(5)) phase5_branch(C);
    SEAM(5);
    if (IN(6)) {
        pg8::Gemm g{(const bf16*)(ws + WS_MERGED), (const bf16*)(ws + WS_WOUT), MX, 1024, 1024}; pg8::StaticOrder S; S.init(MX, 1024, C.G, C.wg);
        pg8::EpiOut E{C.in[0], (const float*)(ws + WS_STATS), C.in[2], C.in[3], (bf16*)(ws + WS_PRE)};
        pg8::gemm_phase<pg8::EpiOut, pg8::StaticOrder, true, true>(C.lds, g, S, E);
    }
    SEAM(6);
    if (IN(7)) { if (dry && hi == 8) phase7_rows<1>(C); else phase7_rows<0>(C); }
    SEAM(7);
    if (IN(8)) phase_moe(C);
    SEAM(9);
    if (IN(10)) { if (dry && hi == 11) phase11_final<1>(C); else phase11_final<0>(C); }
#undef IN
#undef SEAM
}
#ifndef PRE_K
#define PRE_K -1
#endif
__global__ void __launch_bounds__(NWAVES * 64, 2) mk_fwd(Args args) {
    extern __shared__ __attribute__((aligned(16))) unsigned char lds[];
    Ctx C;
    C.lds = (LAS unsigned char*)lds; C.tid = threadIdx.x; C.lane = C.tid & 63; C.wave = __builtin_amdgcn_readfirstlane(C.tid >> 6);
    C.wg = blockIdx.x; C.G = gridDim.x; C.in = args.in; C.out = args.out; C.ws = args.ws; C.ctl = (gu32*)(args.ws + WS_CTL);
    volatile LAS unsigned* MISC = (volatile LAS unsigned*)(C.lds + MISC_OFF);
    for (int u = C.tid; u < (LDS_BYTES - LDSCTL_OFF) / 4; u += NWAVES * 64) ((LAS unsigned*)(C.lds + LDSCTL_OFF))[u] = 0u;
    __syncthreads();
    XcdBarrier bar; bar.bar = (unsigned*)(C.ctl + CW_BAR); bar.x = 0; bar.st = nullptr;
    if (MK_N_LAUNCHES == 1) bar = xcd_barrier_post((unsigned*)(C.ctl + CW_BAR), MISC + 8);
    run_phases(C, bar, args.ph_lo, args.ph_hi);
}

extern "C" void kernel_launch(void* const* d_in, const int* in_sizes, int n_in, void* d_out, int out_size, void* d_ws, size_t ws_size, hipStream_t stream) {
    static int grid = 0;
    if (grid == 0) {
        if (n_in != 32 || in_sizes[0] != MX * D || out_size != MX * D || ws_size < WS_END) { fprintf(stderr, "kernel_launch: unexpected shapes (n_in %d, in0 %d, out %d, ws %zu < %zu); nothing launched\n", n_in, n_in > 0 ? in_sizes[0] : -1, out_size, ws_size, (size_t)WS_END); grid = -1; return; }
        int dev = 0, cus = 0, per_cu = 0;
        if (hipGetDevice(&dev) != hipSuccess || hipDeviceGetAttribute(&cus, hipDeviceAttributeMultiprocessorCount, dev) != hipSuccess) { grid = -1; return; }
        if (hipFuncSetAttribute((const void*)mk_fwd, hipFuncAttributeMaxDynamicSharedMemorySize, LDS_BYTES) != hipSuccess) { fprintf(stderr, "kernel_launch: hipFuncSetAttribute failed\n"); grid = -1; return; }
        if (hipOccupancyMaxActiveBlocksPerMultiprocessor(&per_cu, (const void*)mk_fwd, NWAVES * 64, LDS_BYTES) != hipSuccess || per_cu < 1) fprintf(stderr, "kernel_launch: occupancy query says %d\n", per_cu);
        (void)hipGetLastError();
        grid = cus;
    }
    if (grid < 0) return;
    if (hipMemsetAsync((char*)d_ws + WS_CTL, 0, CTL_ZERO_BYTES, stream) != hipSuccess) { fprintf(stderr, "kernel_launch: hipMemsetAsync failed\n"); return; }
    Args a{};
    for (int i = 0; i < 32; ++i) a.in[i] = (const float*)d_in[i];
    a.out = (float*)d_out; a.ws = (unsigned char*)d_ws;
#if MK_N_LAUNCHES == 1
    if (PRE_K >= 0) { a.ph_lo = 0; a.ph_hi = PRE_K + 1; hipLaunchKernelGGL(mk_fwd, dim3(grid), dim3(NWAVES * 64), LDS_BYTES, stream, a); (void)hipMemsetAsync((char*)d_ws + WS_CTL, 0, CTL_ZERO_BYTES, stream); }
    a.ph_lo = 0; a.ph_hi = N_PHASES;
    hipLaunchKernelGGL(mk_fwd, dim3(grid), dim3(NWAVES * 64), LDS_BYTES, stream, a);
#else
    for (int p = 0; p < N_PHASES; ++p) { a.ph_lo = p; a.ph_hi = p + 1; hipLaunchKernelGGL(mk_fwd, dim3(grid), dim3(NWAVES * 64), LDS_BYTES, stream, a); }
#endif
    const hipError_t le = hipPeekAtLastError();
    if (le != hipSuccess) fprintf(stderr, "kernel_launch: launch failed: %s\n", hipGetErrorName(le));
}
```
